# Optimizing an MI355X kernel written in HIP

```python
import math
import jax, jax.numpy as jnp
from jax import lax
import numpy as np

D_MODEL = 1024
BATCH = 4
SEQ = 4096
DEPTH = 2

GRID_W = 64
CTX_LEN = 256
EPS = 1e-6
NEG = -1e30

D_MIX = D_MODEL
FOURIER_GROUPS = 4
FOURIER_CH = 64
D_FOURIER = FOURIER_GROUPS * FOURIER_CH
HEAD_DIM = 64
ATT_HEADS = 8
ATT_KV_HEADS = 2
ATT_GROUP = ATT_HEADS // ATT_KV_HEADS
D_ATT = ATT_HEADS * HEAD_DIM
D_KV = ATT_KV_HEADS * HEAD_DIM
WINDOW = 128
ATT_BLOCK = 128
ROPE_BASE = 10000.0
MLSTM_HEADS = 4
MLSTM_DIM = 64
D_MLSTM = MLSTM_HEADS * MLSTM_DIM
MLSTM_CHUNK = 64
QK_CONV = 3
D_FF = 2816
N_MOD = 9

SPLIT_SIZES = (D_FOURIER, D_ATT, D_KV, D_KV, D_MLSTM, D_MLSTM, D_MLSTM, D_MLSTM, 2 * MLSTM_HEADS, 2 * MLSTM_HEADS)
D_IN = D_FOURIER + D_ATT + 2 * D_KV + 4 * D_MLSTM + 4 * MLSTM_HEADS

kernel_name = "hybrid_fourier_swa_mlstm_macaron_dit"

F32 = jnp.float32


def rmsnorm(t, g):
    tf = t.astype(F32)
    y = tf * lax.rsqrt(jnp.mean(tf * tf, axis=-1, keepdims=True) + EPS)
    return (y * g.astype(F32)).astype(t.dtype)


def modulate(h, shift, scale):
    return h * (1 + scale) + shift


def swiglu(h, w_in, w_out):
    g, u = jnp.split(h @ w_in, 2, axis=-1)
    return (jax.nn.silu(g) * u) @ w_out


def split_columns(u):
    idx = []
    total = 0
    for s in SPLIT_SIZES[:-1]:
        total += s
        idx.append(total)
    return jnp.split(u, idx, axis=-1)


def axial_rope(n):
    rows = n // GRID_W
    row = jnp.broadcast_to(jnp.arange(rows, dtype=F32)[:, None], (rows, GRID_W)).reshape(n)
    col = jnp.broadcast_to(jnp.arange(GRID_W, dtype=F32)[None, :], (rows, GRID_W)).reshape(n)
    nf = HEAD_DIM // 4
    inv = ROPE_BASE ** (-jnp.arange(nf, dtype=F32) / nf)
    ar = row[:, None] * inv
    ac = col[:, None] * inv
    ang = jnp.concatenate([ar, ar, ac, ac], axis=-1)
    return jnp.cos(ang), jnp.sin(ang)


def apply_rope(t, cos, sin):
    t = t.astype(F32)
    t1, t2, t3, t4 = jnp.split(t, 4, axis=-1)
    rot = jnp.concatenate([-t2, t1, -t4, t3], axis=-1)
    return t * cos[:, None, :] + rot * sin[:, None, :]


def fourier_mix(u, w):
    b, n, _ = u.shape
    ug = u.astype(F32).reshape(b, n, FOURIER_GROUPS, FOURIER_CH)
    f = jnp.fft.fftn(ug, axes=(1, 3), norm="ortho").real
    y = jnp.einsum('bngc,gce->bnge', f, w.astype(F32))
    return y.reshape(b, n, D_FOURIER).astype(u.dtype)


def band(t, nb):
    b = t.shape[0]
    pad = jnp.zeros((b, ATT_BLOCK) + t.shape[2:], t.dtype)
    tp = jnp.concatenate([pad, t, pad], axis=1).reshape((b, nb + 2, ATT_BLOCK) + t.shape[2:])
    return jnp.concatenate([tp[:, :-2], tp[:, 1:-1], tp[:, 2:]], axis=2)


def window_attention(q, k, v, kc, vc, sink):
    b, n, _, d = q.shape
    nb = n // ATT_BLOCK
    scale = d ** -0.5
    qb = q.astype(F32).reshape(b, nb, ATT_BLOCK, ATT_KV_HEADS, ATT_GROUP, d)
    kband = band(k.astype(F32), nb)
    vband = band(v.astype(F32), nb)
    s_loc = jnp.einsum('bnqkgd,bnskd->bnkgqs', qb, kband) * scale
    qi = jnp.arange(ATT_BLOCK)[:, None]
    sj = jnp.arange(3 * ATT_BLOCK)[None, :]
    kglob = jnp.arange(nb)[:, None, None] * ATT_BLOCK + sj[None] - ATT_BLOCK
    valid = (jnp.abs(sj - ATT_BLOCK - qi) <= WINDOW)[None] & (kglob >= 0) & (kglob < n)
    s_loc = jnp.where(valid[None, :, None, None], s_loc, NEG)
    s_ctx = jnp.einsum('bnqkgd,bckd->bnkgqc', qb, kc.astype(F32)) * scale
    sink_l = jnp.broadcast_to(sink.astype(F32).reshape(ATT_KV_HEADS, ATT_GROUP)[None, None, :, :, None, None],
                              s_loc.shape[:-1] + (1,))
    p = jax.nn.softmax(jnp.concatenate([s_loc, s_ctx, sink_l], axis=-1), axis=-1)
    nl = 3 * ATT_BLOCK
    nc = kc.shape[1]
    out = (jnp.einsum('bnkgqs,bnskd->bnqkgd', p[..., :nl], vband)
           + jnp.einsum('bnkgqc,bckd->bnqkgd', p[..., nl:nl + nc], vc.astype(F32)))
    return out.reshape(b, n, D_ATT)


def context_attention(qc, kc, vc, sink):
    b, cl, _, d = qc.shape
    qg = qc.astype(F32).reshape(b, cl, ATT_KV_HEADS, ATT_GROUP, d)
    s = jnp.einsum('bqkgd,bskd->bkgqs', qg, kc.astype(F32)) * (d ** -0.5)
    sink_c = jnp.broadcast_to(sink.astype(F32).reshape(ATT_KV_HEADS, ATT_GROUP)[None, :, :, None, None],
                              s.shape[:-1] + (1,))
    p = jax.nn.softmax(jnp.concatenate([s, sink_c], axis=-1), axis=-1)
    out = jnp.einsum('bkgqs,bskd->bqkgd', p[..., :cl], vc.astype(F32))
    return out.reshape(b, cl, D_ATT)


def centred_dwconv(t, w):
    kw = w.shape[0]
    half = kw // 2
    n = t.shape[1]
    tp = jnp.pad(t, ((0, 0), (half, half), (0, 0)))
    out = tp[:, 0:n] * w[0]
    for j in range(1, kw):
        out = out + tp[:, j:j + n] * w[j]
    return out


def mlstm_prepare(mq, mk, mv, mi, mf, conv_w, b_i, b_f):
    b, n, _ = mq.shape
    qk = jax.nn.silu(centred_dwconv(jnp.concatenate([mq, mk], axis=-1), conv_w))
    q, k = jnp.split(qk, 2, axis=-1)

    def heads(t):
        return t.astype(F32).reshape(b, n, MLSTM_HEADS, MLSTM_DIM).transpose(0, 2, 1, 3)

    q = heads(q)
    k = heads(k) * (MLSTM_DIM ** -0.5)
    v = heads(mv)
    li = (mi.astype(F32).reshape(b, n, 2, MLSTM_HEADS) + b_i.astype(F32)).transpose(2, 0, 3, 1)
    lf = jax.nn.log_sigmoid(mf.astype(F32).reshape(b, n, 2, MLSTM_HEADS) + b_f.astype(F32)).transpose(2, 0, 3, 1)
    return q, k, v, li, lf


def mlstm_zero_state(b):
    return (jnp.zeros((b, MLSTM_HEADS, MLSTM_DIM, MLSTM_DIM), F32),
            jnp.zeros((b, MLSTM_HEADS, MLSTM_DIM), F32),
            jnp.zeros((b, MLSTM_HEADS), F32))


def mlstm_chunkwise(q, k, v, li, lf, state):
    b, h, n, d = q.shape
    L = MLSTM_CHUNK
    nc = n // L

    def to_chunks(a):
        return jnp.moveaxis(a.reshape((b, h, nc, L) + a.shape[3:]), 2, 0)

    xs = (to_chunks(q), to_chunks(k), to_chunks(v), to_chunks(li), to_chunks(lf))
    causal = jnp.tril(jnp.ones((L, L), dtype=bool))

    def step(carry, inp):
        C, nv, m = carry
        qc, kc, vc, lic, lfc = inp
        bcum = jnp.cumsum(lfc, axis=-1)
        dmat = bcum[..., :, None] - bcum[..., None, :] + lic[..., None, :]
        dmat = jnp.where(causal, dmat, -jnp.inf)
        g_prev = bcum + m[..., None]
        m_t = jnp.maximum(g_prev, jnp.max(dmat, axis=-1))
        w_intra = jnp.exp(dmat - m_t[..., None])
        w_prev = jnp.exp(g_prev - m_t)
        qk = jnp.einsum('bhtd,bhsd->bhts', qc, kc) * w_intra
        num = (jnp.einsum('bhts,bhsv->bhtv', qk, vc)
               + w_prev[..., None] * jnp.einsum('bhvk,bhtk->bhtv', C, qc))
        den = qk.sum(axis=-1) + w_prev * jnp.einsum('bhtk,bhk->bht', qc, nv)
        hout = num / jnp.maximum(jnp.abs(den), jnp.exp(-m_t))[..., None]
        b_last = bcum[..., -1]
        dlast = b_last[..., None] - bcum + lic
        m_new = jnp.maximum(b_last + m, jnp.max(dlast, axis=-1))
        w_s = jnp.exp(dlast - m_new[..., None])
        decay = jnp.exp(b_last + m - m_new)
        C_new = decay[..., None, None] * C + jnp.einsum('bhs,bhsv,bhsk->bhvk', w_s, vc, kc)
        n_new = decay[..., None] * nv + jnp.einsum('bhs,bhsk->bhk', w_s, kc)
        return (C_new, n_new, m_new), hout

    state, hs = lax.scan(step, state, xs)
    hs = jnp.moveaxis(hs, 0, 2).reshape(b, h, n, d)
    return hs, state


def mlstm_bidir(q, k, v, li, lf, init_fwd, init_bwd):
    h_f, s_f = mlstm_chunkwise(q, k, v, li[0], lf[0], init_fwd)
    h_b, s_b = mlstm_chunkwise(jnp.flip(q, 2), jnp.flip(k, 2), jnp.flip(v, 2),
                               jnp.flip(li[1], -1), jnp.flip(lf[1], -1), init_bwd)
    return h_f + jnp.flip(h_b, 2), s_f, s_b


def mlstm_output(hsum, mo):
    b, h, n, d = hsum.shape
    hh = hsum.transpose(0, 2, 1, 3).reshape(b, n, h * d)
    return (jax.nn.sigmoid(mo.astype(F32)) * hh).astype(mo.dtype)


def trunk_layer(x, xc, mod_x, mod_c, norm_g, w_ffn_in, w_ffn_out, w_in, w_out, w_fourier,
                sink, conv_qk, b_gate_i, b_gate_f, cos, sin, last):
    mx = jnp.split(mod_x, N_MOD, axis=-1)
    mc = jnp.split(mod_c, N_MOD, axis=-1)
    b, n, _ = x.shape
    cl = xc.shape[1]
    dt = x.dtype

    def ffn_half(t, mods, sub, f):
        h = modulate(rmsnorm(t, norm_g[sub]), mods[3 * sub], mods[3 * sub + 1])
        return t + 0.5 * mods[3 * sub + 2] * swiglu(h, w_ffn_in[f], w_ffn_out[f])

    x = ffn_half(x, mx, 0, 0)
    xc = ffn_half(xc, mc, 0, 0)

    hx = modulate(rmsnorm(x, norm_g[1]), mx[3], mx[4])
    hc = modulate(rmsnorm(xc, norm_g[1]), mc[3], mc[4])
    ax, qx, kx, vx, mqx, mkx, mvx, mox, mix_, mfx = split_columns(hx @ w_in)
    ac, qc, kc, vc, mqc, mkc, mvc, moc, mic, mfc = split_columns(hc @ w_in)
    kc = kc.reshape(b, cl, ATT_KV_HEADS, HEAD_DIM)
    vc = vc.reshape(b, cl, ATT_KV_HEADS, HEAD_DIM)

    zero = mlstm_zero_state(b)
    h_ctx, st_f, st_b = mlstm_bidir(*mlstm_prepare(mqc, mkc, mvc, mic, mfc, conv_qk, b_gate_i, b_gate_f), zero, zero)
    h_lat, _, _ = mlstm_bidir(*mlstm_prepare(mqx, mkx, mvx, mix_, mfx, conv_qk, b_gate_i, b_gate_f), st_f, st_b)

    qr = apply_rope(qx.reshape(b, n, ATT_HEADS, HEAD_DIM), cos, sin)
    kr = apply_rope(kx.reshape(b, n, ATT_KV_HEADS, HEAD_DIM), cos, sin)
    att_x = window_attention(qr, kr, vx.reshape(b, n, ATT_KV_HEADS, HEAD_DIM), kc, vc, sink)

    y = jnp.concatenate([fourier_mix(ax, w_fourier), att_x.astype(dt), mlstm_output(h_lat, mox).astype(dt)], axis=-1) @ w_out
    x = x + mx[5] * y
    x = ffn_half(x, mx, 2, 1)

    if not last:
        att_c = context_attention(qc.reshape(b, cl, ATT_HEADS, HEAD_DIM), kc, vc, sink)
        yc = jnp.concatenate([fourier_mix(ac, w_fourier), att_c.astype(dt), mlstm_output(h_ctx, moc).astype(dt)], axis=-1) @ w_out
        xc = xc + mc[5] * yc
        xc = ffn_half(xc, mc, 2, 1)
    return x, xc


def setup_inputs(seed: int = 0) -> dict:
    key = jax.random.key(seed)
    ks = jax.random.split(key, 20)
    D = D_MODEL
    nrm = jax.random.normal
    x = nrm(ks[0], (BATCH, SEQ, D), F32)
    c = nrm(ks[1], (BATCH, D), F32)
    ctx = nrm(ks[2], (BATCH, CTX_LEN, D), F32)
    c_ctx = nrm(ks[3], (D,), F32)
    w_ada = nrm(ks[4], (DEPTH, D, N_MOD * D), F32) * (0.5 * D ** -0.5)
    b_ada = nrm(ks[5], (DEPTH, N_MOD * D), F32) * 0.01
    norm_g = 1.0 + 0.02 * nrm(ks[6], (DEPTH, 3, D), F32)
    w_ffn_in = nrm(ks[7], (DEPTH, 2, D, 2 * D_FF), F32) * (D ** -0.5)
    w_ffn_out = nrm(ks[8], (DEPTH, 2, D_FF, D), F32) * (D_FF ** -0.5)
    w_in = nrm(ks[9], (DEPTH, D, D_IN), F32) * (D ** -0.5)
    w_out = nrm(ks[10], (DEPTH, D_MIX, D), F32) * (D_MIX ** -0.5)
    w_fourier = nrm(ks[11], (DEPTH, FOURIER_GROUPS, FOURIER_CH, FOURIER_CH), F32) * (FOURIER_CH ** -0.5)
    attn_sink = 0.1 * nrm(ks[12], (DEPTH, ATT_HEADS), F32)
    conv_qk = nrm(ks[13], (DEPTH, QK_CONV, 2 * D_MLSTM), F32) * (QK_CONV ** -0.5)
    b_gate_i = 0.1 * nrm(ks[14], (DEPTH, 2, MLSTM_HEADS), F32)
    b_gate_f = jnp.linspace(3.0, 6.0, MLSTM_HEADS, dtype=F32) + 0.1 * nrm(ks[15], (DEPTH, 2, MLSTM_HEADS), F32)
    g_final = 1.0 + 0.02 * nrm(ks[16], (D,), F32)
    return {"x": x, "c": c, "ctx": ctx, "c_ctx": c_ctx, "w_ada": w_ada, "b_ada": b_ada,
            "norm_g": norm_g, "w_ffn_in": w_ffn_in, "w_ffn_out": w_ffn_out, "w_in": w_in,
            "w_out": w_out, "w_fourier": w_fourier, "attn_sink": attn_sink, "conv_qk": conv_qk,
            "b_gate_i": b_gate_i, "b_gate_f": b_gate_f, "g_final": g_final}


def reference(x, c, ctx, c_ctx, w_ada, b_ada, norm_g, w_ffn_in, w_ffn_out, w_in, w_out, w_fourier,
              attn_sink, conv_qk, b_gate_i, b_gate_f, g_final):
    n = x.shape[1]
    cos, sin = axial_rope(n)
    sc = jax.nn.silu(c)
    scc = jax.nn.silu(c_ctx)
    xc = ctx
    for l in range(DEPTH):
        mod_x = (sc @ w_ada[l] + b_ada[l])[:, None, :]
        mod_c = scc @ w_ada[l] + b_ada[l]
        x, xc = trunk_layer(x, xc, mod_x, mod_c, norm_g[l], w_ffn_in[l], w_ffn_out[l], w_in[l], w_out[l],
                            w_fourier[l], attn_sink[l], conv_qk[l], b_gate_i[l], b_gate_f[l], cos, sin,
                            l == DEPTH - 1)
    return rmsnorm(x, g_final)
```

```cpp
#include <hip/hip_runtime.h>
#include <cstdio>
#include <cstdint>

namespace {
constexpr int D = 1024, NB = 4, SEQ = 4096, CTX = 256, DEPTH = 2;
constexpr int TL = NB * SEQ, TC = NB * CTX, T = TL + TC;
constexpr int DFF = 2816, DIN = 2064, NMOD = 9, MODW = NMOD * D;
constexpr int NR = NB + 1;
constexpr float EPS = 1e-6f;
constexpr int C_AX = 0, C_Q = 256, C_K = 768, C_V = 896, C_MQ = 1024, C_MK = 1280, C_MV = 1536, C_MO = 1792, C_MI = 2048, C_MF = 2056;

struct Ptrs {
    float* xl;
    float* xc;
};
__device__ __forceinline__ int mod_row(int r) { return r < TL ? r / SEQ : NB; }
__device__ __forceinline__ float* xrow(const Ptrs& p, int r) { return r < TL ? p.xl + (size_t)r * D : p.xc + (size_t)(r - TL) * D; }
__device__ __forceinline__ float silu_f(float x) { return x / (1.f + expf(-x)); }
__device__ __forceinline__ float sigmoid_f(float x) { return 1.f / (1.f + expf(-x)); }
__device__ __forceinline__ float logsigmoid_f(float x) { return fminf(x, 0.f) - log1pf(expf(-fabsf(x))); }

__global__ void k_mod(const float* __restrict__ c, const float* __restrict__ cctx, const float* __restrict__ w_ada, const float* __restrict__ b_ada, float* __restrict__ MOD) {
    const int j = blockIdx.x * 256 + threadIdx.x, l = blockIdx.y;
    __shared__ float s[NR][D];
    for (int i = threadIdx.x; i < NR * D; i += 256) { const int r = i / D, k = i % D; const float v = r < NB ? c[r * D + k] : cctx[k]; s[r][k] = silu_f(v); }
    __syncthreads();
    float acc[NR];
#pragma unroll
    for (int r = 0; r < NR; ++r) acc[r] = 0.f;
    const float* w = w_ada + (size_t)l * D * MODW + j;
    for (int k = 0; k < D; ++k) { const float wv = w[(size_t)k * MODW];
#pragma unroll
        for (int r = 0; r < NR; ++r) acc[r] += s[r][k] * wv; }
#pragma unroll
    for (int r = 0; r < NR; ++r) MOD[((size_t)l * NR + r) * MODW + j] = acc[r] + b_ada[l * MODW + j];
}

__global__ void k_init(const float* __restrict__ x, const float* __restrict__ ctx, Ptrs p) {
    const size_t i = (size_t)blockIdx.x * 256 + threadIdx.x;
    if (i < (size_t)TL * D / 4) ((float4*)p.xl)[i] = ((const float4*)x)[i];
    else if (i < (size_t)T * D / 4) ((float4*)p.xc)[i - (size_t)TL * D / 4] = ((const float4*)ctx)[i - (size_t)TL * D / 4];
}

__global__ void k_normmod(Ptrs p, const float* __restrict__ g, const float* __restrict__ mod  , int shift_idx, int scale_idx, float* __restrict__ H) {
    const int r = blockIdx.x, tid = threadIdx.x; const float* x = xrow(p, r); const int mr = mod_row(r);
    float v[4]; float ss = 0.f;
#pragma unroll
    for (int i = 0; i < 4; ++i) { v[i] = x[tid + 256 * i]; ss += v[i] * v[i]; }
    __shared__ float red[4];
#pragma unroll
    for (int o = 32; o >= 1; o >>= 1) ss += __shfl_xor(ss, o);
    if ((tid & 63) == 0) red[tid >> 6] = ss;
    __syncthreads();
    const float tot = red[0] + red[1] + red[2] + red[3];
    const float rstd = rsqrtf(tot * (1.f / D) + EPS);
#pragma unroll
    for (int i = 0; i < 4; ++i) { const int j = tid + 256 * i; const float y = v[i] * rstd * g[j];
        H[(size_t)r * D + j] = y * (1.f + mod[(size_t)mr * MODW + scale_idx * D + j]) + mod[(size_t)mr * MODW + shift_idx * D + j]; }
}

__global__ void k_final(float* __restrict__ xl, const float* __restrict__ g) {
    const int r = blockIdx.x, tid = threadIdx.x; float* x = xl + (size_t)r * D;
    float v[4]; float ss = 0.f;
#pragma unroll
    for (int i = 0; i < 4; ++i) { v[i] = x[tid + 256 * i]; ss += v[i] * v[i]; }
    __shared__ float red[4];
#pragma unroll
    for (int o = 32; o >= 1; o >>= 1) ss += __shfl_xor(ss, o);
    if ((tid & 63) == 0) red[tid >> 6] = ss;
    __syncthreads();
    const float tot = red[0] + red[1] + red[2] + red[3];
    const float rstd = rsqrtf(tot * (1.f / D) + EPS);
#pragma unroll
    for (int i = 0; i < 4; ++i) { const int j = tid + 256 * i; x[j] = v[i] * rstd * g[j]; }
}

struct GemmArgs { const float* A; int lda; const float* W; int ldw; int M, N, K; float* C; int ldc; int NH; Ptrs p; const float* mod; int gate_idx; float coef; int row_base; };
template <int MODE> __global__ void __launch_bounds__(256) k_gemm(GemmArgs a) {
    constexpr int BM = 64, BN = 64, BK = 16;
    __shared__ float As[BK][BM + 4];
    __shared__ float Bs[BK][BN + 4];
    __shared__ float Bu[MODE == 1 ? BK : 1][BN + 4];
    const int tid = threadIdx.x, tx = tid & 15, ty = tid >> 4;
    const int row0 = blockIdx.y * BM, col0 = blockIdx.x * BN;
    float acc[4][4], acu[4][4];
#pragma unroll
    for (int i = 0; i < 4; ++i)
#pragma unroll
        for (int j = 0; j < 4; ++j) { acc[i][j] = 0.f; acu[i][j] = 0.f; }
    const int ar = tid >> 2, ak = (tid & 3) * 4;
    const int bk = tid >> 4, bn = (tid & 15) * 4;
    for (int k0 = 0; k0 < a.K; k0 += BK) {
        const float4 av = *(const float4*)(a.A + (size_t)(row0 + ar) * a.lda + k0 + ak);
        As[ak + 0][ar] = av.x; As[ak + 1][ar] = av.y; As[ak + 2][ar] = av.z; As[ak + 3][ar] = av.w;
        float4 bv = make_float4(0.f, 0.f, 0.f, 0.f), uv = make_float4(0.f, 0.f, 0.f, 0.f);
        if (col0 + bn < a.N) { bv = *(const float4*)(a.W + (size_t)(k0 + bk) * a.ldw + col0 + bn); if (MODE == 1) uv = *(const float4*)(a.W + (size_t)(k0 + bk) * a.ldw + a.NH + col0 + bn); }
        *(float4*)&Bs[bk][bn] = bv;
        if (MODE == 1) *(float4*)&Bu[bk][bn] = uv;
        __syncthreads();
#pragma unroll
        for (int k = 0; k < BK; ++k) {
            const float4 a4 = *(const float4*)&As[k][ty * 4];
            const float4 b4 = *(const float4*)&Bs[k][tx * 4];
            const float aa[4] = {a4.x, a4.y, a4.z, a4.w}, bb[4] = {b4.x, b4.y, b4.z, b4.w};
#pragma unroll
            for (int i = 0; i < 4; ++i)
#pragma unroll
                for (int j = 0; j < 4; ++j) acc[i][j] += aa[i] * bb[j];
            if (MODE == 1) { const float4 u4 = *(const float4*)&Bu[k][tx * 4]; const float uu[4] = {u4.x, u4.y, u4.z, u4.w};
#pragma unroll
                for (int i = 0; i < 4; ++i)
#pragma unroll
                    for (int j = 0; j < 4; ++j) acu[i][j] += aa[i] * uu[j]; }
        }
        __syncthreads();
    }
#pragma unroll
    for (int i = 0; i < 4; ++i) { const int r = row0 + ty * 4 + i;
#pragma unroll
        for (int j = 0; j < 4; ++j) { const int c = col0 + tx * 4 + j; if (c >= a.N) continue;
            if (MODE == 0) a.C[(size_t)r * a.ldc + c] = acc[i][j];
            if (MODE == 1) a.C[(size_t)r * a.ldc + c] = silu_f(acc[i][j]) * acu[i][j];
            if (MODE == 2) { const int gr = a.row_base + r; float* x = xrow(a.p, gr); x[c] += a.coef * a.mod[(size_t)mod_row(gr) * MODW + a.gate_idx * D + c] * acc[i][j]; } } }
}

__global__ void k_rope(float* __restrict__ U) {
    const int gid = blockIdx.x * 256 + threadIdx.x;
    const int i = gid & 15, hs = (gid >> 4) % 10, r = gid / 160;
    if (r >= TL) return;
    const int n = r % SEQ, prow = n / 64, pcol = n % 64;
    const float inv = powf(10000.f, -(float)i / 16.f);
    const float ar = (float)prow * inv, ac = (float)pcol * inv;
    float* base = U + (size_t)r * DIN + C_Q + hs * 64;
    const float t1 = base[i], t2 = base[16 + i], t3 = base[32 + i], t4 = base[48 + i];
    const float c1 = cosf(ar), s1 = sinf(ar), c2 = cosf(ac), s2 = sinf(ac);
    base[i] = t1 * c1 - t2 * s1; base[16 + i] = t2 * c1 + t1 * s1; base[32 + i] = t3 * c2 - t4 * s2; base[48 + i] = t4 * c2 + t3 * s2;
}

__global__ void __launch_bounds__(64) k_attn(const float* __restrict__ U, const float* __restrict__ sink, float* __restrict__ Y) {
    const int gid = blockIdx.x * 64 + threadIdx.x; const int h = gid & 7, r = gid >> 3;
    if (r >= T) return;
    const int kvh = h >> 2; int b, lo = 0, hi = -1;
    if (r < TL) { b = r / SEQ; const int n = r % SEQ; lo = n - 128 < 0 ? 0 : n - 128; hi = n + 128 > SEQ - 1 ? SEQ - 1 : n + 128; } else b = (r - TL) / CTX;
    float q[64];
    { const float* qp = U + (size_t)r * DIN + C_Q + h * 64;
#pragma unroll
      for (int d = 0; d < 64; ++d) q[d] = qp[d] * 0.125f; }
    const float* kl = U + (size_t)(b * SEQ) * DIN + C_K + kvh * 64;
    const float* kc = U + (size_t)(TL + b * CTX) * DIN + C_K + kvh * 64;
    const float sk = sink[h];
    float m = sk;
    for (int kp = lo; kp <= hi; ++kp) { const float* k = kl + (size_t)kp * DIN; float s = 0.f;
#pragma unroll
        for (int d = 0; d < 64; ++d) s += q[d] * k[d];
        m = fmaxf(m, s); }
    for (int j = 0; j < CTX; ++j) { const float* k = kc + (size_t)j * DIN; float s = 0.f;
#pragma unroll
        for (int d = 0; d < 64; ++d) s += q[d] * k[d];
        m = fmaxf(m, s); }
    float o[64]; float l = expf(sk - m);
#pragma unroll
    for (int d = 0; d < 64; ++d) o[d] = 0.f;
    for (int kp = lo; kp <= hi; ++kp) { const float* k = kl + (size_t)kp * DIN; float s = 0.f;
#pragma unroll
        for (int d = 0; d < 64; ++d) s += q[d] * k[d];
        const float e = expf(s - m); l += e; const float* v = k + (C_V - C_K);
#pragma unroll
        for (int d = 0; d < 64; ++d) o[d] += e * v[d]; }
    for (int j = 0; j < CTX; ++j) { const float* k = kc + (size_t)j * DIN; float s = 0.f;
#pragma unroll
        for (int d = 0; d < 64; ++d) s += q[d] * k[d];
        const float e = expf(s - m); l += e; const float* v = k + (C_V - C_K);
#pragma unroll
        for (int d = 0; d < 64; ++d) o[d] += e * v[d]; }
    const float il = 1.f / l; float* yp = Y + (size_t)r * D + 256 + h * 64;
#pragma unroll
    for (int d = 0; d < 64; ++d) yp[d] = o[d] * il;
}

__global__ void k_four_ch(const float* __restrict__ U, float* __restrict__ AB) {
    __shared__ float ct[64], st[64];
    const int tid = threadIdx.x;
    if (tid < 64) { ct[tid] = (float)cos(2.0 * 3.14159265358979323846 * tid / 64.0); st[tid] = (float)sin(2.0 * 3.14159265358979323846 * tid / 64.0); }
    __syncthreads();
    const int r = blockIdx.x, g = tid >> 6, m = tid & 63;
    const float* u = U + (size_t)r * DIN + C_AX + g * 64; float a = 0.f, bsum = 0.f;
    for (int c = 0; c < 64; ++c) { const float v = u[c]; const int idx = (m * c) & 63; a += v * ct[idx]; bsum += v * st[idx]; }
    AB[(size_t)r * 512 + g * 128 + m] = a; AB[(size_t)r * 512 + g * 128 + 64 + m] = bsum;
}
template <int N> __global__ void __launch_bounds__(256) k_four_pos(const float* __restrict__ AB, float* __restrict__ F, int row_base) {
    __shared__ float ct[N], st[N];
    const int tid = threadIdx.x;
    for (int i = tid; i < N; i += 256) { ct[i] = (float)cos(2.0 * 3.14159265358979323846 * i / (double)N); st[i] = (float)sin(2.0 * 3.14159265358979323846 * i / (double)N); }
    __syncthreads();
    const int seq = blockIdx.y, k0 = blockIdx.x * 4, g = tid >> 6, m = tid & 63;
    const float* ab = AB + (size_t)(row_base + seq * N) * 512 + g * 128 + m;
    float acc[4] = {0.f, 0.f, 0.f, 0.f};
    for (int n = 0; n < N; ++n) { const float a = ab[(size_t)n * 512], bb = ab[(size_t)n * 512 + 64];
#pragma unroll
        for (int kk = 0; kk < 4; ++kk) { const int idx = ((k0 + kk) * n) & (N - 1); acc[kk] += ct[idx] * a - st[idx] * bb; } }
    const float sc = rsqrtf(64.f * (float)N);
#pragma unroll
    for (int kk = 0; kk < 4; ++kk) F[(size_t)(row_base + seq * N + k0 + kk) * 256 + g * 64 + m] = acc[kk] * sc;
}
__global__ void k_four_mix(const float* __restrict__ F, const float* __restrict__ wf, float* __restrict__ Y) {
    const int r = blockIdx.x, tid = threadIdx.x, g = tid >> 6, e = tid & 63;
    const float* f = F + (size_t)r * 256 + g * 64; const float* w = wf + (size_t)g * 4096 + e; float a = 0.f;
    for (int c = 0; c < 64; ++c) a += f[c] * w[c * 64];
    Y[(size_t)r * D + g * 64 + e] = a;
}

__global__ void __launch_bounds__(256) k_mlstm_scan(const float* __restrict__ U, const float* __restrict__ conv  , const float* __restrict__ b_i  , const float* __restrict__ b_f, float* __restrict__ HS  ) {
    extern __shared__ float sm[];
    float* qs = sm;
    float* ks = qs + 4096;
    float* vs = ks + 4096;
    float* Cs = vs + 4096;
    float* Ss = Cs + 4096;
    float* nv = Ss + 4096;
    float* li = nv + 64; float* lf = li + 64; float* bc = lf + 64; float* mt = bc + 64; float* wp = mt + 64; float* den = wp + 64; float* wsv = den + 64; float* sc = wsv + 64;
    const int tid = threadIdx.x; const int dir = blockIdx.x & 1, h = (blockIdx.x >> 1) & 3, b = blockIdx.x >> 3;
    for (int i = tid; i < 4096; i += 256) Cs[i] = 0.f;
    if (tid < 64) nv[tid] = 0.f;
    if (tid == 0) sc[0] = 0.f;
    __syncthreads();
    const float bi = b_i[dir * 4 + h], bff = b_f[dir * 4 + h];
    for (int ch = 0; ch < 4 + 64; ++ch) {
        const bool isctx = ch < 4; const int N = isctx ? CTX : SEQ; const int c = isctx ? ch : ch - 4; const int rb = isctx ? TL + b * CTX : b * SEQ;
        { const int t = tid >> 2, dg = (tid & 3) * 16; const int p = dir == 0 ? c * 64 + t : N - 1 - c * 64 - t; const float* u0 = U + (size_t)(rb + p) * DIN;
#pragma unroll
          for (int dd = 0; dd < 16; ++dd) { const int d = dg + dd; const int cq = h * 64 + d, ck = 256 + h * 64 + d;
              float aq = u0[C_MQ + h * 64 + d] * conv[512 + cq], ak = u0[C_MK + h * 64 + d] * conv[512 + ck];
              if (p > 0) { aq += u0[-DIN + C_MQ + h * 64 + d] * conv[cq]; ak += u0[-DIN + C_MK + h * 64 + d] * conv[ck]; }
              if (p < N - 1) { aq += u0[DIN + C_MQ + h * 64 + d] * conv[1024 + cq]; ak += u0[DIN + C_MK + h * 64 + d] * conv[1024 + ck]; }
              qs[t * 64 + d] = silu_f(aq); ks[t * 64 + d] = silu_f(ak) * 0.125f; vs[t * 64 + d] = u0[C_MV + h * 64 + d]; }
          if ((tid & 3) == 0) { li[t] = u0[C_MI + dir * 4 + h] + bi; lf[t] = logsigmoid_f(u0[C_MF + dir * 4 + h] + bff); } }
        __syncthreads();
        if (tid == 0) { float s = 0.f; for (int t = 0; t < 64; ++t) { s += lf[t]; bc[t] = s; } }
        __syncthreads();
        const float m = sc[0];
        if (tid < 64) { const int t = tid; float mx = bc[t] + m; for (int s = 0; s <= t; ++s) mx = fmaxf(mx, bc[t] - bc[s] + li[s]); mt[t] = mx; wp[t] = expf(bc[t] + m - mx); }
        if (tid == 64) { const float bl = bc[63]; float mx = bl + m; for (int s = 0; s < 64; ++s) mx = fmaxf(mx, bl - bc[s] + li[s]); sc[1] = mx; sc[2] = expf(bl + m - mx); }
        __syncthreads();
        if (tid < 64) wsv[tid] = expf(bc[63] - bc[tid] + li[tid] - sc[1]);
        for (int e = tid; e < 4096; e += 256) { const int t = e >> 6, s = e & 63; float v = 0.f;
            if (s <= t) { float dot = 0.f; for (int d = 0; d < 64; ++d) dot += qs[t * 64 + d] * ks[s * 64 + d]; v = dot * expf(bc[t] - bc[s] + li[s] - mt[t]); }
            Ss[e] = v; }
        __syncthreads();
        if (tid < 64) { const int t = tid; float s1 = 0.f, s2 = 0.f; for (int s = 0; s < 64; ++s) s1 += Ss[t * 64 + s]; for (int k = 0; k < 64; ++k) s2 += qs[t * 64 + k] * nv[k]; den[t] = s1 + wp[t] * s2; }
        __syncthreads();
        for (int e = tid; e < 4096; e += 256) { const int t = e >> 6, v = e & 63; float a = 0.f, c2 = 0.f;
            for (int s = 0; s < 64; ++s) a += Ss[t * 64 + s] * vs[s * 64 + v];
            for (int k = 0; k < 64; ++k) c2 += Cs[v * 64 + k] * qs[t * 64 + k];
            const float num = a + wp[t] * c2; const float dn = fmaxf(fabsf(den[t]), expf(-mt[t]));
            const int p = dir == 0 ? c * 64 + t : N - 1 - c * 64 - t;
            HS[((size_t)dir * T + rb + p) * 256 + h * 64 + v] = num / dn; }
        __syncthreads();
        { const float decay = sc[2];
          for (int e = tid; e < 4096; e += 256) { const int v = e >> 6, k = e & 63; float a = 0.f; for (int s = 0; s < 64; ++s) a += wsv[s] * vs[s * 64 + v] * ks[s * 64 + k]; Cs[e] = decay * Cs[e] + a; }
          if (tid < 64) { float a = 0.f; for (int s = 0; s < 64; ++s) a += wsv[s] * ks[s * 64 + tid]; nv[tid] = decay * nv[tid] + a; }
          if (tid == 0) sc[0] = sc[1]; }
        __syncthreads();
    }
}
__global__ void k_mlstm_out(const float* __restrict__ U, const float* __restrict__ HS, float* __restrict__ Y) {
    const int r = blockIdx.x, c = threadIdx.x;
    Y[(size_t)r * D + 768 + c] = sigmoid_f(U[(size_t)r * DIN + C_MO + c]) * (HS[(size_t)r * 256 + c] + HS[((size_t)T + r) * 256 + c]);
}
}

extern "C" void kernel_launch(void* const* d_in, const int* in_sizes, int n_in, void* d_out, int out_size, void* d_ws, size_t ws_size, hipStream_t stream) {
    const float* x = (const float*)d_in[0]; const float* c = (const float*)d_in[1]; const float* ctx = (const float*)d_in[2]; const float* c_ctx = (const float*)d_in[3];
    const float* w_ada = (const float*)d_in[4]; const float* b_ada = (const float*)d_in[5]; const float* norm_g = (const float*)d_in[6];
    const float* w_ffn_in = (const float*)d_in[7]; const float* w_ffn_out = (const float*)d_in[8]; const float* w_in = (const float*)d_in[9]; const float* w_out = (const float*)d_in[10];
    const float* w_fourier = (const float*)d_in[11]; const float* attn_sink = (const float*)d_in[12]; const float* conv_qk = (const float*)d_in[13];
    const float* b_gate_i = (const float*)d_in[14]; const float* b_gate_f = (const float*)d_in[15]; const float* g_final = (const float*)d_in[16];
    float* ws = (float*)d_ws; size_t off = 0;
    auto take = [&](size_t n) { float* p = ws + off; off += (n + 63) & ~(size_t)63; return p; };
    float* MOD = take((size_t)DEPTH * NR * MODW);
    float* XC = take((size_t)TC * D);
    float* H = take((size_t)T * D);
    float* R = take((size_t)T * DIN);
    float* HS = take((size_t)2 * T * 256);
    float* F = take((size_t)T * 256);
    if (off * 4 > ws_size) { fprintf(stderr, "kernel_launch: workspace too small: need %zu have %zu\n", off * 4, ws_size); return; }
    static bool attr_done = false;
    constexpr int SCAN_LDS = (5 * 4096 + 9 * 64) * 4;
    if (!attr_done) { (void)hipFuncSetAttribute((const void*)k_mlstm_scan, hipFuncAttributeMaxDynamicSharedMemorySize, SCAN_LDS); attr_done = true; }
    Ptrs p{(float*)d_out, XC};
    k_mod<<<dim3(MODW / 256, DEPTH), 256, 0, stream>>>(c, c_ctx, w_ada, b_ada, MOD);
    k_init<<<(unsigned)(((size_t)T * D / 4 + 255) / 256), 256, 0, stream>>>(x, ctx, p);
    constexpr int CH = T / 4;
    for (int l = 0; l < DEPTH; ++l) {
        const float* mod = MOD + (size_t)l * NR * MODW; const float* ng = norm_g + (size_t)l * 3 * D;
        auto ffn = [&](int sub, int f) {
            k_normmod<<<T, 256, 0, stream>>>(p, ng + sub * D, mod, 3 * sub, 3 * sub + 1, H);
            const float* wi = w_ffn_in + ((size_t)l * 2 + f) * D * 2 * DFF; const float* wo = w_ffn_out + ((size_t)l * 2 + f) * DFF * D;
            for (int cix = 0; cix < 4; ++cix) {
                GemmArgs a{}; a.A = H + (size_t)cix * CH * D; a.lda = D; a.W = wi; a.ldw = 2 * DFF; a.M = CH; a.N = DFF; a.K = D; a.C = R; a.ldc = DFF; a.NH = DFF; a.p = p;
                k_gemm<1><<<dim3(DFF / 64, CH / 64), 256, 0, stream>>>(a);
                GemmArgs g2{}; g2.A = R; g2.lda = DFF; g2.W = wo; g2.ldw = D; g2.M = CH; g2.N = D; g2.K = DFF; g2.p = p; g2.mod = mod; g2.gate_idx = 3 * sub + 2; g2.coef = 0.5f; g2.row_base = cix * CH;
                k_gemm<2><<<dim3(D / 64, CH / 64), 256, 0, stream>>>(g2);
            }
        };
        ffn(0, 0);
        k_normmod<<<T, 256, 0, stream>>>(p, ng + 1 * D, mod, 3, 4, H);
        { GemmArgs a{}; a.A = H; a.lda = D; a.W = w_in + (size_t)l * D * DIN; a.ldw = DIN; a.M = T; a.N = DIN; a.K = D; a.C = R; a.ldc = DIN; a.p = p;
          k_gemm<0><<<dim3((DIN + 63) / 64, T / 64), 256, 0, stream>>>(a); }
        float* U = R; float* Y = H;
        k_rope<<<(TL * 160 + 255) / 256, 256, 0, stream>>>(U);
        k_attn<<<(T * 8 + 63) / 64, 64, 0, stream>>>(U, attn_sink + l * 8, Y);
        k_four_ch<<<T, 256, 0, stream>>>(U, HS);
        k_four_pos<SEQ><<<dim3(SEQ / 4, NB), 256, 0, stream>>>(HS, F, 0);
        k_four_pos<CTX><<<dim3(CTX / 4, NB), 256, 0, stream>>>(HS, F, TL);
        k_four_mix<<<T, 256, 0, stream>>>(F, w_fourier + (size_t)l * 4 * 4096, Y);
        k_mlstm_scan<<<32, 256, SCAN_LDS, stream>>>(U, conv_qk + (size_t)l * 3 * 512, b_gate_i + l * 8, b_gate_f + l * 8, HS);
        k_mlstm_out<<<T, 256, 0, stream>>>(U, HS, Y);
        { GemmArgs g2{}; g2.A = Y; g2.lda = D; g2.W = w_out + (size_t)l * D * D; g2.ldw = D; g2.M = T; g2.N = D; g2.K = D; g2.p = p; g2.mod = mod; g2.gate_idx = 5; g2.coef = 1.0f; g2.row_base = 0;
          k_gemm<2><<<dim3(D / 64, T / 64), 256, 0, stream>>>(g2); }
        ffn(2, 1);
    }
    k_final<<<TL, 256, 0, stream>>>((float*)d_out, g_final);
}
```

```cpp
#include <hip/hip_runtime.h>
#include <cstdio>
#include <cstdint>
namespace pg8 {
#define PG8_LAS __attribute__((address_space(3)))
typedef unsigned short bf16_t;
typedef short bf16x8 __attribute__((ext_vector_type(8)));
typedef float f32x4 __attribute__((ext_vector_type(4)));
typedef unsigned u32x4 __attribute__((ext_vector_type(4)));
typedef _Float16 half8 __attribute__((ext_vector_type(8)));
constexpr int BM = 256, BK = 64, HALF = 128, HTB = HALF * BK * 2  , STAGE_BYTES = 8 * HTB, NXCD = 8, WGM = 8;

__host__ __device__ __forceinline__ int lds_byte(int r, int c) { const int st = (r >> 4) * 2 + (c >> 5), rr = r & 15, cc = c & 31, ob = rr * 64 + cc * 2; return st * 1024 + (ob ^ (((ob >> 9) & 1) << 5)); }
__host__ __device__ __forceinline__ void stage_rc(int b, int& R, int& C) { const int st = b / 1024, sb = b % 1024, swz = sb ^ (((sb >> 9) & 1) << 5); R = (st >> 1) * 16 + swz / 64; C = (st & 1) * 32 + (swz % 64) / 2; }
__host__ __device__ __forceinline__ int perm32(int rho) { const int n = rho >> 4, i = rho & 15; return 8 * (i >> 2) + 4 * n + (i & 3); }

struct Unit { int pm, pn; };
struct Gemm { const bf16_t* A; const bf16_t* Bt; int M, N, K; };

struct StaticOrder {
    int nM, nN, nwg, G, c;
    __host__ __device__ void init(int M, int N, int G_, int c_) { nM = M / BM; nN = N / BM; nwg = nM * nN; G = G_; c = c_; }
    __host__ __device__ bool next(int i, Unit& u) const {
        const long L = (long)i * G + c; if (L >= nwg) return false;
        int wgid = (int)L; { const int q = nwg / NXCD, r = nwg % NXCD, xcd = wgid % NXCD, off = wgid / NXCD; wgid = (xcd < r ? xcd * (q + 1) : r * (q + 1) + (xcd - r) * q) + off; }
        const int nig = WGM * nN, gid = wgid / nig, fm = gid * WGM, gsz = (nM - fm) < WGM ? (nM - fm) : WGM;
        u.pm = fm + ((wgid % nig) % gsz); u.pn = (wgid % nig) / gsz; return true;
    }
    __device__ __forceinline__ void a_ready(const Unit&) const {}
    __device__ __forceinline__ void done(const Unit&) const {}
};

__device__ __forceinline__ unsigned cvt_pk_bf16(float lo, float hi) { typedef float f2_t __attribute__((ext_vector_type(2))); typedef _Float16 h2_t __attribute__((ext_vector_type(2))); const f2_t v = {lo, hi}; return __builtin_bit_cast(unsigned, __builtin_convertvector(v, h2_t)); }
__device__ __forceinline__ float silu_fast(float x) { return x * __builtin_amdgcn_rcpf(1.f + __expf(-x)); }
struct EpiBf16Plain {
    static constexpr bool PERM = true, AFTER_DRAIN = false;
    bf16_t* O; int ldc;
    __device__ __forceinline__ void operator()(const f32x4 (&acc)[2][2][4][2], const Unit& u, int wr, int wc, int fr, int fq) const {
        const int row0 = u.pm * BM + wr * 64 + fr, col0 = u.pn * BM + wc * 32 + 8 * fq;
#pragma unroll
        for (int ai = 0; ai < 2; ++ai)
#pragma unroll
            for (int m = 0; m < 4; ++m) { bf16_t* rowp = O + (size_t)(row0 + ai * HALF + m * 16) * ldc + col0;
#pragma unroll
                for (int bj = 0; bj < 2; ++bj) { const f32x4 v0 = acc[ai][bj][m][0], v1 = acc[ai][bj][m][1];
                    u32x4 w; w.x = cvt_pk_bf16(v0[0], v0[1]); w.y = cvt_pk_bf16(v0[2], v0[3]); w.z = cvt_pk_bf16(v1[0], v1[1]); w.w = cvt_pk_bf16(v1[2], v1[3]);
                    *(u32x4*)(rowp + bj * HALF) = w; } }
    }
};
struct EpiSwiglu {
    static constexpr bool PERM = true, AFTER_DRAIN = false;
    bf16_t* O; int ldc;
    __device__ __forceinline__ void operator()(const f32x4 (&acc)[2][2][4][2], const Unit& u, int wr, int wc, int fr, int fq) const {
        const int row0 = u.pm * BM + wr * 64 + fr, col0 = u.pn * HALF + wc * 32 + 8 * fq;
#pragma unroll
        for (int ai = 0; ai < 2; ++ai)
#pragma unroll
            for (int m = 0; m < 4; ++m) { bf16_t* rowp = O + (size_t)(row0 + ai * HALF + m * 16) * ldc + col0;
                f32x4 h0, h1;
#pragma unroll
                for (int i = 0; i < 4; ++i) { h0[i] = silu_fast(acc[ai][0][m][0][i]) * acc[ai][1][m][0][i]; h1[i] = silu_fast(acc[ai][0][m][1][i]) * acc[ai][1][m][1][i]; }
                u32x4 w; w.x = cvt_pk_bf16(h0[0], h0[1]); w.y = cvt_pk_bf16(h0[2], h0[3]); w.z = cvt_pk_bf16(h1[0], h1[1]); w.w = cvt_pk_bf16(h1[2], h1[3]);
                *(u32x4*)rowp = w; }
    }
};
struct EpiResid {
    static constexpr bool PERM = false, AFTER_DRAIN = false;
    float* xl; float* xc; int tl_rows; int panels_per_batch; const float* mod; int mod_stride; int gate_off; float coef;
    __device__ __forceinline__ void operator()(const f32x4 (&acc)[2][2][4][2], const Unit& u, int wr, int wc, int fr, int fq) const {
        const int prow = u.pm * BM; const bool lat = prow < tl_rows;
        float* base = lat ? xl + (size_t)prow * 1024 : xc + (size_t)(prow - tl_rows) * 1024;
        const int mr = lat ? u.pm / panels_per_batch : 4;
        const float* gate = mod + (size_t)mr * mod_stride + gate_off;
        const int row0 = wr * 64 + fr, col0 = u.pn * BM + wc * 32 + 4 * fq;
        f32x4 gv[2][2];
#pragma unroll
        for (int bj = 0; bj < 2; ++bj)
#pragma unroll
            for (int n = 0; n < 2; ++n) gv[bj][n] = *(const f32x4*)(gate + col0 + bj * HALF + n * 16) * coef;
#pragma unroll
        for (int ai = 0; ai < 2; ++ai)
#pragma unroll
            for (int m = 0; m < 4; ++m) { float* rowp = base + (size_t)(row0 + ai * HALF + m * 16) * 1024 + col0;
#pragma unroll
                for (int bj = 0; bj < 2; ++bj)
#pragma unroll
                    for (int n = 0; n < 2; ++n) { f32x4* p = (f32x4*)(rowp + bj * HALF + n * 16); *p = *p + gv[bj][n] * acc[ai][bj][m][n]; } }
    }
};
template <class Epi, class Sched, bool ALIGN_EPI = false, bool SP2 = false>
__device__ __forceinline__ void gemm_phase(PG8_LAS unsigned char* lds, const Gemm g, const Sched& S, const Epi& E) {
    const int tid = threadIdx.x, wid = __builtin_amdgcn_readfirstlane(tid >> 6), lane = tid & 63, wr = wid >> 2, wc = wid & 3, fr = lane & 15, fq = lane >> 4;
    const int K = g.K, nt = K / BK;
    unsigned voffA[2], voffB[2];
#pragma unroll
    for (int i = 0; i < 2; ++i) { int R, C; stage_rc(tid * 16 + i * 8192, R, C); const int Rb = Epi::PERM ? ((R & ~31) + perm32(R & 31)) : R;
        voffA[i] = (unsigned)(R * K + C) * 2u; voffB[i] = (unsigned)(Rb * K + C) * 2u; }
    const size_t kstep = (size_t)(BK * 2);
    const size_t hstep = (size_t)HALF * K * 2;
    const size_t tstep = 2 * hstep;
    const unsigned ldsw = (unsigned)wid * 1024u;
    const int aoff = lds_byte(wr * 64 + fr, fq * 8), boff = lds_byte(wc * 32 + fr, fq * 8);
#define PG8_SA(b, h) (((b) * 2 + (h)) * HTB)
#define PG8_SB(b, h) ((4 + (b) * 2 + (h)) * HTB)
#define PG8_STAGE(bufoff, gbase, voff) do { _Pragma("unroll") for (int _i = 0; _i < 2; ++_i) \
        __builtin_amdgcn_global_load_lds((const unsigned*)((const char*)(gbase) + (voff)[_i]), (PG8_LAS unsigned*)(lds + (bufoff) + ldsw + _i * 8192), 16, 0, 0); } while (0)
#define PG8_LDA(dst, b, h) do { _Pragma("unroll") for (int m = 0; m < 4; ++m) _Pragma("unroll") for (int k = 0; k < 2; ++k) dst[m][k] = *(const PG8_LAS bf16x8*)(lds + PG8_SA(b, h) + aoff + m * 2048 + k * 1024); } while (0)
#define PG8_LDB(dst, b, h) do { _Pragma("unroll") for (int n = 0; n < 2; ++n) _Pragma("unroll") for (int k = 0; k < 2; ++k) dst[n][k] = *(const PG8_LAS bf16x8*)(lds + PG8_SB(b, h) + boff + n * 2048 + k * 1024); } while (0)
#define PG8_MMA(ai, bj, At, Bt) do { __builtin_amdgcn_s_setprio(1); _Pragma("unroll") for (int m = 0; m < 4; ++m) _Pragma("unroll") for (int n = 0; n < 2; ++n) _Pragma("unroll") for (int k = 0; k < 2; ++k) \
        acc[ai][bj][m][n] = __builtin_amdgcn_mfma_f32_16x16x32_f16(__builtin_bit_cast(half8, Bt[n][k]), __builtin_bit_cast(half8, At[m][k]), acc[ai][bj][m][n], 0, 0, 0); __builtin_amdgcn_s_setprio(0); } while (0)
#define PG8_WAIT_V(n) asm volatile("s_waitcnt vmcnt(" #n ")" ::: "memory")
#define PG8_WAIT_L(n) asm volatile("s_waitcnt lgkmcnt(" #n ")" ::: "memory")
#define PG8_BAR __builtin_amdgcn_s_barrier()
#define PG8_SCHED __builtin_amdgcn_sched_barrier(0)
    Unit cur, nxt; int ui = 0;
    if (!S.next(0, cur)) return;
    f32x4 acc[2][2][4][2];
#pragma unroll
    for (int a = 0; a < 2; ++a)
#pragma unroll
        for (int b = 0; b < 2; ++b)
#pragma unroll
            for (int m = 0; m < 4; ++m)
#pragma unroll
                for (int n = 0; n < 2; ++n) acc[a][b][m][n] = (f32x4){0.f, 0.f, 0.f, 0.f};
    bf16x8 At[4][2], B0[2][2], B1[2][2];
    const char* cA = (const char*)g.A + (size_t)cur.pm * tstep; const char* cB = (const char*)g.Bt + (size_t)cur.pn * tstep;
    S.a_ready(cur);
    if constexpr (SP2) {
        PG8_STAGE(PG8_SB(0, 0), cB, voffB); PG8_STAGE(PG8_SB(0, 1), cB + hstep, voffB); PG8_STAGE(PG8_SA(0, 0), cA, voffA); PG8_STAGE(PG8_SA(0, 1), cA + hstep, voffA);
        if (wr == 1) PG8_BAR;
        PG8_WAIT_V(2); PG8_BAR;
        PG8_STAGE(PG8_SB(1, 0), cB + kstep, voffB); PG8_STAGE(PG8_SA(1, 0), cA + kstep, voffA); PG8_STAGE(PG8_SB(1, 1), cB + hstep + kstep, voffB);
        PG8_WAIT_V(6); PG8_BAR;
    } else {
        PG8_STAGE(PG8_SB(0, 0), cB, voffB); PG8_STAGE(PG8_SA(0, 0), cA, voffA); PG8_STAGE(PG8_SB(0, 1), cB + hstep, voffB); PG8_STAGE(PG8_SA(0, 1), cA + hstep, voffA);
        if (wr == 1) PG8_BAR;
        PG8_WAIT_V(4); PG8_BAR;
        PG8_STAGE(PG8_SB(1, 0), cB + kstep, voffB); PG8_STAGE(PG8_SA(1, 0), cA + kstep, voffA); PG8_STAGE(PG8_SB(1, 1), cB + hstep + kstep, voffB);
        PG8_WAIT_V(6); PG8_BAR;
    }
    for (;;) {
        const bool has_next = S.next(ui + 1, nxt);
        const char* nA = has_next ? (const char*)g.A + (size_t)nxt.pm * tstep : cA; const char* nB = has_next ? (const char*)g.Bt + (size_t)nxt.pn * tstep : cB;
        for (int t = 0; t < nt; t += 2) {
            const bool last = (t == nt - 2);
            const char* a1 = cA + (size_t)(t + 1) * kstep;
            const char* a2 = last ? nA : cA + (size_t)(t + 2) * kstep; const char* b2 = last ? nB : cB + (size_t)(t + 2) * kstep;
            const char* a3 = a2 + kstep; const char* b3 = b2 + kstep;
            if (last && has_next) S.a_ready(nxt);
            if constexpr (SP2) {
            PG8_LDB(B0, 0, 0); PG8_LDB(B1, 0, 1); PG8_SCHED; PG8_LDA(At, 0, 0); PG8_STAGE(PG8_SA(1, 1), a1 + hstep, voffA);
            PG8_WAIT_V(8); PG8_WAIT_L(0); PG8_BAR; PG8_MMA(0, 0, At, B0); PG8_MMA(0, 1, At, B1); PG8_BAR; PG8_SCHED;
            PG8_LDA(At, 0, 1); PG8_STAGE(PG8_SB(0, 0), b2, voffB); PG8_STAGE(PG8_SB(0, 1), b2 + hstep, voffB); PG8_STAGE(PG8_SA(0, 0), a2, voffA);
            PG8_WAIT_V(8); PG8_WAIT_L(0); PG8_BAR; PG8_MMA(1, 0, At, B0); PG8_MMA(1, 1, At, B1); PG8_BAR; PG8_SCHED;
            PG8_LDB(B0, 1, 0); PG8_LDB(B1, 1, 1); PG8_SCHED; PG8_LDA(At, 1, 0); PG8_STAGE(PG8_SA(0, 1), a2 + hstep, voffA);
            PG8_WAIT_V(8); PG8_WAIT_L(0); PG8_BAR; PG8_MMA(0, 0, At, B0); PG8_MMA(0, 1, At, B1); PG8_BAR; PG8_SCHED;
            PG8_LDA(At, 1, 1); PG8_STAGE(PG8_SB(1, 0), b3, voffB); PG8_STAGE(PG8_SB(1, 1), b3 + hstep, voffB); PG8_STAGE(PG8_SA(1, 0), a3, voffA);
            PG8_WAIT_V(8); PG8_WAIT_L(0); PG8_BAR; PG8_MMA(1, 0, At, B0); PG8_MMA(1, 1, At, B1); PG8_BAR; PG8_SCHED;
            } else {
            PG8_LDB(B0, 0, 0); PG8_SCHED; PG8_LDA(At, 0, 0); PG8_STAGE(PG8_SA(1, 1), a1 + hstep, voffA);
            PG8_WAIT_L(8); PG8_BAR; PG8_WAIT_L(0); PG8_MMA(0, 0, At, B0); PG8_BAR; PG8_SCHED;
            PG8_LDB(B1, 0, 1); PG8_STAGE(PG8_SB(0, 0), b2, voffB);
            PG8_BAR; PG8_WAIT_L(0); PG8_MMA(0, 1, At, B1); PG8_BAR;
            PG8_LDA(At, 0, 1); PG8_STAGE(PG8_SA(0, 0), a2, voffA);
            PG8_BAR; PG8_WAIT_L(0); PG8_MMA(1, 0, At, B0); PG8_BAR; PG8_SCHED;
            PG8_STAGE(PG8_SB(0, 1), b2 + hstep, voffB);
            PG8_WAIT_V(6); PG8_BAR; PG8_MMA(1, 1, At, B1); PG8_BAR;
            PG8_LDB(B0, 1, 0); PG8_SCHED; PG8_LDA(At, 1, 0); PG8_STAGE(PG8_SA(0, 1), a2 + hstep, voffA);
            PG8_WAIT_L(8); PG8_BAR; PG8_WAIT_L(0); PG8_MMA(0, 0, At, B0); PG8_BAR; PG8_SCHED;
            PG8_LDB(B1, 1, 1); PG8_STAGE(PG8_SB(1, 0), b3, voffB);
            PG8_BAR; PG8_WAIT_L(0); PG8_MMA(0, 1, At, B1); PG8_BAR;
            PG8_LDA(At, 1, 1); PG8_STAGE(PG8_SA(1, 0), a3, voffA);
            PG8_BAR; PG8_WAIT_L(0); PG8_MMA(1, 0, At, B0); PG8_BAR; PG8_SCHED;
            PG8_STAGE(PG8_SB(1, 1), b3 + hstep, voffB);
            PG8_WAIT_V(6); PG8_BAR; PG8_MMA(1, 1, At, B1); PG8_BAR;
            }
        }
        if constexpr (ALIGN_EPI) { if (wr == 0) PG8_BAR; }
        if constexpr (!Epi::AFTER_DRAIN) { E(acc, cur, wr, wc, fr, fq); S.done(cur); }
        if (!has_next) break;
#pragma unroll
        for (int a = 0; a < 2; ++a)
#pragma unroll
            for (int b = 0; b < 2; ++b)
#pragma unroll
                for (int m = 0; m < 4; ++m)
#pragma unroll
                    for (int n = 0; n < 2; ++n) acc[a][b][m][n] = (f32x4){0.f, 0.f, 0.f, 0.f};
        cur = nxt; cA = nA; cB = nB; ++ui;
        if constexpr (ALIGN_EPI) { if (wr == 1) PG8_BAR; }
    }
    PG8_WAIT_V(0);
    if constexpr (!ALIGN_EPI) { if (wr == 0) PG8_BAR; }
    PG8_BAR;
    if constexpr (Epi::AFTER_DRAIN) { E.fused(acc, cur, wr, wc, fr, fq, lds, wid, lane); S.done(cur); }
#undef PG8_SA
#undef PG8_SB
#undef PG8_STAGE
#undef PG8_LDA
#undef PG8_LDB
#undef PG8_MMA
#undef PG8_WAIT_V
#undef PG8_WAIT_L
#undef PG8_BAR
#undef PG8_SCHED
}
}

namespace {
#define LAS __attribute__((address_space(3)))
#define GAS __attribute__((address_space(1)))
typedef unsigned short bf16;
typedef unsigned v4u __attribute__((ext_vector_type(4)));
constexpr int D = 1024, NB = 4, SEQ = 4096, CTX = 256, DEPTH = 2;
constexpr int TL = NB * SEQ, TC = NB * CTX, T = TL + TC;
constexpr int DFF = 2816, DIN = 2064, DU = 2048, NMOD = 9, MODW = NMOD * D;
constexpr int NR = NB + 1;
constexpr float EPS = 1e-6f;
constexpr int C_AX = 0, C_Q = 256, C_K = 768, C_V = 896, C_MQ = 1024, C_MK = 1280, C_MV = 1536, C_MO = 1792;
constexpr int NWAVES = 8, NTHREADS = 512, GEMM_LDS = 131072;

struct Ptrs { float* xl; float* xc; };
__device__ __forceinline__ int mod_row(int r) { return r < TL ? r / SEQ : NB; }
__device__ __forceinline__ float* xrow(const Ptrs& p, int r) { return r < TL ? p.xl + (size_t)r * D : p.xc + (size_t)(r - TL) * D; }
__device__ __forceinline__ float silu_f(float x) { return x / (1.f + expf(-x)); }
__device__ __forceinline__ float sigmoid_f(float x) { return 1.f / (1.f + expf(-x)); }
__device__ __forceinline__ float logsigmoid_f(float x) { return fminf(x, 0.f) - log1pf(expf(-fabsf(x))); }
__device__ __forceinline__ float bf2f(bf16 b) { return (float)__builtin_bit_cast(_Float16, b); }
__device__ __forceinline__ unsigned f2bf(float f) { return (unsigned)__builtin_bit_cast(unsigned short, (_Float16)f); }
__device__ __forceinline__ unsigned pk2(float lo, float hi) { return f2bf(lo) | (f2bf(hi) << 16); }

__global__ void k_mod(const float* __restrict__ c, const float* __restrict__ cctx, const float* __restrict__ w_ada, const float* __restrict__ b_ada, float* __restrict__ MOD) {
    const int j = blockIdx.x * 256 + threadIdx.x, l = blockIdx.y;
    __shared__ float s[NR][D];
    for (int i = threadIdx.x; i < NR * D; i += 256) { const int r = i / D, k = i % D; const float v = r < NB ? c[r * D + k] : cctx[k]; s[r][k] = silu_f(v); }
    __syncthreads();
    float acc[NR];
#pragma unroll
    for (int r = 0; r < NR; ++r) acc[r] = 0.f;
    const float* w = w_ada + (size_t)l * D * MODW + j;
    for (int k = 0; k < D; ++k) { const float wv = w[(size_t)k * MODW];
#pragma unroll
        for (int r = 0; r < NR; ++r) acc[r] += s[r][k] * wv; }
#pragma unroll
    for (int r = 0; r < NR; ++r) MOD[((size_t)l * NR + r) * MODW + j] = acc[r] + b_ada[l * MODW + j];
}

__device__ __forceinline__ void transpose_item(const float* W, int ldw, int K, bf16* WT, int dst_row0, int k0, int n0, LAS float* scr, int lane) {
#pragma unroll 8
    for (int i = 0; i < 32; ++i) { const int kk = 2 * i + (lane >> 5); scr[kk * 33 + (lane & 31)] = W[(size_t)(k0 + kk) * ldw + n0 + (lane & 31)]; }
    asm volatile("s_waitcnt lgkmcnt(0)" ::: "memory");
    const int c = lane & 7;
#pragma unroll
    for (int j = 0; j < 4; ++j) { const int n = (lane >> 3) + 8 * j; const LAS float* s = scr + (8 * c) * 33 + n;
        v4u o; o.x = pk2(s[0 * 33], s[1 * 33]); o.y = pk2(s[2 * 33], s[3 * 33]); o.z = pk2(s[4 * 33], s[5 * 33]); o.w = pk2(s[6 * 33], s[7 * 33]);
        *(v4u*)(WT + (size_t)(dst_row0 + n) * K + k0 + 8 * c) = o; }
    asm volatile("s_waitcnt lgkmcnt(0)" ::: "memory");
}
struct ProArgs { const float* x; const float* ctx; const float* w_ffn_in; const float* w_ffn_out; const float* w_in; const float* w_out; bf16* Wi_t; bf16* Wo_t; bf16* Win_t; bf16* Wout_t; float* xl; float* xc; };
__global__ void __launch_bounds__(NTHREADS) k_prologue(ProArgs a) {
    extern __shared__ __attribute__((aligned(16))) unsigned char lds[];
    const int tid = threadIdx.x, lane = tid & 63, wave = tid >> 6;
    LAS float* scr = (LAS float*)((LAS unsigned char*)lds + wave * 16384);
    const int gw = blockIdx.x * NWAVES + wave, NGW = gridDim.x * NWAVES;
    constexpr int I_FI = (D / 64) * (2 * DFF / 32), I_FO = (DFF / 64) * (D / 32), I_IN = (D / 64) * (DU / 32), I_OUT = (D / 64) * (D / 32);
    constexpr int NITEMS = 4 * I_FI + 4 * I_FO + 2 * I_IN + 2 * I_OUT;
    for (int it = gw; it < NITEMS; it += NGW) {
        int r = it;
        if (r < 4 * I_FI) { const int mat = r / I_FI; r %= I_FI; const int nblk = 2 * DFF / 32, kb = r / nblk, nb = r % nblk, n0 = 32 * nb;
            const int nn = n0 < DFF ? n0 : n0 - DFF; const int drow = 256 * (nn / 128) + (n0 < DFF ? 0 : 128) + (nn % 128);
            transpose_item(a.w_ffn_in + (size_t)mat * D * 2 * DFF, 2 * DFF, D, a.Wi_t + (size_t)mat * 2 * DFF * D, drow, 64 * kb, n0, scr, lane); continue; }
        r -= 4 * I_FI;
        if (r < 4 * I_FO) { const int mat = r / I_FO; r %= I_FO; const int nblk = D / 32, kb = r / nblk, nb = r % nblk;
            transpose_item(a.w_ffn_out + (size_t)mat * DFF * D, D, DFF, a.Wo_t + (size_t)mat * D * DFF, 32 * nb, 64 * kb, 32 * nb, scr, lane); continue; }
        r -= 4 * I_FO;
        if (r < 2 * I_IN) { const int mat = r / I_IN; r %= I_IN; const int nblk = DU / 32, kb = r / nblk, nb = r % nblk;
            transpose_item(a.w_in + (size_t)mat * D * DIN, DIN, D, a.Win_t + (size_t)mat * DU * D, 32 * nb, 64 * kb, 32 * nb, scr, lane); continue; }
        r -= 2 * I_IN;
        { const int mat = r / I_OUT; r %= I_OUT; const int nblk = D / 32, kb = r / nblk, nb = r % nblk;
            transpose_item(a.w_out + (size_t)mat * D * D, D, D, a.Wout_t + (size_t)mat * D * D, 32 * nb, 64 * kb, 32 * nb, scr, lane); }
    }
    const size_t gt = (size_t)blockIdx.x * NTHREADS + tid, NGT = (size_t)gridDim.x * NTHREADS;
    for (size_t i = gt; i < (size_t)T * D / 4; i += NGT) {
        if (i < (size_t)TL * D / 4) ((float4*)a.xl)[i] = ((const float4*)a.x)[i]; else ((float4*)a.xc)[i - (size_t)TL * D / 4] = ((const float4*)a.ctx)[i - (size_t)TL * D / 4]; }
}

__global__ void k_normmod(Ptrs p, const float* __restrict__ g, const float* __restrict__ mod, int shift_idx, int scale_idx, bf16* __restrict__ H) {
    const int r = blockIdx.x, tid = threadIdx.x; const float* x = xrow(p, r); const int mr = mod_row(r);
    const float4 v = ((const float4*)x)[tid]; float ss = v.x * v.x + v.y * v.y + v.z * v.z + v.w * v.w;
    __shared__ float red[4];
#pragma unroll
    for (int o = 32; o >= 1; o >>= 1) ss += __shfl_xor(ss, o);
    if ((tid & 63) == 0) red[tid >> 6] = ss;
    __syncthreads();
    const float rstd = rsqrtf((red[0] + red[1] + red[2] + red[3]) * (1.f / D) + EPS);
    const float4 gv = ((const float4*)g)[tid], sc = ((const float4*)(mod + (size_t)mr * MODW + scale_idx * D))[tid], sh = ((const float4*)(mod + (size_t)mr * MODW + shift_idx * D))[tid];
    const float y0 = v.x * rstd * gv.x * (1.f + sc.x) + sh.x, y1 = v.y * rstd * gv.y * (1.f + sc.y) + sh.y, y2 = v.z * rstd * gv.z * (1.f + sc.z) + sh.z, y3 = v.w * rstd * gv.w * (1.f + sc.w) + sh.w;
    uint2 o; o.x = pk2(y0, y1); o.y = pk2(y2, y3);
    ((uint2*)(H + (size_t)r * D))[tid] = o;
}
__global__ void k_final(float* __restrict__ xl, const float* __restrict__ g) {
    const int r = blockIdx.x, tid = threadIdx.x; float* x = xl + (size_t)r * D;
    const float4 v = ((const float4*)x)[tid]; float ss = v.x * v.x + v.y * v.y + v.z * v.z + v.w * v.w;
    __shared__ float red[4];
#pragma unroll
    for (int o = 32; o >= 1; o >>= 1) ss += __shfl_xor(ss, o);
    if ((tid & 63) == 0) red[tid >> 6] = ss;
    __syncthreads();
    const float rstd = rsqrtf((red[0] + red[1] + red[2] + red[3]) * (1.f / D) + EPS);
    const float4 gv = ((const float4*)g)[tid];
    ((float4*)x)[tid] = make_float4(v.x * rstd * gv.x, v.y * rstd * gv.y, v.z * rstd * gv.z, v.w * rstd * gv.w);
}

template <class Epi> __global__ void __launch_bounds__(NTHREADS, 2) k_gemm(pg8::Gemm g, Epi E) {
    extern __shared__ __attribute__((aligned(16))) unsigned char lds[];
    pg8::StaticOrder S; S.init(g.M, g.N, (int)gridDim.x, (int)blockIdx.x);
    pg8::gemm_phase<Epi, pg8::StaticOrder, true, true>((PG8_LAS unsigned char*)lds, g, S, E);
}

__global__ void __launch_bounds__(256) k_gates(const bf16* __restrict__ H, const float* __restrict__ w_in  , float* __restrict__ G) {
    const int lane = threadIdx.x & 63, r = blockIdx.x * 4 + (threadIdx.x >> 6);
    float acc[16];
#pragma unroll
    for (int j = 0; j < 16; ++j) acc[j] = 0.f;
    for (int i = 0; i < 16; ++i) { const int k = lane + 64 * i; const float h = bf2f(H[(size_t)r * D + k]); const float4* w = (const float4*)(w_in + (size_t)k * DIN + DU);
#pragma unroll
        for (int q = 0; q < 4; ++q) { const float4 wv = w[q]; acc[4 * q] += h * wv.x; acc[4 * q + 1] += h * wv.y; acc[4 * q + 2] += h * wv.z; acc[4 * q + 3] += h * wv.w; } }
#pragma unroll
    for (int j = 0; j < 16; ++j) {
#pragma unroll
        for (int o = 32; o >= 1; o >>= 1) acc[j] += __shfl_xor(acc[j], o); }
    if (lane == 0) {
#pragma unroll
        for (int j = 0; j < 16; ++j) G[(size_t)r * 16 + j] = acc[j]; }
}

__global__ void k_rope(bf16* __restrict__ U) {
    const int gid = blockIdx.x * 256 + threadIdx.x;
    const int i = gid & 15, hs = (gid >> 4) % 10, r = gid / 160;
    if (r >= TL) return;
    const int n = r % SEQ, prow = n / 64, pcol = n % 64;
    const float inv = powf(10000.f, -(float)i / 16.f);
    const float ar = (float)prow * inv, ac = (float)pcol * inv;
    bf16* base = U + (size_t)r * DU + C_Q + hs * 64;
    const float t1 = bf2f(base[i]), t2 = bf2f(base[16 + i]), t3 = bf2f(base[32 + i]), t4 = bf2f(base[48 + i]);
    const float c1 = cosf(ar), s1 = sinf(ar), c2 = cosf(ac), s2 = sinf(ac);
    base[i] = (bf16)f2bf(t1 * c1 - t2 * s1); base[16 + i] = (bf16)f2bf(t2 * c1 + t1 * s1); base[32 + i] = (bf16)f2bf(t3 * c2 - t4 * s2); base[48 + i] = (bf16)f2bf(t4 * c2 + t3 * s2);
}

__global__ void __launch_bounds__(64) k_attn(const bf16* __restrict__ U, const float* __restrict__ sink, bf16* __restrict__ Y) {
    const int gid = blockIdx.x * 64 + threadIdx.x; const int h = gid & 7, r = gid >> 3;
    if (r >= T) return;
    const int kvh = h >> 2; int b, lo = 0, hi = -1;
    if (r < TL) { b = r / SEQ; const int n = r % SEQ; lo = n - 128 < 0 ? 0 : n - 128; hi = n + 128 > SEQ - 1 ? SEQ - 1 : n + 128; } else b = (r - TL) / CTX;
    float q[64];
    { const bf16* qp = U + (size_t)r * DU + C_Q + h * 64;
#pragma unroll
      for (int d = 0; d < 64; ++d) q[d] = bf2f(qp[d]) * 0.125f; }
    const bf16* kl = U + (size_t)(b * SEQ) * DU + C_K + kvh * 64;
    const bf16* kc = U + (size_t)(TL + b * CTX) * DU + C_K + kvh * 64;
    const float sk = sink[h];
    float m = sk;
    for (int kp = lo; kp <= hi; ++kp) { const bf16* k = kl + (size_t)kp * DU; float s = 0.f;
#pragma unroll
        for (int d = 0; d < 64; ++d) s += q[d] * bf2f(k[d]);
        m = fmaxf(m, s); }
    for (int j = 0; j < CTX; ++j) { const bf16* k = kc + (size_t)j * DU; float s = 0.f;
#pragma unroll
        for (int d = 0; d < 64; ++d) s += q[d] * bf2f(k[d]);
        m = fmaxf(m, s); }
    float o[64]; float l = expf(sk - m);
#pragma unroll
    for (int d = 0; d < 64; ++d) o[d] = 0.f;
    for (int kp = lo; kp <= hi; ++kp) { const bf16* k = kl + (size_t)kp * DU; float s = 0.f;
#pragma unroll
        for (int d = 0; d < 64; ++d) s += q[d] * bf2f(k[d]);
        const float e = expf(s - m); l += e; const bf16* v = k + (C_V - C_K);
#pragma unroll
        for (int d = 0; d < 64; ++d) o[d] += e * bf2f(v[d]); }
    for (int j = 0; j < CTX; ++j) { const bf16* k = kc + (size_t)j * DU; float s = 0.f;
#pragma unroll
        for (int d = 0; d < 64; ++d) s += q[d] * bf2f(k[d]);
        const float e = expf(s - m); l += e; const bf16* v = k + (C_V - C_K);
#pragma unroll
        for (int d = 0; d < 64; ++d) o[d] += e * bf2f(v[d]); }
    const float il = 1.f / l; bf16* yp = Y + (size_t)r * D + 256 + h * 64;
#pragma unroll
    for (int d = 0; d < 64; ++d) yp[d] = (bf16)f2bf(o[d] * il);
}

__global__ void k_four_ch(const bf16* __restrict__ U, float* __restrict__ AB) {
    __shared__ float ct[64], st[64];
    const int tid = threadIdx.x;
    if (tid < 64) { ct[tid] = (float)cos(2.0 * 3.14159265358979323846 * tid / 64.0); st[tid] = (float)sin(2.0 * 3.14159265358979323846 * tid / 64.0); }
    __syncthreads();
    const int r = blockIdx.x, g = tid >> 6, m = tid & 63;
    const bf16* u = U + (size_t)r * DU + C_AX + g * 64; float a = 0.f, bsum = 0.f;
    for (int c = 0; c < 64; ++c) { const float v = bf2f(u[c]); const int idx = (m * c) & 63; a += v * ct[idx]; bsum += v * st[idx]; }
    AB[(size_t)r * 512 + g * 128 + m] = a; AB[(size_t)r * 512 + g * 128 + 64 + m] = bsum;
}
template <int N> __global__ void __launch_bounds__(256) k_four_pos(const float* __restrict__ AB, float* __restrict__ F, int row_base) {
    __shared__ float ct[N], st[N];
    const int tid = threadIdx.x;
    for (int i = tid; i < N; i += 256) { ct[i] = (float)cos(2.0 * 3.14159265358979323846 * i / (double)N); st[i] = (float)sin(2.0 * 3.14159265358979323846 * i / (double)N); }
    __syncthreads();
    const int seq = blockIdx.y, k0 = blockIdx.x * 4, g = tid >> 6, m = tid & 63;
    const float* ab = AB + (size_t)(row_base + seq * N) * 512 + g * 128 + m;
    float acc[4] = {0.f, 0.f, 0.f, 0.f};
    for (int n = 0; n < N; ++n) { const float a = ab[(size_t)n * 512], bb = ab[(size_t)n * 512 + 64];
#pragma unroll
        for (int kk = 0; kk < 4; ++kk) { const int idx = ((k0 + kk) * n) & (N - 1); acc[kk] += ct[idx] * a - st[idx] * bb; } }
    const float sc = rsqrtf(64.f * (float)N);
#pragma unroll
    for (int kk = 0; kk < 4; ++kk) F[(size_t)(row_base + seq * N + k0 + kk) * 256 + g * 64 + m] = acc[kk] * sc;
}
__global__ void k_four_mix(const float* __restrict__ F, const float* __restrict__ wf, bf16* __restrict__ Y) {
    const int r = blockIdx.x, tid = threadIdx.x, g = tid >> 6, e = tid & 63;
    const float* f = F + (size_t)r * 256 + g * 64; const float* w = wf + (size_t)g * 4096 + e; float a = 0.f;
    for (int c = 0; c < 64; ++c) a += f[c] * w[c * 64];
    Y[(size_t)r * D + g * 64 + e] = (bf16)f2bf(a);
}

__global__ void __launch_bounds__(256) k_mlstm_scan(const bf16* __restrict__ U, const float* __restrict__ G, const float* __restrict__ conv, const float* __restrict__ b_i, const float* __restrict__ b_f, float* __restrict__ HS) {
    extern __shared__ float sm[];
    float* qs = sm; float* ks = qs + 4096; float* vs = ks + 4096; float* Cs = vs + 4096; float* Ss = Cs + 4096; float* nv = Ss + 4096;
    float* li = nv + 64; float* lf = li + 64; float* bc = lf + 64; float* mt = bc + 64; float* wp = mt + 64; float* den = wp + 64; float* wsv = den + 64; float* sc = wsv + 64;
    const int tid = threadIdx.x; const int dir = blockIdx.x & 1, h = (blockIdx.x >> 1) & 3, b = blockIdx.x >> 3;
    for (int i = tid; i < 4096; i += 256) Cs[i] = 0.f;
    if (tid < 64) nv[tid] = 0.f;
    if (tid == 0) sc[0] = 0.f;
    __syncthreads();
    const float bi = b_i[dir * 4 + h], bff = b_f[dir * 4 + h];
    for (int ch = 0; ch < 4 + 64; ++ch) {
        const bool isctx = ch < 4; const int N = isctx ? CTX : SEQ; const int c = isctx ? ch : ch - 4; const int rb = isctx ? TL + b * CTX : b * SEQ;
        { const int t = tid >> 2, dg = (tid & 3) * 16; const int p = dir == 0 ? c * 64 + t : N - 1 - c * 64 - t; const bf16* u0 = U + (size_t)(rb + p) * DU;
#pragma unroll
          for (int dd = 0; dd < 16; ++dd) { const int d = dg + dd; const int cq = h * 64 + d, ck = 256 + h * 64 + d;
              float aq = bf2f(u0[C_MQ + h * 64 + d]) * conv[512 + cq], ak = bf2f(u0[C_MK + h * 64 + d]) * conv[512 + ck];
              if (p > 0) { aq += bf2f(u0[-DU + C_MQ + h * 64 + d]) * conv[cq]; ak += bf2f(u0[-DU + C_MK + h * 64 + d]) * conv[ck]; }
              if (p < N - 1) { aq += bf2f(u0[DU + C_MQ + h * 64 + d]) * conv[1024 + cq]; ak += bf2f(u0[DU + C_MK + h * 64 + d]) * conv[1024 + ck]; }
              qs[t * 64 + d] = silu_f(aq); ks[t * 64 + d] = silu_f(ak) * 0.125f; vs[t * 64 + d] = bf2f(u0[C_MV + h * 64 + d]); }
          if ((tid & 3) == 0) { const float* g0 = G + (size_t)(rb + p) * 16; li[t] = g0[dir * 4 + h] + bi; lf[t] = logsigmoid_f(g0[8 + dir * 4 + h] + bff); } }
        __syncthreads();
        if (tid == 0) { float s = 0.f; for (int t = 0; t < 64; ++t) { s += lf[t]; bc[t] = s; } }
        __syncthreads();
        const float m = sc[0];
        if (tid < 64) { const int t = tid; float mx = bc[t] + m; for (int s = 0; s <= t; ++s) mx = fmaxf(mx, bc[t] - bc[s] + li[s]); mt[t] = mx; wp[t] = expf(bc[t] + m - mx); }
        if (tid == 64) { const float bl = bc[63]; float mx = bl + m; for (int s = 0; s < 64; ++s) mx = fmaxf(mx, bl - bc[s] + li[s]); sc[1] = mx; sc[2] = expf(bl + m - mx); }
        __syncthreads();
        if (tid < 64) wsv[tid] = expf(bc[63] - bc[tid] + li[tid] - sc[1]);
        for (int e = tid; e < 4096; e += 256) { const int t = e >> 6, s = e & 63; float v = 0.f;
            if (s <= t) { float dot = 0.f; for (int d = 0; d < 64; ++d) dot += qs[t * 64 + d] * ks[s * 64 + d]; v = dot * expf(bc[t] - bc[s] + li[s] - mt[t]); }
            Ss[e] = v; }
        __syncthreads();
        if (tid < 64) { const int t = tid; float s1 = 0.f, s2 = 0.f; for (int s = 0; s < 64; ++s) s1 += Ss[t * 64 + s]; for (int k = 0; k < 64; ++k) s2 += qs[t * 64 + k] * nv[k]; den[t] = s1 + wp[t] * s2; }
        __syncthreads();
        for (int e = tid; e < 4096; e += 256) { const int t = e >> 6, v = e & 63; float a = 0.f, c2 = 0.f;
            for (int s = 0; s < 64; ++s) a += Ss[t * 64 + s] * vs[s * 64 + v];
            for (int k = 0; k < 64; ++k) c2 += Cs[v * 64 + k] * qs[t * 64 + k];
            const float num = a + wp[t] * c2; const float dn = fmaxf(fabsf(den[t]), expf(-mt[t]));
            const int p = dir == 0 ? c * 64 + t : N - 1 - c * 64 - t;
            HS[((size_t)dir * T + rb + p) * 256 + h * 64 + v] = num / dn; }
        __syncthreads();
        { const float decay = sc[2];
          for (int e = tid; e < 4096; e += 256) { const int v = e >> 6, k = e & 63; float a = 0.f; for (int s = 0; s < 64; ++s) a += wsv[s] * vs[s * 64 + v] * ks[s * 64 + k]; Cs[e] = decay * Cs[e] + a; }
          if (tid < 64) { float a = 0.f; for (int s = 0; s < 64; ++s) a += wsv[s] * ks[s * 64 + tid]; nv[tid] = decay * nv[tid] + a; }
          if (tid == 0) sc[0] = sc[1]; }
        __syncthreads();
    }
}
__global__ void k_mlstm_out(const bf16* __restrict__ U, const float* __restrict__ HS, bf16* __restrict__ Y) {
    const int r = blockIdx.x, c = threadIdx.x;
    const float v = sigmoid_f(bf2f(U[(size_t)r * DU + C_MO + c])) * (HS[(size_t)r * 256 + c] + HS[((size_t)T + r) * 256 + c]);
    Y[(size_t)r * D + 768 + c] = (bf16)f2bf(fminf(fmaxf(v, -60000.f), 60000.f));
}
}

extern "C" void kernel_launch(void* const* d_in, const int* in_sizes, int n_in, void* d_out, int out_size, void* d_ws, size_t ws_size, hipStream_t stream) {
    const float* x = (const float*)d_in[0]; const float* c = (const float*)d_in[1]; const float* ctx = (const float*)d_in[2]; const float* c_ctx = (const float*)d_in[3];
    const float* w_ada = (const float*)d_in[4]; const float* b_ada = (const float*)d_in[5]; const float* norm_g = (const float*)d_in[6];
    const float* w_ffn_in = (const float*)d_in[7]; const float* w_ffn_out = (const float*)d_in[8]; const float* w_in = (const float*)d_in[9]; const float* w_out = (const float*)d_in[10];
    const float* w_fourier = (const float*)d_in[11]; const float* attn_sink = (const float*)d_in[12]; const float* conv_qk = (const float*)d_in[13];
    const float* b_gate_i = (const float*)d_in[14]; const float* b_gate_f = (const float*)d_in[15]; const float* g_final = (const float*)d_in[16];
    unsigned char* ws = (unsigned char*)d_ws; size_t off = 1u << 20;
    auto take = [&](size_t bytes) { unsigned char* p = ws + off; off += (bytes + 255) & ~(size_t)255; return p; };
    float* MOD = (float*)take((size_t)DEPTH * NR * MODW * 4);
    bf16* Wi_t = (bf16*)take((size_t)4 * 2 * DFF * D * 2);
    bf16* Wo_t = (bf16*)take((size_t)4 * D * DFF * 2);
    bf16* Win_t = (bf16*)take((size_t)2 * DU * D * 2);
    bf16* Wout_t = (bf16*)take((size_t)2 * D * D * 2);
    float* XC = (float*)take((size_t)TC * D * 4);
    float* G = (float*)take((size_t)T * 16 * 4);
    bf16* HB = (bf16*)take((size_t)T * D * 2);
    bf16* Y = (bf16*)take((size_t)T * D * 2);
    unsigned char* R = take((size_t)T * DFF * 2);
    if (off > ws_size) { fprintf(stderr, "kernel_launch: workspace too small: need %zu have %zu\n", off, ws_size); return; }
    float* HS = (float*)HB; bf16* HID = (bf16*)R; bf16* U = (bf16*)R; float* F = (float*)(R + (size_t)T * DU * 2);
    static bool attr_done = false;
    constexpr int SCAN_LDS = (5 * 4096 + 9 * 64) * 4;
    if (!attr_done) {
        (void)hipFuncSetAttribute((const void*)k_mlstm_scan, hipFuncAttributeMaxDynamicSharedMemorySize, SCAN_LDS);
        (void)hipFuncSetAttribute((const void*)k_prologue, hipFuncAttributeMaxDynamicSharedMemorySize, GEMM_LDS);
        (void)hipFuncSetAttribute((const void*)k_gemm<pg8::EpiSwiglu>, hipFuncAttributeMaxDynamicSharedMemorySize, GEMM_LDS);
        (void)hipFuncSetAttribute((const void*)k_gemm<pg8::EpiResid>, hipFuncAttributeMaxDynamicSharedMemorySize, GEMM_LDS);
        (void)hipFuncSetAttribute((const void*)k_gemm<pg8::EpiBf16Plain>, hipFuncAttributeMaxDynamicSharedMemorySize, GEMM_LDS);
        attr_done = true; }
    Ptrs p{(float*)d_out, XC};
    constexpr int GRID = 256;
    k_mod<<<dim3(MODW / 256, DEPTH), 256, 0, stream>>>(c, c_ctx, w_ada, b_ada, MOD);
    { ProArgs a{x, ctx, w_ffn_in, w_ffn_out, w_in, w_out, Wi_t, Wo_t, Win_t, Wout_t, p.xl, p.xc}; k_prologue<<<GRID, NTHREADS, GEMM_LDS, stream>>>(a); }
    for (int l = 0; l < DEPTH; ++l) {
        const float* mod = MOD + (size_t)l * NR * MODW; const float* ng = norm_g + (size_t)l * 3 * D;
        auto ffn = [&](int sub, int f) {
            k_normmod<<<T, 256, 0, stream>>>(p, ng + sub * D, mod, 3 * sub, 3 * sub + 1, HB);
            { pg8::Gemm g{HB, Wi_t + (size_t)(l * 2 + f) * 2 * DFF * D, T, 2 * DFF, D}; pg8::EpiSwiglu E{HID, DFF}; k_gemm<pg8::EpiSwiglu><<<GRID, NTHREADS, GEMM_LDS, stream>>>(g, E); }
            { pg8::Gemm g{HID, Wo_t + (size_t)(l * 2 + f) * D * DFF, T, D, DFF}; pg8::EpiResid E{p.xl, p.xc, TL, SEQ / 256, mod, MODW, (3 * sub + 2) * D, 0.5f}; k_gemm<pg8::EpiResid><<<GRID, NTHREADS, GEMM_LDS, stream>>>(g, E); }
        };
        ffn(0, 0);
        k_normmod<<<T, 256, 0, stream>>>(p, ng + 1 * D, mod, 3, 4, HB);
        { pg8::Gemm g{HB, Win_t + (size_t)l * DU * D, T, DU, D}; pg8::EpiBf16Plain E{U, DU}; k_gemm<pg8::EpiBf16Plain><<<GRID, NTHREADS, GEMM_LDS, stream>>>(g, E); }
        k_gates<<<T / 4, 256, 0, stream>>>(HB, w_in + (size_t)l * D * DIN, G);
        k_rope<<<(TL * 160 + 255) / 256, 256, 0, stream>>>(U);
        k_attn<<<(T * 8 + 63) / 64, 64, 0, stream>>>(U, attn_sink + l * 8, Y);
        k_four_ch<<<T, 256, 0, stream>>>(U, HS);
        k_four_pos<SEQ><<<dim3(SEQ / 4, NB), 256, 0, stream>>>(HS, F, 0);
        k_four_pos<CTX><<<dim3(CTX / 4, NB), 256, 0, stream>>>(HS, F, TL);
        k_four_mix<<<T, 256, 0, stream>>>(F, w_fourier + (size_t)l * 4 * 4096, Y);
        k_mlstm_scan<<<32, 256, SCAN_LDS, stream>>>(U, G, conv_qk + (size_t)l * 3 * 512, b_gate_i + l * 8, b_gate_f + l * 8, HS);
        k_mlstm_out<<<T, 256, 0, stream>>>(U, HS, Y);
        { pg8::Gemm g{Y, Wout_t + (size_t)l * D * D, T, D, D}; pg8::EpiResid E{p.xl, p.xc, TL, SEQ / 256, mod, MODW, 5 * D, 1.0f}; k_gemm<pg8::EpiResid><<<GRID, NTHREADS, GEMM_LDS, stream>>>(g, E); }
        ffn(2, 1);
    }
    k_final<<<TL, 256, 0, stream>>>((float*)d_out, g_final);
}
```

```cpp
#include <hip/hip_runtime.h>
#include <cstdio>
#include <cstdint>
namespace pg8 {
#define PG8_LAS __attribute__((address_space(3)))
typedef unsigned short bf16_t;
typedef short bf16x8 __attribute__((ext_vector_type(8)));
typedef float f32x4 __attribute__((ext_vector_type(4)));
typedef unsigned u32x4 __attribute__((ext_vector_type(4)));
typedef _Float16 half8 __attribute__((ext_vector_type(8)));
constexpr int BM = 256, BK = 64, HALF = 128, HTB = HALF * BK * 2  , STAGE_BYTES = 8 * HTB, NXCD = 8, WGM = 8;

__host__ __device__ __forceinline__ int lds_byte(int r, int c) { const int st = (r >> 4) * 2 + (c >> 5), rr = r & 15, cc = c & 31, ob = rr * 64 + cc * 2; return st * 1024 + (ob ^ (((ob >> 9) & 1) << 5)); }
__host__ __device__ __forceinline__ void stage_rc(int b, int& R, int& C) { const int st = b / 1024, sb = b % 1024, swz = sb ^ (((sb >> 9) & 1) << 5); R = (st >> 1) * 16 + swz / 64; C = (st & 1) * 32 + (swz % 64) / 2; }
__host__ __device__ __forceinline__ int perm32(int rho) { const int n = rho >> 4, i = rho & 15; return 8 * (i >> 2) + 4 * n + (i & 3); }

struct Unit { int pm, pn; };
struct Gemm { const bf16_t* A; const bf16_t* Bt; int M, N, K; };

struct StaticOrder {
    int nM, nN, nwg, G, c;
    __host__ __device__ void init(int M, int N, int G_, int c_) { nM = M / BM; nN = N / BM; nwg = nM * nN; G = G_; c = c_; }
    __host__ __device__ bool next(int i, Unit& u) const {
        const long L = (long)i * G + c; if (L >= nwg) return false;
        int wgid = (int)L; { const int q = nwg / NXCD, r = nwg % NXCD, xcd = wgid % NXCD, off = wgid / NXCD; wgid = (xcd < r ? xcd * (q + 1) : r * (q + 1) + (xcd - r) * q) + off; }
        const int nig = WGM * nN, gid = wgid / nig, fm = gid * WGM, gsz = (nM - fm) < WGM ? (nM - fm) : WGM;
        u.pm = fm + ((wgid % nig) % gsz); u.pn = (wgid % nig) / gsz; return true;
    }
    __device__ __forceinline__ void a_ready(const Unit&) const {}
    __device__ __forceinline__ void done(const Unit&) const {}
};

__device__ __forceinline__ unsigned cvt_pk_bf16(float lo, float hi) { typedef float f2_t __attribute__((ext_vector_type(2))); typedef _Float16 h2_t __attribute__((ext_vector_type(2))); const f2_t v = {lo, hi}; return __builtin_bit_cast(unsigned, __builtin_convertvector(v, h2_t)); }
__device__ __forceinline__ float silu_fast(float x) { return x * __builtin_amdgcn_rcpf(1.f + __expf(-x)); }
struct EpiBf16Plain {
    static constexpr bool PERM = true, AFTER_DRAIN = false;
    bf16_t* O; int ldc;
    __device__ __forceinline__ void operator()(const f32x4 (&acc)[2][2][4][2], const Unit& u, int wr, int wc, int fr, int fq) const {
        const int row0 = u.pm * BM + wr * 64 + fr, col0 = u.pn * BM + wc * 32 + 8 * fq;
#pragma unroll
        for (int ai = 0; ai < 2; ++ai)
#pragma unroll
            for (int m = 0; m < 4; ++m) { bf16_t* rowp = O + (size_t)(row0 + ai * HALF + m * 16) * ldc + col0;
#pragma unroll
                for (int bj = 0; bj < 2; ++bj) { const f32x4 v0 = acc[ai][bj][m][0], v1 = acc[ai][bj][m][1];
                    u32x4 w; w.x = cvt_pk_bf16(v0[0], v0[1]); w.y = cvt_pk_bf16(v0[2], v0[3]); w.z = cvt_pk_bf16(v1[0], v1[1]); w.w = cvt_pk_bf16(v1[2], v1[3]);
                    *(u32x4*)(rowp + bj * HALF) = w; } }
    }
};
struct EpiSwiglu {
    static constexpr bool PERM = true, AFTER_DRAIN = false;
    bf16_t* O; int ldc;
    __device__ __forceinline__ void operator()(const f32x4 (&acc)[2][2][4][2], const Unit& u, int wr, int wc, int fr, int fq) const {
        const int row0 = u.pm * BM + wr * 64 + fr, col0 = u.pn * HALF + wc * 32 + 8 * fq;
#pragma unroll
        for (int ai = 0; ai < 2; ++ai)
#pragma unroll
            for (int m = 0; m < 4; ++m) { bf16_t* rowp = O + (size_t)(row0 + ai * HALF + m * 16) * ldc + col0;
                f32x4 h0, h1;
#pragma unroll
                for (int i = 0; i < 4; ++i) { h0[i] = silu_fast(acc[ai][0][m][0][i]) * acc[ai][1][m][0][i]; h1[i] = silu_fast(acc[ai][0][m][1][i]) * acc[ai][1][m][1][i]; }
                u32x4 w; w.x = cvt_pk_bf16(h0[0], h0[1]); w.y = cvt_pk_bf16(h0[2], h0[3]); w.z = cvt_pk_bf16(h1[0], h1[1]); w.w = cvt_pk_bf16(h1[2], h1[3]);
                *(u32x4*)rowp = w; }
    }
};
struct EpiResid {
    static constexpr bool PERM = false, AFTER_DRAIN = false;
    float* xl; float* xc; int tl_rows; int panels_per_batch; const float* mod; int mod_stride; int gate_off; float coef;
    __device__ __forceinline__ void operator()(const f32x4 (&acc)[2][2][4][2], const Unit& u, int wr, int wc, int fr, int fq) const {
        const int prow = u.pm * BM; const bool lat = prow < tl_rows;
        float* base = lat ? xl + (size_t)prow * 1024 : xc + (size_t)(prow - tl_rows) * 1024;
        const int mr = lat ? u.pm / panels_per_batch : 4;
        const float* gate = mod + (size_t)mr * mod_stride + gate_off;
        const int row0 = wr * 64 + fr, col0 = u.pn * BM + wc * 32 + 4 * fq;
        f32x4 gv[2][2];
#pragma unroll
        for (int bj = 0; bj < 2; ++bj)
#pragma unroll
            for (int n = 0; n < 2; ++n) gv[bj][n] = *(const f32x4*)(gate + col0 + bj * HALF + n * 16) * coef;
#pragma unroll
        for (int ai = 0; ai < 2; ++ai)
#pragma unroll
            for (int m = 0; m < 4; ++m) { float* rowp = base + (size_t)(row0 + ai * HALF + m * 16) * 1024 + col0;
#pragma unroll
                for (int bj = 0; bj < 2; ++bj)
#pragma unroll
                    for (int n = 0; n < 2; ++n) { f32x4* p = (f32x4*)(rowp + bj * HALF + n * 16); *p = *p + gv[bj][n] * acc[ai][bj][m][n]; } }
    }
};
template <class Epi, class Sched, bool ALIGN_EPI = false, bool SP2 = false>
__device__ __forceinline__ void gemm_phase(PG8_LAS unsigned char* lds, const Gemm g, const Sched& S, const Epi& E, const int tid  ) {
    const int wid = __builtin_amdgcn_readfirstlane(tid >> 6), lane = tid & 63, wr = wid >> 2, wc = wid & 3, fr = lane & 15, fq = lane >> 4;
    const int K = g.K, nt = K / BK;
    unsigned voffA[2], voffB[2];
#pragma unroll
    for (int i = 0; i < 2; ++i) { int R, C; stage_rc(tid * 16 + i * 8192, R, C); const int Rb = Epi::PERM ? ((R & ~31) + perm32(R & 31)) : R;
        voffA[i] = (unsigned)(R * K + C) * 2u; voffB[i] = (unsigned)(Rb * K + C) * 2u; }
    const size_t kstep = (size_t)(BK * 2);
    const size_t hstep = (size_t)HALF * K * 2;
    const size_t tstep = 2 * hstep;
    const unsigned ldsw = (unsigned)wid * 1024u;
    const int aoff = lds_byte(wr * 64 + fr, fq * 8), boff = lds_byte(wc * 32 + fr, fq * 8);
#define PG8_SA(b, h) (((b) * 2 + (h)) * HTB)
#define PG8_SB(b, h) ((4 + (b) * 2 + (h)) * HTB)
#define PG8_STAGE(bufoff, gbase, voff) do { _Pragma("unroll") for (int _i = 0; _i < 2; ++_i) \
        __builtin_amdgcn_global_load_lds((const unsigned*)((const char*)(gbase) + (voff)[_i]), (PG8_LAS unsigned*)(lds + (bufoff) + ldsw + _i * 8192), 16, 0, 0); } while (0)
#define PG8_LDA(dst, b, h) do { _Pragma("unroll") for (int m = 0; m < 4; ++m) _Pragma("unroll") for (int k = 0; k < 2; ++k) dst[m][k] = *(const PG8_LAS bf16x8*)(lds + PG8_SA(b, h) + aoff + m * 2048 + k * 1024); } while (0)
#define PG8_LDB(dst, b, h) do { _Pragma("unroll") for (int n = 0; n < 2; ++n) _Pragma("unroll") for (int k = 0; k < 2; ++k) dst[n][k] = *(const PG8_LAS bf16x8*)(lds + PG8_SB(b, h) + boff + n * 2048 + k * 1024); } while (0)
#define PG8_MMA(ai, bj, At, Bt) do { __builtin_amdgcn_s_setprio(1); _Pragma("unroll") for (int m = 0; m < 4; ++m) _Pragma("unroll") for (int n = 0; n < 2; ++n) _Pragma("unroll") for (int k = 0; k < 2; ++k) \
        acc[ai][bj][m][n] = __builtin_amdgcn_mfma_f32_16x16x32_f16(__builtin_bit_cast(half8, Bt[n][k]), __builtin_bit_cast(half8, At[m][k]), acc[ai][bj][m][n], 0, 0, 0); __builtin_amdgcn_s_setprio(0); } while (0)
#define PG8_WAIT_V(n) asm volatile("s_waitcnt vmcnt(" #n ")" ::: "memory")
#define PG8_WAIT_L(n) asm volatile("s_waitcnt lgkmcnt(" #n ")" ::: "memory")
#define PG8_BAR __builtin_amdgcn_s_barrier()
#define PG8_SCHED __builtin_amdgcn_sched_barrier(0)
    Unit cur, nxt; int ui = 0;
    if (!S.next(0, cur)) return;
    f32x4 acc[2][2][4][2];
#pragma unroll
    for (int a = 0; a < 2; ++a)
#pragma unroll
        for (int b = 0; b < 2; ++b)
#pragma unroll
            for (int m = 0; m < 4; ++m)
#pragma unroll
                for (int n = 0; n < 2; ++n) acc[a][b][m][n] = (f32x4){0.f, 0.f, 0.f, 0.f};
    bf16x8 At[4][2], B0[2][2], B1[2][2];
    const char* cA = (const char*)g.A + (size_t)cur.pm * tstep; const char* cB = (const char*)g.Bt + (size_t)cur.pn * tstep;
    S.a_ready(cur);
    if constexpr (SP2) {
        PG8_STAGE(PG8_SB(0, 0), cB, voffB); PG8_STAGE(PG8_SB(0, 1), cB + hstep, voffB); PG8_STAGE(PG8_SA(0, 0), cA, voffA); PG8_STAGE(PG8_SA(0, 1), cA + hstep, voffA);
        if (wr == 1) PG8_BAR;
        PG8_WAIT_V(2); PG8_BAR;
        PG8_STAGE(PG8_SB(1, 0), cB + kstep, voffB); PG8_STAGE(PG8_SA(1, 0), cA + kstep, voffA); PG8_STAGE(PG8_SB(1, 1), cB + hstep + kstep, voffB);
        PG8_WAIT_V(6); PG8_BAR;
    } else {
        PG8_STAGE(PG8_SB(0, 0), cB, voffB); PG8_STAGE(PG8_SA(0, 0), cA, voffA); PG8_STAGE(PG8_SB(0, 1), cB + hstep, voffB); PG8_STAGE(PG8_SA(0, 1), cA + hstep, voffA);
        if (wr == 1) PG8_BAR;
        PG8_WAIT_V(4); PG8_BAR;
        PG8_STAGE(PG8_SB(1, 0), cB + kstep, voffB); PG8_STAGE(PG8_SA(1, 0), cA + kstep, voffA); PG8_STAGE(PG8_SB(1, 1), cB + hstep + kstep, voffB);
        PG8_WAIT_V(6); PG8_BAR;
    }
    for (;;) {
        const bool has_next = S.next(ui + 1, nxt);
        const char* nA = has_next ? (const char*)g.A + (size_t)nxt.pm * tstep : cA; const char* nB = has_next ? (const char*)g.Bt + (size_t)nxt.pn * tstep : cB;
        for (int t = 0; t < nt; t += 2) {
            const bool last = (t == nt - 2);
            const char* a1 = cA + (size_t)(t + 1) * kstep;
            const char* a2 = last ? nA : cA + (size_t)(t + 2) * kstep; const char* b2 = last ? nB : cB + (size_t)(t + 2) * kstep;
            const char* a3 = a2 + kstep; const char* b3 = b2 + kstep;
            if (last && has_next) S.a_ready(nxt);
            if constexpr (SP2) {
            PG8_LDB(B0, 0, 0); PG8_LDB(B1, 0, 1); PG8_SCHED; PG8_LDA(At, 0, 0); PG8_STAGE(PG8_SA(1, 1), a1 + hstep, voffA);
            PG8_WAIT_V(8); PG8_WAIT_L(0); PG8_BAR; PG8_MMA(0, 0, At, B0); PG8_MMA(0, 1, At, B1); PG8_BAR; PG8_SCHED;
            PG8_LDA(At, 0, 1); PG8_STAGE(PG8_SB(0, 0), b2, voffB); PG8_STAGE(PG8_SB(0, 1), b2 + hstep, voffB); PG8_STAGE(PG8_SA(0, 0), a2, voffA);
            PG8_WAIT_V(8); PG8_WAIT_L(0); PG8_BAR; PG8_MMA(1, 0, At, B0); PG8_MMA(1, 1, At, B1); PG8_BAR; PG8_SCHED;
            PG8_LDB(B0, 1, 0); PG8_LDB(B1, 1, 1); PG8_SCHED; PG8_LDA(At, 1, 0); PG8_STAGE(PG8_SA(0, 1), a2 + hstep, voffA);
            PG8_WAIT_V(8); PG8_WAIT_L(0); PG8_BAR; PG8_MMA(0, 0, At, B0); PG8_MMA(0, 1, At, B1); PG8_BAR; PG8_SCHED;
            PG8_LDA(At, 1, 1); PG8_STAGE(PG8_SB(1, 0), b3, voffB); PG8_STAGE(PG8_SB(1, 1), b3 + hstep, voffB); PG8_STAGE(PG8_SA(1, 0), a3, voffA);
            PG8_WAIT_V(8); PG8_WAIT_L(0); PG8_BAR; PG8_MMA(1, 0, At, B0); PG8_MMA(1, 1, At, B1); PG8_BAR; PG8_SCHED;
            } else {
            PG8_LDB(B0, 0, 0); PG8_SCHED; PG8_LDA(At, 0, 0); PG8_STAGE(PG8_SA(1, 1), a1 + hstep, voffA);
            PG8_WAIT_L(8); PG8_BAR; PG8_WAIT_L(0); PG8_MMA(0, 0, At, B0); PG8_BAR; PG8_SCHED;
            PG8_LDB(B1, 0, 1); PG8_STAGE(PG8_SB(0, 0), b2, voffB);
            PG8_BAR; PG8_WAIT_L(0); PG8_MMA(0, 1, At, B1); PG8_BAR;
            PG8_LDA(At, 0, 1); PG8_STAGE(PG8_SA(0, 0), a2, voffA);
            PG8_BAR; PG8_WAIT_L(0); PG8_MMA(1, 0, At, B0); PG8_BAR; PG8_SCHED;
            PG8_STAGE(PG8_SB(0, 1), b2 + hstep, voffB);
            PG8_WAIT_V(6); PG8_BAR; PG8_MMA(1, 1, At, B1); PG8_BAR;
            PG8_LDB(B0, 1, 0); PG8_SCHED; PG8_LDA(At, 1, 0); PG8_STAGE(PG8_SA(0, 1), a2 + hstep, voffA);
            PG8_WAIT_L(8); PG8_BAR; PG8_WAIT_L(0); PG8_MMA(0, 0, At, B0); PG8_BAR; PG8_SCHED;
            PG8_LDB(B1, 1, 1); PG8_STAGE(PG8_SB(1, 0), b3, voffB);
            PG8_BAR; PG8_WAIT_L(0); PG8_MMA(0, 1, At, B1); PG8_BAR;
            PG8_LDA(At, 1, 1); PG8_STAGE(PG8_SA(1, 0), a3, voffA);
            PG8_BAR; PG8_WAIT_L(0); PG8_MMA(1, 0, At, B0); PG8_BAR; PG8_SCHED;
            PG8_STAGE(PG8_SB(1, 1), b3 + hstep, voffB);
            PG8_WAIT_V(6); PG8_BAR; PG8_MMA(1, 1, At, B1); PG8_BAR;
            }
        }
        if constexpr (ALIGN_EPI) { if (wr == 0) PG8_BAR; }
        if constexpr (!Epi::AFTER_DRAIN) { E(acc, cur, wr, wc, fr, fq); S.done(cur); }
        if (!has_next) break;
#pragma unroll
        for (int a = 0; a < 2; ++a)
#pragma unroll
            for (int b = 0; b < 2; ++b)
#pragma unroll
                for (int m = 0; m < 4; ++m)
#pragma unroll
                    for (int n = 0; n < 2; ++n) acc[a][b][m][n] = (f32x4){0.f, 0.f, 0.f, 0.f};
        cur = nxt; cA = nA; cB = nB; ++ui;
        if constexpr (ALIGN_EPI) { if (wr == 1) PG8_BAR; }
    }
    PG8_WAIT_V(0);
    if constexpr (!ALIGN_EPI) { if (wr == 0) PG8_BAR; }
    PG8_BAR;
    if constexpr (Epi::AFTER_DRAIN) { E.fused(acc, cur, wr, wc, fr, fq, lds, wid, lane); S.done(cur); }
#undef PG8_SA
#undef PG8_SB
#undef PG8_STAGE
#undef PG8_LDA
#undef PG8_LDB
#undef PG8_MMA
#undef PG8_WAIT_V
#undef PG8_WAIT_L
#undef PG8_BAR
#undef PG8_SCHED
}
}

namespace {
#define LAS __attribute__((address_space(3)))
#define GAS __attribute__((address_space(1)))
typedef unsigned short bf16;
typedef unsigned v4u __attribute__((ext_vector_type(4)));
typedef GAS unsigned gu32;
constexpr int D = 1024, NB = 4, SEQ = 4096, CTX = 256, DEPTH = 2;
constexpr int TL = NB * SEQ, TC = NB * CTX, T = TL + TC;
constexpr int DFF = 2816, DIN = 2064, DU = 2048, NMOD = 9, MODW = NMOD * D;
constexpr int NR = NB + 1;
constexpr float EPS = 1e-6f;
constexpr int C_AX = 0, C_Q = 256, C_K = 768, C_V = 896, C_MQ = 1024, C_MK = 1280, C_MV = 1536, C_MO = 1792;
constexpr int NWAVES = 8, NTHREADS = 512;
constexpr int RING_BYTES = 131072, MISC_OFF = RING_BYTES, LDS_BYTES = 147456;
constexpr size_t al256(size_t x) { return (x + 255) & ~(size_t)255; }
constexpr size_t WS_CTL = 0, CTL_ZERO_BYTES = 65536;
constexpr int CW_BAR = 1024;
constexpr size_t WS_MOD = 1u << 20;
constexpr size_t WS_WI = al256(WS_MOD + (size_t)DEPTH * NR * MODW * 4);
constexpr size_t WS_WO = al256(WS_WI + (size_t)4 * 2 * DFF * D * 2);
constexpr size_t WS_WIN = al256(WS_WO + (size_t)4 * D * DFF * 2);
constexpr size_t WS_WOUT = al256(WS_WIN + (size_t)2 * DU * D * 2);
constexpr size_t WS_XC = al256(WS_WOUT + (size_t)2 * D * D * 2);
constexpr size_t WS_G = al256(WS_XC + (size_t)TC * D * 4);
constexpr size_t WS_HB = al256(WS_G + (size_t)T * 16 * 4);
constexpr size_t WS_Y = al256(WS_HB + (size_t)T * D * 2);
constexpr size_t WS_R = al256(WS_Y + (size_t)T * D * 2);
constexpr size_t WS_HS = al256(WS_R + (size_t)T * DFF * 2);
constexpr size_t WS_END = al256(WS_HS + (size_t)2 * T * 256 * 4);

struct Ptrs { float* xl; float* xc; };
__device__ __forceinline__ int mod_row(int r) { return r < TL ? r / SEQ : NB; }
__device__ __forceinline__ float* xrow(const Ptrs& p, int r) { return r < TL ? p.xl + (size_t)r * D : p.xc + (size_t)(r - TL) * D; }
__device__ __forceinline__ float silu_f(float x) { return x / (1.f + expf(-x)); }
__device__ __forceinline__ float sigmoid_f(float x) { return 1.f / (1.f + expf(-x)); }
__device__ __forceinline__ float logsigmoid_f(float x) { return fminf(x, 0.f) - log1pf(expf(-fabsf(x))); }
__device__ __forceinline__ float bf2f(bf16 b) { return (float)__builtin_bit_cast(_Float16, b); }
__device__ __forceinline__ unsigned f2bf(float f) { return (unsigned)__builtin_bit_cast(unsigned short, (_Float16)f); }
__device__ __forceinline__ unsigned pk2(float lo, float hi) { return f2bf(lo) | (f2bf(hi) << 16); }
__device__ __forceinline__ float wave_sum(float v) {
#pragma unroll
    for (int o = 1; o < 64; o <<= 1) v += __shfl_xor(v, o);
    return v; }
#define RLX_AGENT __ATOMIC_RELAXED, __HIP_MEMORY_SCOPE_AGENT
#define XB_TMO      128
#define XB_XCNT(j)  (256  + 64 * (j))
#define XB_XSUB(j)  (1280 + 64 * (j))
#define XB_XGEN(j)  (2304 + 64 * (j))
#define XB_TOP      3328
#define XB_TOPGEN   3392
#define XCD_BAR_WORDS 3456
#define XB_SPIN_CAP (1u << 18)

__device__ __forceinline__ unsigned xb_ld(unsigned* p)              { return __hip_atomic_load(p, __ATOMIC_RELAXED, __HIP_MEMORY_SCOPE_AGENT); }
__device__ __forceinline__ unsigned xb_add(unsigned* p, unsigned v) { return __hip_atomic_fetch_add(p, v, __ATOMIC_RELAXED, __HIP_MEMORY_SCOPE_AGENT); }
__device__ __forceinline__ unsigned xb_xcc_id() { return (unsigned)__builtin_amdgcn_s_getreg((3 << 11) | 20) & 0xFu; }
#define XB_SPIN(cond, bar) do { unsigned _sp = 0; while (cond) { __builtin_amdgcn_s_sleep(1); \
    if ((++_sp & 255u) == 0u) { if (xb_ld(&(bar)[XB_TMO])) break; if (_sp > XB_SPIN_CAP) { atomicAdd(&(bar)[XB_TMO], 1u); break; } } } } while (0)

struct XcdBarrier {
    unsigned* bar; unsigned x;
    volatile LAS unsigned* st;
};

__device__ __forceinline__ XcdBarrier xcd_barrier_post(unsigned* bar, volatile LAS unsigned* st) {
    XcdBarrier b; b.bar = bar; b.x = xb_xcc_id(); b.st = st;
    if (threadIdx.x == 0) (void)xb_add(&bar[XB_XCNT(b.x)], 1u);
    return b;
}
__device__ __forceinline__ void xcd_barrier_complete(unsigned* bar, unsigned x, unsigned& nloc, unsigned& nx) {
    const unsigned G = gridDim.x * gridDim.y * gridDim.z;
    unsigned sum, cnt, mine, sp = 0u;
    for (;;) {
        sum = 0u; cnt = 0u; mine = 0u;
#pragma unroll
        for (unsigned j = 0; j < 16; ++j) { const unsigned c = xb_ld(&bar[XB_XCNT(j)]); sum += c; cnt += (c > 0u) ? 1u : 0u; mine = (j == x) ? c : mine; }
        if (sum == G) break;
        __builtin_amdgcn_s_sleep(1);
        if ((++sp & 255u) == 0u) { if (xb_ld(&bar[XB_TMO])) break; if (sp > XB_SPIN_CAP) { atomicAdd(&bar[XB_TMO], 1u); break; } }
    }
    nloc = mine > 0u ? mine : 1u; nx = cnt > 0u ? cnt : 1u;
}

__device__ __forceinline__ void xcd_barrier(const XcdBarrier& b) {
    asm volatile("s_waitcnt vmcnt(0)" ::: "memory");
    __syncthreads();
    if (threadIdx.x == 0) {
        unsigned* bar = b.bar;
        __builtin_amdgcn_s_waitcnt(0);
        unsigned nloc = b.st[0], nx = b.st[1];
        if (nloc == 0u) { xcd_barrier_complete(bar, b.x, nloc, nx); b.st[0] = nloc; b.st[1] = nx; }
        const unsigned old = xb_add(&bar[XB_XSUB(b.x)], 1u);
        const unsigned gen = old / nloc;
        if (old + 1u == (gen + 1u) * nloc) {
            __builtin_amdgcn_fence(__ATOMIC_RELEASE, "agent");
            asm volatile("s_waitcnt vmcnt(0)" ::: "memory");
            const unsigned og = xb_add(&bar[XB_TOP], 1u);
            const unsigned tg = og / nx;
            if (og + 1u == (tg + 1u) * nx) xb_add(&bar[XB_TOPGEN], 1u);
            else XB_SPIN(xb_ld(&bar[XB_TOPGEN]) == tg, bar);
            __builtin_amdgcn_fence(__ATOMIC_ACQUIRE, "agent");
            xb_add(&bar[XB_XGEN(b.x)], 1u);
            asm volatile("s_waitcnt vmcnt(0)" ::: "memory");
        } else {
            XB_SPIN(xb_ld(&bar[XB_XGEN(b.x)]) == gen, bar);
            __builtin_amdgcn_fence(__ATOMIC_ACQUIRE, "agent");
            asm volatile("s_waitcnt vmcnt(0)" ::: "memory");
        }
    }
    __syncthreads();
}

struct Frame {
    LAS unsigned char* lds; unsigned char* ldsg;
    int tid, lane, wave, G, bid, gw, NGW;
    float* out; unsigned char* ws;
};

struct Params { const float* in[17]; float* out; unsigned char* ws; };
__device__ __forceinline__ void ph_mod(Frame& F, const Params& P) {
    const float* c = P.in[1]; const float* cctx = P.in[3]; const float* w_ada = P.in[4]; const float* b_ada = P.in[5]; float* MOD = (float*)(F.ws + WS_MOD);
    float* s = (float*)F.ldsg;
    for (int vb = F.bid; vb < DEPTH * (MODW / NTHREADS); vb += F.G) {
        const int l = vb / (MODW / NTHREADS), j = (vb % (MODW / NTHREADS)) * NTHREADS + F.tid;
        __syncthreads();
        for (int i = F.tid; i < NR * D; i += NTHREADS) { const int r = i / D, k = i % D; const float v = r < NB ? c[r * D + k] : cctx[k]; s[i] = silu_f(v); }
        __syncthreads();
        float acc[NR];
#pragma unroll
        for (int r = 0; r < NR; ++r) acc[r] = 0.f;
        const float* w = w_ada + (size_t)l * D * MODW + j;
        for (int k = 0; k < D; ++k) { const float wv = w[(size_t)k * MODW];
#pragma unroll
            for (int r = 0; r < NR; ++r) acc[r] += s[r * D + k] * wv; }
#pragma unroll
        for (int r = 0; r < NR; ++r) MOD[((size_t)l * NR + r) * MODW + j] = acc[r] + b_ada[l * MODW + j];
    }
    __syncthreads();
}
__device__ __forceinline__ void transpose_item(const float* W, int ldw, int K, bf16* WT, int dst_row0, int k0, int n0, LAS float* scr, int lane) {
#pragma unroll 8
    for (int i = 0; i < 32; ++i) { const int kk = 2 * i + (lane >> 5); scr[kk * 33 + (lane & 31)] = W[(size_t)(k0 + kk) * ldw + n0 + (lane & 31)]; }
    asm volatile("s_waitcnt lgkmcnt(0)" ::: "memory");
    const int c = lane & 7;
#pragma unroll
    for (int j = 0; j < 4; ++j) { const int n = (lane >> 3) + 8 * j; const LAS float* s = scr + (8 * c) * 33 + n;
        v4u o; o.x = pk2(s[0 * 33], s[1 * 33]); o.y = pk2(s[2 * 33], s[3 * 33]); o.z = pk2(s[4 * 33], s[5 * 33]); o.w = pk2(s[6 * 33], s[7 * 33]);
        *(v4u*)(WT + (size_t)(dst_row0 + n) * K + k0 + 8 * c) = o; }
    asm volatile("s_waitcnt lgkmcnt(0)" ::: "memory");
}
__device__ __forceinline__ void ph_prologue(Frame& F, const Params& P) {
    const float* w_ffn_in = P.in[7]; const float* w_ffn_out = P.in[8]; const float* w_in = P.in[9]; const float* w_out = P.in[10];
    bf16* Wi_t = (bf16*)(F.ws + WS_WI); bf16* Wo_t = (bf16*)(F.ws + WS_WO); bf16* Win_t = (bf16*)(F.ws + WS_WIN); bf16* Wout_t = (bf16*)(F.ws + WS_WOUT);
    LAS float* scr = (LAS float*)(F.lds + F.wave * 16384);
    constexpr int I_FI = (D / 64) * (2 * DFF / 32), I_FO = (DFF / 64) * (D / 32), I_IN = (D / 64) * (DU / 32), I_OUT = (D / 64) * (D / 32);
    constexpr int NITEMS = 4 * I_FI + 4 * I_FO + 2 * I_IN + 2 * I_OUT;
    for (int it = F.gw; it < NITEMS; it += F.NGW) {
        int r = it;
        if (r < 4 * I_FI) { const int mat = r / I_FI; r %= I_FI; const int nblk = 2 * DFF / 32, kb = r / nblk, nb = r % nblk, n0 = 32 * nb;
            const int nn = n0 < DFF ? n0 : n0 - DFF; const int drow = 256 * (nn / 128) + (n0 < DFF ? 0 : 128) + (nn % 128);
            transpose_item(w_ffn_in + (size_t)mat * D * 2 * DFF, 2 * DFF, D, Wi_t + (size_t)mat * 2 * DFF * D, drow, 64 * kb, n0, scr, F.lane); continue; }
        r -= 4 * I_FI;
        if (r < 4 * I_FO) { const int mat = r / I_FO; r %= I_FO; const int nblk = D / 32, kb = r / nblk, nb = r % nblk;
            transpose_item(w_ffn_out + (size_t)mat * DFF * D, D, DFF, Wo_t + (size_t)mat * D * DFF, 32 * nb, 64 * kb, 32 * nb, scr, F.lane); continue; }
        r -= 4 * I_FO;
        if (r < 2 * I_IN) { const int mat = r / I_IN; r %= I_IN; const int nblk = DU / 32, kb = r / nblk, nb = r % nblk;
            transpose_item(w_in + (size_t)mat * D * DIN, DIN, D, Win_t + (size_t)mat * DU * D, 32 * nb, 64 * kb, 32 * nb, scr, F.lane); continue; }
        r -= 2 * I_IN;
        { const int mat = r / I_OUT; r %= I_OUT; const int nblk = D / 32, kb = r / nblk, nb = r % nblk;
            transpose_item(w_out + (size_t)mat * D * D, D, D, Wout_t + (size_t)mat * D * D, 32 * nb, 64 * kb, 32 * nb, scr, F.lane); }
    }
    const float* x = P.in[0]; const float* ctx = P.in[2]; float* xl = F.out; float* xc = (float*)(F.ws + WS_XC);
    const size_t gt = (size_t)F.bid * NTHREADS + F.tid, NGT = (size_t)F.G * NTHREADS;
    for (size_t i = gt; i < (size_t)T * D / 4; i += NGT) {
        if (i < (size_t)TL * D / 4) ((float4*)xl)[i] = ((const float4*)x)[i]; else ((float4*)xc)[i - (size_t)TL * D / 4] = ((const float4*)ctx)[i - (size_t)TL * D / 4]; }
}
__device__ __forceinline__ void ph_normmod(Frame& F, const Ptrs& p, const float* g, const float* mod, int shift_idx, int scale_idx) {
    bf16* H = (bf16*)(F.ws + WS_HB);
    for (int r = F.gw; r < T; r += F.NGW) {
        const float* x = xrow(p, r); const int mr = mod_row(r);
        float4 v[4]; float ss = 0.f;
#pragma unroll
        for (int j = 0; j < 4; ++j) { v[j] = ((const float4*)x)[F.lane + 64 * j]; ss += v[j].x * v[j].x + v[j].y * v[j].y + v[j].z * v[j].z + v[j].w * v[j].w; }
        const float rstd = rsqrtf(wave_sum(ss) * (1.f / D) + EPS);
#pragma unroll
        for (int j = 0; j < 4; ++j) { const int q = F.lane + 64 * j;
            const float4 gv = ((const float4*)g)[q], sc = ((const float4*)(mod + (size_t)mr * MODW + scale_idx * D))[q], sh = ((const float4*)(mod + (size_t)mr * MODW + shift_idx * D))[q];
            uint2 o; o.x = pk2(v[j].x * rstd * gv.x * (1.f + sc.x) + sh.x, v[j].y * rstd * gv.y * (1.f + sc.y) + sh.y); o.y = pk2(v[j].z * rstd * gv.z * (1.f + sc.z) + sh.z, v[j].w * rstd * gv.w * (1.f + sc.w) + sh.w);
            ((uint2*)(H + (size_t)r * D))[q] = o; }
    }
}
__device__ __forceinline__ void ph_final(Frame& F, const Params& P) {
    const float* g = P.in[16];
    for (int r = F.gw; r < TL; r += F.NGW) {
        float* x = F.out + (size_t)r * D;
        float4 v[4]; float ss = 0.f;
#pragma unroll
        for (int j = 0; j < 4; ++j) { v[j] = ((const float4*)x)[F.lane + 64 * j]; ss += v[j].x * v[j].x + v[j].y * v[j].y + v[j].z * v[j].z + v[j].w * v[j].w; }
        const float rstd = rsqrtf(wave_sum(ss) * (1.f / D) + EPS);
#pragma unroll
        for (int j = 0; j < 4; ++j) { const int q = F.lane + 64 * j; const float4 gv = ((const float4*)g)[q];
            ((float4*)x)[q] = make_float4(v[j].x * rstd * gv.x, v[j].y * rstd * gv.y, v[j].z * rstd * gv.z, v[j].w * rstd * gv.w); }
    }
}
__device__ __forceinline__ void ph_gates(Frame& F, const float* w_in_l) {
    const bf16* H = (const bf16*)(F.ws + WS_HB); float* G = (float*)(F.ws + WS_G);
    for (int r = F.gw; r < T; r += F.NGW) {
        float acc[16];
#pragma unroll
        for (int j = 0; j < 16; ++j) acc[j] = 0.f;
        for (int i = 0; i < 16; ++i) { const int k = F.lane + 64 * i; const float h = bf2f(H[(size_t)r * D + k]); const float4* w = (const float4*)(w_in_l + (size_t)k * DIN + DU);
#pragma unroll
            for (int q = 0; q < 4; ++q) { const float4 wv = w[q]; acc[4 * q] += h * wv.x; acc[4 * q + 1] += h * wv.y; acc[4 * q + 2] += h * wv.z; acc[4 * q + 3] += h * wv.w; } }
#pragma unroll
        for (int j = 0; j < 16; ++j) acc[j] = wave_sum(acc[j]);
        if (F.lane == 0) {
#pragma unroll
            for (int j = 0; j < 16; ++j) G[(size_t)r * 16 + j] = acc[j]; }
    }
}
__device__ __forceinline__ void ph_rope(Frame& F) {
    bf16* U = (bf16*)(F.ws + WS_R);
    for (int gid = F.bid * NTHREADS + F.tid; gid < TL * 160; gid += F.G * NTHREADS) {
        const int i = gid & 15, hs = (gid >> 4) % 10, r = gid / 160;
        const int n = r % SEQ, prow = n / 64, pcol = n % 64;
        const float inv = powf(10000.f, -(float)i / 16.f);
        const float ar = (float)prow * inv, ac = (float)pcol * inv;
        bf16* base = U + (size_t)r * DU + C_Q + hs * 64;
        const float t1 = bf2f(base[i]), t2 = bf2f(base[16 + i]), t3 = bf2f(base[32 + i]), t4 = bf2f(base[48 + i]);
        const float c1 = cosf(ar), s1 = sinf(ar), c2 = cosf(ac), s2 = sinf(ac);
        base[i] = (bf16)f2bf(t1 * c1 - t2 * s1); base[16 + i] = (bf16)f2bf(t2 * c1 + t1 * s1); base[32 + i] = (bf16)f2bf(t3 * c2 - t4 * s2); base[48 + i] = (bf16)f2bf(t4 * c2 + t3 * s2);
    }
}
__device__ __forceinline__ void ph_attn_simple(Frame& F, const float* sink, int wg0, int nwg) {
    const bf16* U = (const bf16*)(F.ws + WS_R); bf16* Y = (bf16*)(F.ws + WS_Y);
    for (int gid = (F.bid - wg0) * NTHREADS + F.tid; gid < T * 16; gid += nwg * NTHREADS) {
        const int half = gid & 1, h = (gid >> 1) & 7, r = gid >> 4;
        const int kvh = h >> 2; int b, lo = 0, hi = -1;
        if (r < TL) { b = r / SEQ; const int n = r % SEQ; lo = n - 128 < 0 ? 0 : n - 128; hi = n + 128 > SEQ - 1 ? SEQ - 1 : n + 128; } else b = (r - TL) / CTX;
        float q[64];
        { const bf16* qp = U + (size_t)r * DU + C_Q + h * 64;
#pragma unroll
          for (int d = 0; d < 64; ++d) q[d] = bf2f(qp[d]) * 0.125f; }
        const bf16* kl = U + (size_t)(b * SEQ) * DU + C_K + kvh * 64;
        const bf16* kc = U + (size_t)(TL + b * CTX) * DU + C_K + kvh * 64;
        const float sk = sink[h];
        float m = sk;
        for (int kp = lo; kp <= hi; ++kp) { const bf16* k = kl + (size_t)kp * DU; float s = 0.f;
#pragma unroll
            for (int d = 0; d < 64; ++d) s += q[d] * bf2f(k[d]);
            m = fmaxf(m, s); }
        for (int j = 0; j < CTX; ++j) { const bf16* k = kc + (size_t)j * DU; float s = 0.f;
#pragma unroll
            for (int d = 0; d < 64; ++d) s += q[d] * bf2f(k[d]);
            m = fmaxf(m, s); }
        float o[32]; float l = expf(sk - m);
#pragma unroll
        for (int d = 0; d < 32; ++d) o[d] = 0.f;
        for (int kp = lo; kp <= hi; ++kp) { const bf16* k = kl + (size_t)kp * DU; float s = 0.f;
#pragma unroll
            for (int d = 0; d < 64; ++d) s += q[d] * bf2f(k[d]);
            const float e = expf(s - m); l += e; const bf16* v = k + (C_V - C_K) + half * 32;
#pragma unroll
            for (int d = 0; d < 32; ++d) o[d] += e * bf2f(v[d]); }
        for (int j = 0; j < CTX; ++j) { const bf16* k = kc + (size_t)j * DU; float s = 0.f;
#pragma unroll
            for (int d = 0; d < 64; ++d) s += q[d] * bf2f(k[d]);
            const float e = expf(s - m); l += e; const bf16* v = k + (C_V - C_K) + half * 32;
#pragma unroll
            for (int d = 0; d < 32; ++d) o[d] += e * bf2f(v[d]); }
        const float il = 1.f / l; bf16* yp = Y + (size_t)r * D + 256 + h * 64 + half * 32;
#pragma unroll
        for (int d = 0; d < 32; ++d) yp[d] = (bf16)f2bf(o[d] * il);
    }
}
__device__ __forceinline__ void ph_four_ch(Frame& F, int wg0, int nwg) {
    const bf16* U = (const bf16*)(F.ws + WS_R); float* AB = (float*)(F.ws + WS_HB);
    float* ct = (float*)F.ldsg; float* st = ct + 64;
    if (F.tid < 64) { float s, c; sincospif((float)F.tid / 32.f, &s, &c); ct[F.tid] = c; st[F.tid] = s; }
    __syncthreads();
    for (int gid = (F.bid - wg0) * NTHREADS + F.tid; gid < T * 256; gid += nwg * NTHREADS) {
        const int r = gid >> 8, g = (gid >> 6) & 3, m = gid & 63;
        const bf16* u = U + (size_t)r * DU + C_AX + g * 64; float a = 0.f, bsum = 0.f;
        for (int c = 0; c < 64; ++c) { const float v = bf2f(u[c]); const int idx = (m * c) & 63; a += v * ct[idx]; bsum += v * st[idx]; }
        AB[(size_t)r * 512 + g * 128 + m] = a; AB[(size_t)r * 512 + g * 128 + 64 + m] = bsum;
    }
    __syncthreads();
}
__device__ __forceinline__ void ph_four_pos(Frame& F) {
    const float* AB = (const float*)(F.ws + WS_HB); float* Fo = (float*)(F.ws + WS_R + (size_t)T * DU * 2);
    float* ct = (float*)F.ldsg; float* st = ct + SEQ;
    for (int i = F.tid; i < SEQ; i += NTHREADS) { float s, c; sincospif((float)i / (float)(SEQ / 2), &s, &c); ct[i] = c; st[i] = s; }
    __syncthreads();
    const int kh = F.tid >> 8, g = (F.tid >> 6) & 3, m = F.tid & 63;
    constexpr int VB_L = NB * (SEQ / 8), VB_C = NB * (CTX / 8);
    for (int vb = F.bid; vb < VB_L + VB_C; vb += F.G) {
        const bool lat = vb < VB_L; const int N = lat ? SEQ : CTX; const int v2 = lat ? vb : vb - VB_L; const int seq = v2 / (N / 8), k0 = (v2 % (N / 8)) * 8 + kh * 4;
        const int row_base = (lat ? 0 : TL) + seq * N; const int tstep = SEQ / N;
        const float* ab = AB + (size_t)row_base * 512 + g * 128 + m;
        float acc[4] = {0.f, 0.f, 0.f, 0.f};
        for (int n = 0; n < N; ++n) { const float a = ab[(size_t)n * 512], bb = ab[(size_t)n * 512 + 64];
#pragma unroll
            for (int kk = 0; kk < 4; ++kk) { const int idx = (((k0 + kk) * n) & (N - 1)) * tstep; acc[kk] += ct[idx] * a - st[idx] * bb; } }
        const float sc = rsqrtf(64.f * (float)N);
#pragma unroll
        for (int kk = 0; kk < 4; ++kk) Fo[(size_t)(row_base + k0 + kk) * 256 + g * 64 + m] = acc[kk] * sc;
    }
    __syncthreads();
}
__device__ __forceinline__ void ph_four_mix(Frame& F, const float* wf) {
    const float* Fo = (const float*)(F.ws + WS_R + (size_t)T * DU * 2); bf16* Y = (bf16*)(F.ws + WS_Y);
    for (int gid = F.bid * NTHREADS + F.tid; gid < T * 256; gid += F.G * NTHREADS) {
        const int r = gid >> 8, g = (gid >> 6) & 3, e = gid & 63;
        const float* f = Fo + (size_t)r * 256 + g * 64; const float* w = wf + (size_t)g * 4096 + e; float a = 0.f;
        for (int c = 0; c < 64; ++c) a += f[c] * w[c * 64];
        Y[(size_t)r * D + g * 64 + e] = (bf16)f2bf(a);
    }
}
__device__ __forceinline__ void ph_mlstm_scan(Frame& F, const float* conv, const float* b_i, const float* b_f) {
    const bf16* U = (const bf16*)(F.ws + WS_R); const float* G = (const float*)(F.ws + WS_G); float* HS = (float*)(F.ws + WS_HS);
    float* sm = (float*)F.ldsg;
    float* qs = sm; float* ks = qs + 4096; float* vs = ks + 4096; float* Cs = vs + 4096; float* Ss = Cs + 4096; float* nv = Ss + 4096;
    float* li = nv + 64; float* lf = li + 64; float* bc = lf + 64; float* mt = bc + 64; float* wp = mt + 64; float* den = wp + 64; float* wsv = den + 64; float* sc = wsv + 64;
    const int tid = F.tid; const int dir = F.bid & 1, h = (F.bid >> 1) & 3, b = F.bid >> 3;
    for (int i = tid; i < 4096; i += NTHREADS) Cs[i] = 0.f;
    if (tid < 64) nv[tid] = 0.f;
    if (tid == 0) sc[0] = 0.f;
    __syncthreads();
    const float bi = b_i[dir * 4 + h], bff = b_f[dir * 4 + h];
    for (int ch = 0; ch < 4 + 64; ++ch) {
        const bool isctx = ch < 4; const int N = isctx ? CTX : SEQ; const int c = isctx ? ch : ch - 4; const int rb = isctx ? TL + b * CTX : b * SEQ;
        { const int t = tid >> 3, dg = (tid & 7) * 8; const int p = dir == 0 ? c * 64 + t : N - 1 - c * 64 - t; const bf16* u0 = U + (size_t)(rb + p) * DU;
#pragma unroll
          for (int dd = 0; dd < 8; ++dd) { const int d = dg + dd; const int cq = h * 64 + d, ck = 256 + h * 64 + d;
              float aq = bf2f(u0[C_MQ + h * 64 + d]) * conv[512 + cq], ak = bf2f(u0[C_MK + h * 64 + d]) * conv[512 + ck];
              if (p > 0) { aq += bf2f(u0[-DU + C_MQ + h * 64 + d]) * conv[cq]; ak += bf2f(u0[-DU + C_MK + h * 64 + d]) * conv[ck]; }
              if (p < N - 1) { aq += bf2f(u0[DU + C_MQ + h * 64 + d]) * conv[1024 + cq]; ak += bf2f(u0[DU + C_MK + h * 64 + d]) * conv[1024 + ck]; }
              qs[t * 64 + d] = silu_f(aq); ks[t * 64 + d] = silu_f(ak) * 0.125f; vs[t * 64 + d] = bf2f(u0[C_MV + h * 64 + d]); }
          if ((tid & 7) == 0) { const float* g0 = G + (size_t)(rb + p) * 16; li[t] = g0[dir * 4 + h] + bi; lf[t] = logsigmoid_f(g0[8 + dir * 4 + h] + bff); } }
        __syncthreads();
        if (tid == 0) { float s = 0.f; for (int t = 0; t < 64; ++t) { s += lf[t]; bc[t] = s; } }
        __syncthreads();
        const float m = sc[0];
        if (tid < 64) { const int t = tid; float mx = bc[t] + m; for (int s = 0; s <= t; ++s) mx = fmaxf(mx, bc[t] - bc[s] + li[s]); mt[t] = mx; wp[t] = expf(bc[t] + m - mx); }
        if (tid == 64) { const float bl = bc[63]; float mx = bl + m; for (int s = 0; s < 64; ++s) mx = fmaxf(mx, bl - bc[s] + li[s]); sc[1] = mx; sc[2] = expf(bl + m - mx); }
        __syncthreads();
        if (tid < 64) wsv[tid] = expf(bc[63] - bc[tid] + li[tid] - sc[1]);
        for (int e = tid; e < 4096; e += NTHREADS) { const int t = e >> 6, s = e & 63; float v = 0.f;
            if (s <= t) { float dot = 0.f; for (int d = 0; d < 64; ++d) dot += qs[t * 64 + d] * ks[s * 64 + d]; v = dot * expf(bc[t] - bc[s] + li[s] - mt[t]); }
            Ss[e] = v; }
        __syncthreads();
        if (tid < 64) { const int t = tid; float s1 = 0.f, s2 = 0.f; for (int s = 0; s < 64; ++s) s1 += Ss[t * 64 + s]; for (int k = 0; k < 64; ++k) s2 += qs[t * 64 + k] * nv[k]; den[t] = s1 + wp[t] * s2; }
        __syncthreads();
        for (int e = tid; e < 4096; e += NTHREADS) { const int t = e >> 6, v = e & 63; float a = 0.f, c2 = 0.f;
            for (int s = 0; s < 64; ++s) a += Ss[t * 64 + s] * vs[s * 64 + v];
            for (int k = 0; k < 64; ++k) c2 += Cs[v * 64 + k] * qs[t * 64 + k];
            const float num = a + wp[t] * c2; const float dn = fmaxf(fabsf(den[t]), expf(-mt[t]));
            const int p = dir == 0 ? c * 64 + t : N - 1 - c * 64 - t;
            HS[((size_t)dir * T + rb + p) * 256 + h * 64 + v] = num / dn; }
        __syncthreads();
        { const float decay = sc[2];
          for (int e = tid; e < 4096; e += NTHREADS) { const int v = e >> 6, k = e & 63; float a = 0.f; for (int s = 0; s < 64; ++s) a += wsv[s] * vs[s * 64 + v] * ks[s * 64 + k]; Cs[e] = decay * Cs[e] + a; }
          if (tid < 64) { float a = 0.f; for (int s = 0; s < 64; ++s) a += wsv[s] * ks[s * 64 + tid]; nv[tid] = decay * nv[tid] + a; }
          if (tid == 0) sc[0] = sc[1]; }
        __syncthreads();
    }
}
__device__ __forceinline__ void ph_mlstm_out(Frame& F) {
    const bf16* U = (const bf16*)(F.ws + WS_R); const float* HS = (const float*)(F.ws + WS_HS); bf16* Y = (bf16*)(F.ws + WS_Y);
    for (int gid = F.bid * NTHREADS + F.tid; gid < T * 256; gid += F.G * NTHREADS) {
        const int r = gid >> 8, c = gid & 255;
        const float v = sigmoid_f(bf2f(U[(size_t)r * DU + C_MO + c])) * (HS[(size_t)r * 256 + c] + HS[((size_t)T + r) * 256 + c]);
        Y[(size_t)r * D + 768 + c] = (bf16)f2bf(fminf(fmaxf(v, -60000.f), 60000.f));
    }
}

template <class Epi> __device__ __forceinline__ void run_gemm(Frame& F, const bf16* A, const bf16* Bt, int M, int N, int K, const Epi& E) {
    pg8::Gemm g{A, Bt, M, N, K}; pg8::StaticOrder S; S.init(M, N, F.G, F.bid);
    pg8::gemm_phase<Epi, pg8::StaticOrder, true, true>(F.lds, g, S, E, F.tid);
}
__device__ __forceinline__ Frame make_frame(const Params& P, unsigned char* lds_raw) {
    Frame F; int t = threadIdx.x; asm volatile("" : "+v"(t));
    F.lds = (LAS unsigned char*)lds_raw; F.ldsg = lds_raw;
    F.tid = t; F.lane = t & 63; F.wave = __builtin_amdgcn_readfirstlane(t >> 6);
    int g = gridDim.x, b = blockIdx.x; asm volatile("" : "+s"(g), "+s"(b));
    F.G = g; F.bid = b; F.gw = b * NWAVES + F.wave; F.NGW = g * NWAVES;
    unsigned char* ws = P.ws; float* out = P.out; asm volatile("" : "+s"(ws), "+s"(out));
    F.out = out; F.ws = ws;
    return F;
}
__device__ __forceinline__ void grid_bar(const Params& P, unsigned char* lds_raw) {
    unsigned char* ws = P.ws; asm volatile("" : "+s"(ws));
    XcdBarrier b; b.bar = (unsigned*)(ws + WS_CTL) + CW_BAR; b.x = xb_xcc_id(); b.st = (volatile LAS unsigned*)((LAS unsigned char*)lds_raw + MISC_OFF) + 8;
    xcd_barrier(b);
}
__global__ void __launch_bounds__(NTHREADS, 2) mega_fwd(Params P) {
    extern __shared__ __attribute__((aligned(16))) unsigned char lds_raw[];
    { const int tid = threadIdx.x;
      for (int u = tid; u < (LDS_BYTES - MISC_OFF) / 4; u += NTHREADS) ((LAS unsigned*)((LAS unsigned char*)lds_raw + MISC_OFF))[u] = 0u;
      __syncthreads();
      (void)xcd_barrier_post((unsigned*)(P.ws + WS_CTL) + CW_BAR, (volatile LAS unsigned*)((LAS unsigned char*)lds_raw + MISC_OFF) + 8); }
#define GRID_BAR() grid_bar(P, lds_raw)
#define FRAME() Frame F = make_frame(P, lds_raw); Ptrs p{F.out, (float*)(F.ws + WS_XC)}; (void)p

    { FRAME(); ph_mod(F, P); ph_prologue(F, P); }
    GRID_BAR();
#pragma unroll 1
    for (int l = 0; l < DEPTH; ++l) {
#pragma unroll 1
        for (int half = 0; half < 2; ++half) {
            const int sub = half * 2, f = half;
            if (half == 1) {
                { FRAME(); const float* mod = (const float*)(F.ws + WS_MOD) + (size_t)l * NR * MODW; ph_normmod(F, p, P.in[6] + (size_t)l * 3 * D + 1 * D, mod, 3, 4); }
                GRID_BAR();
                { FRAME(); pg8::EpiBf16Plain E{(bf16*)(F.ws + WS_R), DU}; run_gemm(F, (const bf16*)(F.ws + WS_HB), (const bf16*)(F.ws + WS_WIN) + (size_t)l * DU * D, T, DU, D, E); }
                { FRAME(); ph_gates(F, P.in[9] + (size_t)l * D * DIN); }
                GRID_BAR();
                { FRAME(); ph_rope(F); }
                GRID_BAR();
                { FRAME();
                  if (F.bid < 32) ph_mlstm_scan(F, P.in[13] + (size_t)l * 3 * 512, P.in[14] + l * 8, P.in[15] + l * 8);
                  else { ph_four_ch(F, 32, F.G - 32); ph_attn_simple(F, P.in[12] + l * 8, 32, F.G - 32); } }
                GRID_BAR();
                { FRAME(); ph_four_pos(F); }
                GRID_BAR();
                { FRAME(); ph_four_mix(F, P.in[11] + (size_t)l * 4 * 4096); ph_mlstm_out(F); }
                GRID_BAR();
                { FRAME(); const float* mod = (const float*)(F.ws + WS_MOD) + (size_t)l * NR * MODW;
                  pg8::EpiResid E{p.xl, p.xc, TL, SEQ / 256, mod, MODW, 5 * D, 1.0f}; run_gemm(F, (const bf16*)(F.ws + WS_Y), (const bf16*)(F.ws + WS_WOUT) + (size_t)l * D * D, T, D, D, E); }
                GRID_BAR();
            }
            { FRAME(); const float* mod = (const float*)(F.ws + WS_MOD) + (size_t)l * NR * MODW; ph_normmod(F, p, P.in[6] + (size_t)l * 3 * D + sub * D, mod, 3 * sub, 3 * sub + 1); }
            GRID_BAR();
            { FRAME(); pg8::EpiSwiglu E{(bf16*)(F.ws + WS_R), DFF}; run_gemm(F, (const bf16*)(F.ws + WS_HB), (const bf16*)(F.ws + WS_WI) + (size_t)(l * 2 + f) * 2 * DFF * D, T, 2 * DFF, D, E); }
            GRID_BAR();
            { FRAME(); const float* mod = (const float*)(F.ws + WS_MOD) + (size_t)l * NR * MODW;
              pg8::EpiResid E{p.xl, p.xc, TL, SEQ / 256, mod, MODW, (3 * sub + 2) * D, 0.5f}; run_gemm(F, (const bf16*)(F.ws + WS_R), (const bf16*)(F.ws + WS_WO) + (size_t)(l * 2 + f) * D * DFF, T, D, DFF, E); }
            GRID_BAR();
        }
    }
    { FRAME(); ph_final(F, P); }
}
}

extern "C" void kernel_launch(void* const* d_in, const int* in_sizes, int n_in, void* d_out, int out_size, void* d_ws, size_t ws_size, hipStream_t stream) {
    static int grid = 0;
    if (grid == 0) {
        if (n_in != 17 || ws_size < WS_END) { fprintf(stderr, "kernel_launch: need 17 inputs and %zu bytes of workspace; got %d inputs, %zu bytes\n", (size_t)WS_END, n_in, ws_size); grid = -1; return; }
        int dev = 0, cus = 0, per_cu = 0;
        if (hipGetDevice(&dev) != hipSuccess || hipDeviceGetAttribute(&cus, hipDeviceAttributeMultiprocessorCount, dev) != hipSuccess) { grid = -1; return; }
        if (hipFuncSetAttribute((const void*)mega_fwd, hipFuncAttributeMaxDynamicSharedMemorySize, LDS_BYTES) != hipSuccess) { fprintf(stderr, "kernel_launch: hipFuncSetAttribute failed\n"); grid = -1; return; }
        if (hipOccupancyMaxActiveBlocksPerMultiprocessor(&per_cu, (const void*)mega_fwd, NTHREADS, LDS_BYTES) != hipSuccess || per_cu < 1) { fprintf(stderr, "kernel_launch: occupancy query says %d workgroups per CU\n", per_cu); (void)hipGetLastError(); grid = -1; return; }
        grid = cus;
    }
    if (grid < 0) return;
    (void)hipMemsetAsync((char*)d_ws + WS_CTL, 0, CTL_ZERO_BYTES, stream);
    Params P{};
    for (int i = 0; i < 17; ++i) P.in[i] = (const float*)d_in[i];
    P.out = (float*)d_out; P.ws = (unsigned char*)d_ws;
    hipLaunchKernelGGL(mega_fwd, dim3(grid), dim3(NTHREADS), LDS_BYTES, stream, P);
}
```

```cpp
#include <hip/hip_runtime.h>
#include <cstdio>
#include <cstdint>
namespace pg8 {
#define PG8_LAS __attribute__((address_space(3)))
typedef unsigned short bf16_t;
typedef short bf16x8 __attribute__((ext_vector_type(8)));
typedef float f32x4 __attribute__((ext_vector_type(4)));
typedef unsigned u32x4 __attribute__((ext_vector_type(4)));
typedef _Float16 half8 __attribute__((ext_vector_type(8)));
constexpr int BM = 256, BK = 64, HALF = 128, HTB = HALF * BK * 2  , STAGE_BYTES = 8 * HTB, NXCD = 8, WGM = 8;

__host__ __device__ __forceinline__ int lds_byte(int r, int c) { const int st = (r >> 4) * 2 + (c >> 5), rr = r & 15, cc = c & 31, ob = rr * 64 + cc * 2; return st * 1024 + (ob ^ (((ob >> 9) & 1) << 5)); }
__host__ __device__ __forceinline__ void stage_rc(int b, int& R, int& C) { const int st = b / 1024, sb = b % 1024, swz = sb ^ (((sb >> 9) & 1) << 5); R = (st >> 1) * 16 + swz / 64; C = (st & 1) * 32 + (swz % 64) / 2; }
__host__ __device__ __forceinline__ int perm32(int rho) { const int n = rho >> 4, i = rho & 15; return 8 * (i >> 2) + 4 * n + (i & 3); }

struct Unit { int pm, pn; };
struct Gemm { const bf16_t* A; const bf16_t* Bt; int M, N, K; };

struct StaticOrder {
    int nM, nN, nwg, G, c;
    __host__ __device__ void init(int M, int N, int G_, int c_) { nM = M / BM; nN = N / BM; nwg = nM * nN; G = G_; c = c_; }
    __host__ __device__ bool next(int i, Unit& u) const {
        const long L = (long)i * G + c; if (L >= nwg) return false;
        int wgid = (int)L; { const int q = nwg / NXCD, r = nwg % NXCD, xcd = wgid % NXCD, off = wgid / NXCD; wgid = (xcd < r ? xcd * (q + 1) : r * (q + 1) + (xcd - r) * q) + off; }
        const int nig = WGM * nN, gid = wgid / nig, fm = gid * WGM, gsz = (nM - fm) < WGM ? (nM - fm) : WGM;
        u.pm = fm + ((wgid % nig) % gsz); u.pn = (wgid % nig) / gsz; return true;
    }
    __device__ __forceinline__ void a_ready(const Unit&) const {}
    __device__ __forceinline__ void done(const Unit&) const {}
};

__device__ __forceinline__ unsigned cvt_pk_bf16(float lo, float hi) { typedef float f2_t __attribute__((ext_vector_type(2))); typedef _Float16 h2_t __attribute__((ext_vector_type(2))); const f2_t v = {lo, hi}; return __builtin_bit_cast(unsigned, __builtin_convertvector(v, h2_t)); }
__device__ __forceinline__ float silu_fast(float x) { return x * __builtin_amdgcn_rcpf(1.f + __expf(-x)); }
struct EpiBf16Plain {
    static constexpr bool PERM = true, AFTER_DRAIN = false;
    bf16_t* O; int ldc;
    __device__ __forceinline__ void operator()(const f32x4 (&acc)[2][2][4][2], const Unit& u, int wr, int wc, int fr, int fq) const {
        const int row0 = u.pm * BM + wr * 64 + fr, col0 = u.pn * BM + wc * 32 + 8 * fq;
#pragma unroll
        for (int ai = 0; ai < 2; ++ai)
#pragma unroll
            for (int m = 0; m < 4; ++m) { bf16_t* rowp = O + (size_t)(row0 + ai * HALF + m * 16) * ldc + col0;
#pragma unroll
                for (int bj = 0; bj < 2; ++bj) { const f32x4 v0 = acc[ai][bj][m][0], v1 = acc[ai][bj][m][1];
                    u32x4 w; w.x = cvt_pk_bf16(v0[0], v0[1]); w.y = cvt_pk_bf16(v0[2], v0[3]); w.z = cvt_pk_bf16(v1[0], v1[1]); w.w = cvt_pk_bf16(v1[2], v1[3]);
                    *(u32x4*)(rowp + bj * HALF) = w; } }
    }
};
struct EpiSwiglu {
    static constexpr bool PERM = true, AFTER_DRAIN = false;
    bf16_t* O; int ldc;
    __device__ __forceinline__ void operator()(const f32x4 (&acc)[2][2][4][2], const Unit& u, int wr, int wc, int fr, int fq) const {
        const int row0 = u.pm * BM + wr * 64 + fr, col0 = u.pn * HALF + wc * 32 + 8 * fq;
#pragma unroll
        for (int ai = 0; ai < 2; ++ai)
#pragma unroll
            for (int m = 0; m < 4; ++m) { bf16_t* rowp = O + (size_t)(row0 + ai * HALF + m * 16) * ldc + col0;
                f32x4 h0, h1;
#pragma unroll
                for (int i = 0; i < 4; ++i) { h0[i] = silu_fast(acc[ai][0][m][0][i]) * acc[ai][1][m][0][i]; h1[i] = silu_fast(acc[ai][0][m][1][i]) * acc[ai][1][m][1][i]; }
                u32x4 w; w.x = cvt_pk_bf16(h0[0], h0[1]); w.y = cvt_pk_bf16(h0[2], h0[3]); w.z = cvt_pk_bf16(h1[0], h1[1]); w.w = cvt_pk_bf16(h1[2], h1[3]);
                *(u32x4*)rowp = w; }
    }
};
struct EpiResid {
    static constexpr bool PERM = false, AFTER_DRAIN = false;
    float* xl; float* xc; int tl_rows; int panels_per_batch; const float* mod; int mod_stride; int gate_off; float coef;
    __device__ __forceinline__ void operator()(const f32x4 (&acc)[2][2][4][2], const Unit& u, int wr, int wc, int fr, int fq) const {
        const int prow = u.pm * BM; const bool lat = prow < tl_rows;
        float* base = lat ? xl + (size_t)prow * 1024 : xc + (size_t)(prow - tl_rows) * 1024;
        const int mr = lat ? u.pm / panels_per_batch : 4;
        const float* gate = mod + (size_t)mr * mod_stride + gate_off;
        const int row0 = wr * 64 + fr, col0 = u.pn * BM + wc * 32 + 4 * fq;
        f32x4 gv[2][2];
#pragma unroll
        for (int bj = 0; bj < 2; ++bj)
#pragma unroll
            for (int n = 0; n < 2; ++n) gv[bj][n] = *(const f32x4*)(gate + col0 + bj * HALF + n * 16) * coef;
#pragma unroll
        for (int ai = 0; ai < 2; ++ai)
#pragma unroll
            for (int m = 0; m < 4; ++m) { float* rowp = base + (size_t)(row0 + ai * HALF + m * 16) * 1024 + col0;
#pragma unroll
                for (int bj = 0; bj < 2; ++bj)
#pragma unroll
                    for (int n = 0; n < 2; ++n) { f32x4* p = (f32x4*)(rowp + bj * HALF + n * 16); *p = *p + gv[bj][n] * acc[ai][bj][m][n]; } }
    }
};
template <class Epi, class Sched, bool ALIGN_EPI = false, bool SP2 = false>
__device__ __forceinline__ void gemm_phase(PG8_LAS unsigned char* lds, const Gemm g, const Sched& S, const Epi& E, const int tid  ) {
    const int wid = __builtin_amdgcn_readfirstlane(tid >> 6), lane = tid & 63, wr = wid >> 2, wc = wid & 3, fr = lane & 15, fq = lane >> 4;
    const int K = g.K, nt = K / BK;
    unsigned voffA[2], voffB[2];
#pragma unroll
    for (int i = 0; i < 2; ++i) { int R, C; stage_rc(tid * 16 + i * 8192, R, C); const int Rb = Epi::PERM ? ((R & ~31) + perm32(R & 31)) : R;
        voffA[i] = (unsigned)(R * K + C) * 2u; voffB[i] = (unsigned)(Rb * K + C) * 2u; }
    const size_t kstep = (size_t)(BK * 2);
    const size_t hstep = (size_t)HALF * K * 2;
    const size_t tstep = 2 * hstep;
    const unsigned ldsw = (unsigned)wid * 1024u;
    const int aoff = lds_byte(wr * 64 + fr, fq * 8), boff = lds_byte(wc * 32 + fr, fq * 8);
#define PG8_SA(b, h) (((b) * 2 + (h)) * HTB)
#define PG8_SB(b, h) ((4 + (b) * 2 + (h)) * HTB)
#define PG8_STAGE(bufoff, gbase, voff) do { _Pragma("unroll") for (int _i = 0; _i < 2; ++_i) \
        __builtin_amdgcn_global_load_lds((const unsigned*)((const char*)(gbase) + (voff)[_i]), (PG8_LAS unsigned*)(lds + (bufoff) + ldsw + _i * 8192), 16, 0, 0); } while (0)
#define PG8_LDA(dst, b, h) do { _Pragma("unroll") for (int m = 0; m < 4; ++m) _Pragma("unroll") for (int k = 0; k < 2; ++k) dst[m][k] = *(const PG8_LAS bf16x8*)(lds + PG8_SA(b, h) + aoff + m * 2048 + k * 1024); } while (0)
#define PG8_LDB(dst, b, h) do { _Pragma("unroll") for (int n = 0; n < 2; ++n) _Pragma("unroll") for (int k = 0; k < 2; ++k) dst[n][k] = *(const PG8_LAS bf16x8*)(lds + PG8_SB(b, h) + boff + n * 2048 + k * 1024); } while (0)
#define PG8_MMA(ai, bj, At, Bt) do { __builtin_amdgcn_s_setprio(1); _Pragma("unroll") for (int m = 0; m < 4; ++m) _Pragma("unroll") for (int n = 0; n < 2; ++n) _Pragma("unroll") for (int k = 0; k < 2; ++k) \
        acc[ai][bj][m][n] = __builtin_amdgcn_mfma_f32_16x16x32_f16(__builtin_bit_cast(half8, Bt[n][k]), __builtin_bit_cast(half8, At[m][k]), acc[ai][bj][m][n], 0, 0, 0); __builtin_amdgcn_s_setprio(0); } while (0)
#define PG8_WAIT_V(n) asm volatile("s_waitcnt vmcnt(" #n ")" ::: "memory")
#define PG8_WAIT_L(n) asm volatile("s_waitcnt lgkmcnt(" #n ")" ::: "memory")
#define PG8_BAR __builtin_amdgcn_s_barrier()
#define PG8_SCHED __builtin_amdgcn_sched_barrier(0)
    Unit cur, nxt; int ui = 0;
    if (!S.next(0, cur)) return;
    f32x4 acc[2][2][4][2];
#pragma unroll
    for (int a = 0; a < 2; ++a)
#pragma unroll
        for (int b = 0; b < 2; ++b)
#pragma unroll
            for (int m = 0; m < 4; ++m)
#pragma unroll
                for (int n = 0; n < 2; ++n) acc[a][b][m][n] = (f32x4){0.f, 0.f, 0.f, 0.f};
    bf16x8 At[4][2], B0[2][2], B1[2][2];
    const char* cA = (const char*)g.A + (size_t)cur.pm * tstep; const char* cB = (const char*)g.Bt + (size_t)cur.pn * tstep;
    S.a_ready(cur);
    if constexpr (SP2) {
        PG8_STAGE(PG8_SB(0, 0), cB, voffB); PG8_STAGE(PG8_SB(0, 1), cB + hstep, voffB); PG8_STAGE(PG8_SA(0, 0), cA, voffA); PG8_STAGE(PG8_SA(0, 1), cA + hstep, voffA);
        if (wr == 1) PG8_BAR;
        PG8_WAIT_V(2); PG8_BAR;
        PG8_STAGE(PG8_SB(1, 0), cB + kstep, voffB); PG8_STAGE(PG8_SA(1, 0), cA + kstep, voffA); PG8_STAGE(PG8_SB(1, 1), cB + hstep + kstep, voffB);
        PG8_WAIT_V(6); PG8_BAR;
    } else {
        PG8_STAGE(PG8_SB(0, 0), cB, voffB); PG8_STAGE(PG8_SA(0, 0), cA, voffA); PG8_STAGE(PG8_SB(0, 1), cB + hstep, voffB); PG8_STAGE(PG8_SA(0, 1), cA + hstep, voffA);
        if (wr == 1) PG8_BAR;
        PG8_WAIT_V(4); PG8_BAR;
        PG8_STAGE(PG8_SB(1, 0), cB + kstep, voffB); PG8_STAGE(PG8_SA(1, 0), cA + kstep, voffA); PG8_STAGE(PG8_SB(1, 1), cB + hstep + kstep, voffB);
        PG8_WAIT_V(6); PG8_BAR;
    }
    for (;;) {
        const bool has_next = S.next(ui + 1, nxt);
        const char* nA = has_next ? (const char*)g.A + (size_t)nxt.pm * tstep : cA; const char* nB = has_next ? (const char*)g.Bt + (size_t)nxt.pn * tstep : cB;
        for (int t = 0; t < nt; t += 2) {
            const bool last = (t == nt - 2);
            const char* a1 = cA + (size_t)(t + 1) * kstep;
            const char* a2 = last ? nA : cA + (size_t)(t + 2) * kstep; const char* b2 = last ? nB : cB + (size_t)(t + 2) * kstep;
            const char* a3 = a2 + kstep; const char* b3 = b2 + kstep;
            if (last && has_next) S.a_ready(nxt);
            if constexpr (SP2) {
            PG8_LDB(B0, 0, 0); PG8_LDB(B1, 0, 1); PG8_SCHED; PG8_LDA(At, 0, 0); PG8_STAGE(PG8_SA(1, 1), a1 + hstep, voffA);
            PG8_WAIT_V(8); PG8_WAIT_L(0); PG8_BAR; PG8_MMA(0, 0, At, B0); PG8_MMA(0, 1, At, B1); PG8_BAR; PG8_SCHED;
            PG8_LDA(At, 0, 1); PG8_STAGE(PG8_SB(0, 0), b2, voffB); PG8_STAGE(PG8_SB(0, 1), b2 + hstep, voffB); PG8_STAGE(PG8_SA(0, 0), a2, voffA);
            PG8_WAIT_V(8); PG8_WAIT_L(0); PG8_BAR; PG8_MMA(1, 0, At, B0); PG8_MMA(1, 1, At, B1); PG8_BAR; PG8_SCHED;
            PG8_LDB(B0, 1, 0); PG8_LDB(B1, 1, 1); PG8_SCHED; PG8_LDA(At, 1, 0); PG8_STAGE(PG8_SA(0, 1), a2 + hstep, voffA);
            PG8_WAIT_V(8); PG8_WAIT_L(0); PG8_BAR; PG8_MMA(0, 0, At, B0); PG8_MMA(0, 1, At, B1); PG8_BAR; PG8_SCHED;
            PG8_LDA(At, 1, 1); PG8_STAGE(PG8_SB(1, 0), b3, voffB); PG8_STAGE(PG8_SB(1, 1), b3 + hstep, voffB); PG8_STAGE(PG8_SA(1, 0), a3, voffA);
            PG8_WAIT_V(8); PG8_WAIT_L(0); PG8_BAR; PG8_MMA(1, 0, At, B0); PG8_MMA(1, 1, At, B1); PG8_BAR; PG8_SCHED;
            } else {
            PG8_LDB(B0, 0, 0); PG8_SCHED; PG8_LDA(At, 0, 0); PG8_STAGE(PG8_SA(1, 1), a1 + hstep, voffA);
            PG8_WAIT_L(8); PG8_BAR; PG8_WAIT_L(0); PG8_MMA(0, 0, At, B0); PG8_BAR; PG8_SCHED;
            PG8_LDB(B1, 0, 1); PG8_STAGE(PG8_SB(0, 0), b2, voffB);
            PG8_BAR; PG8_WAIT_L(0); PG8_MMA(0, 1, At, B1); PG8_BAR;
            PG8_LDA(At, 0, 1); PG8_STAGE(PG8_SA(0, 0), a2, voffA);
            PG8_BAR; PG8_WAIT_L(0); PG8_MMA(1, 0, At, B0); PG8_BAR; PG8_SCHED;
            PG8_STAGE(PG8_SB(0, 1), b2 + hstep, voffB);
            PG8_WAIT_V(6); PG8_BAR; PG8_MMA(1, 1, At, B1); PG8_BAR;
            PG8_LDB(B0, 1, 0); PG8_SCHED; PG8_LDA(At, 1, 0); PG8_STAGE(PG8_SA(0, 1), a2 + hstep, voffA);
            PG8_WAIT_L(8); PG8_BAR; PG8_WAIT_L(0); PG8_MMA(0, 0, At, B0); PG8_BAR; PG8_SCHED;
            PG8_LDB(B1, 1, 1); PG8_STAGE(PG8_SB(1, 0), b3, voffB);
            PG8_BAR; PG8_WAIT_L(0); PG8_MMA(0, 1, At, B1); PG8_BAR;
            PG8_LDA(At, 1, 1); PG8_STAGE(PG8_SA(1, 0), a3, voffA);
            PG8_BAR; PG8_WAIT_L(0); PG8_MMA(1, 0, At, B0); PG8_BAR; PG8_SCHED;
            PG8_STAGE(PG8_SB(1, 1), b3 + hstep, voffB);
            PG8_WAIT_V(6); PG8_BAR; PG8_MMA(1, 1, At, B1); PG8_BAR;
            }
        }
        if constexpr (ALIGN_EPI) { if (wr == 0) PG8_BAR; }
        if constexpr (!Epi::AFTER_DRAIN) { E(acc, cur, wr, wc, fr, fq); S.done(cur); }
        if (!has_next) break;
#pragma unroll
        for (int a = 0; a < 2; ++a)
#pragma unroll
            for (int b = 0; b < 2; ++b)
#pragma unroll
                for (int m = 0; m < 4; ++m)
#pragma unroll
                    for (int n = 0; n < 2; ++n) acc[a][b][m][n] = (f32x4){0.f, 0.f, 0.f, 0.f};
        cur = nxt; cA = nA; cB = nB; ++ui;
        if constexpr (ALIGN_EPI) { if (wr == 1) PG8_BAR; }
    }
    PG8_WAIT_V(0);
    if constexpr (!ALIGN_EPI) { if (wr == 0) PG8_BAR; }
    PG8_BAR;
    if constexpr (Epi::AFTER_DRAIN) { E.fused(acc, cur, wr, wc, fr, fq, lds, wid, lane); S.done(cur); }
#undef PG8_SA
#undef PG8_SB
#undef PG8_STAGE
#undef PG8_LDA
#undef PG8_LDB
#undef PG8_MMA
#undef PG8_WAIT_V
#undef PG8_WAIT_L
#undef PG8_BAR
#undef PG8_SCHED
}
}

namespace {
#define LAS __attribute__((address_space(3)))
#define GAS __attribute__((address_space(1)))
typedef unsigned short bf16;
typedef unsigned v4u __attribute__((ext_vector_type(4)));
typedef GAS unsigned gu32;
constexpr int D = 1024, NB = 4, SEQ = 4096, CTX = 256, DEPTH = 2;
constexpr int TL = NB * SEQ, TC = NB * CTX, T = TL + TC;
constexpr int DFF = 2816, DIN = 2064, DU = 2048, NMOD = 9, MODW = NMOD * D;
constexpr int NR = NB + 1;
constexpr float EPS = 1e-6f;
constexpr int C_AX = 0, C_Q = 256, C_K = 768, C_V = 896, C_MQ = 1024, C_MK = 1280, C_MV = 1536, C_MO = 1792;
constexpr int NWAVES = 8, NTHREADS = 512;
constexpr int RING_BYTES = 131072, MISC_OFF = RING_BYTES, LDS_BYTES = 147456;
constexpr size_t al256(size_t x) { return (x + 255) & ~(size_t)255; }
constexpr size_t WS_CTL = 0, CTL_ZERO_BYTES = 65536;
constexpr int CW_BAR = 1024;
constexpr size_t WS_MOD = 1u << 20;
constexpr size_t WS_WI = al256(WS_MOD + (size_t)DEPTH * NR * MODW * 4);
constexpr size_t WS_WO = al256(WS_WI + (size_t)4 * 2 * DFF * D * 2);
constexpr size_t WS_WIN = al256(WS_WO + (size_t)4 * D * DFF * 2);
constexpr size_t WS_WOUT = al256(WS_WIN + (size_t)2 * DU * D * 2);
constexpr size_t WS_XC = al256(WS_WOUT + (size_t)2 * D * D * 2);
constexpr size_t WS_G = al256(WS_XC + (size_t)TC * D * 4);
constexpr size_t WS_HB = al256(WS_G + (size_t)T * 16 * 4);
constexpr size_t WS_Y = al256(WS_HB + (size_t)T * D * 2);
constexpr size_t WS_R = al256(WS_Y + (size_t)T * D * 2);
constexpr size_t WS_HS = al256(WS_R + (size_t)T * DFF * 2);
constexpr size_t WS_NL = al256(WS_HS + (size_t)2 * T * 256 * 4);
constexpr size_t WS_AM = al256(WS_NL + (size_t)32 * 68 * 64 * 4);
constexpr size_t WS_MS = al256(WS_AM + (size_t)32 * 68 * 2 * 4);
constexpr size_t WS_END = al256(WS_MS + (size_t)32 * 68 * 4);

struct Ptrs { float* xl; float* xc; };
__device__ __forceinline__ int mod_row(int r) { return r < TL ? r / SEQ : NB; }
__device__ __forceinline__ float* xrow(const Ptrs& p, int r) { return r < TL ? p.xl + (size_t)r * D : p.xc + (size_t)(r - TL) * D; }
__device__ __forceinline__ float silu_f(float x) { return x / (1.f + expf(-x)); }
__device__ __forceinline__ float sigmoid_f(float x) { return 1.f / (1.f + expf(-x)); }
__device__ __forceinline__ float logsigmoid_f(float x) { return fminf(x, 0.f) - log1pf(expf(-fabsf(x))); }
__device__ __forceinline__ float bf2f(bf16 b) { return (float)__builtin_bit_cast(_Float16, b); }
__device__ __forceinline__ unsigned f2bf(float f) { return (unsigned)__builtin_bit_cast(unsigned short, (_Float16)f); }
__device__ __forceinline__ unsigned pk2(float lo, float hi) { return f2bf(lo) | (f2bf(hi) << 16); }
__device__ __forceinline__ float wave_sum(float v) {
#pragma unroll
    for (int o = 1; o < 64; o <<= 1) v += __shfl_xor(v, o);
    return v; }
#define RLX_AGENT __ATOMIC_RELAXED, __HIP_MEMORY_SCOPE_AGENT
#define XB_TMO      128
#define XB_XCNT(j)  (256  + 64 * (j))
#define XB_XSUB(j)  (1280 + 64 * (j))
#define XB_XGEN(j)  (2304 + 64 * (j))
#define XB_TOP      3328
#define XB_TOPGEN   3392
#define XCD_BAR_WORDS 3456
#define XB_SPIN_CAP (1u << 18)

__device__ __forceinline__ unsigned xb_ld(unsigned* p)              { return __hip_atomic_load(p, __ATOMIC_RELAXED, __HIP_MEMORY_SCOPE_AGENT); }
__device__ __forceinline__ unsigned xb_add(unsigned* p, unsigned v) { return __hip_atomic_fetch_add(p, v, __ATOMIC_RELAXED, __HIP_MEMORY_SCOPE_AGENT); }
__device__ __forceinline__ unsigned xb_xcc_id() { return (unsigned)__builtin_amdgcn_s_getreg((3 << 11) | 20) & 0xFu; }
#define XB_SPIN(cond, bar) do { unsigned _sp = 0; while (cond) { __builtin_amdgcn_s_sleep(1); \
    if ((++_sp & 255u) == 0u) { if (xb_ld(&(bar)[XB_TMO])) break; if (_sp > XB_SPIN_CAP) { atomicAdd(&(bar)[XB_TMO], 1u); break; } } } } while (0)

struct XcdBarrier {
    unsigned* bar; unsigned x;
    volatile LAS unsigned* st;
};

__device__ __forceinline__ XcdBarrier xcd_barrier_post(unsigned* bar, volatile LAS unsigned* st) {
    XcdBarrier b; b.bar = bar; b.x = xb_xcc_id(); b.st = st;
    if (threadIdx.x == 0) (void)xb_add(&bar[XB_XCNT(b.x)], 1u);
    return b;
}
__device__ __forceinline__ void xcd_barrier_complete(unsigned* bar, unsigned x, unsigned& nloc, unsigned& nx) {
    const unsigned G = gridDim.x * gridDim.y * gridDim.z;
    unsigned sum, cnt, mine, sp = 0u;
    for (;;) {
        sum = 0u; cnt = 0u; mine = 0u;
#pragma unroll
        for (unsigned j = 0; j < 16; ++j) { const unsigned c = xb_ld(&bar[XB_XCNT(j)]); sum += c; cnt += (c > 0u) ? 1u : 0u; mine = (j == x) ? c : mine; }
        if (sum == G) break;
        __builtin_amdgcn_s_sleep(1);
        if ((++sp & 255u) == 0u) { if (xb_ld(&bar[XB_TMO])) break; if (sp > XB_SPIN_CAP) { atomicAdd(&bar[XB_TMO], 1u); break; } }
    }
    nloc = mine > 0u ? mine : 1u; nx = cnt > 0u ? cnt : 1u;
}

__device__ __forceinline__ void xcd_barrier(const XcdBarrier& b) {
    asm volatile("s_waitcnt vmcnt(0)" ::: "memory");
    __syncthreads();
    if (threadIdx.x == 0) {
        unsigned* bar = b.bar;
        __builtin_amdgcn_s_waitcnt(0);
        unsigned nloc = b.st[0], nx = b.st[1];
        if (nloc == 0u) { xcd_barrier_complete(bar, b.x, nloc, nx); b.st[0] = nloc; b.st[1] = nx; }
        const unsigned old = xb_add(&bar[XB_XSUB(b.x)], 1u);
        const unsigned gen = old / nloc;
        if (old + 1u == (gen + 1u) * nloc) {
            __builtin_amdgcn_fence(__ATOMIC_RELEASE, "agent");
            asm volatile("s_waitcnt vmcnt(0)" ::: "memory");
            const unsigned og = xb_add(&bar[XB_TOP], 1u);
            const unsigned tg = og / nx;
            if (og + 1u == (tg + 1u) * nx) xb_add(&bar[XB_TOPGEN], 1u);
            else XB_SPIN(xb_ld(&bar[XB_TOPGEN]) == tg, bar);
            __builtin_amdgcn_fence(__ATOMIC_ACQUIRE, "agent");
            xb_add(&bar[XB_XGEN(b.x)], 1u);
            asm volatile("s_waitcnt vmcnt(0)" ::: "memory");
        } else {
            XB_SPIN(xb_ld(&bar[XB_XGEN(b.x)]) == gen, bar);
            __builtin_amdgcn_fence(__ATOMIC_ACQUIRE, "agent");
            asm volatile("s_waitcnt vmcnt(0)" ::: "memory");
        }
    }
    __syncthreads();
}

struct Frame {
    LAS unsigned char* lds; unsigned char* ldsg;
    int tid, lane, wave, G, bid, gw, NGW;
    float* out; unsigned char* ws;
};

struct Params { const float* in[17]; float* out; unsigned char* ws; };
__device__ __forceinline__ void ph_mod(Frame& F, const Params& P) {
    const float* c = P.in[1]; const float* cctx = P.in[3]; const float* w_ada = P.in[4]; const float* b_ada = P.in[5]; float* MOD = (float*)(F.ws + WS_MOD);
    float* s = (float*)F.ldsg;
    for (int vb = F.bid; vb < DEPTH * (MODW / NTHREADS); vb += F.G) {
        const int l = vb / (MODW / NTHREADS), j = (vb % (MODW / NTHREADS)) * NTHREADS + F.tid;
        __syncthreads();
        for (int i = F.tid; i < NR * D; i += NTHREADS) { const int r = i / D, k = i % D; const float v = r < NB ? c[r * D + k] : cctx[k]; s[i] = silu_f(v); }
        __syncthreads();
        float acc[NR];
#pragma unroll
        for (int r = 0; r < NR; ++r) acc[r] = 0.f;
        const float* w = w_ada + (size_t)l * D * MODW + j;
        for (int k = 0; k < D; ++k) { const float wv = w[(size_t)k * MODW];
#pragma unroll
            for (int r = 0; r < NR; ++r) acc[r] += s[r * D + k] * wv; }
#pragma unroll
        for (int r = 0; r < NR; ++r) MOD[((size_t)l * NR + r) * MODW + j] = acc[r] + b_ada[l * MODW + j];
    }
    __syncthreads();
}
__device__ __forceinline__ void transpose_item(const float* W, int ldw, int K, bf16* WT, int dst_row0, int k0, int n0, LAS float* scr, int lane) {
#pragma unroll 8
    for (int i = 0; i < 32; ++i) { const int kk = 2 * i + (lane >> 5); scr[kk * 33 + (lane & 31)] = W[(size_t)(k0 + kk) * ldw + n0 + (lane & 31)]; }
    asm volatile("s_waitcnt lgkmcnt(0)" ::: "memory");
    const int c = lane & 7;
#pragma unroll
    for (int j = 0; j < 4; ++j) { const int n = (lane >> 3) + 8 * j; const LAS float* s = scr + (8 * c) * 33 + n;
        v4u o; o.x = pk2(s[0 * 33], s[1 * 33]); o.y = pk2(s[2 * 33], s[3 * 33]); o.z = pk2(s[4 * 33], s[5 * 33]); o.w = pk2(s[6 * 33], s[7 * 33]);
        *(v4u*)(WT + (size_t)(dst_row0 + n) * K + k0 + 8 * c) = o; }
    asm volatile("s_waitcnt lgkmcnt(0)" ::: "memory");
}
__device__ __forceinline__ void ph_prologue(Frame& F, const Params& P) {
    const float* w_ffn_in = P.in[7]; const float* w_ffn_out = P.in[8]; const float* w_in = P.in[9]; const float* w_out = P.in[10];
    bf16* Wi_t = (bf16*)(F.ws + WS_WI); bf16* Wo_t = (bf16*)(F.ws + WS_WO); bf16* Win_t = (bf16*)(F.ws + WS_WIN); bf16* Wout_t = (bf16*)(F.ws + WS_WOUT);
    LAS float* scr = (LAS float*)(F.lds + F.wave * 16384);
    constexpr int I_FI = (D / 64) * (2 * DFF / 32), I_FO = (DFF / 64) * (D / 32), I_IN = (D / 64) * (DU / 32), I_OUT = (D / 64) * (D / 32);
    constexpr int NITEMS = 4 * I_FI + 4 * I_FO + 2 * I_IN + 2 * I_OUT;
    for (int it = F.gw; it < NITEMS; it += F.NGW) {
        int r = it;
        if (r < 4 * I_FI) { const int mat = r / I_FI; r %= I_FI; const int nblk = 2 * DFF / 32, kb = r / nblk, nb = r % nblk, n0 = 32 * nb;
            const int nn = n0 < DFF ? n0 : n0 - DFF; const int drow = 256 * (nn / 128) + (n0 < DFF ? 0 : 128) + (nn % 128);
            transpose_item(w_ffn_in + (size_t)mat * D * 2 * DFF, 2 * DFF, D, Wi_t + (size_t)mat * 2 * DFF * D, drow, 64 * kb, n0, scr, F.lane); continue; }
        r -= 4 * I_FI;
        if (r < 4 * I_FO) { const int mat = r / I_FO; r %= I_FO; const int nblk = D / 32, kb = r / nblk, nb = r % nblk;
            transpose_item(w_ffn_out + (size_t)mat * DFF * D, D, DFF, Wo_t + (size_t)mat * D * DFF, 32 * nb, 64 * kb, 32 * nb, scr, F.lane); continue; }
        r -= 4 * I_FO;
        if (r < 2 * I_IN) { const int mat = r / I_IN; r %= I_IN; const int nblk = DU / 32, kb = r / nblk, nb = r % nblk;
            transpose_item(w_in + (size_t)mat * D * DIN, DIN, D, Win_t + (size_t)mat * DU * D, 32 * nb, 64 * kb, 32 * nb, scr, F.lane); continue; }
        r -= 2 * I_IN;
        { const int mat = r / I_OUT; r %= I_OUT; const int nblk = D / 32, kb = r / nblk, nb = r % nblk;
            transpose_item(w_out + (size_t)mat * D * D, D, D, Wout_t + (size_t)mat * D * D, 32 * nb, 64 * kb, 32 * nb, scr, F.lane); }
    }
    const float* x = P.in[0]; const float* ctx = P.in[2]; float* xl = F.out; float* xc = (float*)(F.ws + WS_XC);
    const size_t gt = (size_t)F.bid * NTHREADS + F.tid, NGT = (size_t)F.G * NTHREADS;
    for (size_t i = gt; i < (size_t)T * D / 4; i += NGT) {
        if (i < (size_t)TL * D / 4) ((float4*)xl)[i] = ((const float4*)x)[i]; else ((float4*)xc)[i - (size_t)TL * D / 4] = ((const float4*)ctx)[i - (size_t)TL * D / 4]; }
}
__device__ __forceinline__ void ph_normmod(Frame& F, const Ptrs& p, const float* g, const float* mod, int shift_idx, int scale_idx) {
    bf16* H = (bf16*)(F.ws + WS_HB);
    for (int r = F.gw; r < T; r += F.NGW) {
        const float* x = xrow(p, r); const int mr = mod_row(r);
        float4 v[4]; float ss = 0.f;
#pragma unroll
        for (int j = 0; j < 4; ++j) { v[j] = ((const float4*)x)[F.lane + 64 * j]; ss += v[j].x * v[j].x + v[j].y * v[j].y + v[j].z * v[j].z + v[j].w * v[j].w; }
        const float rstd = rsqrtf(wave_sum(ss) * (1.f / D) + EPS);
#pragma unroll
        for (int j = 0; j < 4; ++j) { const int q = F.lane + 64 * j;
            const float4 gv = ((const float4*)g)[q], sc = ((const float4*)(mod + (size_t)mr * MODW + scale_idx * D))[q], sh = ((const float4*)(mod + (size_t)mr * MODW + shift_idx * D))[q];
            uint2 o; o.x = pk2(v[j].x * rstd * gv.x * (1.f + sc.x) + sh.x, v[j].y * rstd * gv.y * (1.f + sc.y) + sh.y); o.y = pk2(v[j].z * rstd * gv.z * (1.f + sc.z) + sh.z, v[j].w * rstd * gv.w * (1.f + sc.w) + sh.w);
            ((uint2*)(H + (size_t)r * D))[q] = o; }
    }
}
__device__ __forceinline__ void ph_final(Frame& F, const Params& P) {
    const float* g = P.in[16];
    for (int r = F.gw; r < TL; r += F.NGW) {
        float* x = F.out + (size_t)r * D;
        float4 v[4]; float ss = 0.f;
#pragma unroll
        for (int j = 0; j < 4; ++j) { v[j] = ((const float4*)x)[F.lane + 64 * j]; ss += v[j].x * v[j].x + v[j].y * v[j].y + v[j].z * v[j].z + v[j].w * v[j].w; }
        const float rstd = rsqrtf(wave_sum(ss) * (1.f / D) + EPS);
#pragma unroll
        for (int j = 0; j < 4; ++j) { const int q = F.lane + 64 * j; const float4 gv = ((const float4*)g)[q];
            ((float4*)x)[q] = make_float4(v[j].x * rstd * gv.x, v[j].y * rstd * gv.y, v[j].z * rstd * gv.z, v[j].w * rstd * gv.w); }
    }
}
__device__ __forceinline__ void ph_gates(Frame& F, const float* w_in_l) {
    const bf16* H = (const bf16*)(F.ws + WS_HB); float* G = (float*)(F.ws + WS_G);
    for (int r = F.gw; r < T; r += F.NGW) {
        float acc[16];
#pragma unroll
        for (int j = 0; j < 16; ++j) acc[j] = 0.f;
        for (int i = 0; i < 16; ++i) { const int k = F.lane + 64 * i; const float h = bf2f(H[(size_t)r * D + k]); const float4* w = (const float4*)(w_in_l + (size_t)k * DIN + DU);
#pragma unroll
            for (int q = 0; q < 4; ++q) { const float4 wv = w[q]; acc[4 * q] += h * wv.x; acc[4 * q + 1] += h * wv.y; acc[4 * q + 2] += h * wv.z; acc[4 * q + 3] += h * wv.w; } }
#pragma unroll
        for (int j = 0; j < 16; ++j) acc[j] = wave_sum(acc[j]);
        if (F.lane == 0) {
#pragma unroll
            for (int j = 0; j < 16; ++j) G[(size_t)r * 16 + j] = acc[j]; }
    }
}
__device__ __forceinline__ void ph_rope(Frame& F) {
    bf16* U = (bf16*)(F.ws + WS_R);
    for (int gid = F.bid * NTHREADS + F.tid; gid < TL * 160; gid += F.G * NTHREADS) {
        const int i = gid & 15, hs = (gid >> 4) % 10, r = gid / 160;
        const int n = r % SEQ, prow = n / 64, pcol = n % 64;
        const float inv = powf(10000.f, -(float)i / 16.f);
        const float ar = (float)prow * inv, ac = (float)pcol * inv;
        bf16* base = U + (size_t)r * DU + C_Q + hs * 64;
        const float t1 = bf2f(base[i]), t2 = bf2f(base[16 + i]), t3 = bf2f(base[32 + i]), t4 = bf2f(base[48 + i]);
        const float c1 = cosf(ar), s1 = sinf(ar), c2 = cosf(ac), s2 = sinf(ac);
        base[i] = (bf16)f2bf(t1 * c1 - t2 * s1); base[16 + i] = (bf16)f2bf(t2 * c1 + t1 * s1); base[32 + i] = (bf16)f2bf(t3 * c2 - t4 * s2); base[48 + i] = (bf16)f2bf(t4 * c2 + t3 * s2);
    }
}
__device__ __forceinline__ void ph_attn_simple(Frame& F, const float* sink, int wg0, int nwg) {
    const bf16* U = (const bf16*)(F.ws + WS_R); bf16* Y = (bf16*)(F.ws + WS_Y);
    for (int gid = (F.bid - wg0) * NTHREADS + F.tid; gid < T * 16; gid += nwg * NTHREADS) {
        const int half = gid & 1, h = (gid >> 1) & 7, r = gid >> 4;
        const int kvh = h >> 2; int b, lo = 0, hi = -1;
        if (r < TL) { b = r / SEQ; const int n = r % SEQ; lo = n - 128 < 0 ? 0 : n - 128; hi = n + 128 > SEQ - 1 ? SEQ - 1 : n + 128; } else b = (r - TL) / CTX;
        float q[64];
        { const bf16* qp = U + (size_t)r * DU + C_Q + h * 64;
#pragma unroll
          for (int d = 0; d < 64; ++d) q[d] = bf2f(qp[d]) * 0.125f; }
        const bf16* kl = U + (size_t)(b * SEQ) * DU + C_K + kvh * 64;
        const bf16* kc = U + (size_t)(TL + b * CTX) * DU + C_K + kvh * 64;
        const float sk = sink[h];
        float m = sk;
        for (int kp = lo; kp <= hi; ++kp) { const bf16* k = kl + (size_t)kp * DU; float s = 0.f;
#pragma unroll
            for (int d = 0; d < 64; ++d) s += q[d] * bf2f(k[d]);
            m = fmaxf(m, s); }
        for (int j = 0; j < CTX; ++j) { const bf16* k = kc + (size_t)j * DU; float s = 0.f;
#pragma unroll
            for (int d = 0; d < 64; ++d) s += q[d] * bf2f(k[d]);
            m = fmaxf(m, s); }
        float o[32]; float l = expf(sk - m);
#pragma unroll
        for (int d = 0; d < 32; ++d) o[d] = 0.f;
        for (int kp = lo; kp <= hi; ++kp) { const bf16* k = kl + (size_t)kp * DU; float s = 0.f;
#pragma unroll
            for (int d = 0; d < 64; ++d) s += q[d] * bf2f(k[d]);
            const float e = expf(s - m); l += e; const bf16* v = k + (C_V - C_K) + half * 32;
#pragma unroll
            for (int d = 0; d < 32; ++d) o[d] += e * bf2f(v[d]); }
        for (int j = 0; j < CTX; ++j) { const bf16* k = kc + (size_t)j * DU; float s = 0.f;
#pragma unroll
            for (int d = 0; d < 64; ++d) s += q[d] * bf2f(k[d]);
            const float e = expf(s - m); l += e; const bf16* v = k + (C_V - C_K) + half * 32;
#pragma unroll
            for (int d = 0; d < 32; ++d) o[d] += e * bf2f(v[d]); }
        const float il = 1.f / l; bf16* yp = Y + (size_t)r * D + 256 + h * 64 + half * 32;
#pragma unroll
        for (int d = 0; d < 32; ++d) yp[d] = (bf16)f2bf(o[d] * il);
    }
}
__device__ __forceinline__ void ph_four_ch(Frame& F, int wg0, int nwg) {
    const bf16* U = (const bf16*)(F.ws + WS_R); float* AB = (float*)(F.ws + WS_HB);
    float* ct = (float*)F.ldsg; float* st = ct + 64;
    if (F.tid < 64) { float s, c; sincospif((float)F.tid / 32.f, &s, &c); ct[F.tid] = c; st[F.tid] = s; }
    __syncthreads();
    for (int gid = (F.bid - wg0) * NTHREADS + F.tid; gid < T * 256; gid += nwg * NTHREADS) {
        const int r = gid >> 8, g = (gid >> 6) & 3, m = gid & 63;
        const bf16* u = U + (size_t)r * DU + C_AX + g * 64; float a = 0.f, bsum = 0.f;
        for (int c = 0; c < 64; ++c) { const float v = bf2f(u[c]); const int idx = (m * c) & 63; a += v * ct[idx]; bsum += v * st[idx]; }
        AB[(size_t)r * 512 + g * 128 + m] = a; AB[(size_t)r * 512 + g * 128 + 64 + m] = bsum;
    }
    __syncthreads();
}
__device__ __forceinline__ void ph_four_pos(Frame& F) {
    const float* AB = (const float*)(F.ws + WS_HB); float* Fo = (float*)(F.ws + WS_R + (size_t)T * DU * 2);
    float* ct = (float*)F.ldsg; float* st = ct + SEQ;
    for (int i = F.tid; i < SEQ; i += NTHREADS) { float s, c; sincospif((float)i / (float)(SEQ / 2), &s, &c); ct[i] = c; st[i] = s; }
    __syncthreads();
    const int kh = F.tid >> 8, g = (F.tid >> 6) & 3, m = F.tid & 63;
    constexpr int VB_L = NB * (SEQ / 8), VB_C = NB * (CTX / 8);
    for (int vb = F.bid; vb < VB_L + VB_C; vb += F.G) {
        const bool lat = vb < VB_L; const int N = lat ? SEQ : CTX; const int v2 = lat ? vb : vb - VB_L; const int seq = v2 / (N / 8), k0 = (v2 % (N / 8)) * 8 + kh * 4;
        const int row_base = (lat ? 0 : TL) + seq * N; const int tstep = SEQ / N;
        const float* ab = AB + (size_t)row_base * 512 + g * 128 + m;
        float acc[4] = {0.f, 0.f, 0.f, 0.f};
        for (int n = 0; n < N; ++n) { const float a = ab[(size_t)n * 512], bb = ab[(size_t)n * 512 + 64];
#pragma unroll
            for (int kk = 0; kk < 4; ++kk) { const int idx = (((k0 + kk) * n) & (N - 1)) * tstep; acc[kk] += ct[idx] * a - st[idx] * bb; } }
        const float sc = rsqrtf(64.f * (float)N);
#pragma unroll
        for (int kk = 0; kk < 4; ++kk) Fo[(size_t)(row_base + k0 + kk) * 256 + g * 64 + m] = acc[kk] * sc;
    }
    __syncthreads();
}
__device__ __forceinline__ void ph_four_mix(Frame& F, const float* wf) {
    const float* Fo = (const float*)(F.ws + WS_R + (size_t)T * DU * 2); bf16* Y = (bf16*)(F.ws + WS_Y);
    for (int gid = F.bid * NTHREADS + F.tid; gid < T * 256; gid += F.G * NTHREADS) {
        const int r = gid >> 8, g = (gid >> 6) & 3, e = gid & 63;
        const float* f = Fo + (size_t)r * 256 + g * 64; const float* w = wf + (size_t)g * 4096 + e; float a = 0.f;
        for (int c = 0; c < 64; ++c) a += f[c] * w[c * 64];
        Y[(size_t)r * D + g * 64 + e] = (bf16)f2bf(a);
    }
}

typedef _Float16 half8 __attribute__((ext_vector_type(8)));
typedef _Float16 half4 __attribute__((ext_vector_type(4)));
typedef float f32x16 __attribute__((ext_vector_type(16)));
typedef float f32x4v __attribute__((ext_vector_type(4)));
constexpr int TP = 144;
constexpr int NCH = 68, NCHAIN = 32, NITEM = NCHAIN * NCH;
__device__ __forceinline__ f32x16 mfma32(half8 a, half8 b, f32x16 c) { return __builtin_amdgcn_mfma_f32_32x32x16_f16(a, b, c, 0, 0, 0); }
__device__ __forceinline__ float wave_max(float v) {
#pragma unroll
    for (int o = 1; o < 64; o <<= 1) v = fmaxf(v, __shfl_xor(v, o));
    return v; }
struct ChunkGeo { int N, rb, p0, dp; };
__device__ __forceinline__ ChunkGeo chunk_geo(int b, int dir, int c  ) {
    ChunkGeo g; const bool isctx = c < 4; const int cc = isctx ? c : c - 4; g.N = isctx ? CTX : SEQ; g.rb = isctx ? TL + b * CTX : b * SEQ;
    if (dir == 0) { g.p0 = cc * 64; g.dp = 1; } else { g.p0 = g.N - 1 - cc * 64; g.dp = -1; }
    return g; }
__device__ __forceinline__ void conv16(const bf16* urow  , int p, int N, int colbase, const float* cw, float scale, float (&out)[16]) {
    const v4u c0 = *(const v4u*)(urow + colbase), c1 = *(const v4u*)(urow + colbase + 8);
    v4u m0 = {0u, 0u, 0u, 0u}, m1 = m0, n0 = m0, n1 = m0;
    if (p > 0) { m0 = *(const v4u*)(urow - DU + colbase); m1 = *(const v4u*)(urow - DU + colbase + 8); }
    if (p < N - 1) { n0 = *(const v4u*)(urow + DU + colbase); n1 = *(const v4u*)(urow + DU + colbase + 8); }
    const half8 hc0 = __builtin_bit_cast(half8, c0), hc1 = __builtin_bit_cast(half8, c1), hm0 = __builtin_bit_cast(half8, m0), hm1 = __builtin_bit_cast(half8, m1), hn0 = __builtin_bit_cast(half8, n0), hn1 = __builtin_bit_cast(half8, n1);
#pragma unroll
    for (int i = 0; i < 16; ++i) { const float xm = i < 8 ? (float)hm0[i] : (float)hm1[i - 8], xc = i < 8 ? (float)hc0[i] : (float)hc1[i - 8], xn = i < 8 ? (float)hn0[i] : (float)hn1[i - 8];
        const float a = xm * cw[i] + xc * cw[512 + i] + xn * cw[1024 + i]; out[i] = a * __builtin_amdgcn_rcpf(1.f + __expf(-a)) * scale; }
}
__device__ __forceinline__ void st_row16(LAS unsigned char* tile, int row, int c0, const float (&v)[16]) {
    v4u a, b; a.x = pk2(v[0], v[1]); a.y = pk2(v[2], v[3]); a.z = pk2(v[4], v[5]); a.w = pk2(v[6], v[7]); b.x = pk2(v[8], v[9]); b.y = pk2(v[10], v[11]); b.z = pk2(v[12], v[13]); b.w = pk2(v[14], v[15]);
    *(LAS v4u*)(tile + row * TP + c0 * 2) = a; *(LAS v4u*)(tile + row * TP + c0 * 2 + 16) = b; }
__device__ __forceinline__ void st_col16(LAS unsigned char* tile, int col, int r0, const float (&v)[16]) {
#pragma unroll
    for (int i = 0; i < 16; ++i) *(LAS unsigned short*)(tile + (r0 + i) * TP + col * 2) = (unsigned short)f2bf(v[i]); }
__device__ __forceinline__ half8 ld_row8(const LAS unsigned char* tile, int row, int c0) { return __builtin_bit_cast(half8, *(const LAS v4u*)(tile + row * TP + c0 * 2)); }

__device__ __forceinline__ void ph_mlstm_m1(Frame& F, const float* conv, const float* b_i, const float* b_f) {
    const bf16* U = (const bf16*)(F.ws + WS_R); const float* G = (const float*)(F.ws + WS_G);
    float* CL = (float*)(F.ws + WS_HS); float* NL = (float*)(F.ws + WS_NL); float* AM = (float*)(F.ws + WS_AM);
    const int dir = F.wave >> 2, wg = F.wave & 3, tg = F.tid & 255, r32 = F.lane & 31, hh = F.lane >> 5;
    LAS unsigned char* base = F.lds + dir * 24576; LAS unsigned char* KT = base; LAS unsigned char* VT = base + 9216; LAS float* wS = (LAS float*)(base + 18432);
    for (int it = F.bid; it < 16 * NCH; it += F.G) {
        const int bh = it / NCH, c = it % NCH, b = bh >> 2, h = bh & 3; const ChunkGeo g = chunk_geo(b, dir, c); const int item = (bh * 2 + dir) * NCH + c;
        if (wg == 0) { const int p = g.p0 + g.dp * F.lane; const float* g0 = G + (size_t)(g.rb + p) * 16;
            const float liv = g0[dir * 4 + h] + b_i[dir * 4 + h], lfv = logsigmoid_f(g0[8 + dir * 4 + h] + b_f[dir * 4 + h]);
            float bc = lfv;
#pragma unroll
            for (int o = 1; o < 64; o <<= 1) { const float t = __shfl_up(bc, o); if (F.lane >= o) bc += t; }
            const float a = __shfl(bc, 63); const float dl = a - bc + liv; const float ml = wave_max(dl);
            wS[F.lane] = __expf(dl - ml);
            if (F.lane == 0) { AM[item * 2] = a; AM[item * 2 + 1] = ml; } }
        __syncthreads();
        { const int tau = tg >> 2, d0 = (tg & 3) * 16; const int p = g.p0 + g.dp * tau; const bf16* urow = U + (size_t)(g.rb + p) * DU;
          float kv[16], vv[16]; conv16(urow, p, g.N, C_MK + h * 64 + d0, conv + 256 + h * 64 + d0, 0.125f, kv);
          const float w = wS[tau]; const half8 v0 = __builtin_bit_cast(half8, *(const v4u*)(urow + C_MV + h * 64 + d0)), v1 = __builtin_bit_cast(half8, *(const v4u*)(urow + C_MV + h * 64 + d0 + 8));
#pragma unroll
          for (int i = 0; i < 16; ++i) vv[i] = (i < 8 ? (float)v0[i] : (float)v1[i - 8]) * w;
          st_col16(KT, tau, d0, kv); st_col16(VT, tau, d0, vv); }
        __syncthreads();
        { const int tm = wg >> 1, tn = wg & 1; f32x16 acc = {};
#pragma unroll
          for (int s = 0; s < 4; ++s) acc = mfma32(ld_row8(VT, 32 * tm + r32, 16 * s + 8 * hh), ld_row8(KT, 32 * tn + r32, 16 * s + 8 * hh), acc);
          float* cl = CL + (size_t)item * 4096 + 32 * tn + r32;
#pragma unroll
          for (int r = 0; r < 16; ++r) cl[(size_t)(32 * tm + (r & 3) + 8 * (r >> 2) + 4 * hh) * 64] = acc[r];
          if (tg < 64) { float a = 0.f; const LAS unsigned char* kr = KT + tg * TP;
#pragma unroll 8
              for (int s = 0; s < 64; ++s) a += wS[s] * bf2f(*(const LAS unsigned short*)(kr + s * 2));
              NL[(size_t)item * 64 + tg] = a; } }
        __syncthreads();
    }
}
__device__ __forceinline__ void ph_mlstm_m2(Frame& F) {
    float* CL = (float*)(F.ws + WS_HS); float* NL = (float*)(F.ws + WS_NL); const float* AM = (const float*)(F.ws + WS_AM); float* MS = (float*)(F.ws + WS_MS);
    for (int vb = F.bid; vb < NCHAIN * 8; vb += F.G) {
        const int chain = vb >> 3, sl = vb & 7, e = sl * NTHREADS + F.tid; const bool don = (sl == 0 && F.tid < 64);
        float* cp = CL + (size_t)chain * NCH * 4096 + e; float* np = NL + (size_t)chain * NCH * 64 + F.tid; const float* am = AM + (size_t)chain * NCH * 2;
        float C = 0.f, nvv = 0.f, m = 0.f;
        float pre[4], pren[4];
#pragma unroll
        for (int j = 0; j < 4; ++j) { pre[j] = cp[(size_t)j * 4096]; pren[j] = don ? np[j * 64] : 0.f; }
        for (int c0 = 0; c0 < NCH; c0 += 4) {
            float cur[4], curn[4];
#pragma unroll
            for (int j = 0; j < 4; ++j) { cur[j] = pre[j]; curn[j] = pren[j]; }
            if (c0 + 4 < NCH) {
#pragma unroll
                for (int j = 0; j < 4; ++j) { pre[j] = cp[(size_t)(c0 + 4 + j) * 4096]; pren[j] = don ? np[(c0 + 4 + j) * 64] : 0.f; } }
#pragma unroll
            for (int j = 0; j < 4; ++j) { const int c = c0 + j; const float a = am[c * 2], ml = am[c * 2 + 1];
                const float mn = fmaxf(a + m, ml), al = __expf(a + m - mn), be = __expf(ml - mn);
                cp[(size_t)c * 4096] = C; C = al * C + be * cur[j];
                if (don) { np[c * 64] = nvv; nvv = al * nvv + be * curn[j]; }
                if (sl == 0 && F.tid == 0) MS[chain * NCH + c] = m;
                m = mn; }
        }
    }
}
__device__ __forceinline__ void ph_mlstm_m3(Frame& F, const float* conv, const float* b_i, const float* b_f) {
    const bf16* U = (const bf16*)(F.ws + WS_R); const float* G = (const float*)(F.ws + WS_G); bf16* Y = (bf16*)(F.ws + WS_Y);
    const float* CS = (const float*)(F.ws + WS_HS); const float* NS = (const float*)(F.ws + WS_NL); const float* MS = (const float*)(F.ws + WS_MS);
    const int dir = F.wave >> 2, wg = F.wave & 3, tg = F.tid & 255, r32 = F.lane & 31, hh = F.lane >> 5;
    LAS unsigned char* base = F.lds + dir * 40960; LAS unsigned char* Qs = base; LAS unsigned char* Ks = base + 9216; LAS unsigned char* VT = base + 18432; LAS unsigned char* Cs = base + 27648;
    LAS float* fa = (LAS float*)(base + 36864); LAS float* bcS = fa; LAS float* lmbS = fa + 64; LAS float* mtS = fa + 128; LAS float* wpS = fa + 192; LAS float* n0S = fa + 256;
    LAS float* HO = (LAS float*)(F.lds + 81920);
    for (int it = F.bid; it < 16 * NCH; it += F.G) {
        const int bh = it / NCH, pbi = it % NCH, b = bh >> 2, h = bh & 3;
        const bool isctx = pbi < 4; const int pb = isctx ? pbi : pbi - 4, N = isctx ? CTX : SEQ, rb = isctx ? TL + b * CTX : b * SEQ;
        const int cs = dir == 0 ? pb : N / 64 - 1 - pb;
        const int item = (bh * 2 + dir) * NCH + (isctx ? cs : 4 + cs);
        const int p0 = dir == 0 ? pb * 64 : pb * 64 + 63, dp = dir == 0 ? 1 : -1;
        if (wg == 0) { const int p = p0 + dp * F.lane; const float* g0 = G + (size_t)(rb + p) * 16;
            const float liv = g0[dir * 4 + h] + b_i[dir * 4 + h], lfv = logsigmoid_f(g0[8 + dir * 4 + h] + b_f[dir * 4 + h]);
            float bc = lfv;
#pragma unroll
            for (int o = 1; o < 64; o <<= 1) { const float t = __shfl_up(bc, o); if (F.lane >= o) bc += t; }
            const float lmb = liv - bc; float pm = lmb;
#pragma unroll
            for (int o = 1; o < 64; o <<= 1) { const float t = __shfl_up(pm, o); if (F.lane >= o) pm = fmaxf(pm, t); }
            const float m0 = MS[item]; const float mt = bc + fmaxf(m0, pm);
            bcS[F.lane] = bc; lmbS[F.lane] = lmb; mtS[F.lane] = mt; wpS[F.lane] = __expf(bc + m0 - mt); n0S[F.lane] = NS[(size_t)item * 64 + F.lane]; }
        { const int tau = tg >> 2, d0 = (tg & 3) * 16; const int p = p0 + dp * tau; const bf16* urow = U + (size_t)(rb + p) * DU;
          float qv[16], kv[16], vv[16]; conv16(urow, p, N, C_MQ + h * 64 + d0, conv + h * 64 + d0, 1.0f, qv); conv16(urow, p, N, C_MK + h * 64 + d0, conv + 256 + h * 64 + d0, 0.125f, kv);
          const half8 v0 = __builtin_bit_cast(half8, *(const v4u*)(urow + C_MV + h * 64 + d0)), v1 = __builtin_bit_cast(half8, *(const v4u*)(urow + C_MV + h * 64 + d0 + 8));
#pragma unroll
          for (int i = 0; i < 16; ++i) vv[i] = i < 8 ? (float)v0[i] : (float)v1[i - 8];
          st_row16(Qs, tau, d0, qv); st_row16(Ks, tau, d0, kv); st_col16(VT, tau, d0, vv);
          const float* cg = CS + (size_t)item * 4096 + tau * 64 + d0; float cv[16];
#pragma unroll
          for (int q4 = 0; q4 < 4; ++q4) { const f32x4v x = *(const f32x4v*)(cg + 4 * q4); cv[4 * q4] = x[0]; cv[4 * q4 + 1] = x[1]; cv[4 * q4 + 2] = x[2]; cv[4 * q4 + 3] = x[3]; }
          st_row16(Cs, tau, d0, cv); }
        __syncthreads();
        f32x16 ho;
        { const int tt = wg & 1, tv = wg >> 1; const int tau = 32 * tt + r32;
          half8 qf[4];
#pragma unroll
          for (int s = 0; s < 4; ++s) qf[s] = ld_row8(Qs, tau, 16 * s + 8 * hh);
          f32x16 st0 = {}, st1 = {};
#pragma unroll
          for (int s = 0; s < 4; ++s) { st0 = mfma32(ld_row8(Ks, r32, 16 * s + 8 * hh), qf[s], st0); st1 = mfma32(ld_row8(Ks, 32 + r32, 16 * s + 8 * hh), qf[s], st1); }
          const float ct = bcS[tau] - mtS[tau]; float dpart = 0.f;
#pragma unroll
          for (int r = 0; r < 16; ++r) { const int sg = (r & 3) + 8 * (r >> 2) + 4 * hh;
              const float w0 = sg <= tau ? __expf(ct + lmbS[sg]) : 0.f, w1 = sg + 32 <= tau ? __expf(ct + lmbS[sg + 32]) : 0.f;
              st0[r] *= w0; st1[r] *= w1; dpart += st0[r] + st1[r]; }
          float qn = 0.f;
#pragma unroll
          for (int s = 0; s < 4; ++s)
#pragma unroll
              for (int j = 0; j < 8; ++j) qn += (float)qf[s][j] * n0S[16 * s + 8 * hh + j];
          dpart += __shfl_xor(dpart, 32); qn += __shfl_xor(qn, 32);
          const float wp = wpS[tau], mt = mtS[tau]; const float den = dpart + wp * qn; const float inv = 1.f / fmaxf(fabsf(den), __expf(-mt));
          f32x16 an = {}, ac = {};
#pragma unroll
          for (int ks = 0; ks < 4; ++ks) { const f32x16& sx = (ks >> 1) ? st1 : st0; const int rbs = 8 * (ks & 1);
              half8 bf;
#pragma unroll
              for (int j = 0; j < 8; ++j) bf[j] = (_Float16)sx[rbs + j];
              const LAS unsigned char* vr = VT + (32 * tv + r32) * TP + (16 * ks + 4 * hh) * 2;
              const half4 a0 = *(const LAS half4*)vr, a1 = *(const LAS half4*)(vr + 16);
              const half8 af = {a0[0], a0[1], a0[2], a0[3], a1[0], a1[1], a1[2], a1[3]};
              an = mfma32(af, bf, an); }
#pragma unroll
          for (int s = 0; s < 4; ++s) ac = mfma32(ld_row8(Cs, 32 * tv + r32, 16 * s + 8 * hh), qf[s], ac);
#pragma unroll
          for (int r = 0; r < 16; ++r) ho[r] = (an[r] + wp * ac[r]) * inv;
          if (dir == 0) {
#pragma unroll
              for (int q4 = 0; q4 < 4; ++q4) { f32x4v x = {ho[4 * q4], ho[4 * q4 + 1], ho[4 * q4 + 2], ho[4 * q4 + 3]}; *(LAS f32x4v*)(HO + tau * 68 + 32 * tv + 8 * q4 + 4 * hh) = x; } } }
        __syncthreads();
        if (dir == 1) { const int tt = wg & 1, tv = wg >> 1; const int tau = 32 * tt + r32, pos = 63 - tau; const size_t row = (size_t)(rb + pb * 64 + pos);
#pragma unroll
            for (int q4 = 0; q4 < 4; ++q4) { const int v0 = 32 * tv + 8 * q4 + 4 * hh; const f32x4v x = *(const LAS f32x4v*)(HO + pos * 68 + v0);
                const half4 mo = *(const half4*)(U + row * DU + C_MO + h * 64 + v0); float o[4];
#pragma unroll
                for (int i = 0; i < 4; ++i) { const float g = 1.f / (1.f + __expf(-(float)mo[i])); o[i] = fminf(fmaxf(g * (x[i] + ho[4 * q4 + i]), -60000.f), 60000.f); }
                uint2 w; w.x = pk2(o[0], o[1]); w.y = pk2(o[2], o[3]); *(uint2*)(Y + row * D + 768 + h * 64 + v0) = w; } }
        __syncthreads();
    }
}

template <class Epi> __device__ __forceinline__ void run_gemm(Frame& F, const bf16* A, const bf16* Bt, int M, int N, int K, const Epi& E) {
    pg8::Gemm g{A, Bt, M, N, K}; pg8::StaticOrder S; S.init(M, N, F.G, F.bid);
    pg8::gemm_phase<Epi, pg8::StaticOrder, true, true>(F.lds, g, S, E, F.tid);
}
__device__ __forceinline__ Frame make_frame(const Params& P, unsigned char* lds_raw) {
    Frame F; int t = threadIdx.x; asm volatile("" : "+v"(t));
    F.lds = (LAS unsigned char*)lds_raw; F.ldsg = lds_raw;
    F.tid = t; F.lane = t & 63; F.wave = __builtin_amdgcn_readfirstlane(t >> 6);
    int g = gridDim.x, b = blockIdx.x; asm volatile("" : "+s"(g), "+s"(b));
    F.G = g; F.bid = b; F.gw = b * NWAVES + F.wave; F.NGW = g * NWAVES;
    unsigned char* ws = P.ws; float* out = P.out; asm volatile("" : "+s"(ws), "+s"(out));
    F.out = out; F.ws = ws;
    return F;
}
__device__ __forceinline__ void grid_bar(const Params& P, unsigned char* lds_raw) {
    unsigned char* ws = P.ws; asm volatile("" : "+s"(ws));
    XcdBarrier b; b.bar = (unsigned*)(ws + WS_CTL) + CW_BAR; b.x = xb_xcc_id(); b.st = (volatile LAS unsigned*)((LAS unsigned char*)lds_raw + MISC_OFF) + 8;
    xcd_barrier(b);
}
__global__ void __launch_bounds__(NTHREADS, 2) mega_fwd(Params P) {
    extern __shared__ __attribute__((aligned(16))) unsigned char lds_raw[];
    { const int tid = threadIdx.x;
      for (int u = tid; u < (LDS_BYTES - MISC_OFF) / 4; u += NTHREADS) ((LAS unsigned*)((LAS unsigned char*)lds_raw + MISC_OFF))[u] = 0u;
      __syncthreads();
      (void)xcd_barrier_post((unsigned*)(P.ws + WS_CTL) + CW_BAR, (volatile LAS unsigned*)((LAS unsigned char*)lds_raw + MISC_OFF) + 8); }
#define GRID_BAR() grid_bar(P, lds_raw)
#define FRAME() Frame F = make_frame(P, lds_raw); Ptrs p{F.out, (float*)(F.ws + WS_XC)}; (void)p

    { FRAME(); ph_mod(F, P); ph_prologue(F, P); }
    GRID_BAR();
#pragma unroll 1
    for (int l = 0; l < DEPTH; ++l) {
#pragma unroll 1
        for (int half = 0; half < 2; ++half) {
            const int sub = half * 2, f = half;
            if (half == 1) {
                { FRAME(); const float* mod = (const float*)(F.ws + WS_MOD) + (size_t)l * NR * MODW; ph_normmod(F, p, P.in[6] + (size_t)l * 3 * D + 1 * D, mod, 3, 4); }
                GRID_BAR();
                { FRAME(); pg8::EpiBf16Plain E{(bf16*)(F.ws + WS_R), DU}; run_gemm(F, (const bf16*)(F.ws + WS_HB), (const bf16*)(F.ws + WS_WIN) + (size_t)l * DU * D, T, DU, D, E); }
                { FRAME(); ph_gates(F, P.in[9] + (size_t)l * D * DIN); }
                GRID_BAR();
                { FRAME(); ph_rope(F); }
                GRID_BAR();
                { FRAME(); ph_mlstm_m1(F, P.in[13] + (size_t)l * 3 * 512, P.in[14] + l * 8, P.in[15] + l * 8); }
                { FRAME(); ph_four_ch(F, 0, F.G); ph_attn_simple(F, P.in[12] + l * 8, 0, F.G); }
                GRID_BAR();
                { FRAME(); ph_mlstm_m2(F); }
                { FRAME(); ph_four_pos(F); }
                GRID_BAR();
                { FRAME(); ph_mlstm_m3(F, P.in[13] + (size_t)l * 3 * 512, P.in[14] + l * 8, P.in[15] + l * 8); }
                { FRAME(); ph_four_mix(F, P.in[11] + (size_t)l * 4 * 4096); }
                GRID_BAR();
                { FRAME(); const float* mod = (const float*)(F.ws + WS_MOD) + (size_t)l * NR * MODW;
                  pg8::EpiResid E{p.xl, p.xc, TL, SEQ / 256, mod, MODW, 5 * D, 1.0f}; run_gemm(F, (const bf16*)(F.ws + WS_Y), (const bf16*)(F.ws + WS_WOUT) + (size_t)l * D * D, T, D, D, E); }
                GRID_BAR();
            }
            { FRAME(); const float* mod = (const float*)(F.ws + WS_MOD) + (size_t)l * NR * MODW; ph_normmod(F, p, P.in[6] + (size_t)l * 3 * D + sub * D, mod, 3 * sub, 3 * sub + 1); }
            GRID_BAR();
            { FRAME(); pg8::EpiSwiglu E{(bf16*)(F.ws + WS_R), DFF}; run_gemm(F, (const bf16*)(F.ws + WS_HB), (const bf16*)(F.ws + WS_WI) + (size_t)(l * 2 + f) * 2 * DFF * D, T, 2 * DFF, D, E); }
            GRID_BAR();
            { FRAME(); const float* mod = (const float*)(F.ws + WS_MOD) + (size_t)l * NR * MODW;
              pg8::EpiResid E{p.xl, p.xc, TL, SEQ / 256, mod, MODW, (3 * sub + 2) * D, 0.5f}; run_gemm(F, (const bf16*)(F.ws + WS_R), (const bf16*)(F.ws + WS_WO) + (size_t)(l * 2 + f) * D * DFF, T, D, DFF, E); }
            GRID_BAR();
        }
    }
    { FRAME(); ph_final(F, P); }
}
}

extern "C" void kernel_launch(void* const* d_in, const int* in_sizes, int n_in, void* d_out, int out_size, void* d_ws, size_t ws_size, hipStream_t stream) {
    static int grid = 0;
    if (grid == 0) {
        if (n_in != 17 || ws_size < WS_END) { fprintf(stderr, "kernel_launch: need 17 inputs and %zu bytes of workspace; got %d inputs, %zu bytes\n", (size_t)WS_END, n_in, ws_size); grid = -1; return; }
        int dev = 0, cus = 0, per_cu = 0;
        if (hipGetDevice(&dev) != hipSuccess || hipDeviceGetAttribute(&cus, hipDeviceAttributeMultiprocessorCount, dev) != hipSuccess) { grid = -1; return; }
        if (hipFuncSetAttribute((const void*)mega_fwd, hipFuncAttributeMaxDynamicSharedMemorySize, LDS_BYTES) != hipSuccess) { fprintf(stderr, "kernel_launch: hipFuncSetAttribute failed\n"); grid = -1; return; }
        if (hipOccupancyMaxActiveBlocksPerMultiprocessor(&per_cu, (const void*)mega_fwd, NTHREADS, LDS_BYTES) != hipSuccess || per_cu < 1) { fprintf(stderr, "kernel_launch: occupancy query says %d workgroups per CU\n", per_cu); (void)hipGetLastError(); grid = -1; return; }
        grid = cus;
    }
    if (grid < 0) return;
    (void)hipMemsetAsync((char*)d_ws + WS_CTL, 0, CTL_ZERO_BYTES, stream);
    Params P{};
    for (int i = 0; i < 17; ++i) P.in[i] = (const float*)d_in[i];
    P.out = (float*)d_out; P.ws = (unsigned char*)d_ws;
    hipLaunchKernelGGL(mega_fwd, dim3(grid), dim3(NTHREADS), LDS_BYTES, stream, P);
}
```

```cpp
#include <hip/hip_runtime.h>
#include <cstdio>
#include <cstdint>
namespace pg8 {
#define PG8_LAS __attribute__((address_space(3)))
typedef unsigned short bf16_t;
typedef short bf16x8 __attribute__((ext_vector_type(8)));
typedef float f32x4 __attribute__((ext_vector_type(4)));
typedef unsigned u32x4 __attribute__((ext_vector_type(4)));
typedef _Float16 half8 __attribute__((ext_vector_type(8)));
constexpr int BM = 256, BK = 64, HALF = 128, HTB = HALF * BK * 2  , STAGE_BYTES = 8 * HTB, NXCD = 8, WGM = 8;

__host__ __device__ __forceinline__ int lds_byte(int r, int c) { const int st = (r >> 4) * 2 + (c >> 5), rr = r & 15, cc = c & 31, ob = rr * 64 + cc * 2; return st * 1024 + (ob ^ (((ob >> 9) & 1) << 5)); }
__host__ __device__ __forceinline__ void stage_rc(int b, int& R, int& C) { const int st = b / 1024, sb = b % 1024, swz = sb ^ (((sb >> 9) & 1) << 5); R = (st >> 1) * 16 + swz / 64; C = (st & 1) * 32 + (swz % 64) / 2; }
__host__ __device__ __forceinline__ int perm32(int rho) { const int n = rho >> 4, i = rho & 15; return 8 * (i >> 2) + 4 * n + (i & 3); }

struct Unit { int pm, pn; };
struct Gemm { const bf16_t* A; const bf16_t* Bt; int M, N, K; };

struct StaticOrder {
    int nM, nN, nwg, G, c;
    __host__ __device__ void init(int M, int N, int G_, int c_) { nM = M / BM; nN = N / BM; nwg = nM * nN; G = G_; c = c_; }
    __host__ __device__ bool next(int i, Unit& u) const {
        const long L = (long)i * G + c; if (L >= nwg) return false;
        int wgid = (int)L; { const int q = nwg / NXCD, r = nwg % NXCD, xcd = wgid % NXCD, off = wgid / NXCD; wgid = (xcd < r ? xcd * (q + 1) : r * (q + 1) + (xcd - r) * q) + off; }
        const int nig = WGM * nN, gid = wgid / nig, fm = gid * WGM, gsz = (nM - fm) < WGM ? (nM - fm) : WGM;
        u.pm = fm + ((wgid % nig) % gsz); u.pn = (wgid % nig) / gsz; return true;
    }
    __device__ __forceinline__ void a_ready(const Unit&) const {}
    __device__ __forceinline__ void done(const Unit&) const {}
};

__device__ __forceinline__ unsigned cvt_pk_bf16(float lo, float hi) { typedef float f2_t __attribute__((ext_vector_type(2))); typedef _Float16 h2_t __attribute__((ext_vector_type(2))); const f2_t v = {lo, hi}; return __builtin_bit_cast(unsigned, __builtin_convertvector(v, h2_t)); }
__device__ __forceinline__ float silu_fast(float x) { return x * __builtin_amdgcn_rcpf(1.f + __expf(-x)); }
struct EpiBf16Plain {
    static constexpr bool PERM = true, AFTER_DRAIN = false;
    bf16_t* O; int ldc;
    __device__ __forceinline__ void operator()(const f32x4 (&acc)[2][2][4][2], const Unit& u, int wr, int wc, int fr, int fq) const {
        const int row0 = u.pm * BM + wr * 64 + fr, col0 = u.pn * BM + wc * 32 + 8 * fq;
#pragma unroll
        for (int ai = 0; ai < 2; ++ai)
#pragma unroll
            for (int m = 0; m < 4; ++m) { bf16_t* rowp = O + (size_t)(row0 + ai * HALF + m * 16) * ldc + col0;
#pragma unroll
                for (int bj = 0; bj < 2; ++bj) { const f32x4 v0 = acc[ai][bj][m][0], v1 = acc[ai][bj][m][1];
                    u32x4 w; w.x = cvt_pk_bf16(v0[0], v0[1]); w.y = cvt_pk_bf16(v0[2], v0[3]); w.z = cvt_pk_bf16(v1[0], v1[1]); w.w = cvt_pk_bf16(v1[2], v1[3]);
                    *(u32x4*)(rowp + bj * HALF) = w; } }
    }
};
struct EpiSwiglu {
    static constexpr bool PERM = true, AFTER_DRAIN = false;
    bf16_t* O; int ldc;
    __device__ __forceinline__ void operator()(const f32x4 (&acc)[2][2][4][2], const Unit& u, int wr, int wc, int fr, int fq) const {
        const int row0 = u.pm * BM + wr * 64 + fr, col0 = u.pn * HALF + wc * 32 + 8 * fq;
#pragma unroll
        for (int ai = 0; ai < 2; ++ai)
#pragma unroll
            for (int m = 0; m < 4; ++m) { bf16_t* rowp = O + (size_t)(row0 + ai * HALF + m * 16) * ldc + col0;
                f32x4 h0, h1;
#pragma unroll
                for (int i = 0; i < 4; ++i) { h0[i] = silu_fast(acc[ai][0][m][0][i]) * acc[ai][1][m][0][i]; h1[i] = silu_fast(acc[ai][0][m][1][i]) * acc[ai][1][m][1][i]; }
                u32x4 w; w.x = cvt_pk_bf16(h0[0], h0[1]); w.y = cvt_pk_bf16(h0[2], h0[3]); w.z = cvt_pk_bf16(h1[0], h1[1]); w.w = cvt_pk_bf16(h1[2], h1[3]);
                *(u32x4*)rowp = w; }
    }
};
struct EpiResid {
    static constexpr bool PERM = false, AFTER_DRAIN = false;
    float* xl; float* xc; int tl_rows; int panels_per_batch; const float* mod; int mod_stride; int gate_off; float coef;
    __device__ __forceinline__ void operator()(const f32x4 (&acc)[2][2][4][2], const Unit& u, int wr, int wc, int fr, int fq) const {
        const int prow = u.pm * BM; const bool lat = prow < tl_rows;
        float* base = lat ? xl + (size_t)prow * 1024 : xc + (size_t)(prow - tl_rows) * 1024;
        const int mr = lat ? u.pm / panels_per_batch : 4;
        const float* gate = mod + (size_t)mr * mod_stride + gate_off;
        const int row0 = wr * 64 + fr, col0 = u.pn * BM + wc * 32 + 4 * fq;
        f32x4 gv[2][2];
#pragma unroll
        for (int bj = 0; bj < 2; ++bj)
#pragma unroll
            for (int n = 0; n < 2; ++n) gv[bj][n] = *(const f32x4*)(gate + col0 + bj * HALF + n * 16) * coef;
#pragma unroll
        for (int ai = 0; ai < 2; ++ai)
#pragma unroll
            for (int m = 0; m < 4; ++m) { float* rowp = base + (size_t)(row0 + ai * HALF + m * 16) * 1024 + col0;
#pragma unroll
                for (int bj = 0; bj < 2; ++bj)
#pragma unroll
                    for (int n = 0; n < 2; ++n) { f32x4* p = (f32x4*)(rowp + bj * HALF + n * 16); *p = *p + gv[bj][n] * acc[ai][bj][m][n]; } }
    }
};
template <class Epi, class Sched, bool ALIGN_EPI = false, bool SP2 = false>
__device__ __forceinline__ void gemm_phase(PG8_LAS unsigned char* lds, const Gemm g, const Sched& S, const Epi& E, const int tid  ) {
    const int wid = __builtin_amdgcn_readfirstlane(tid >> 6), lane = tid & 63, wr = wid >> 2, wc = wid & 3, fr = lane & 15, fq = lane >> 4;
    const int K = g.K, nt = K / BK;
    unsigned voffA[2], voffB[2];
#pragma unroll
    for (int i = 0; i < 2; ++i) { int R, C; stage_rc(tid * 16 + i * 8192, R, C); const int Rb = Epi::PERM ? ((R & ~31) + perm32(R & 31)) : R;
        voffA[i] = (unsigned)(R * K + C) * 2u; voffB[i] = (unsigned)(Rb * K + C) * 2u; }
    const size_t kstep = (size_t)(BK * 2);
    const size_t hstep = (size_t)HALF * K * 2;
    const size_t tstep = 2 * hstep;
    const unsigned ldsw = (unsigned)wid * 1024u;
    const int aoff = lds_byte(wr * 64 + fr, fq * 8), boff = lds_byte(wc * 32 + fr, fq * 8);
#define PG8_SA(b, h) (((b) * 2 + (h)) * HTB)
#define PG8_SB(b, h) ((4 + (b) * 2 + (h)) * HTB)
#define PG8_STAGE(bufoff, gbase, voff) do { _Pragma("unroll") for (int _i = 0; _i < 2; ++_i) \
        __builtin_amdgcn_global_load_lds((const unsigned*)((const char*)(gbase) + (voff)[_i]), (PG8_LAS unsigned*)(lds + (bufoff) + ldsw + _i * 8192), 16, 0, 0); } while (0)
#define PG8_LDA(dst, b, h) do { _Pragma("unroll") for (int m = 0; m < 4; ++m) _Pragma("unroll") for (int k = 0; k < 2; ++k) dst[m][k] = *(const PG8_LAS bf16x8*)(lds + PG8_SA(b, h) + aoff + m * 2048 + k * 1024); } while (0)
#define PG8_LDB(dst, b, h) do { _Pragma("unroll") for (int n = 0; n < 2; ++n) _Pragma("unroll") for (int k = 0; k < 2; ++k) dst[n][k] = *(const PG8_LAS bf16x8*)(lds + PG8_SB(b, h) + boff + n * 2048 + k * 1024); } while (0)
#define PG8_MMA(ai, bj, At, Bt) do { __builtin_amdgcn_s_setprio(1); _Pragma("unroll") for (int m = 0; m < 4; ++m) _Pragma("unroll") for (int n = 0; n < 2; ++n) _Pragma("unroll") for (int k = 0; k < 2; ++k) \
        acc[ai][bj][m][n] = __builtin_amdgcn_mfma_f32_16x16x32_f16(__builtin_bit_cast(half8, Bt[n][k]), __builtin_bit_cast(half8, At[m][k]), acc[ai][bj][m][n], 0, 0, 0); __builtin_amdgcn_s_setprio(0); } while (0)
#define PG8_WAIT_V(n) asm volatile("s_waitcnt vmcnt(" #n ")" ::: "memory")
#define PG8_WAIT_L(n) asm volatile("s_waitcnt lgkmcnt(" #n ")" ::: "memory")
#define PG8_BAR __builtin_amdgcn_s_barrier()
#define PG8_SCHED __builtin_amdgcn_sched_barrier(0)
    Unit cur, nxt; int ui = 0;
    if (!S.next(0, cur)) return;
    f32x4 acc[2][2][4][2];
#pragma unroll
    for (int a = 0; a < 2; ++a)
#pragma unroll
        for (int b = 0; b < 2; ++b)
#pragma unroll
            for (int m = 0; m < 4; ++m)
#pragma unroll
                for (int n = 0; n < 2; ++n) acc[a][b][m][n] = (f32x4){0.f, 0.f, 0.f, 0.f};
    bf16x8 At[4][2], B0[2][2], B1[2][2];
    const char* cA = (const char*)g.A + (size_t)cur.pm * tstep; const char* cB = (const char*)g.Bt + (size_t)cur.pn * tstep;
    S.a_ready(cur);
    if constexpr (SP2) {
        PG8_STAGE(PG8_SB(0, 0), cB, voffB); PG8_STAGE(PG8_SB(0, 1), cB + hstep, voffB); PG8_STAGE(PG8_SA(0, 0), cA, voffA); PG8_STAGE(PG8_SA(0, 1), cA + hstep, voffA);
        if (wr == 1) PG8_BAR;
        PG8_WAIT_V(2); PG8_BAR;
        PG8_STAGE(PG8_SB(1, 0), cB + kstep, voffB); PG8_STAGE(PG8_SA(1, 0), cA + kstep, voffA); PG8_STAGE(PG8_SB(1, 1), cB + hstep + kstep, voffB);
        PG8_WAIT_V(6); PG8_BAR;
    } else {
        PG8_STAGE(PG8_SB(0, 0), cB, voffB); PG8_STAGE(PG8_SA(0, 0), cA, voffA); PG8_STAGE(PG8_SB(0, 1), cB + hstep, voffB); PG8_STAGE(PG8_SA(0, 1), cA + hstep, voffA);
        if (wr == 1) PG8_BAR;
        PG8_WAIT_V(4); PG8_BAR;
        PG8_STAGE(PG8_SB(1, 0), cB + kstep, voffB); PG8_STAGE(PG8_SA(1, 0), cA + kstep, voffA); PG8_STAGE(PG8_SB(1, 1), cB + hstep + kstep, voffB);
        PG8_WAIT_V(6); PG8_BAR;
    }
    for (;;) {
        const bool has_next = S.next(ui + 1, nxt);
        const char* nA = has_next ? (const char*)g.A + (size_t)nxt.pm * tstep : cA; const char* nB = has_next ? (const char*)g.Bt + (size_t)nxt.pn * tstep : cB;
        for (int t = 0; t < nt; t += 2) {
            const bool last = (t == nt - 2);
            const char* a1 = cA + (size_t)(t + 1) * kstep;
            const char* a2 = last ? nA : cA + (size_t)(t + 2) * kstep; const char* b2 = last ? nB : cB + (size_t)(t + 2) * kstep;
            const char* a3 = a2 + kstep; const char* b3 = b2 + kstep;
            if (last && has_next) S.a_ready(nxt);
            if constexpr (SP2) {
            PG8_LDB(B0, 0, 0); PG8_LDB(B1, 0, 1); PG8_SCHED; PG8_LDA(At, 0, 0); PG8_STAGE(PG8_SA(1, 1), a1 + hstep, voffA);
            PG8_WAIT_V(8); PG8_WAIT_L(0); PG8_BAR; PG8_MMA(0, 0, At, B0); PG8_MMA(0, 1, At, B1); PG8_BAR; PG8_SCHED;
            PG8_LDA(At, 0, 1); PG8_STAGE(PG8_SB(0, 0), b2, voffB); PG8_STAGE(PG8_SB(0, 1), b2 + hstep, voffB); PG8_STAGE(PG8_SA(0, 0), a2, voffA);
            PG8_WAIT_V(8); PG8_WAIT_L(0); PG8_BAR; PG8_MMA(1, 0, At, B0); PG8_MMA(1, 1, At, B1); PG8_BAR; PG8_SCHED;
            PG8_LDB(B0, 1, 0); PG8_LDB(B1, 1, 1); PG8_SCHED; PG8_LDA(At, 1, 0); PG8_STAGE(PG8_SA(0, 1), a2 + hstep, voffA);
            PG8_WAIT_V(8); PG8_WAIT_L(0); PG8_BAR; PG8_MMA(0, 0, At, B0); PG8_MMA(0, 1, At, B1); PG8_BAR; PG8_SCHED;
            PG8_LDA(At, 1, 1); PG8_STAGE(PG8_SB(1, 0), b3, voffB); PG8_STAGE(PG8_SB(1, 1), b3 + hstep, voffB); PG8_STAGE(PG8_SA(1, 0), a3, voffA);
            PG8_WAIT_V(8); PG8_WAIT_L(0); PG8_BAR; PG8_MMA(1, 0, At, B0); PG8_MMA(1, 1, At, B1); PG8_BAR; PG8_SCHED;
            } else {
            PG8_LDB(B0, 0, 0); PG8_SCHED; PG8_LDA(At, 0, 0); PG8_STAGE(PG8_SA(1, 1), a1 + hstep, voffA);
            PG8_WAIT_L(8); PG8_BAR; PG8_WAIT_L(0); PG8_MMA(0, 0, At, B0); PG8_BAR; PG8_SCHED;
            PG8_LDB(B1, 0, 1); PG8_STAGE(PG8_SB(0, 0), b2, voffB);
            PG8_BAR; PG8_WAIT_L(0); PG8_MMA(0, 1, At, B1); PG8_BAR;
            PG8_LDA(At, 0, 1); PG8_STAGE(PG8_SA(0, 0), a2, voffA);
            PG8_BAR; PG8_WAIT_L(0); PG8_MMA(1, 0, At, B0); PG8_BAR; PG8_SCHED;
            PG8_STAGE(PG8_SB(0, 1), b2 + hstep, voffB);
            PG8_WAIT_V(6); PG8_BAR; PG8_MMA(1, 1, At, B1); PG8_BAR;
            PG8_LDB(B0, 1, 0); PG8_SCHED; PG8_LDA(At, 1, 0); PG8_STAGE(PG8_SA(0, 1), a2 + hstep, voffA);
            PG8_WAIT_L(8); PG8_BAR; PG8_WAIT_L(0); PG8_MMA(0, 0, At, B0); PG8_BAR; PG8_SCHED;
            PG8_LDB(B1, 1, 1); PG8_STAGE(PG8_SB(1, 0), b3, voffB);
            PG8_BAR; PG8_WAIT_L(0); PG8_MMA(0, 1, At, B1); PG8_BAR;
            PG8_LDA(At, 1, 1); PG8_STAGE(PG8_SA(1, 0), a3, voffA);
            PG8_BAR; PG8_WAIT_L(0); PG8_MMA(1, 0, At, B0); PG8_BAR; PG8_SCHED;
            PG8_STAGE(PG8_SB(1, 1), b3 + hstep, voffB);
            PG8_WAIT_V(6); PG8_BAR; PG8_MMA(1, 1, At, B1); PG8_BAR;
            }
        }
        if constexpr (ALIGN_EPI) { if (wr == 0) PG8_BAR; }
        if constexpr (!Epi::AFTER_DRAIN) { E(acc, cur, wr, wc, fr, fq); S.done(cur); }
        if (!has_next) break;
#pragma unroll
        for (int a = 0; a < 2; ++a)
#pragma unroll
            for (int b = 0; b < 2; ++b)
#pragma unroll
                for (int m = 0; m < 4; ++m)
#pragma unroll
                    for (int n = 0; n < 2; ++n) acc[a][b][m][n] = (f32x4){0.f, 0.f, 0.f, 0.f};
        cur = nxt; cA = nA; cB = nB; ++ui;
        if constexpr (ALIGN_EPI) { if (wr == 1) PG8_BAR; }
    }
    PG8_WAIT_V(0);
    if constexpr (!ALIGN_EPI) { if (wr == 0) PG8_BAR; }
    PG8_BAR;
    if constexpr (Epi::AFTER_DRAIN) { E.fused(acc, cur, wr, wc, fr, fq, lds, wid, lane); S.done(cur); }
#undef PG8_SA
#undef PG8_SB
#undef PG8_STAGE
#undef PG8_LDA
#undef PG8_LDB
#undef PG8_MMA
#undef PG8_WAIT_V
#undef PG8_WAIT_L
#undef PG8_BAR
#undef PG8_SCHED
}
}

namespace {
#define LAS __attribute__((address_space(3)))
#define GAS __attribute__((address_space(1)))
typedef unsigned short bf16;
typedef unsigned v4u __attribute__((ext_vector_type(4)));
typedef GAS unsigned gu32;
constexpr int D = 1024, NB = 4, SEQ = 4096, CTX = 256, DEPTH = 2;
constexpr int TL = NB * SEQ, TC = NB * CTX, T = TL + TC;
constexpr int DFF = 2816, DIN = 2064, DU = 2304, NMOD = 9, MODW = NMOD * D;
constexpr int NR = NB + 1;
constexpr float EPS = 1e-6f;
constexpr int C_GA = 0, C_GB = 256, C_Q = 512, C_K = 1024, C_V = 1152, C_MQ = 1280, C_MK = 1536, C_MV = 1792, C_MO = 2048;
constexpr int SRC_COL0 = 256, SRC_GATE = 2048;
constexpr int NWAVES = 8, NTHREADS = 512;
constexpr int RING_BYTES = 131072, MISC_OFF = RING_BYTES, LDS_BYTES = 147456;
constexpr size_t al256(size_t x) { return (x + 255) & ~(size_t)255; }
constexpr size_t WS_CTL = 0, CTL_ZERO_BYTES = 65536;
constexpr int CW_BAR = 1024;
constexpr size_t WS_MOD = 1u << 20;
constexpr size_t WS_WI = al256(WS_MOD + (size_t)DEPTH * NR * MODW * 4);
constexpr size_t WS_WO = al256(WS_WI + (size_t)4 * 2 * DFF * D * 2);
constexpr size_t WS_WIN = al256(WS_WO + (size_t)4 * D * DFF * 2);
constexpr size_t WS_WOUT = al256(WS_WIN + (size_t)2 * DU * D * 2);
constexpr size_t WS_XC = al256(WS_WOUT + (size_t)2 * D * D * 2);
constexpr size_t WS_G = al256(WS_XC + (size_t)TC * D * 4);
constexpr size_t WS_HB = al256(WS_G + (size_t)T * 16 * 4);
constexpr size_t WS_Y = al256(WS_HB + (size_t)T * D * 2);
constexpr size_t WS_R = al256(WS_Y + (size_t)T * D * 2);
constexpr size_t WS_HS = al256(WS_R + (size_t)T * DFF * 2);
constexpr size_t WS_NL = al256(WS_HS + (size_t)2 * T * 256 * 4);
constexpr size_t WS_AM = al256(WS_NL + (size_t)32 * 68 * 64 * 4);
constexpr size_t WS_MS = al256(WS_AM + (size_t)32 * 68 * 2 * 4);
constexpr size_t WS_FM1 = al256(WS_MS + (size_t)32 * 68 * 4);
constexpr size_t WS_FM3 = al256(WS_FM1 + 128 * 128 * 2);
constexpr size_t WS_TW = al256(WS_FM3 + 64 * 128 * 2);
constexpr size_t WS_CT = al256(WS_TW + 4096 * 8);
constexpr size_t WS_END = al256(WS_CT + 256 * 8);

struct Ptrs { float* xl; float* xc; };
__device__ __forceinline__ int mod_row(int r) { return r < TL ? r / SEQ : NB; }
__device__ __forceinline__ float* xrow(const Ptrs& p, int r) { return r < TL ? p.xl + (size_t)r * D : p.xc + (size_t)(r - TL) * D; }
__device__ __forceinline__ float silu_f(float x) { return x / (1.f + expf(-x)); }
__device__ __forceinline__ float sigmoid_f(float x) { return 1.f / (1.f + expf(-x)); }
__device__ __forceinline__ float logsigmoid_f(float x) { return fminf(x, 0.f) - log1pf(expf(-fabsf(x))); }
__device__ __forceinline__ float bf2f(bf16 b) { return (float)__builtin_bit_cast(_Float16, b); }
__device__ __forceinline__ unsigned f2bf(float f) { return (unsigned)__builtin_bit_cast(unsigned short, (_Float16)f); }
__device__ __forceinline__ unsigned pk2(float lo, float hi) { return f2bf(lo) | (f2bf(hi) << 16); }
__device__ __forceinline__ float lane_xor(float v, int lane, int o) { return __int_as_float(__builtin_amdgcn_ds_bpermute((lane ^ o) << 2, __float_as_int(v))); }
__device__ __forceinline__ float lane_get(float v, int src) { return __int_as_float(__builtin_amdgcn_ds_bpermute(src << 2, __float_as_int(v))); }
__device__ __forceinline__ float wave_sum(float v, int lane) {
#pragma unroll
    for (int o = 1; o < 64; o <<= 1) v += lane_xor(v, lane, o);
    return v; }
#define RLX_AGENT __ATOMIC_RELAXED, __HIP_MEMORY_SCOPE_AGENT
#define XB_TMO      128
#define XB_XCNT(j)  (256  + 64 * (j))
#define XB_XSUB(j)  (1280 + 64 * (j))
#define XB_XGEN(j)  (2304 + 64 * (j))
#define XB_TOP      3328
#define XB_TOPGEN   3392
#define XCD_BAR_WORDS 3456
#define XB_SPIN_CAP (1u << 18)

__device__ __forceinline__ unsigned xb_ld(unsigned* p)              { return __hip_atomic_load(p, __ATOMIC_RELAXED, __HIP_MEMORY_SCOPE_AGENT); }
__device__ __forceinline__ unsigned xb_add(unsigned* p, unsigned v) { return __hip_atomic_fetch_add(p, v, __ATOMIC_RELAXED, __HIP_MEMORY_SCOPE_AGENT); }
__device__ __forceinline__ unsigned xb_xcc_id() { return (unsigned)__builtin_amdgcn_s_getreg((3 << 11) | 20) & 0xFu; }
#define XB_SPIN(cond, bar) do { unsigned _sp = 0; while (cond) { __builtin_amdgcn_s_sleep(1); \
    if ((++_sp & 255u) == 0u) { if (xb_ld(&(bar)[XB_TMO])) break; if (_sp > XB_SPIN_CAP) { atomicAdd(&(bar)[XB_TMO], 1u); break; } } } } while (0)

struct XcdBarrier {
    unsigned* bar; unsigned x;
    volatile LAS unsigned* st;
};

__device__ __forceinline__ XcdBarrier xcd_barrier_post(unsigned* bar, volatile LAS unsigned* st) {
    XcdBarrier b; b.bar = bar; b.x = xb_xcc_id(); b.st = st;
    if (threadIdx.x == 0) (void)xb_add(&bar[XB_XCNT(b.x)], 1u);
    return b;
}
__device__ __forceinline__ void xcd_barrier_complete(unsigned* bar, unsigned x, unsigned& nloc, unsigned& nx) {
    const unsigned G = gridDim.x * gridDim.y * gridDim.z;
    unsigned sum, cnt, mine, sp = 0u;
    for (;;) {
        sum = 0u; cnt = 0u; mine = 0u;
#pragma unroll
        for (unsigned j = 0; j < 16; ++j) { const unsigned c = xb_ld(&bar[XB_XCNT(j)]); sum += c; cnt += (c > 0u) ? 1u : 0u; mine = (j == x) ? c : mine; }
        if (sum == G) break;
        __builtin_amdgcn_s_sleep(1);
        if ((++sp & 255u) == 0u) { if (xb_ld(&bar[XB_TMO])) break; if (sp > XB_SPIN_CAP) { atomicAdd(&bar[XB_TMO], 1u); break; } }
    }
    nloc = mine > 0u ? mine : 1u; nx = cnt > 0u ? cnt : 1u;
}

__device__ __forceinline__ void xcd_barrier(const XcdBarrier& b) {
    asm volatile("s_waitcnt vmcnt(0)" ::: "memory");
    __syncthreads();
    if (threadIdx.x == 0) {
        unsigned* bar = b.bar;
        __builtin_amdgcn_s_waitcnt(0);
        unsigned nloc = b.st[0], nx = b.st[1];
        if (nloc == 0u) { xcd_barrier_complete(bar, b.x, nloc, nx); b.st[0] = nloc; b.st[1] = nx; }
        const unsigned old = xb_add(&bar[XB_XSUB(b.x)], 1u);
        const unsigned gen = old / nloc;
        if (old + 1u == (gen + 1u) * nloc) {
            __builtin_amdgcn_fence(__ATOMIC_RELEASE, "agent");
            asm volatile("s_waitcnt vmcnt(0)" ::: "memory");
            const unsigned og = xb_add(&bar[XB_TOP], 1u);
            const unsigned tg = og / nx;
            if (og + 1u == (tg + 1u) * nx) xb_add(&bar[XB_TOPGEN], 1u);
            else XB_SPIN(xb_ld(&bar[XB_TOPGEN]) == tg, bar);
            __builtin_amdgcn_fence(__ATOMIC_ACQUIRE, "agent");
            xb_add(&bar[XB_XGEN(b.x)], 1u);
            asm volatile("s_waitcnt vmcnt(0)" ::: "memory");
        } else {
            XB_SPIN(xb_ld(&bar[XB_XGEN(b.x)]) == gen, bar);
            __builtin_amdgcn_fence(__ATOMIC_ACQUIRE, "agent");
            asm volatile("s_waitcnt vmcnt(0)" ::: "memory");
        }
    }
    __syncthreads();
}

struct Frame {
    LAS unsigned char* lds; unsigned char* ldsg;
    int tid, lane, wave, G, bid, gw, NGW;
    float* out; unsigned char* ws;
};

struct Params { const float* in[17]; float* out; unsigned char* ws; };
__device__ __forceinline__ void ph_mod(Frame& F, const Params& P) {
    const float* c = P.in[1]; const float* cctx = P.in[3]; const float* w_ada = P.in[4]; const float* b_ada = P.in[5]; float* MOD = (float*)(F.ws + WS_MOD);
    float* s = (float*)F.ldsg;
    for (int vb = F.bid; vb < DEPTH * (MODW / NTHREADS); vb += F.G) {
        const int l = vb / (MODW / NTHREADS), j = (vb % (MODW / NTHREADS)) * NTHREADS + F.tid;
        __syncthreads();
        for (int i = F.tid; i < NR * D; i += NTHREADS) { const int r = i / D, k = i % D; const float v = r < NB ? c[r * D + k] : cctx[k]; s[i] = silu_f(v); }
        __syncthreads();
        float acc[NR];
#pragma unroll
        for (int r = 0; r < NR; ++r) acc[r] = 0.f;
        const float* w = w_ada + (size_t)l * D * MODW + j;
        for (int k = 0; k < D; ++k) { const float wv = w[(size_t)k * MODW];
#pragma unroll
            for (int r = 0; r < NR; ++r) acc[r] += s[r * D + k] * wv; }
#pragma unroll
        for (int r = 0; r < NR; ++r) MOD[((size_t)l * NR + r) * MODW + j] = acc[r] + b_ada[l * MODW + j];
    }
    __syncthreads();
}
__device__ __forceinline__ void transpose_item(const float* W, int ldw, int K, bf16* WT, int dst_row0, int k0, int n0, LAS float* scr, int lane) {
#pragma unroll 8
    for (int i = 0; i < 32; ++i) { const int kk = 2 * i + (lane >> 5); scr[kk * 33 + (lane & 31)] = W[(size_t)(k0 + kk) * ldw + n0 + (lane & 31)]; }
    asm volatile("s_waitcnt lgkmcnt(0)" ::: "memory");
    const int c = lane & 7;
#pragma unroll
    for (int j = 0; j < 4; ++j) { const int n = (lane >> 3) + 8 * j; const LAS float* s = scr + (8 * c) * 33 + n;
        v4u o; o.x = pk2(s[0 * 33], s[1 * 33]); o.y = pk2(s[2 * 33], s[3 * 33]); o.z = pk2(s[4 * 33], s[5 * 33]); o.w = pk2(s[6 * 33], s[7 * 33]);
        *(v4u*)(WT + (size_t)(dst_row0 + n) * K + k0 + 8 * c) = o; }
    asm volatile("s_waitcnt lgkmcnt(0)" ::: "memory");
}
__device__ __forceinline__ void ph_prologue(Frame& F, const Params& P) {
    const float* w_ffn_in = P.in[7]; const float* w_ffn_out = P.in[8]; const float* w_in = P.in[9]; const float* w_out = P.in[10];
    bf16* Wi_t = (bf16*)(F.ws + WS_WI); bf16* Wo_t = (bf16*)(F.ws + WS_WO); bf16* Win_t = (bf16*)(F.ws + WS_WIN); bf16* Wout_t = (bf16*)(F.ws + WS_WOUT);
    LAS float* scr = (LAS float*)(F.lds + F.wave * 16384);
    constexpr int NSRC = SRC_GATE - SRC_COL0; constexpr int I_FI = (D / 64) * (2 * DFF / 32), I_FO = (DFF / 64) * (D / 32), I_IN = (D / 64) * (NSRC / 32), I_OUT = (D / 64) * (D / 32);
    constexpr int NITEMS = 4 * I_FI + 4 * I_FO + 2 * I_IN + 2 * I_OUT;
    for (int it = F.gw; it < NITEMS; it += F.NGW) {
        int r = it;
        if (r < 4 * I_FI) { const int mat = r / I_FI; r %= I_FI; const int nblk = 2 * DFF / 32, kb = r / nblk, nb = r % nblk, n0 = 32 * nb;
            const int nn = n0 < DFF ? n0 : n0 - DFF; const int drow = 256 * (nn / 128) + (n0 < DFF ? 0 : 128) + (nn % 128);
            transpose_item(w_ffn_in + (size_t)mat * D * 2 * DFF, 2 * DFF, D, Wi_t + (size_t)mat * 2 * DFF * D, drow, 64 * kb, n0, scr, F.lane); continue; }
        r -= 4 * I_FI;
        if (r < 4 * I_FO) { const int mat = r / I_FO; r %= I_FO; const int nblk = D / 32, kb = r / nblk, nb = r % nblk;
            transpose_item(w_ffn_out + (size_t)mat * DFF * D, D, DFF, Wo_t + (size_t)mat * D * DFF, 32 * nb, 64 * kb, 32 * nb, scr, F.lane); continue; }
        r -= 4 * I_FO;
        if (r < 2 * I_IN) { const int mat = r / I_IN; r %= I_IN; const int nblk = NSRC / 32, kb = r / nblk, nb = r % nblk;
            transpose_item(w_in + (size_t)mat * D * DIN, DIN, D, Win_t + (size_t)mat * DU * D, 512 + 32 * nb, 64 * kb, SRC_COL0 + 32 * nb, scr, F.lane); continue; }
        r -= 2 * I_IN;
        { const int mat = r / I_OUT; r %= I_OUT; const int nblk = D / 32, kb = r / nblk, nb = r % nblk;
            transpose_item(w_out + (size_t)mat * D * D, D, D, Wout_t + (size_t)mat * D * D, 32 * nb, 64 * kb, 32 * nb, scr, F.lane); }
    }
    const float* x = P.in[0]; const float* ctx = P.in[2]; float* xl = F.out; float* xc = (float*)(F.ws + WS_XC);
    const size_t gt = (size_t)F.bid * NTHREADS + F.tid, NGT = (size_t)F.G * NTHREADS;
    for (size_t i = gt; i < (size_t)T * D / 4; i += NGT) {
        if (i < (size_t)TL * D / 4) ((float4*)xl)[i] = ((const float4*)x)[i]; else ((float4*)xc)[i - (size_t)TL * D / 4] = ((const float4*)ctx)[i - (size_t)TL * D / 4]; }
}
__device__ __forceinline__ void ph_normmod(Frame& F, const Ptrs& p, const float* g, const float* mod, int shift_idx, int scale_idx) {
    bf16* H = (bf16*)(F.ws + WS_HB);
    for (int r = F.gw; r < T; r += F.NGW) {
        const float* x = xrow(p, r); const int mr = mod_row(r);
        float4 v[4]; float ss = 0.f;
#pragma unroll
        for (int j = 0; j < 4; ++j) { v[j] = ((const float4*)x)[F.lane + 64 * j]; ss += v[j].x * v[j].x + v[j].y * v[j].y + v[j].z * v[j].z + v[j].w * v[j].w; }
        const float rstd = rsqrtf(wave_sum(ss, F.lane) * (1.f / D) + EPS);
#pragma unroll
        for (int j = 0; j < 4; ++j) { const int q = F.lane + 64 * j;
            const float4 gv = ((const float4*)g)[q], sc = ((const float4*)(mod + (size_t)mr * MODW + scale_idx * D))[q], sh = ((const float4*)(mod + (size_t)mr * MODW + shift_idx * D))[q];
            uint2 o; o.x = pk2(v[j].x * rstd * gv.x * (1.f + sc.x) + sh.x, v[j].y * rstd * gv.y * (1.f + sc.y) + sh.y); o.y = pk2(v[j].z * rstd * gv.z * (1.f + sc.z) + sh.z, v[j].w * rstd * gv.w * (1.f + sc.w) + sh.w);
            ((uint2*)(H + (size_t)r * D))[q] = o; }
    }
}
__device__ __forceinline__ void ph_final(Frame& F, const Params& P) {
    const float* g = P.in[16];
    for (int r = F.gw; r < TL; r += F.NGW) {
        float* x = F.out + (size_t)r * D;
        float4 v[4]; float ss = 0.f;
#pragma unroll
        for (int j = 0; j < 4; ++j) { v[j] = ((const float4*)x)[F.lane + 64 * j]; ss += v[j].x * v[j].x + v[j].y * v[j].y + v[j].z * v[j].z + v[j].w * v[j].w; }
        const float rstd = rsqrtf(wave_sum(ss, F.lane) * (1.f / D) + EPS);
#pragma unroll
        for (int j = 0; j < 4; ++j) { const int q = F.lane + 64 * j; const float4 gv = ((const float4*)g)[q];
            ((float4*)x)[q] = make_float4(v[j].x * rstd * gv.x, v[j].y * rstd * gv.y, v[j].z * rstd * gv.z, v[j].w * rstd * gv.w); }
    }
}
__device__ __forceinline__ void ph_gates(Frame& F, const float* w_in_l) {
    const bf16* H = (const bf16*)(F.ws + WS_HB); float* G = (float*)(F.ws + WS_G);
    for (int r = F.gw; r < T; r += F.NGW) {
        float acc[16];
#pragma unroll
        for (int j = 0; j < 16; ++j) acc[j] = 0.f;
        for (int i = 0; i < 16; ++i) { const int k = F.lane + 64 * i; const float h = bf2f(H[(size_t)r * D + k]); const float4* w = (const float4*)(w_in_l + (size_t)k * DIN + SRC_GATE);
#pragma unroll
            for (int q = 0; q < 4; ++q) { const float4 wv = w[q]; acc[4 * q] += h * wv.x; acc[4 * q + 1] += h * wv.y; acc[4 * q + 2] += h * wv.z; acc[4 * q + 3] += h * wv.w; } }
#pragma unroll
        for (int j = 0; j < 16; ++j) acc[j] = wave_sum(acc[j], F.lane);
        if (F.lane == 0) {
#pragma unroll
            for (int j = 0; j < 16; ++j) G[(size_t)r * 16 + j] = acc[j]; }
    }
}
__device__ __forceinline__ void ph_rope(Frame& F) {
    bf16* U = (bf16*)(F.ws + WS_R);
    for (int gid = F.bid * NTHREADS + F.tid; gid < TL * 160; gid += F.G * NTHREADS) {
        const int i = gid & 15, hs = (gid >> 4) % 10, r = gid / 160;
        const int n = r % SEQ, prow = n / 64, pcol = n % 64;
        const float inv = powf(10000.f, -(float)i / 16.f);
        const float ar = (float)prow * inv, ac = (float)pcol * inv;
        bf16* base = U + (size_t)r * DU + C_Q + hs * 64;
        const float t1 = bf2f(base[i]), t2 = bf2f(base[16 + i]), t3 = bf2f(base[32 + i]), t4 = bf2f(base[48 + i]);
        const float c1 = cosf(ar), s1 = sinf(ar), c2 = cosf(ac), s2 = sinf(ac);
        base[i] = (bf16)f2bf(t1 * c1 - t2 * s1); base[16 + i] = (bf16)f2bf(t2 * c1 + t1 * s1); base[32 + i] = (bf16)f2bf(t3 * c2 - t4 * s2); base[48 + i] = (bf16)f2bf(t4 * c2 + t3 * s2);
    }
}
typedef _Float16 half8 __attribute__((ext_vector_type(8)));
typedef _Float16 half4 __attribute__((ext_vector_type(4)));
typedef float f32x16 __attribute__((ext_vector_type(16)));
typedef float f32x4v __attribute__((ext_vector_type(4)));
constexpr int TP = 144;
constexpr int NCH = 68, NCHAIN = 32, NITEM = NCHAIN * NCH;
__device__ __forceinline__ f32x16 mfma32(half8 a, half8 b, f32x16 c) { return __builtin_amdgcn_mfma_f32_32x32x16_f16(a, b, c, 0, 0, 0); }
__device__ __forceinline__ float wave_max(float v, int lane) {
#pragma unroll
    for (int o = 1; o < 64; o <<= 1) v = fmaxf(v, lane_xor(v, lane, o));
    return v; }
struct ChunkGeo { int N, rb, p0, dp; };
__device__ __forceinline__ ChunkGeo chunk_geo(int b, int dir, int c  ) {
    ChunkGeo g; const bool isctx = c < 4; const int cc = isctx ? c : c - 4; g.N = isctx ? CTX : SEQ; g.rb = isctx ? TL + b * CTX : b * SEQ;
    if (dir == 0) { g.p0 = cc * 64; g.dp = 1; } else { g.p0 = g.N - 1 - cc * 64; g.dp = -1; }
    return g; }
__device__ __forceinline__ void conv16(const bf16* urow  , int p, int N, int colbase, const float* cw, float scale, float (&out)[16]) {
    const v4u c0 = *(const v4u*)(urow + colbase), c1 = *(const v4u*)(urow + colbase + 8);
    v4u m0 = {0u, 0u, 0u, 0u}, m1 = m0, n0 = m0, n1 = m0;
    if (p > 0) { m0 = *(const v4u*)(urow - DU + colbase); m1 = *(const v4u*)(urow - DU + colbase + 8); }
    if (p < N - 1) { n0 = *(const v4u*)(urow + DU + colbase); n1 = *(const v4u*)(urow + DU + colbase + 8); }
    const half8 hc0 = __builtin_bit_cast(half8, c0), hc1 = __builtin_bit_cast(half8, c1), hm0 = __builtin_bit_cast(half8, m0), hm1 = __builtin_bit_cast(half8, m1), hn0 = __builtin_bit_cast(half8, n0), hn1 = __builtin_bit_cast(half8, n1);
#pragma unroll
    for (int i = 0; i < 16; ++i) { const float xm = i < 8 ? (float)hm0[i] : (float)hm1[i - 8], xc = i < 8 ? (float)hc0[i] : (float)hc1[i - 8], xn = i < 8 ? (float)hn0[i] : (float)hn1[i - 8];
        const float a = xm * cw[i] + xc * cw[512 + i] + xn * cw[1024 + i]; out[i] = a * __builtin_amdgcn_rcpf(1.f + __expf(-a)) * scale; }
}
__device__ __forceinline__ void st_row16(LAS unsigned char* tile, int row, int c0, const float (&v)[16]) {
    v4u a, b; a.x = pk2(v[0], v[1]); a.y = pk2(v[2], v[3]); a.z = pk2(v[4], v[5]); a.w = pk2(v[6], v[7]); b.x = pk2(v[8], v[9]); b.y = pk2(v[10], v[11]); b.z = pk2(v[12], v[13]); b.w = pk2(v[14], v[15]);
    *(LAS v4u*)(tile + row * TP + c0 * 2) = a; *(LAS v4u*)(tile + row * TP + c0 * 2 + 16) = b; }
__device__ __forceinline__ void st_col16(LAS unsigned char* tile, int col, int r0, const float (&v)[16]) {
#pragma unroll
    for (int i = 0; i < 16; ++i) *(LAS unsigned short*)(tile + (r0 + i) * TP + col * 2) = (unsigned short)f2bf(v[i]); }
__device__ __forceinline__ half8 ld_row8(const LAS unsigned char* tile, int row, int c0) { return __builtin_bit_cast(half8, *(const LAS v4u*)(tile + row * TP + c0 * 2)); }

__device__ __forceinline__ void ph_mlstm_m1(Frame& F, const float* conv, const float* b_i, const float* b_f) {
    const bf16* U = (const bf16*)(F.ws + WS_R); const float* G = (const float*)(F.ws + WS_G);
    float* CL = (float*)(F.ws + WS_HS); float* NL = (float*)(F.ws + WS_NL); float* AM = (float*)(F.ws + WS_AM);
    const int dir = F.wave >> 2, wg = F.wave & 3, tg = F.tid & 255, r32 = F.lane & 31, hh = F.lane >> 5;
    LAS unsigned char* base = F.lds + dir * 24576; LAS unsigned char* KT = base; LAS unsigned char* VT = base + 9216; LAS float* wS = (LAS float*)(base + 18432);
    for (int it = F.bid; it < 16 * NCH; it += F.G) {
        const int bh = it / NCH, c = it % NCH, b = bh >> 2, h = bh & 3; const ChunkGeo g = chunk_geo(b, dir, c); const int item = (bh * 2 + dir) * NCH + c;
        if (wg == 0) { const int p = g.p0 + g.dp * F.lane; const float* g0 = G + (size_t)(g.rb + p) * 16;
            const float liv = g0[dir * 4 + h] + b_i[dir * 4 + h], lfv = logsigmoid_f(g0[8 + dir * 4 + h] + b_f[dir * 4 + h]);
            float bc = lfv;
#pragma unroll
            for (int o = 1; o < 64; o <<= 1) { const float t = lane_get(bc, F.lane - o); if (F.lane >= o) bc += t; }
            const float a = lane_get(bc, 63); const float dl = a - bc + liv; const float ml = wave_max(dl, F.lane);
            wS[F.lane] = __expf(dl - ml);
            if (F.lane == 0) { AM[item * 2] = a; AM[item * 2 + 1] = ml; } }
        __syncthreads();
        { const int tau = tg >> 2, d0 = (tg & 3) * 16; const int p = g.p0 + g.dp * tau; const bf16* urow = U + (size_t)(g.rb + p) * DU;
          float kv[16], vv[16]; conv16(urow, p, g.N, C_MK + h * 64 + d0, conv + 256 + h * 64 + d0, 0.125f, kv);
          const float w = wS[tau]; const half8 v0 = __builtin_bit_cast(half8, *(const v4u*)(urow + C_MV + h * 64 + d0)), v1 = __builtin_bit_cast(half8, *(const v4u*)(urow + C_MV + h * 64 + d0 + 8));
#pragma unroll
          for (int i = 0; i < 16; ++i) vv[i] = (i < 8 ? (float)v0[i] : (float)v1[i - 8]) * w;
          st_col16(KT, tau, d0, kv); st_col16(VT, tau, d0, vv); }
        __syncthreads();
        { const int tm = wg >> 1, tn = wg & 1; f32x16 acc = {};
#pragma unroll
          for (int s = 0; s < 4; ++s) acc = mfma32(ld_row8(VT, 32 * tm + r32, 16 * s + 8 * hh), ld_row8(KT, 32 * tn + r32, 16 * s + 8 * hh), acc);
          float* cl = CL + (size_t)item * 4096 + 32 * tn + r32;
#pragma unroll
          for (int r = 0; r < 16; ++r) cl[(size_t)(32 * tm + (r & 3) + 8 * (r >> 2) + 4 * hh) * 64] = acc[r];
          if (tg < 64) { float a = 0.f; const LAS unsigned char* kr = KT + tg * TP;
#pragma unroll 8
              for (int s = 0; s < 64; ++s) a += wS[s] * bf2f(*(const LAS unsigned short*)(kr + s * 2));
              NL[(size_t)item * 64 + tg] = a; } }
        __syncthreads();
    }
}
__device__ __forceinline__ void ph_mlstm_m2(Frame& F) {
    float* CL = (float*)(F.ws + WS_HS); float* NL = (float*)(F.ws + WS_NL); const float* AM = (const float*)(F.ws + WS_AM); float* MS = (float*)(F.ws + WS_MS);
    for (int vb = F.bid; vb < NCHAIN * 8; vb += F.G) {
        const int chain = vb >> 3, sl = vb & 7, e = sl * NTHREADS + F.tid; const bool don = (sl == 0 && F.tid < 64);
        float* cp = CL + (size_t)chain * NCH * 4096 + e; float* np = NL + (size_t)chain * NCH * 64 + F.tid; const float* am = AM + (size_t)chain * NCH * 2;
        float C = 0.f, nvv = 0.f, m = 0.f;
        float pre[4], pren[4];
#pragma unroll
        for (int j = 0; j < 4; ++j) { pre[j] = cp[(size_t)j * 4096]; pren[j] = don ? np[j * 64] : 0.f; }
        for (int c0 = 0; c0 < NCH; c0 += 4) {
            float cur[4], curn[4];
#pragma unroll
            for (int j = 0; j < 4; ++j) { cur[j] = pre[j]; curn[j] = pren[j]; }
            if (c0 + 4 < NCH) {
#pragma unroll
                for (int j = 0; j < 4; ++j) { pre[j] = cp[(size_t)(c0 + 4 + j) * 4096]; pren[j] = don ? np[(c0 + 4 + j) * 64] : 0.f; } }
#pragma unroll
            for (int j = 0; j < 4; ++j) { const int c = c0 + j; const float a = am[c * 2], ml = am[c * 2 + 1];
                const float mn = fmaxf(a + m, ml), al = __expf(a + m - mn), be = __expf(ml - mn);
                cp[(size_t)c * 4096] = C; C = al * C + be * cur[j];
                if (don) { np[c * 64] = nvv; nvv = al * nvv + be * curn[j]; }
                if (sl == 0 && F.tid == 0) MS[chain * NCH + c] = m;
                m = mn; }
        }
    }
}
__device__ __forceinline__ void ph_mlstm_m3(Frame& F, const float* conv, const float* b_i, const float* b_f) {
    const bf16* U = (const bf16*)(F.ws + WS_R); const float* G = (const float*)(F.ws + WS_G); bf16* Y = (bf16*)(F.ws + WS_Y);
    const float* CS = (const float*)(F.ws + WS_HS); const float* NS = (const float*)(F.ws + WS_NL); const float* MS = (const float*)(F.ws + WS_MS);
    const int dir = F.wave >> 2, wg = F.wave & 3, tg = F.tid & 255, r32 = F.lane & 31, hh = F.lane >> 5;
    LAS unsigned char* base = F.lds + dir * 40960; LAS unsigned char* Qs = base; LAS unsigned char* Ks = base + 9216; LAS unsigned char* VT = base + 18432; LAS unsigned char* Cs = base + 27648;
    LAS float* fa = (LAS float*)(base + 36864); LAS float* bcS = fa; LAS float* lmbS = fa + 64; LAS float* mtS = fa + 128; LAS float* wpS = fa + 192; LAS float* n0S = fa + 256;
    LAS float* HO = (LAS float*)(F.lds + 81920);
    for (int it = F.bid; it < 16 * NCH; it += F.G) {
        const int bh = it / NCH, pbi = it % NCH, b = bh >> 2, h = bh & 3;
        const bool isctx = pbi < 4; const int pb = isctx ? pbi : pbi - 4, N = isctx ? CTX : SEQ, rb = isctx ? TL + b * CTX : b * SEQ;
        const int cs = dir == 0 ? pb : N / 64 - 1 - pb;
        const int item = (bh * 2 + dir) * NCH + (isctx ? cs : 4 + cs);
        const int p0 = dir == 0 ? pb * 64 : pb * 64 + 63, dp = dir == 0 ? 1 : -1;
        if (wg == 0) { const int p = p0 + dp * F.lane; const float* g0 = G + (size_t)(rb + p) * 16;
            const float liv = g0[dir * 4 + h] + b_i[dir * 4 + h], lfv = logsigmoid_f(g0[8 + dir * 4 + h] + b_f[dir * 4 + h]);
            float bc = lfv;
#pragma unroll
            for (int o = 1; o < 64; o <<= 1) { const float t = lane_get(bc, F.lane - o); if (F.lane >= o) bc += t; }
            const float lmb = liv - bc; float pm = lmb;
#pragma unroll
            for (int o = 1; o < 64; o <<= 1) { const float t = lane_get(pm, F.lane - o); if (F.lane >= o) pm = fmaxf(pm, t); }
            const float m0 = MS[item]; const float mt = bc + fmaxf(m0, pm);
            bcS[F.lane] = bc; lmbS[F.lane] = lmb; mtS[F.lane] = mt; wpS[F.lane] = __expf(bc + m0 - mt); n0S[F.lane] = NS[(size_t)item * 64 + F.lane]; }
        { const int tau = tg >> 2, d0 = (tg & 3) * 16; const int p = p0 + dp * tau; const bf16* urow = U + (size_t)(rb + p) * DU;
          float qv[16], kv[16], vv[16]; conv16(urow, p, N, C_MQ + h * 64 + d0, conv + h * 64 + d0, 1.0f, qv); conv16(urow, p, N, C_MK + h * 64 + d0, conv + 256 + h * 64 + d0, 0.125f, kv);
          const half8 v0 = __builtin_bit_cast(half8, *(const v4u*)(urow + C_MV + h * 64 + d0)), v1 = __builtin_bit_cast(half8, *(const v4u*)(urow + C_MV + h * 64 + d0 + 8));
#pragma unroll
          for (int i = 0; i < 16; ++i) vv[i] = i < 8 ? (float)v0[i] : (float)v1[i - 8];
          st_row16(Qs, tau, d0, qv); st_row16(Ks, tau, d0, kv); st_col16(VT, tau, d0, vv);
          const float* cg = CS + (size_t)item * 4096 + tau * 64 + d0; float cv[16];
#pragma unroll
          for (int q4 = 0; q4 < 4; ++q4) { const f32x4v x = *(const f32x4v*)(cg + 4 * q4); cv[4 * q4] = x[0]; cv[4 * q4 + 1] = x[1]; cv[4 * q4 + 2] = x[2]; cv[4 * q4 + 3] = x[3]; }
          st_row16(Cs, tau, d0, cv); }
        __syncthreads();
        f32x16 ho;
        { const int tt = wg & 1, tv = wg >> 1; const int tau = 32 * tt + r32;
          half8 qf[4];
#pragma unroll
          for (int s = 0; s < 4; ++s) qf[s] = ld_row8(Qs, tau, 16 * s + 8 * hh);
          f32x16 st0 = {}, st1 = {};
#pragma unroll
          for (int s = 0; s < 4; ++s) { st0 = mfma32(ld_row8(Ks, r32, 16 * s + 8 * hh), qf[s], st0); st1 = mfma32(ld_row8(Ks, 32 + r32, 16 * s + 8 * hh), qf[s], st1); }
          const float ct = bcS[tau] - mtS[tau]; float dpart = 0.f;
#pragma unroll
          for (int r = 0; r < 16; ++r) { const int sg = (r & 3) + 8 * (r >> 2) + 4 * hh;
              const float w0 = sg <= tau ? __expf(ct + lmbS[sg]) : 0.f, w1 = sg + 32 <= tau ? __expf(ct + lmbS[sg + 32]) : 0.f;
              st0[r] *= w0; st1[r] *= w1; dpart += st0[r] + st1[r]; }
          float qn = 0.f;
#pragma unroll
          for (int s = 0; s < 4; ++s)
#pragma unroll
              for (int j = 0; j < 8; ++j) qn += (float)qf[s][j] * n0S[16 * s + 8 * hh + j];
          dpart += lane_xor(dpart, F.lane, 32); qn += lane_xor(qn, F.lane, 32);
          const float wp = wpS[tau], mt = mtS[tau]; const float den = dpart + wp * qn; const float inv = 1.f / fmaxf(fabsf(den), __expf(-mt));
          f32x16 an = {}, ac = {};
#pragma unroll
          for (int ks = 0; ks < 4; ++ks) { const f32x16& sx = (ks >> 1) ? st1 : st0; const int rbs = 8 * (ks & 1);
              half8 bf;
#pragma unroll
              for (int j = 0; j < 8; ++j) bf[j] = (_Float16)sx[rbs + j];
              const LAS unsigned char* vr = VT + (32 * tv + r32) * TP + (16 * ks + 4 * hh) * 2;
              const half4 a0 = *(const LAS half4*)vr, a1 = *(const LAS half4*)(vr + 16);
              const half8 af = {a0[0], a0[1], a0[2], a0[3], a1[0], a1[1], a1[2], a1[3]};
              an = mfma32(af, bf, an); }
#pragma unroll
          for (int s = 0; s < 4; ++s) ac = mfma32(ld_row8(Cs, 32 * tv + r32, 16 * s + 8 * hh), qf[s], ac);
#pragma unroll
          for (int r = 0; r < 16; ++r) ho[r] = (an[r] + wp * ac[r]) * inv;
          if (dir == 0) {
#pragma unroll
              for (int q4 = 0; q4 < 4; ++q4) { f32x4v x = {ho[4 * q4], ho[4 * q4 + 1], ho[4 * q4 + 2], ho[4 * q4 + 3]}; *(LAS f32x4v*)(HO + tau * 68 + 32 * tv + 8 * q4 + 4 * hh) = x; } } }
        __syncthreads();
        if (dir == 1) { const int tt = wg & 1, tv = wg >> 1; const int tau = 32 * tt + r32, pos = 63 - tau; const size_t row = (size_t)(rb + pb * 64 + pos);
#pragma unroll
            for (int q4 = 0; q4 < 4; ++q4) { const int v0 = 32 * tv + 8 * q4 + 4 * hh; const f32x4v x = *(const LAS f32x4v*)(HO + pos * 68 + v0);
                const half4 mo = *(const half4*)(U + row * DU + C_MO + h * 64 + v0); float o[4];
#pragma unroll
                for (int i = 0; i < 4; ++i) { const float g = 1.f / (1.f + __expf(-(float)mo[i])); o[i] = fminf(fmaxf(g * (x[i] + ho[4 * q4 + i]), -60000.f), 60000.f); }
                uint2 w; w.x = pk2(o[0], o[1]); w.y = pk2(o[2], o[3]); *(uint2*)(Y + row * D + 768 + h * 64 + v0) = w; } }
        __syncthreads();
    }
}


__device__ __forceinline__ void ph_attn(Frame& F, const float* sink, bool do_ctx) {
    const bf16* U = (const bf16*)(F.ws + WS_R); bf16* Y = (bf16*)(F.ws + WS_Y);
    const int g = F.wave >> 1, qh = F.wave & 1, r32 = F.lane & 31, hh = F.lane >> 5;
    const int lrow = F.tid >> 3, lch = F.tid & 7;
    constexpr float C2 = 0.125f * 1.4426950408889634f, LOG2E = 1.4426950408889634f;
    const int nunits = 512 + (do_ctx ? 32 : 0);
    for (int u = F.bid; u < nunits; u += F.G) {
        const bool lat = u < 512; int b, kvh, qb;
        if (lat) { b = u >> 7; kvh = (u >> 6) & 1; qb = u & 63; } else { const int v = u - 512; b = v >> 3; kvh = (v >> 2) & 1; qb = v & 3; }
        const int head = kvh * 4 + g;
        const size_t qrow = (size_t)(lat ? b * SEQ : TL + b * CTX) + qb * 64 + qh * 32 + r32;
        half8 qf[4];
#pragma unroll
        for (int s = 0; s < 4; ++s) { const half8 x = __builtin_bit_cast(half8, *(const v4u*)(U + qrow * DU + C_Q + head * 64 + 16 * s + 8 * hh));
#pragma unroll
            for (int j = 0; j < 8; ++j) qf[s][j] = (_Float16)((float)x[j] * C2); }
        const int kt_lo = lat ? (qb - 2 < 0 ? 0 : qb - 2) : 0, kt_hi = lat ? (qb + 2 > 63 ? 63 : qb + 2) : -1; const int nloc = kt_hi - kt_lo + 1, nt = nloc + 4;
        float m = sink[head] * LOG2E, l = 1.f; f32x16 o0 = {}, o1 = {};
        v4u kreg, vreg;
#define ATT_TILE_ROW0(t) ((t) < nloc ? (size_t)b * SEQ + (size_t)(kt_lo + (t)) * 64 : (size_t)TL + (size_t)b * CTX + (size_t)((t) - nloc) * 64)
#define ATT_LOAD(t) do { const bf16* rp = U + (ATT_TILE_ROW0(t) + lrow) * DU + kvh * 64 + 8 * lch; kreg = *(const v4u*)(rp + C_K); vreg = *(const v4u*)(rp + C_V); } while (0)
#define ATT_STORE(buf) do { LAS unsigned char* kb = F.lds + (buf) * 9216; LAS unsigned char* vb = F.lds + 18432 + (buf) * 9216; *(LAS v4u*)(kb + lrow * TP + lch * 16) = kreg; \
        const half8 vh = __builtin_bit_cast(half8, vreg); _Pragma("unroll") for (int i = 0; i < 8; ++i) *(LAS _Float16*)(vb + (8 * lch + i) * TP + lrow * 2) = vh[i]; } while (0)
        ATT_LOAD(0); ATT_STORE(0);
        __syncthreads();
        for (int t = 0; t < nt; ++t) {
            if (t + 1 < nt) ATT_LOAD(t + 1);
            const LAS unsigned char* Kb = F.lds + (t & 1) * 9216; const LAS unsigned char* Vb = F.lds + 18432 + (t & 1) * 9216;
            f32x16 s0 = {}, s1 = {};
#pragma unroll
            for (int s = 0; s < 4; ++s) { s0 = mfma32(ld_row8(Kb, r32, 16 * s + 8 * hh), qf[s], s0); s1 = mfma32(ld_row8(Kb, 32 + r32, 16 * s + 8 * hh), qf[s], s1); }
            int ttype = 0; if (t < nloc) { const int kt = kt_lo + t; ttype = (kt == qb - 2) ? 1 : (kt == qb + 2) ? 2 : 0; }
            const int qi = qh * 32 + r32;
            if (ttype != 0) {
#pragma unroll
                for (int r = 0; r < 16; ++r) { const int jk = (r & 3) + 8 * (r >> 2) + 4 * hh;
                    const bool v0 = ttype == 1 ? (jk >= qi) : (jk <= qi), v1 = ttype == 1 ? (jk + 32 >= qi) : (jk + 32 <= qi);
                    s0[r] = v0 ? s0[r] : -INFINITY; s1[r] = v1 ? s1[r] : -INFINITY; } }
            float mx = fmaxf(s0[0], s1[0]);
#pragma unroll
            for (int r = 1; r < 16; ++r) mx = fmaxf(mx, fmaxf(s0[r], s1[r]));
            mx = fmaxf(mx, lane_xor(mx, F.lane, 32));
            const float mn = fmaxf(m, mx), alpha = __builtin_amdgcn_exp2f(m - mn); m = mn;
            float ls = 0.f;
#pragma unroll
            for (int r = 0; r < 16; ++r) { s0[r] = __builtin_amdgcn_exp2f(s0[r] - mn); s1[r] = __builtin_amdgcn_exp2f(s1[r] - mn); ls += s0[r] + s1[r]; }
            ls += lane_xor(ls, F.lane, 32); l = l * alpha + ls;
#pragma unroll
            for (int r = 0; r < 16; ++r) { o0[r] *= alpha; o1[r] *= alpha; }
#pragma unroll
            for (int ks = 0; ks < 4; ++ks) { const f32x16& sx = (ks >> 1) ? s1 : s0; const int rbs = 8 * (ks & 1);
                half8 pf;
#pragma unroll
                for (int j = 0; j < 8; ++j) pf[j] = (_Float16)sx[rbs + j];
                const LAS unsigned char* v0p = Vb + r32 * TP + (16 * ks + 4 * hh) * 2; const LAS unsigned char* v1p = v0p + 32 * TP;
                const half4 a0 = *(const LAS half4*)v0p, a1 = *(const LAS half4*)(v0p + 16), c0 = *(const LAS half4*)v1p, c1 = *(const LAS half4*)(v1p + 16);
                const half8 af0 = {a0[0], a0[1], a0[2], a0[3], a1[0], a1[1], a1[2], a1[3]}, af1 = {c0[0], c0[1], c0[2], c0[3], c1[0], c1[1], c1[2], c1[3]};
                o0 = mfma32(af0, pf, o0); o1 = mfma32(af1, pf, o1); }
            if (t + 1 < nt) ATT_STORE((t + 1) & 1);
            __syncthreads();
        }
#undef ATT_TILE_ROW0
#undef ATT_LOAD
#undef ATT_STORE
        const float il = 1.f / l; bf16* yp = Y + qrow * D + 256 + head * 64;
#pragma unroll
        for (int q4 = 0; q4 < 4; ++q4) { uint2 w0, w1;
            w0.x = pk2(o0[4 * q4] * il, o0[4 * q4 + 1] * il); w0.y = pk2(o0[4 * q4 + 2] * il, o0[4 * q4 + 3] * il);
            w1.x = pk2(o1[4 * q4] * il, o1[4 * q4 + 1] * il); w1.y = pk2(o1[4 * q4 + 2] * il, o1[4 * q4 + 3] * il);
            *(uint2*)(yp + 8 * q4 + 4 * hh) = w0; *(uint2*)(yp + 32 + 8 * q4 + 4 * hh) = w1; }
    }
}


constexpr int FP = 272;
__device__ __forceinline__ void ph_fft_consts(Frame& F) {
    bf16* M1 = (bf16*)(F.ws + WS_FM1); bf16* M3 = (bf16*)(F.ws + WS_FM3); float2* TW = (float2*)(F.ws + WS_TW); float2* CT = (float2*)(F.ws + WS_CT);
    for (int i = F.bid * NTHREADS + F.tid; i < 16384 + 8192 + 4096 + 256; i += F.G * NTHREADS) {
        float s, c;
        if (i < 16384) { const int row = i >> 7, col = i & 127, pr = row >> 6, k1 = row & 63, pc = col >> 6, n1 = col & 63; sincospif((float)((k1 * n1) & 63) * (1.f / 32.f), &s, &c);
            M1[i] = (bf16)f2bf(pr == pc ? c : (pr == 0 ? s : -s)); }
        else if (i < 16384 + 8192) { const int j = i - 16384, k2 = j >> 7, col = j & 127, pc = col >> 6, n2 = col & 63; sincospif((float)((k2 * n2) & 63) * (1.f / 32.f), &s, &c); M3[j] = (bf16)f2bf(pc == 0 ? c : s); }
        else if (i < 16384 + 8192 + 4096) { const int j = i - 16384 - 8192; sincospif((float)j * (1.f / 2048.f), &s, &c); TW[j] = make_float2(c, s); }
        else { const int j = i - 16384 - 8192 - 4096; sincospif((float)j * (1.f / 128.f), &s, &c); CT[j] = make_float2(c, s); }
    }
}
__device__ __forceinline__ void ph_fold(Frame& F, const Params& P) {
    const float* w_in = P.in[9]; const float* wfo = P.in[11]; bf16* Win_t = (bf16*)(F.ws + WS_WIN);
    float* Wx = (float*)F.ldsg; float* ct = Wx + 4096; float* st = ct + 64;
    for (int it = F.bid; it < 256; it += F.G) {
        const int l = it >> 7, g = (it >> 5) & 3, part = (it >> 4) & 1, kb = it & 15;
        __syncthreads();
        if (F.tid < 64) { float s, c; sincospif((float)F.tid * (1.f / 32.f), &s, &c); ct[F.tid] = c; st[F.tid] = s; }
        __syncthreads();
        const float* wf = wfo + ((size_t)l * 4 + g) * 4096;
        for (int idx = F.tid; idx < 4096; idx += NTHREADS) { const int c = idx >> 6, e = idx & 63; float a = 0.f;
            for (int m = 0; m < 64; ++m) { const int q = (m * c) & 63; a += (part == 0 ? ct[q] : -st[q]) * wf[m * 64 + e]; }
            Wx[idx] = a * (1.f / 512.f); }
        __syncthreads();
        const int k = kb * 64 + (F.tid >> 3), e0 = (F.tid & 7) * 8; const float* wr = w_in + ((size_t)l * D + k) * DIN + g * 64;
        float acc[8];
#pragma unroll
        for (int j = 0; j < 8; ++j) acc[j] = 0.f;
        for (int c = 0; c < 64; ++c) { const float a = wr[c];
#pragma unroll
            for (int j = 0; j < 8; ++j) acc[j] += a * Wx[c * 64 + e0 + j]; }
#pragma unroll
        for (int j = 0; j < 8; ++j) Win_t[((size_t)l * DU + part * 256 + g * 64 + e0 + j) * D + k] = (bf16)f2bf(acc[j]);
    }
    __syncthreads();
}
__device__ __forceinline__ void ph_fft(Frame& F) {
    const bf16* U = (const bf16*)(F.ws + WS_R); bf16* Y = (bf16*)(F.ws + WS_Y); const float2* TW = (const float2*)(F.ws + WS_TW);
    LAS unsigned char* BUF = F.lds; LAS unsigned char* M1s = F.lds + 69632; LAS unsigned char* M3s = F.lds + 69632 + 34816;
    const int r32 = F.lane & 31, hh = F.lane >> 5, w = F.wave;
    if (F.bid < 256) {
        const v4u* m1 = (const v4u*)(F.ws + WS_FM1); const v4u* m3 = (const v4u*)(F.ws + WS_FM3);
        for (int i = F.tid; i < 128 * 16; i += NTHREADS) *(LAS v4u*)(M1s + (i >> 4) * FP + (i & 15) * 16) = m1[i];
        for (int i = F.tid; i < 64 * 16; i += NTHREADS) *(LAS v4u*)(M3s + (i >> 4) * FP + (i & 15) * 16) = m3[i];
    }
    for (int it = F.bid; it < 256; it += F.G) {
        const int b = it >> 6, cg = it & 63;
        __syncthreads();
        for (int q = w; q < 128; q += NWAVES) { const int n2 = q >> 1, part = q & 1, n1 = F.lane;
            const half4 x = *(const half4*)(U + (size_t)(b * SEQ + 64 * n1 + n2) * DU + part * 256 + cg * 4);
#pragma unroll
            for (int i = 0; i < 4; ++i) *(LAS _Float16*)(BUF + (n2 * 4 + i) * FP + (part * 64 + n1) * 2) = x[i]; }
        __syncthreads();
        f32x16 acc[4] = {};
#pragma unroll
        for (int s = 0; s < 8; ++s) { const half8 bf = __builtin_bit_cast(half8, *(const LAS v4u*)(BUF + (32 * w + r32) * FP + (16 * s + 8 * hh) * 2));
#pragma unroll
            for (int tm = 0; tm < 4; ++tm) acc[tm] = mfma32(__builtin_bit_cast(half8, *(const LAS v4u*)(M1s + (32 * tm + r32) * FP + (16 * s + 8 * hh) * 2)), bf, acc[tm]); }
        int nidx = 32 * w + r32; asm volatile("" : "+v"(nidx));
        const int n2 = nidx >> 2, col = nidx & 3;
        __syncthreads();
#pragma unroll
        for (int tm = 0; tm < 2; ++tm)
#pragma unroll
            for (int r = 0; r < 16; ++r) { const int k1 = 32 * tm + (r & 3) + 8 * (r >> 2) + 4 * hh; const float2 t = *(const float2*)((const char*)TW + ((unsigned)((k1 * n2) & 4095) << 3));
                const float re = acc[tm][r], im = acc[tm + 2][r];
                *(LAS _Float16*)(BUF + (k1 * 4 + col) * FP + n2 * 2) = (_Float16)(re * t.x + im * t.y);
                *(LAS _Float16*)(BUF + (k1 * 4 + col) * FP + (64 + n2) * 2) = (_Float16)(im * t.x - re * t.y); }
        __syncthreads();
        f32x16 y0 = {}, y1 = {};
#pragma unroll
        for (int s = 0; s < 8; ++s) { const half8 bf = __builtin_bit_cast(half8, *(const LAS v4u*)(BUF + (32 * w + r32) * FP + (16 * s + 8 * hh) * 2));
            y0 = mfma32(__builtin_bit_cast(half8, *(const LAS v4u*)(M3s + r32 * FP + (16 * s + 8 * hh) * 2)), bf, y0);
            y1 = mfma32(__builtin_bit_cast(half8, *(const LAS v4u*)(M3s + (32 + r32) * FP + (16 * s + 8 * hh) * 2)), bf, y1); }
        const int k1o = nidx >> 2; bf16* yb = Y + (size_t)(b * SEQ) * D + cg * 4 + col;
#pragma unroll
        for (int r = 0; r < 16; ++r) { const int k2 = (r & 3) + 8 * (r >> 2) + 4 * hh;
            yb[(size_t)(k1o + 64 * k2) * D] = (bf16)f2bf(y0[r]); yb[(size_t)(k1o + 64 * (k2 + 32)) * D] = (bf16)f2bf(y1[r]); }
    }
    __syncthreads();
}
__device__ __forceinline__ void ph_ctx_dft(Frame& F) {
    const bf16* U = (const bf16*)(F.ws + WS_R); bf16* Y = (bf16*)(F.ws + WS_Y); const float2* CT = (const float2*)(F.ws + WS_CT);
    for (int gid = F.bid * NTHREADS + F.tid; gid < NB * CTX * 256; gid += F.G * NTHREADS) {
        const int b = gid >> 16, k = (gid >> 8) & 255, col = gid & 255; const bf16* u = U + (size_t)(TL + b * CTX) * DU + col; float a = 0.f;
        for (int n = 0; n < CTX; ++n) { const float2 t = CT[(k * n) & 255]; a += t.x * bf2f(u[(size_t)n * DU]) + t.y * bf2f(u[(size_t)n * DU + 256]); }
        Y[(size_t)(TL + b * CTX + k) * D + col] = (bf16)f2bf(4.f * a);
    }
}

template <class Epi> __device__ __forceinline__ void run_gemm(Frame& F, const bf16* A, const bf16* Bt, int M, int N, int K, const Epi& E) {
    pg8::Gemm g{A, Bt, M, N, K}; pg8::StaticOrder S; S.init(M, N, F.G, F.bid);
    pg8::gemm_phase<Epi, pg8::StaticOrder, true, true>(F.lds, g, S, E, F.tid);
}
__device__ __forceinline__ Frame make_frame(const Params& P, unsigned char* lds_raw) {
    Frame F; int t = threadIdx.x; asm volatile("" : "+v"(t));
    F.lds = (LAS unsigned char*)lds_raw; F.ldsg = lds_raw;
    F.tid = t; F.lane = t & 63; F.wave = __builtin_amdgcn_readfirstlane(t >> 6);
    int g = gridDim.x, b = blockIdx.x; asm volatile("" : "+s"(g), "+s"(b));
    F.G = g; F.bid = b; F.gw = b * NWAVES + F.wave; F.NGW = g * NWAVES;
    unsigned char* ws = P.ws; float* out = P.out; asm volatile("" : "+s"(ws), "+s"(out));
    F.out = out; F.ws = ws;
    return F;
}
__device__ __forceinline__ void grid_bar(const Params& P, unsigned char* lds_raw) {
    unsigned char* ws = P.ws; asm volatile("" : "+s"(ws));
    XcdBarrier b; b.bar = (unsigned*)(ws + WS_CTL) + CW_BAR; b.x = xb_xcc_id(); b.st = (volatile LAS unsigned*)((LAS unsigned char*)lds_raw + MISC_OFF) + 8;
    xcd_barrier(b);
}
__global__ void __launch_bounds__(NTHREADS, 2) mega_fwd(Params P) {
    extern __shared__ __attribute__((aligned(16))) unsigned char lds_raw[];
    { const int tid = threadIdx.x;
      for (int u = tid; u < (LDS_BYTES - MISC_OFF) / 4; u += NTHREADS) ((LAS unsigned*)((LAS unsigned char*)lds_raw + MISC_OFF))[u] = 0u;
      __syncthreads();
      (void)xcd_barrier_post((unsigned*)(P.ws + WS_CTL) + CW_BAR, (volatile LAS unsigned*)((LAS unsigned char*)lds_raw + MISC_OFF) + 8); }
#define GRID_BAR() grid_bar(P, lds_raw)
#define FRAME() Frame F = make_frame(P, lds_raw); Ptrs p{F.out, (float*)(F.ws + WS_XC)}; (void)p

    { FRAME(); ph_mod(F, P); ph_prologue(F, P); }
    { FRAME(); ph_fold(F, P); ph_fft_consts(F); }
    GRID_BAR();
#pragma unroll 1
    for (int l = 0; l < DEPTH; ++l) {
#pragma unroll 1
        for (int half = 0; half < 2; ++half) {
            const int sub = half * 2, f = half;
            if (half == 1) {
                { FRAME(); const float* mod = (const float*)(F.ws + WS_MOD) + (size_t)l * NR * MODW; ph_normmod(F, p, P.in[6] + (size_t)l * 3 * D + 1 * D, mod, 3, 4); }
                GRID_BAR();
                { FRAME(); pg8::EpiBf16Plain E{(bf16*)(F.ws + WS_R), DU}; run_gemm(F, (const bf16*)(F.ws + WS_HB), (const bf16*)(F.ws + WS_WIN) + (size_t)l * DU * D, T, DU, D, E); }
                { FRAME(); ph_gates(F, P.in[9] + (size_t)l * D * DIN); }
                GRID_BAR();
                { FRAME(); ph_rope(F); }
                GRID_BAR();
                { FRAME(); ph_mlstm_m1(F, P.in[13] + (size_t)l * 3 * 512, P.in[14] + l * 8, P.in[15] + l * 8); }
                { FRAME(); ph_attn(F, P.in[12] + l * 8, l + 1 < DEPTH); }
                { FRAME(); ph_fft(F); if (l + 1 < DEPTH) ph_ctx_dft(F); }
                GRID_BAR();
                { FRAME(); ph_mlstm_m2(F); }
                GRID_BAR();
                { FRAME(); ph_mlstm_m3(F, P.in[13] + (size_t)l * 3 * 512, P.in[14] + l * 8, P.in[15] + l * 8); }
                GRID_BAR();
                { FRAME(); const float* mod = (const float*)(F.ws + WS_MOD) + (size_t)l * NR * MODW;
                  pg8::EpiResid E{p.xl, p.xc, TL, SEQ / 256, mod, MODW, 5 * D, 1.0f}; run_gemm(F, (const bf16*)(F.ws + WS_Y), (const bf16*)(F.ws + WS_WOUT) + (size_t)l * D * D, T, D, D, E); }
                GRID_BAR();
            }
            { FRAME(); const float* mod = (const float*)(F.ws + WS_MOD) + (size_t)l * NR * MODW; ph_normmod(F, p, P.in[6] + (size_t)l * 3 * D + sub * D, mod, 3 * sub, 3 * sub + 1); }
            GRID_BAR();
            { FRAME(); pg8::EpiSwiglu E{(bf16*)(F.ws + WS_R), DFF}; run_gemm(F, (const bf16*)(F.ws + WS_HB), (const bf16*)(F.ws + WS_WI) + (size_t)(l * 2 + f) * 2 * DFF * D, T, 2 * DFF, D, E); }
            GRID_BAR();
            { FRAME(); const float* mod = (const float*)(F.ws + WS_MOD) + (size_t)l * NR * MODW;
              pg8::EpiResid E{p.xl, p.xc, TL, SEQ / 256, mod, MODW, (3 * sub + 2) * D, 0.5f}; run_gemm(F, (const bf16*)(F.ws + WS_R), (const bf16*)(F.ws + WS_WO) + (size_t)(l * 2 + f) * D * DFF, T, D, DFF, E); }
            GRID_BAR();
        }
    }
    { FRAME(); ph_final(F, P); }
}
}

extern "C" void kernel_launch(void* const* d_in, const int* in_sizes, int n_in, void* d_out, int out_size, void* d_ws, size_t ws_size, hipStream_t stream) {
    static int grid = 0;
    if (grid == 0) {
        if (n_in != 17 || ws_size < WS_END) { fprintf(stderr, "kernel_launch: need 17 inputs and %zu bytes of workspace; got %d inputs, %zu bytes\n", (size_t)WS_END, n_in, ws_size); grid = -1; return; }
        int dev = 0, cus = 0, per_cu = 0;
        if (hipGetDevice(&dev) != hipSuccess || hipDeviceGetAttribute(&cus, hipDeviceAttributeMultiprocessorCount, dev) != hipSuccess) { grid = -1; return; }
        if (hipFuncSetAttribute((const void*)mega_fwd, hipFuncAttributeMaxDynamicSharedMemorySize, LDS_BYTES) != hipSuccess) { fprintf(stderr, "kernel_launch: hipFuncSetAttribute failed\n"); grid = -1; return; }
        if (hipOccupancyMaxActiveBlocksPerMultiprocessor(&per_cu, (const void*)mega_fwd, NTHREADS, LDS_BYTES) != hipSuccess || per_cu < 1) { fprintf(stderr, "kernel_launch: occupancy query says %d workgroups per CU\n", per_cu); (void)hipGetLastError(); grid = -1; return; }
        grid = cus;
    }
    if (grid < 0) return;
    (void)hipMemsetAsync((char*)d_ws + WS_CTL, 0, CTL_ZERO_BYTES, stream);
    Params P{};
    for (int i = 0; i < 17; ++i) P.in[i] = (const float*)d_in[i];
    P.out = (float*)d_out; P.ws = (unsigned char*)d_ws;
    hipLaunchKernelGGL(mega_fwd, dim3(grid), dim3(NTHREADS), LDS_BYTES, stream, P);
}
```

```cpp
#include <hip/hip_runtime.h>
#include <cstdio>
#include <cstdint>
#ifndef PROBE_ID
#define PROBE_ID 0
#endif
#ifndef PROBE_WG
#define PROBE_WG 0
#endif
namespace pg8 {
#define PG8_LAS __attribute__((address_space(3)))
typedef unsigned short bf16_t;
typedef short bf16x8 __attribute__((ext_vector_type(8)));
typedef float f32x4 __attribute__((ext_vector_type(4)));
typedef unsigned u32x4 __attribute__((ext_vector_type(4)));
typedef _Float16 half8 __attribute__((ext_vector_type(8)));
constexpr int BM = 256, BK = 64, HALF = 128, HTB = HALF * BK * 2  , STAGE_BYTES = 8 * HTB, NXCD = 8, WGM = 8;

__host__ __device__ __forceinline__ int lds_byte(int r, int c) { const int st = (r >> 4) * 2 + (c >> 5), rr = r & 15, cc = c & 31, ob = rr * 64 + cc * 2; return st * 1024 + (ob ^ (((ob >> 9) & 1) << 5)); }
__host__ __device__ __forceinline__ void stage_rc(int b, int& R, int& C) { const int st = b / 1024, sb = b % 1024, swz = sb ^ (((sb >> 9) & 1) << 5); R = (st >> 1) * 16 + swz / 64; C = (st & 1) * 32 + (swz % 64) / 2; }
__host__ __device__ __forceinline__ int perm32(int rho) { const int n = rho >> 4, i = rho & 15; return 8 * (i >> 2) + 4 * n + (i & 3); }

struct Unit { int pm, pn; };
struct Gemm { const bf16_t* A; const bf16_t* Bt; int M, N, K; };

struct StaticOrder {
    int nM, nN, nwg, G, c;
    __host__ __device__ void init(int M, int N, int G_, int c_) { nM = M / BM; nN = N / BM; nwg = nM * nN; G = G_; c = c_; }
    __host__ __device__ bool next(int i, Unit& u) const {
        const long L = (long)i * G + c; if (L >= nwg) return false;
        int wgid = (int)L; { const int q = nwg / NXCD, r = nwg % NXCD, xcd = wgid % NXCD, off = wgid / NXCD; wgid = (xcd < r ? xcd * (q + 1) : r * (q + 1) + (xcd - r) * q) + off; }
        const int nig = WGM * nN, gid = wgid / nig, fm = gid * WGM, gsz = (nM - fm) < WGM ? (nM - fm) : WGM;
        u.pm = fm + ((wgid % nig) % gsz); u.pn = (wgid % nig) / gsz; return true;
    }
    __device__ __forceinline__ void a_ready(const Unit&) const {}
    __device__ __forceinline__ void done(const Unit&) const {}
};
template <class Epi, class Sched, bool ALIGN_EPI = false, bool SP2 = false>
__device__ __forceinline__ void gemm_phase(PG8_LAS unsigned char* lds, const Gemm g, const Sched& S, const Epi& E, const int tid  ) {
    const int wid = __builtin_amdgcn_readfirstlane(tid >> 6), lane = tid & 63, wr = wid >> 2, wc = wid & 3, fr = lane & 15, fq = lane >> 4;
    const int K = g.K, nt = K / BK;
    unsigned voffA[2], voffB[2];
#pragma unroll
    for (int i = 0; i < 2; ++i) { int R, C; stage_rc(tid * 16 + i * 8192, R, C); const int Rb = Epi::PERM ? ((R & ~31) + perm32(R & 31)) : R;
        voffA[i] = (unsigned)(R * K + C) * 2u; voffB[i] = (unsigned)(Rb * K + C) * 2u; }
    const size_t kstep = (size_t)(BK * 2);
    const size_t hstep = (size_t)HALF * K * 2;
    const size_t tstep = 2 * hstep;
    const unsigned ldsw = (unsigned)wid * 1024u;
    const int aoff = lds_byte(wr * 64 + fr, fq * 8), boff = lds_byte(wc * 32 + fr, fq * 8);
#define PG8_SA(b, h) (((b) * 2 + (h)) * HTB)
#define PG8_SB(b, h) ((4 + (b) * 2 + (h)) * HTB)
#define PG8_STAGE(bufoff, gbase, voff) do { _Pragma("unroll") for (int _i = 0; _i < 2; ++_i) \
        __builtin_amdgcn_global_load_lds((const unsigned*)((const char*)(gbase) + (voff)[_i]), (PG8_LAS unsigned*)(lds + (bufoff) + ldsw + _i * 8192), 16, 0, 0); } while (0)
#define PG8_LDA(dst, b, h) do { _Pragma("unroll") for (int m = 0; m < 4; ++m) _Pragma("unroll") for (int k = 0; k < 2; ++k) dst[m][k] = *(const PG8_LAS bf16x8*)(lds + PG8_SA(b, h) + aoff + m * 2048 + k * 1024); } while (0)
#define PG8_LDB(dst, b, h) do { _Pragma("unroll") for (int n = 0; n < 2; ++n) _Pragma("unroll") for (int k = 0; k < 2; ++k) dst[n][k] = *(const PG8_LAS bf16x8*)(lds + PG8_SB(b, h) + boff + n * 2048 + k * 1024); } while (0)
#define PG8_MMA(ai, bj, At, Bt) do { __builtin_amdgcn_s_setprio(1); _Pragma("unroll") for (int m = 0; m < 4; ++m) _Pragma("unroll") for (int n = 0; n < 2; ++n) _Pragma("unroll") for (int k = 0; k < 2; ++k) \
        acc[ai][bj][m][n] = __builtin_amdgcn_mfma_f32_16x16x32_f16(__builtin_bit_cast(half8, Bt[n][k]), __builtin_bit_cast(half8, At[m][k]), acc[ai][bj][m][n], 0, 0, 0); __builtin_amdgcn_s_setprio(0); } while (0)
#define PG8_WAIT_V(n) asm volatile("s_waitcnt vmcnt(" #n ")" ::: "memory")
#define PG8_WAIT_L(n) asm volatile("s_waitcnt lgkmcnt(" #n ")" ::: "memory")
#define PG8_BAR __builtin_amdgcn_s_barrier()
#define PG8_SCHED __builtin_amdgcn_sched_barrier(0)
    Unit cur, nxt; int ui = 0;
    if (!S.next(0, cur)) return;
    f32x4 acc[2][2][4][2];
#pragma unroll
    for (int a = 0; a < 2; ++a)
#pragma unroll
        for (int b = 0; b < 2; ++b)
#pragma unroll
            for (int m = 0; m < 4; ++m)
#pragma unroll
                for (int n = 0; n < 2; ++n) acc[a][b][m][n] = (f32x4){0.f, 0.f, 0.f, 0.f};
    bf16x8 At[4][2], B0[2][2], B1[2][2];
    const char* cA = (const char*)g.A + (size_t)cur.pm * tstep; const char* cB = (const char*)g.Bt + (size_t)cur.pn * tstep;
    S.a_ready(cur);
    if constexpr (SP2) {
        PG8_STAGE(PG8_SB(0, 0), cB, voffB); PG8_STAGE(PG8_SB(0, 1), cB + hstep, voffB); PG8_STAGE(PG8_SA(0, 0), cA, voffA); PG8_STAGE(PG8_SA(0, 1), cA + hstep, voffA);
        if (wr == 1) PG8_BAR;
        PG8_WAIT_V(2); PG8_BAR;
        PG8_STAGE(PG8_SB(1, 0), cB + kstep, voffB); PG8_STAGE(PG8_SA(1, 0), cA + kstep, voffA); PG8_STAGE(PG8_SB(1, 1), cB + hstep + kstep, voffB);
        PG8_WAIT_V(6); PG8_BAR;
    } else {
        PG8_STAGE(PG8_SB(0, 0), cB, voffB); PG8_STAGE(PG8_SA(0, 0), cA, voffA); PG8_STAGE(PG8_SB(0, 1), cB + hstep, voffB); PG8_STAGE(PG8_SA(0, 1), cA + hstep, voffA);
        if (wr == 1) PG8_BAR;
        PG8_WAIT_V(4); PG8_BAR;
        PG8_STAGE(PG8_SB(1, 0), cB + kstep, voffB); PG8_STAGE(PG8_SA(1, 0), cA + kstep, voffA); PG8_STAGE(PG8_SB(1, 1), cB + hstep + kstep, voffB);
        PG8_WAIT_V(6); PG8_BAR;
    }
    for (;;) {
        const bool has_next = S.next(ui + 1, nxt);
        const char* nA = has_next ? (const char*)g.A + (size_t)nxt.pm * tstep : cA; const char* nB = has_next ? (const char*)g.Bt + (size_t)nxt.pn * tstep : cB;
        for (int t = 0; t < nt; t += 2) {
            const bool last = (t == nt - 2);
            const char* a1 = cA + (size_t)(t + 1) * kstep;
            const char* a2 = last ? nA : cA + (size_t)(t + 2) * kstep; const char* b2 = last ? nB : cB + (size_t)(t + 2) * kstep;
            const char* a3 = a2 + kstep; const char* b3 = b2 + kstep;
            if (last && has_next) S.a_ready(nxt);
            if constexpr (SP2) {
            PG8_LDB(B0, 0, 0); PG8_LDB(B1, 0, 1); PG8_SCHED; PG8_LDA(At, 0, 0); PG8_STAGE(PG8_SA(1, 1), a1 + hstep, voffA);
            PG8_WAIT_V(8); PG8_WAIT_L(0); PG8_BAR; PG8_MMA(0, 0, At, B0); PG8_MMA(0, 1, At, B1); PG8_BAR; PG8_SCHED;
            PG8_LDA(At, 0, 1); PG8_STAGE(PG8_SB(0, 0), b2, voffB); PG8_STAGE(PG8_SB(0, 1), b2 + hstep, voffB); PG8_STAGE(PG8_SA(0, 0), a2, voffA);
            PG8_WAIT_V(8); PG8_WAIT_L(0); PG8_BAR; PG8_MMA(1, 0, At, B0); PG8_MMA(1, 1, At, B1); PG8_BAR; PG8_SCHED;
            PG8_LDB(B0, 1, 0); PG8_LDB(B1, 1, 1); PG8_SCHED; PG8_LDA(At, 1, 0); PG8_STAGE(PG8_SA(0, 1), a2 + hstep, voffA);
            PG8_WAIT_V(8); PG8_WAIT_L(0); PG8_BAR; PG8_MMA(0, 0, At, B0); PG8_MMA(0, 1, At, B1); PG8_BAR; PG8_SCHED;
            PG8_LDA(At, 1, 1); PG8_STAGE(PG8_SB(1, 0), b3, voffB); PG8_STAGE(PG8_SB(1, 1), b3 + hstep, voffB); PG8_STAGE(PG8_SA(1, 0), a3, voffA);
            PG8_WAIT_V(8); PG8_WAIT_L(0); PG8_BAR; PG8_MMA(1, 0, At, B0); PG8_MMA(1, 1, At, B1); PG8_BAR; PG8_SCHED;
            } else {
            PG8_LDB(B0, 0, 0); PG8_SCHED; PG8_LDA(At, 0, 0); PG8_STAGE(PG8_SA(1, 1), a1 + hstep, voffA);
            PG8_WAIT_L(8); PG8_BAR; PG8_WAIT_L(0); PG8_MMA(0, 0, At, B0); PG8_BAR; PG8_SCHED;
            PG8_LDB(B1, 0, 1); PG8_STAGE(PG8_SB(0, 0), b2, voffB);
            PG8_BAR; PG8_WAIT_L(0); PG8_MMA(0, 1, At, B1); PG8_BAR;
            PG8_LDA(At, 0, 1); PG8_STAGE(PG8_SA(0, 0), a2, voffA);
            PG8_BAR; PG8_WAIT_L(0); PG8_MMA(1, 0, At, B0); PG8_BAR; PG8_SCHED;
            PG8_STAGE(PG8_SB(0, 1), b2 + hstep, voffB);
            PG8_WAIT_V(6); PG8_BAR; PG8_MMA(1, 1, At, B1); PG8_BAR;
            PG8_LDB(B0, 1, 0); PG8_SCHED; PG8_LDA(At, 1, 0); PG8_STAGE(PG8_SA(0, 1), a2 + hstep, voffA);
            PG8_WAIT_L(8); PG8_BAR; PG8_WAIT_L(0); PG8_MMA(0, 0, At, B0); PG8_BAR; PG8_SCHED;
            PG8_LDB(B1, 1, 1); PG8_STAGE(PG8_SB(1, 0), b3, voffB);
            PG8_BAR; PG8_WAIT_L(0); PG8_MMA(0, 1, At, B1); PG8_BAR;
            PG8_LDA(At, 1, 1); PG8_STAGE(PG8_SA(1, 0), a3, voffA);
            PG8_BAR; PG8_WAIT_L(0); PG8_MMA(1, 0, At, B0); PG8_BAR; PG8_SCHED;
            PG8_STAGE(PG8_SB(1, 1), b3 + hstep, voffB);
            PG8_WAIT_V(6); PG8_BAR; PG8_MMA(1, 1, At, B1); PG8_BAR;
            }
        }
        if constexpr (ALIGN_EPI) { if (wr == 0) PG8_BAR; }
        if constexpr (!Epi::AFTER_DRAIN) { E(acc, cur, wr, wc, fr, fq); S.done(cur); }
        if (!has_next) break;
#pragma unroll
        for (int a = 0; a < 2; ++a)
#pragma unroll
            for (int b = 0; b < 2; ++b)
#pragma unroll
                for (int m = 0; m < 4; ++m)
#pragma unroll
                    for (int n = 0; n < 2; ++n) acc[a][b][m][n] = (f32x4){0.f, 0.f, 0.f, 0.f};
        cur = nxt; cA = nA; cB = nB; ++ui;
        if constexpr (ALIGN_EPI) { if (wr == 1) PG8_BAR; }
    }
    PG8_WAIT_V(0);
    if constexpr (!ALIGN_EPI) { if (wr == 0) PG8_BAR; }
    PG8_BAR;
    if constexpr (Epi::AFTER_DRAIN) { E.fused(acc, cur, wr, wc, fr, fq, lds, wid, lane); S.done(cur); }
#undef PG8_SA
#undef PG8_SB
#undef PG8_STAGE
#undef PG8_LDA
#undef PG8_LDB
#undef PG8_MMA
#undef PG8_WAIT_V
#undef PG8_WAIT_L
#undef PG8_BAR
#undef PG8_SCHED
}
}

namespace {
#define LAS __attribute__((address_space(3)))
#define GAS __attribute__((address_space(1)))
typedef unsigned short bf16;
typedef unsigned v4u __attribute__((ext_vector_type(4)));
typedef GAS unsigned gu32;
constexpr int D = 1024, NB = 4, SEQ = 4096, CTX = 256, DEPTH = 2;
constexpr int TL = NB * SEQ, TC = NB * CTX, T = TL + TC;
constexpr int DFF = 2816, DIN = 2064, DU = 2304, NMOD = 9, MODW = NMOD * D;
constexpr int NR = NB + 1;
constexpr float EPS = 1e-6f;
constexpr int C_GA = 0, C_GB = 256, C_Q = 512, C_K = 1024, C_V = 1152, C_MQ = 1280, C_MK = 1536, C_MV = 1792, C_MO = 2048;
constexpr int SRC_COL0 = 256, SRC_GATE = 2048;
constexpr int NWAVES = 8, NTHREADS = 512;
constexpr int RING_BYTES = 131072, MISC_OFF = RING_BYTES, LDS_BYTES = 147456;
constexpr size_t al256(size_t x) { return (x + 255) & ~(size_t)255; }
constexpr size_t WS_CTL = 0, CTL_ZERO_BYTES = 65536;
constexpr int CW_BAR = 1024;
constexpr size_t WS_MOD = 1u << 20;
constexpr size_t WS_WI = al256(WS_MOD + (size_t)DEPTH * NR * MODW * 4);
constexpr size_t WS_WO = al256(WS_WI + (size_t)4 * 2 * DFF * D * 2);
constexpr size_t WS_WIN = al256(WS_WO + (size_t)4 * D * DFF * 2);
constexpr size_t WS_WOUT = al256(WS_WIN + (size_t)2 * DU * D * 2);
constexpr size_t WS_XC = al256(WS_WOUT + (size_t)2 * D * D * 2);
constexpr size_t WS_G = al256(WS_XC + (size_t)TC * D * 4);
constexpr size_t WS_HB = al256(WS_G + (size_t)T * 16 * 4);
constexpr size_t WS_X16 = al256(WS_HB + (size_t)T * D * 2);
constexpr size_t WS_Y_UNUSED = WS_X16;
constexpr size_t WS_R = al256(WS_X16 + (size_t)T * D * 2);
constexpr size_t WS_HS = al256(WS_R + (size_t)T * DFF * 2);
constexpr size_t WS_NL = al256(WS_HS + (size_t)2 * T * 256 * 4);
constexpr size_t WS_AM = al256(WS_NL + (size_t)32 * 68 * 64 * 4);
constexpr size_t WS_MS = al256(WS_AM + (size_t)32 * 68 * 2 * 4);
constexpr size_t WS_FM1 = al256(WS_MS + (size_t)32 * 68 * 4);
constexpr size_t WS_FM3 = al256(WS_FM1 + 128 * 128 * 2);
constexpr size_t WS_TW = al256(WS_FM3 + 64 * 128 * 2);
constexpr size_t WS_CT = al256(WS_TW + 4096 * 8);
constexpr size_t WS_RS = al256(WS_CT + 256 * 8);
constexpr size_t WS_SWFI = al256(WS_RS + (size_t)T * 16 * 4);
constexpr size_t WS_SWIN = al256(WS_SWFI + (size_t)4 * NR * 2 * DFF * 4);
constexpr size_t WS_SWG = al256(WS_SWIN + (size_t)2 * NR * DU * 4);
constexpr size_t WS_ROPE = al256(WS_SWG + (size_t)2 * NR * 16 * 4);
constexpr size_t WS_WGT = al256(WS_ROPE + 64 * 16 * 8);
constexpr size_t WS_DMC = al256(WS_WGT + (size_t)DEPTH * 32 * D * 2);
constexpr size_t WS_PROBE = al256(WS_DMC + 256 * 512 * 2);
constexpr size_t WS_END = al256(WS_PROBE + 256);

struct Ptrs { float* xl; float* xc; };
__device__ __forceinline__ int mod_row(int r) { return r < TL ? r / SEQ : NB; }
__device__ __forceinline__ float* xrow(const Ptrs& p, int r) { return r < TL ? p.xl + (size_t)r * D : p.xc + (size_t)(r - TL) * D; }
__device__ __forceinline__ float silu_f(float x) { return x / (1.f + expf(-x)); }
__device__ __forceinline__ float sigmoid_f(float x) { return 1.f / (1.f + expf(-x)); }
__device__ __forceinline__ float logsigmoid_f(float x) { return fminf(x, 0.f) - log1pf(expf(-fabsf(x))); }
__device__ __forceinline__ float bf2f(bf16 b) { return (float)__builtin_bit_cast(_Float16, b); }
__device__ __forceinline__ unsigned f2bf(float f) { return (unsigned)__builtin_bit_cast(unsigned short, (_Float16)f); }
__device__ __forceinline__ unsigned pk2(float lo, float hi) { return f2bf(lo) | (f2bf(hi) << 16); }
__device__ __forceinline__ float lane_xor(float v, int lane, int o) { return __int_as_float(__builtin_amdgcn_ds_bpermute((lane ^ o) << 2, __float_as_int(v))); }
__device__ __forceinline__ float lane_get(float v, int src) { return __int_as_float(__builtin_amdgcn_ds_bpermute(src << 2, __float_as_int(v))); }
__device__ __forceinline__ float wave_sum(float v, int lane) {
#pragma unroll
    for (int o = 1; o < 64; o <<= 1) v += lane_xor(v, lane, o);
    return v; }
#define RLX_AGENT __ATOMIC_RELAXED, __HIP_MEMORY_SCOPE_AGENT
struct Params { const float* in[17]; float* out; unsigned char* ws; };
typedef _Float16 half8 __attribute__((ext_vector_type(8)));
typedef _Float16 half4 __attribute__((ext_vector_type(4)));
typedef float f32x16 __attribute__((ext_vector_type(16)));
typedef float f32x4v __attribute__((ext_vector_type(4)));

using pg8::half8; using pg8::f32x4; using pg8::u32x4; using pg8::Unit; using pg8::bf16_t; using pg8::BM; using pg8::HALF;
__device__ __forceinline__ unsigned cvt_pk_bf16(float lo, float hi) { typedef float f2_t __attribute__((ext_vector_type(2))); typedef _Float16 h2_t __attribute__((ext_vector_type(2))); const f2_t v = {lo, hi}; return __builtin_bit_cast(unsigned, __builtin_convertvector(v, h2_t)); }
__device__ __forceinline__ float silu_fast(float x) { return x * __builtin_amdgcn_rcpf(1.f + __expf(-x)); }
__device__ __forceinline__ float rstd_row(const float* rowss, int row) {
    const f32x4 a = *(const f32x4*)(rowss + (size_t)row * 16), b = *(const f32x4*)(rowss + (size_t)row * 16 + 4), c = *(const f32x4*)(rowss + (size_t)row * 16 + 8), d = *(const f32x4*)(rowss + (size_t)row * 16 + 12);
    const f32x4 s = (a + b) + (c + d); return __builtin_amdgcn_rsqf(((s[0] + s[1]) + (s[2] + s[3])) * (1.f / 1024.f) + 1e-6f); }
typedef unsigned u32x2e __attribute__((ext_vector_type(2)));
constexpr int RSTD_TAB_OFF = MISC_OFF + 1024;
constexpr int BIAS_TAB_OFF = RSTD_TAB_OFF + 2048;
struct RstdOrder : pg8::StaticOrder {
    const float* rowss; LAS float* tab; int tid; mutable int cnt; const float* sw; int ncols;
    __device__ __forceinline__ void a_ready(const Unit& u) const { const int par = cnt & 1; ++cnt;
        if (tid < 256) tab[par * 256 + tid] = rstd_row(rowss, u.pm * BM + tid);
        else if (tid < 320) { const int mr = u.pm < TL / 256 ? u.pm / (SEQ / 256) : 4; *(LAS f32x4*)(tab + 512 + par * 256 + (tid - 256) * 4) = *(const f32x4*)(sw + (size_t)mr * ncols + u.pn * BM + (tid - 256) * 4); } }
};

struct EpiSwiglu {
    static constexpr bool PERM = true, AFTER_DRAIN = false;
    unsigned char* ws; int mat; LAS float* tab; mutable int cnt;
    __device__ __forceinline__ void operator()(const f32x4 (&acc)[2][2][4][2], const Unit& u, int wr, int wc, int fr, int fq) const {
        bf16_t* O = (bf16_t*)(ws + WS_R); constexpr int ldc = DFF;
        const LAS float* rt = tab + (cnt & 1) * 256 + wr * 64 + fr;
        const int row0 = u.pm * BM + wr * 64 + fr, col0 = u.pn * HALF + wc * 32 + 8 * fq;
        const LAS float* bs = tab + 512 + (cnt & 1) * 256 + wc * 32 + 8 * fq;
        const f32x4 bg0 = *(const LAS f32x4*)bs, bg1 = *(const LAS f32x4*)(bs + 4), bu0 = *(const LAS f32x4*)(bs + HALF), bu1 = *(const LAS f32x4*)(bs + HALF + 4); ++cnt;
#pragma unroll
        for (int ai = 0; ai < 2; ++ai)
#pragma unroll
            for (int m = 0; m < 4; ++m) { const int row = row0 + ai * HALF + m * 16; const float rs = rt[ai * HALF + m * 16]; bf16_t* rowp = O + (size_t)row * ldc + col0;
                const f32x4 g0 = acc[ai][0][m][0] * rs + bg0, g1 = acc[ai][0][m][1] * rs + bg1, u0 = acc[ai][1][m][0] * rs + bu0, u1 = acc[ai][1][m][1] * rs + bu1;
                f32x4 h0, h1;
#pragma unroll
                for (int i = 0; i < 4; ++i) { h0[i] = silu_fast(g0[i]) * u0[i]; h1[i] = silu_fast(g1[i]) * u1[i]; }
                u32x4 w; w.x = cvt_pk_bf16(h0[0], h0[1]); w.y = cvt_pk_bf16(h0[2], h0[3]); w.z = cvt_pk_bf16(h1[0], h1[1]); w.w = cvt_pk_bf16(h1[2], h1[3]);
                *(u32x4*)rowp = w; }
    }
};
struct EpiUProj {
    static constexpr bool PERM = true, AFTER_DRAIN = false;
    unsigned char* ws; int l; LAS float* tab; mutable int cnt;
    __device__ __forceinline__ void operator()(const f32x4 (&acc)[2][2][4][2], const Unit& u, int wr, int wc, int fr, int fq) const {
        bf16_t* O = (bf16_t*)(ws + WS_R); constexpr int ldc = DU, tl_panels = TL / 256; constexpr float qscale = 0.125f * 1.4426950408889634f;
        const float* rope = (const float*)(ws + WS_ROPE);
        const LAS float* rt = tab + (cnt & 1) * 256 + wr * 64 + fr; const LAS float* bs = tab + 512 + (cnt & 1) * 256 + wc * 32 + 8 * fq; ++cnt;
        const int row0 = u.pm * BM + wr * 64 + fr, col0 = u.pn * BM + wc * 32 + 8 * fq; const bool lat = u.pm < tl_panels;
        f32x4 bv[2][2];
#pragma unroll
        for (int bj = 0; bj < 2; ++bj)
#pragma unroll
            for (int n = 0; n < 2; ++n) bv[bj][n] = *(const LAS f32x4*)(bs + bj * HALF + n * 4);
        const bool isq = (u.pn == 2 || u.pn == 3); const bool isk = (u.pn == 4); const bool upper = fq >= 2;
#pragma unroll
        for (int ai = 0; ai < 2; ++ai)
#pragma unroll
            for (int m = 0; m < 4; ++m) { const int row = row0 + ai * HALF + m * 16; const float rs = rt[ai * HALF + m * 16]; bf16_t* rowp = O + (size_t)row * ldc + col0;
                f32x4 v[2][2];
#pragma unroll
                for (int bj = 0; bj < 2; ++bj)
#pragma unroll
                    for (int n = 0; n < 2; ++n) v[bj][n] = acc[ai][bj][m][n] * rs + bv[bj][n];
                if (isq || isk) {
                    if (lat) { const int pos = row & 4095; const int p = (wc & 1) ? (pos & 63) : (pos >> 6); const float* rp = rope + (size_t)(p * 16 + 8 * (fq & 1)) * 2;
                        const f32x4 cs0 = *(const f32x4*)rp, cs1 = *(const f32x4*)(rp + 4), cs2 = *(const f32x4*)(rp + 8), cs3 = *(const f32x4*)(rp + 12);
                        const f32x4 cc[2] = {{cs0[0], cs0[2], cs1[0], cs1[2]}, {cs2[0], cs2[2], cs3[0], cs3[2]}}, ss[2] = {{cs0[1], cs0[3], cs1[1], cs1[3]}, {cs2[1], cs2[3], cs3[1], cs3[3]}};
#pragma unroll
                        for (int bj = 0; bj < 2; ++bj) if (isq || bj == 0) {
#pragma unroll
                            for (int n = 0; n < 2; ++n) { f32x4 pv;
#pragma unroll
                                for (int i = 0; i < 4; ++i) { const unsigned xv = __float_as_uint(v[bj][n][i]); const auto sw = __builtin_amdgcn_permlane32_swap(xv, xv, false, false); pv[i] = __uint_as_float(upper ? sw[0] : sw[1]); }
                                v[bj][n] = upper ? (v[bj][n] * cc[n] + pv * ss[n]) : (v[bj][n] * cc[n] - pv * ss[n]); } } }
                    if (isq) {
#pragma unroll
                        for (int bj = 0; bj < 2; ++bj) { v[bj][0] = v[bj][0] * qscale; v[bj][1] = v[bj][1] * qscale; } } }
#pragma unroll
                for (int bj = 0; bj < 2; ++bj) { u32x4 w; w.x = cvt_pk_bf16(v[bj][0][0], v[bj][0][1]); w.y = cvt_pk_bf16(v[bj][0][2], v[bj][0][3]); w.z = cvt_pk_bf16(v[bj][1][0], v[bj][1][1]); w.w = cvt_pk_bf16(v[bj][1][2], v[bj][1][3]);
                    *(u32x4*)(rowp + bj * HALF) = w; } }
    }
};
struct EpiResid {
    static constexpr bool PERM = true, AFTER_DRAIN = false;
    unsigned char* ws; const float* xsrc32; const float* ng; int gate_off, nscale_off; float coef;
    __device__ __forceinline__ void operator()(const f32x4 (&acc)[2][2][4][2], const Unit& u, int wr, int wc, int fr, int fq) const {
        constexpr int ppb = SEQ / 256, mod_stride = MODW; const float* gate = (const float*)(ws + WS_MOD) + gate_off; const float* nscale = (const float*)(ws + WS_MOD) + nscale_off;
        bf16_t* hraw = (bf16_t*)(ws + WS_HB); float* rowss = (float*)(ws + WS_RS); bf16_t* x16 = (bf16_t*)(ws + WS_X16);
        const int prow = u.pm * BM; const int mr = u.pm / ppb;
        const int row0 = wr * 64 + fr, col0 = u.pn * BM + wc * 32 + 8 * fq;
        float ssq[2][4];
#pragma unroll
        for (int ai = 0; ai < 2; ++ai)
#pragma unroll
            for (int m = 0; m < 4; ++m) ssq[ai][m] = 0.f;
#pragma unroll
        for (int bj = 0; bj < 2; ++bj) { const int c = col0 + bj * HALF;
            const f32x4 gv0 = *(const f32x4*)(gate + (size_t)mr * mod_stride + c) * coef, gv1 = *(const f32x4*)(gate + (size_t)mr * mod_stride + c + 4) * coef;
            f32x4 hs0 = {0.f, 0.f, 0.f, 0.f}, hs1 = hs0;
            if (ng) { hs0 = *(const f32x4*)(ng + c) * (*(const f32x4*)(nscale + (size_t)mr * mod_stride + c) + 1.f); hs1 = *(const f32x4*)(ng + c + 4) * (*(const f32x4*)(nscale + (size_t)mr * mod_stride + c + 4) + 1.f); }
#pragma unroll
            for (int ai = 0; ai < 2; ++ai)
#pragma unroll
                for (int m = 0; m < 4; ++m) { const int rl = row0 + ai * HALF + m * 16; const size_t off = (size_t)(prow + rl) * 1024 + c;
                    f32x4 xo0, xo1;
                    if (xsrc32) { xo0 = *(const f32x4*)(xsrc32 + off); xo1 = *(const f32x4*)(xsrc32 + off + 4); }
                    else { const half8 hx = __builtin_bit_cast(half8, *(const u32x4*)(x16 + off)); xo0 = (f32x4){(float)hx[0], (float)hx[1], (float)hx[2], (float)hx[3]}; xo1 = (f32x4){(float)hx[4], (float)hx[5], (float)hx[6], (float)hx[7]}; }
                    const f32x4 x0 = xo0 + gv0 * acc[ai][bj][m][0], x1 = xo1 + gv1 * acc[ai][bj][m][1];
                    { u32x4 w; w.x = cvt_pk_bf16(x0[0], x0[1]); w.y = cvt_pk_bf16(x0[2], x0[3]); w.z = cvt_pk_bf16(x1[0], x1[1]); w.w = cvt_pk_bf16(x1[2], x1[3]); *(u32x4*)(x16 + off) = w; }
                    ssq[ai][m] += ((x0[0] * x0[0] + x0[1] * x0[1]) + (x0[2] * x0[2] + x0[3] * x0[3])) + ((x1[0] * x1[0] + x1[1] * x1[1]) + (x1[2] * x1[2] + x1[3] * x1[3]));
                    if (ng) { const f32x4 h0 = x0 * hs0, h1 = x1 * hs1; u32x4 w; w.x = cvt_pk_bf16(h0[0], h0[1]); w.y = cvt_pk_bf16(h0[2], h0[3]); w.z = cvt_pk_bf16(h1[0], h1[1]); w.w = cvt_pk_bf16(h1[2], h1[3]); *(u32x4*)(hraw + off) = w; } } }
        const int lane = fq * 16 + fr;
#pragma unroll
        for (int ai = 0; ai < 2; ++ai)
#pragma unroll
            for (int m = 0; m < 4; ++m) { float q = ssq[ai][m];
                q += __int_as_float(__builtin_amdgcn_ds_bpermute((lane ^ 16) << 2, __float_as_int(q)));
                q += __int_as_float(__builtin_amdgcn_ds_bpermute((lane ^ 32) << 2, __float_as_int(q)));
                if (fq == 0) rowss[(size_t)(prow + row0 + ai * HALF + m * 16) * 16 + u.pn * 4 + wc] = q; }
    }
};
#define XB_TMO      128
#define XB_XCNT(j)  (256  + 64 * (j))
#define XB_XSUB(j)  (1280 + 64 * (j))
#define XB_XGEN(j)  (2304 + 64 * (j))
#define XB_TOP      3328
#define XB_TOPGEN   3392
#define XCD_BAR_WORDS 3456
#define XB_SPIN_CAP (1u << 18)

__device__ __forceinline__ unsigned xb_ld(unsigned* p)              { return __hip_atomic_load(p, __ATOMIC_RELAXED, __HIP_MEMORY_SCOPE_AGENT); }
__device__ __forceinline__ unsigned xb_add(unsigned* p, unsigned v) { return __hip_atomic_fetch_add(p, v, __ATOMIC_RELAXED, __HIP_MEMORY_SCOPE_AGENT); }
__device__ __forceinline__ unsigned xb_xcc_id() { return (unsigned)__builtin_amdgcn_s_getreg((3 << 11) | 20) & 0xFu; }
#define XB_SPIN(cond, bar) do { unsigned _sp = 0; while (cond) { __builtin_amdgcn_s_sleep(1); \
    if ((++_sp & 255u) == 0u) { if (xb_ld(&(bar)[XB_TMO])) break; if (_sp > XB_SPIN_CAP) { atomicAdd(&(bar)[XB_TMO], 1u); break; } } } } while (0)

struct XcdBarrier {
    unsigned* bar; unsigned x;
    volatile LAS unsigned* st;
};

__device__ __forceinline__ XcdBarrier xcd_barrier_post(unsigned* bar, volatile LAS unsigned* st) {
    XcdBarrier b; b.bar = bar; b.x = xb_xcc_id(); b.st = st;
    if (threadIdx.x == 0) (void)xb_add(&bar[XB_XCNT(b.x)], 1u);
    return b;
}
__device__ __forceinline__ void xcd_barrier_complete(unsigned* bar, unsigned x, unsigned& nloc, unsigned& nx) {
    const unsigned G = gridDim.x * gridDim.y * gridDim.z;
    unsigned sum, cnt, mine, sp = 0u;
    for (;;) {
        sum = 0u; cnt = 0u; mine = 0u;
#pragma unroll
        for (unsigned j = 0; j < 16; ++j) { const unsigned c = xb_ld(&bar[XB_XCNT(j)]); sum += c; cnt += (c > 0u) ? 1u : 0u; mine = (j == x) ? c : mine; }
        if (sum == G) break;
        __builtin_amdgcn_s_sleep(1);
        if ((++sp & 255u) == 0u) { if (xb_ld(&bar[XB_TMO])) break; if (sp > XB_SPIN_CAP) { atomicAdd(&bar[XB_TMO], 1u); break; } }
    }
    nloc = mine > 0u ? mine : 1u; nx = cnt > 0u ? cnt : 1u;
}

__device__ __forceinline__ void xcd_barrier(const XcdBarrier& b) {
    asm volatile("s_waitcnt vmcnt(0)" ::: "memory");
    __syncthreads();
    if (threadIdx.x == 0) {
        unsigned* bar = b.bar;
        __builtin_amdgcn_s_waitcnt(0);
        unsigned nloc = b.st[0], nx = b.st[1];
        if (nloc == 0u) { xcd_barrier_complete(bar, b.x, nloc, nx); b.st[0] = nloc; b.st[1] = nx; }
        const unsigned old = xb_add(&bar[XB_XSUB(b.x)], 1u);
        const unsigned gen = old / nloc;
        if (old + 1u == (gen + 1u) * nloc) {
            __builtin_amdgcn_fence(__ATOMIC_RELEASE, "agent");
            asm volatile("s_waitcnt vmcnt(0)" ::: "memory");
            const unsigned og = xb_add(&bar[XB_TOP], 1u);
            const unsigned tg = og / nx;
            if (og + 1u == (tg + 1u) * nx) xb_add(&bar[XB_TOPGEN], 1u);
            else XB_SPIN(xb_ld(&bar[XB_TOPGEN]) == tg, bar);
            __builtin_amdgcn_fence(__ATOMIC_ACQUIRE, "agent");
            xb_add(&bar[XB_XGEN(b.x)], 1u);
            asm volatile("s_waitcnt vmcnt(0)" ::: "memory");
        } else {
            XB_SPIN(xb_ld(&bar[XB_XGEN(b.x)]) == gen, bar);
            __builtin_amdgcn_fence(__ATOMIC_ACQUIRE, "agent");
            asm volatile("s_waitcnt vmcnt(0)" ::: "memory");
        }
    }
    __syncthreads();
}

struct Frame {
    LAS unsigned char* lds; unsigned char* ldsg;
    int tid, lane, wave, G, bid, gw, NGW;
    float* out; unsigned char* ws;
};

__device__ __forceinline__ void ph_mod(Frame& F, const Params& P) {
    const float* c = P.in[1]; const float* cctx = P.in[3]; const float* w_ada = P.in[4]; const float* b_ada = P.in[5]; float* MOD = (float*)(F.ws + WS_MOD);
    float* s = (float*)F.ldsg; float* red = s + NR * D;
    constexpr int NMODIT = DEPTH * (MODW / 128); const int mb = F.bid - (F.G - NMODIT);
    if (mb >= 0) { for (int i = F.tid; i < NR * D; i += NTHREADS) { const int r = i / D, k = i % D; const float v = r < NB ? c[r * D + k] : cctx[k]; s[i] = silu_f(v); } }
    for (int it = mb; it >= 0 && it < NMODIT; it += F.G) {
        const int l = it / (MODW / 128), j = (it % (MODW / 128)) * 128 + 2 * F.lane;
        __syncthreads();
        float a0[NR], a1[NR];
#pragma unroll
        for (int r = 0; r < NR; ++r) { a0[r] = 0.f; a1[r] = 0.f; }
        const float* w = w_ada + ((size_t)l * D + 128 * F.wave) * MODW + j;
#pragma unroll 16
        for (int k = 0; k < 128; ++k) { const float2 wv = *(const float2*)(w + (size_t)k * MODW);
#pragma unroll
            for (int r = 0; r < NR; ++r) { const float sv = s[r * D + 128 * F.wave + k]; a0[r] += sv * wv.x; a1[r] += sv * wv.y; } }
#pragma unroll
        for (int r = 0; r < NR; ++r) { red[(F.wave * NR + r) * 128 + 2 * F.lane] = a0[r]; red[(F.wave * NR + r) * 128 + 2 * F.lane + 1] = a1[r]; }
        __syncthreads();
        for (int idx = F.tid; idx < NR * 128; idx += NTHREADS) { const int r = idx >> 7, cc = idx & 127; float a = 0.f;
#pragma unroll
            for (int w8 = 0; w8 < 8; ++w8) a += red[(w8 * NR + r) * 128 + cc];
            const int jj = (it % (MODW / 128)) * 128 + cc; MOD[((size_t)l * NR + r) * MODW + jj] = a + b_ada[l * MODW + jj]; }
    }
    __syncthreads();
}
__device__ __forceinline__ void transpose_item(const float* W, int ldw, int K, bf16* WT, int dst_row0, int k0, int n0, LAS float* scr, int lane) {
#pragma unroll
    for (int i = 0; i < 8; ++i) { const int kk = 8 * i + (lane >> 3), nq = (lane & 7) * 4; const float4 v = *(const float4*)(W + (size_t)(k0 + kk) * ldw + n0 + nq);
        scr[kk * 33 + nq] = v.x; scr[kk * 33 + nq + 1] = v.y; scr[kk * 33 + nq + 2] = v.z; scr[kk * 33 + nq + 3] = v.w; }
    asm volatile("s_waitcnt lgkmcnt(0)" ::: "memory");
    const int c = lane & 7;
#pragma unroll
    for (int j = 0; j < 4; ++j) { const int n = (lane >> 3) + 8 * j; const LAS float* s = scr + (8 * c) * 33 + n;
        v4u o; o.x = pk2(s[0 * 33], s[1 * 33]); o.y = pk2(s[2 * 33], s[3 * 33]); o.z = pk2(s[4 * 33], s[5 * 33]); o.w = pk2(s[6 * 33], s[7 * 33]);
        *(v4u*)(WT + (size_t)(dst_row0 + n) * K + k0 + 8 * c) = o; }
    asm volatile("s_waitcnt lgkmcnt(0)" ::: "memory");
}
__device__ __forceinline__ void ph_convert(Frame& F, const Params& P, int l, int it0, int it1, int rank, int nw) {
    const float* w_ffn_in = P.in[7]; const float* w_ffn_out = P.in[8]; const float* w_in = P.in[9]; const float* w_out = P.in[10];
    bf16* Wi_t = (bf16*)(F.ws + WS_WI); bf16* Wo_t = (bf16*)(F.ws + WS_WO); bf16* Win_t = (bf16*)(F.ws + WS_WIN); bf16* Wout_t = (bf16*)(F.ws + WS_WOUT);
    LAS float* scr = (LAS float*)(F.lds + F.wave * 16384);
    constexpr int NSRC = SRC_GATE - SRC_COL0; constexpr int I_FI = (D / 64) * (2 * DFF / 32), I_FO = (DFF / 64) * (D / 32), I_IN = (D / 64) * (NSRC / 32), I_OUT = (D / 64) * (D / 32);
    constexpr int NITEMS = 2 * I_FI + 2 * I_FO + I_IN + I_OUT;
    if (it1 > NITEMS) it1 = NITEMS;
    for (int it = it0 + rank; it < it1; it += nw) {
        int r = it;
        if (r < 2 * I_FI) { const int mat = 2 * l + r / I_FI; r %= I_FI; const int nblk = 2 * DFF / 32, kb = r / nblk, nb = r % nblk, n0 = 32 * nb;
            const int nn = n0 < DFF ? n0 : n0 - DFF; const int drow = 256 * (nn / 128) + (n0 < DFF ? 0 : 128) + (nn % 128);
            transpose_item(w_ffn_in + (size_t)mat * D * 2 * DFF, 2 * DFF, D, Wi_t + (size_t)mat * 2 * DFF * D, drow, 64 * kb, n0, scr, F.lane); continue; }
        r -= 2 * I_FI;
        if (r < 2 * I_FO) { const int mat = 2 * l + r / I_FO; r %= I_FO; const int nblk = D / 32, kb = r / nblk, nb = r % nblk;
            transpose_item(w_ffn_out + (size_t)mat * DFF * D, D, DFF, Wo_t + (size_t)mat * D * DFF, 32 * nb, 64 * kb, 32 * nb, scr, F.lane); continue; }
        r -= 2 * I_FO;
        if (r < I_IN) { const int nblk = NSRC / 32, kb = r / nblk, nb = r % nblk;
            transpose_item(w_in + (size_t)l * D * DIN, DIN, D, Win_t + (size_t)l * DU * D, 512 + 32 * nb, 64 * kb, SRC_COL0 + 32 * nb, scr, F.lane); continue; }
        r -= I_IN;
        { const int nblk = D / 32, kb = r / nblk, nb = r % nblk;
            transpose_item(w_out + (size_t)l * D * D, D, D, Wout_t + (size_t)l * D * D, 32 * nb, 64 * kb, 32 * nb, scr, F.lane); }
    }
}
__device__ __forceinline__ void ph_first(Frame& F, const Params& P) {
    const float* xin = P.in[0]; const float* cin = P.in[2]; const float* g = P.in[6]; const float* MOD = (const float*)(F.ws + WS_MOD);
    bf16* H = (bf16*)(F.ws + WS_HB); float* RS = (float*)(F.ws + WS_RS);
    constexpr int RB = 4;
    for (int r0 = F.gw * RB; r0 < T; r0 += F.NGW * RB) {
        float4 v[RB][4];
#pragma unroll
        for (int i = 0; i < RB; ++i) { const int r = r0 + i; const float* src = r < TL ? xin + (size_t)r * D : cin + (size_t)(r - TL) * D;
#pragma unroll
            for (int j = 0; j < 4; ++j) v[i][j] = ((const float4*)src)[F.lane + 64 * j]; }
        const int mr = mod_row(r0);
        float4 gs[4];
#pragma unroll
        for (int j = 0; j < 4; ++j) { const int q = F.lane + 64 * j; const float4 gv = ((const float4*)g)[q], sc = ((const float4*)(MOD + (size_t)mr * MODW + 1 * D))[q]; gs[j] = make_float4(gv.x * (1.f + sc.x), gv.y * (1.f + sc.y), gv.z * (1.f + sc.z), gv.w * (1.f + sc.w)); }
        float ss[RB];
#pragma unroll
        for (int i = 0; i < RB; ++i) { const int r = r0 + i; ss[i] = 0.f;
#pragma unroll
            for (int j = 0; j < 4; ++j) { const float4 x = v[i][j]; ss[i] += x.x * x.x + x.y * x.y + x.z * x.z + x.w * x.w;
                uint2 o; o.x = pk2(x.x * gs[j].x, x.y * gs[j].y); o.y = pk2(x.z * gs[j].z, x.w * gs[j].w); ((uint2*)(H + (size_t)r * D))[F.lane + 64 * j] = o; } }
#pragma unroll
        for (int i = 0; i < RB; ++i) ss[i] = wave_sum(ss[i], F.lane);
#pragma unroll
        for (int i = 0; i < RB; ++i) if (F.lane < 16) RS[(size_t)(r0 + i) * 16 + F.lane] = F.lane == 0 ? ss[i] : 0.f;
    }
}
__device__ __forceinline__ void ph_bias(Frame& F, const Params& P, int l) {
    const float* MOD = (const float*)(F.ws + WS_MOD); const bf16* Wi_t = (const bf16*)(F.ws + WS_WI); const bf16* Win_t = (const bf16*)(F.ws + WS_WIN);
    float* SWFI = (float*)(F.ws + WS_SWFI); float* SWIN = (float*)(F.ws + WS_SWIN); float* SWG = (float*)(F.ws + WS_SWG);
#pragma unroll 1
    for (int mg = 0; mg < 4; ++mg) {
        const bool fi = mg < 2; const int mat = fi ? 2 * l + mg : l, sidx = fi ? (mg ? 6 : 0) : 3, nrows = fi ? 2 * DFF : (mg == 2 ? DU : 16);
        float sh[NR][16];
#pragma unroll
        for (int r = 0; r < NR; ++r) { const float4* sp = (const float4*)(MOD + ((size_t)l * NR + r) * MODW + sidx * D + F.lane * 16);
#pragma unroll
            for (int q4 = 0; q4 < 4; ++q4) { const float4 s4 = sp[q4]; sh[r][4 * q4] = s4.x; sh[r][4 * q4 + 1] = s4.y; sh[r][4 * q4 + 2] = s4.z; sh[r][4 * q4 + 3] = s4.w; } }
        const bf16* wbase = fi ? Wi_t + (size_t)mat * 2 * DFF * D : (mg == 2 ? Win_t + (size_t)mat * DU * D : (const bf16*)(F.ws + WS_WGT) + (size_t)l * 32 * D);
        float* obase = fi ? SWFI + (size_t)mat * NR * 2 * DFF : (mg == 2 ? SWIN + (size_t)mat * NR * DU : SWG + (size_t)l * NR * 16);
        for (int row = F.gw; row < nrows; row += F.NGW) {
            const bf16* wr = wbase + (size_t)row * D + F.lane * 16;
            const half8 w0 = __builtin_bit_cast(half8, *(const v4u*)wr), w1 = __builtin_bit_cast(half8, *(const v4u*)(wr + 8));
            float x[16];
#pragma unroll
            for (int i = 0; i < 16; ++i) x[i] = i < 8 ? (float)w0[i] : (float)w1[i - 8];
#pragma unroll
            for (int r = 0; r < NR; ++r) { float a = 0.f;
#pragma unroll
                for (int i = 0; i < 16; ++i) a += sh[r][i] * x[i];
                a = wave_sum(a, F.lane); if (F.lane == 0) obase[(size_t)r * nrows + row] = a; }
        }
    }
}
__device__ __forceinline__ void ph_rope_table(Frame& F, const Params& P) {
    float2* RT = (float2*)(F.ws + WS_ROPE); bf16* WgT = (bf16*)(F.ws + WS_WGT);
    for (int i = F.bid * NTHREADS + F.tid; i < DEPTH * 32 * D; i += F.G * NTHREADS) { const int l = i / (32 * D), j = (i / D) & 31, k = i % D; WgT[i] = (bf16)(j < 16 ? f2bf(P.in[9][((size_t)l * D + k) * DIN + SRC_GATE + j]) : 0u); }
    for (int i = F.bid + F.G * F.tid; i < 64 * 16 && F.tid < 8; i += F.G * 8) { const int p = i >> 4, f = i & 15;     const float ang = (float)p * powf(10000.f, -(float)f / 16.f); RT[i] = make_float2(cosf(ang), sinf(ang)); }
}
__device__ __forceinline__ void ph_final(Frame& F, const Params& P) {
    const float* g = P.in[16]; const float* RS = (const float*)(F.ws + WS_RS); const bf16* X16 = (const bf16*)(F.ws + WS_X16);
    constexpr int RB = 4;
    float4 gv[4];
#pragma unroll
    for (int j = 0; j < 4; ++j) gv[j] = ((const float4*)g)[F.lane + 64 * j];
    for (int r0 = F.gw * RB; r0 < TL; r0 += F.NGW * RB) {
        half4 hx[RB][4]; float rstd[RB];
#pragma unroll
        for (int i = 0; i < RB; ++i) { rstd[i] = rstd_row(RS, r0 + i);
#pragma unroll
            for (int j = 0; j < 4; ++j) hx[i][j] = *(const half4*)(X16 + (size_t)(r0 + i) * D + 4 * (F.lane + 64 * j)); }
#pragma unroll
        for (int i = 0; i < RB; ++i) { float* o = F.out + (size_t)(r0 + i) * D;
#pragma unroll
            for (int j = 0; j < 4; ++j) ((float4*)o)[F.lane + 64 * j] = make_float4((float)hx[i][j][0] * rstd[i] * gv[j].x, (float)hx[i][j][1] * rstd[i] * gv[j].y, (float)hx[i][j][2] * rstd[i] * gv[j].z, (float)hx[i][j][3] * rstd[i] * gv[j].w); }
    }
}
__device__ __forceinline__ void ph_gates(Frame& F, int l) {
    const bf16* H = (const bf16*)(F.ws + WS_HB); float* G = (float*)(F.ws + WS_G); const float* RS = (const float*)(F.ws + WS_RS); const float* SWG = (const float*)(F.ws + WS_SWG) + l * NR * 16;
    const bf16* WgT = (const bf16*)(F.ws + WS_WGT) + (size_t)l * 32 * D;
    const int r32 = F.lane & 31, hh = F.lane >> 5;
    for (int rb = (F.gw + F.NGW - 100 * NWAVES) % F.NGW; rb < T / 32; rb += F.NGW) {
        const bf16* hp = H + (size_t)(rb * 32 + r32) * D + 8 * hh; const bf16* wp = WgT + (size_t)r32 * D + 8 * hh;
        f32x16 acc = {};
#pragma unroll 8
        for (int s = 0; s < 64; ++s) acc = __builtin_amdgcn_mfma_f32_32x32x16_f16(__builtin_bit_cast(half8, *(const v4u*)(wp + 16 * s)), __builtin_bit_cast(half8, *(const v4u*)(hp + 16 * s)), acc, 0, 0, 0);
        const int row = rb * 32 + r32; const float rstd = rstd_row(RS, row); const float* sb = SWG + mod_row(row) * 16;
#pragma unroll
        for (int q4 = 0; q4 < 2; ++q4) { const int j0 = 8 * q4 + 4 * hh; f32x4v o;
#pragma unroll
            for (int i = 0; i < 4; ++i) o[i] = acc[4 * q4 + i] * rstd + sb[j0 + i];
            *(f32x4v*)(G + (size_t)row * 16 + j0) = o; }
    }
}
constexpr int TP = 144;
constexpr int NCH = 68, NCHAIN = 32, NITEM = NCHAIN * NCH;
__device__ __forceinline__ f32x16 mfma32(half8 a, half8 b, f32x16 c) { return __builtin_amdgcn_mfma_f32_32x32x16_f16(a, b, c, 0, 0, 0); }
__device__ __forceinline__ float wave_max(float v, int lane) {
#pragma unroll
    for (int o = 1; o < 64; o <<= 1) v = fmaxf(v, lane_xor(v, lane, o));
    return v; }
struct ChunkGeo { int N, rb, p0, dp; };
__device__ __forceinline__ ChunkGeo chunk_geo(int b, int dir, int c  ) {
    ChunkGeo g; const bool isctx = c < 4; const int cc = isctx ? c : c - 4; g.N = isctx ? CTX : SEQ; g.rb = isctx ? TL + b * CTX : b * SEQ;
    if (dir == 0) { g.p0 = cc * 64; g.dp = 1; } else { g.p0 = g.N - 1 - cc * 64; g.dp = -1; }
    return g; }
__device__ __forceinline__ void conv16(const bf16* urow  , int p, int N, int colbase, const float* cw, float scale, float (&out)[16]) {
    const v4u c0 = *(const v4u*)(urow + colbase), c1 = *(const v4u*)(urow + colbase + 8);
    v4u m0 = {0u, 0u, 0u, 0u}, m1 = m0, n0 = m0, n1 = m0;
    if (p > 0) { m0 = *(const v4u*)(urow - DU + colbase); m1 = *(const v4u*)(urow - DU + colbase + 8); }
    if (p < N - 1) { n0 = *(const v4u*)(urow + DU + colbase); n1 = *(const v4u*)(urow + DU + colbase + 8); }
    const half8 hc0 = __builtin_bit_cast(half8, c0), hc1 = __builtin_bit_cast(half8, c1), hm0 = __builtin_bit_cast(half8, m0), hm1 = __builtin_bit_cast(half8, m1), hn0 = __builtin_bit_cast(half8, n0), hn1 = __builtin_bit_cast(half8, n1);
#pragma unroll
    for (int i = 0; i < 16; ++i) { const float xm = i < 8 ? (float)hm0[i] : (float)hm1[i - 8], xc = i < 8 ? (float)hc0[i] : (float)hc1[i - 8], xn = i < 8 ? (float)hn0[i] : (float)hn1[i - 8];
        const float a = xm * cw[i] + xc * cw[512 + i] + xn * cw[1024 + i]; out[i] = a * __builtin_amdgcn_rcpf(1.f + __expf(-a)) * scale; }
}
__device__ __forceinline__ void st_row16(LAS unsigned char* tile, int row, int c0, const float (&v)[16]) {
    v4u a, b; a.x = pk2(v[0], v[1]); a.y = pk2(v[2], v[3]); a.z = pk2(v[4], v[5]); a.w = pk2(v[6], v[7]); b.x = pk2(v[8], v[9]); b.y = pk2(v[10], v[11]); b.z = pk2(v[12], v[13]); b.w = pk2(v[14], v[15]);
    *(LAS v4u*)(tile + row * TP + c0 * 2) = a; *(LAS v4u*)(tile + row * TP + c0 * 2 + 16) = b; }
__device__ __forceinline__ void st_col16(LAS unsigned char* tile, int col, int r0, const float (&v)[16]) {
#pragma unroll
    for (int i = 0; i < 16; ++i) *(LAS unsigned short*)(tile + (r0 + i) * TP + col * 2) = (unsigned short)f2bf(v[i]); }
__device__ __forceinline__ half8 ld_row8(const LAS unsigned char* tile, int row, int c0) { return __builtin_bit_cast(half8, *(const LAS v4u*)(tile + row * TP + c0 * 2)); }

__device__ __forceinline__ void ph_mlstm_m1(Frame& F, const float* conv, const float* b_i, const float* b_f) {
    const bf16* U = (const bf16*)(F.ws + WS_R); const float* G = (const float*)(F.ws + WS_G);
    bf16* CL = (bf16*)(F.ws + WS_HS); float* NL = (float*)(F.ws + WS_NL); float* AM = (float*)(F.ws + WS_AM);
    const int dir = F.wave >> 2, wg = F.wave & 3, tg = F.tid & 255, r32 = F.lane & 31, hh = F.lane >> 5;
    LAS unsigned char* base = F.lds + dir * 24576; LAS unsigned char* KT = base; LAS unsigned char* VT = base + 9216; LAS float* wS = (LAS float*)(base + 18432);
    for (int it = F.bid; it < 16 * NCH; it += F.G) {
        const int bh = it / NCH, c = it % NCH, b = bh >> 2, h = bh & 3; const ChunkGeo g = chunk_geo(b, dir, c); const int item = (bh * 2 + dir) * NCH + c;
        if (wg == 0) { const int p = g.p0 + g.dp * F.lane; const float* g0 = G + (size_t)(g.rb + p) * 16;
            const float liv = g0[dir * 4 + h] + b_i[dir * 4 + h], lfv = logsigmoid_f(g0[8 + dir * 4 + h] + b_f[dir * 4 + h]);
            float bc = lfv;
#pragma unroll
            for (int o = 1; o < 64; o <<= 1) { const float t = lane_get(bc, F.lane - o); if (F.lane >= o) bc += t; }
            const float a = lane_get(bc, 63); const float dl = a - bc + liv; const float ml = wave_max(dl, F.lane);
            wS[F.lane] = __expf(dl - ml);
            if (F.lane == 0) { AM[item * 2] = a; AM[item * 2 + 1] = ml; } }
        __syncthreads();
        { const int tau = tg >> 2, d0 = (tg & 3) * 16; const int p = g.p0 + g.dp * tau; const bf16* urow = U + (size_t)(g.rb + p) * DU;
          float kv[16], vv[16]; conv16(urow, p, g.N, C_MK + h * 64 + d0, conv + 256 + h * 64 + d0, 0.125f, kv);
          const float w = wS[tau]; const half8 v0 = __builtin_bit_cast(half8, *(const v4u*)(urow + C_MV + h * 64 + d0)), v1 = __builtin_bit_cast(half8, *(const v4u*)(urow + C_MV + h * 64 + d0 + 8));
#pragma unroll
          for (int i = 0; i < 16; ++i) vv[i] = (i < 8 ? (float)v0[i] : (float)v1[i - 8]) * w;
          st_col16(KT, tau, d0, kv); st_col16(VT, tau, d0, vv); }
        __syncthreads();
        { const int tm = wg >> 1, tn = wg & 1; f32x16 acc = {};
#pragma unroll
          for (int s = 0; s < 4; ++s) acc = mfma32(ld_row8(VT, 32 * tm + r32, 16 * s + 8 * hh), ld_row8(KT, 32 * tn + r32, 16 * s + 8 * hh), acc);
          bf16* cl = CL + (size_t)item * 4096 + 32 * tn + r32;
#pragma unroll
          for (int r = 0; r < 16; ++r) cl[(size_t)(32 * tm + (r & 3) + 8 * (r >> 2) + 4 * hh) * 64] = (bf16)f2bf(acc[r]);
          if (tg < 64) { float a = 0.f; const LAS unsigned char* kr = KT + tg * TP;
#pragma unroll 8
              for (int s = 0; s < 64; ++s) a += wS[s] * bf2f(*(const LAS unsigned short*)(kr + s * 2));
              NL[(size_t)item * 64 + tg] = a; } }
        __syncthreads();
    }
}
__device__ __forceinline__ void ph_mlstm_m2(Frame& F) {
    bf16* CL = (bf16*)(F.ws + WS_HS); float* NL = (float*)(F.ws + WS_NL); const float* AM = (const float*)(F.ws + WS_AM); float* MS = (float*)(F.ws + WS_MS);
    for (int vb = F.bid; vb < NCHAIN * 8; vb += F.G) {
        const int chain = vb >> 3, sl = vb & 7, e = sl * NTHREADS + F.tid; const bool don = (sl == 0 && F.tid < 64);
        bf16* cp = CL + (size_t)chain * NCH * 4096 + e; float* np = NL + (size_t)chain * NCH * 64 + (F.tid & 63); const float* am = AM + (size_t)chain * NCH * 2;
        float cl[NCH];
#pragma unroll
        for (int c = 0; c < NCH; ++c) cl[c] = bf2f(cp[(size_t)c * 4096]);
        { float C = 0.f, m = 0.f;
#pragma unroll
          for (int c = 0; c < NCH; ++c) { const float a = am[c * 2], ml = am[c * 2 + 1]; const float mn = fmaxf(a + m, ml), al = __expf(a + m - mn), be = __expf(ml - mn);
              cp[(size_t)c * 4096] = (bf16)f2bf(fminf(fmaxf(C, -60000.f), 60000.f)); C = al * C + be * cl[c];
              if (sl == 0 && F.tid == 0) MS[chain * NCH + c] = m;
              m = mn; } }
        if (don) {
#pragma unroll
            for (int c = 0; c < NCH; ++c) cl[c] = np[c * 64];
            float nvv = 0.f, m = 0.f;
#pragma unroll
            for (int c = 0; c < NCH; ++c) { const float a = am[c * 2], ml = am[c * 2 + 1]; const float mn = fmaxf(a + m, ml), al = __expf(a + m - mn), be = __expf(ml - mn);
                np[c * 64] = nvv; nvv = al * nvv + be * cl[c]; m = mn; } }
    }
}
__device__ __forceinline__ void ph_mlstm_m3(Frame& F, const float* conv, const float* b_i, const float* b_f, bool do_ctx) {
    const bf16* U = (const bf16*)(F.ws + WS_R); const float* G = (const float*)(F.ws + WS_G); bf16* Y = (bf16*)F.out;
    const bf16* CS = (const bf16*)(F.ws + WS_HS); const float* NS = (const float*)(F.ws + WS_NL); const float* MS = (const float*)(F.ws + WS_MS);
    const int dir = F.wave >> 2, wg = F.wave & 3, tg = F.tid & 255, r32 = F.lane & 31, hh = F.lane >> 5;
    LAS unsigned char* base = F.lds + dir * 40960; LAS unsigned char* Qs = base; LAS unsigned char* Ks = base + 9216; LAS unsigned char* VT = base + 18432; LAS unsigned char* Cs = base + 27648;
    LAS float* fa = (LAS float*)(base + 36864); LAS float* bcS = fa; LAS float* lmbS = fa + 64; LAS float* mtS = fa + 128; LAS float* wpS = fa + 192; LAS float* n0S = fa + 256;
    LAS float* HO = (LAS float*)(F.lds + 81920);
    const int nblk = do_ctx ? NCH : NCH - 4;
    for (int it = F.bid; it < 16 * nblk; it += F.G) {
        const int bh = it / nblk, pbi = it % nblk + (do_ctx ? 0 : 4), b = bh >> 2, h = bh & 3;
        const bool isctx = pbi < 4; const int pb = isctx ? pbi : pbi - 4, N = isctx ? CTX : SEQ, rb = isctx ? TL + b * CTX : b * SEQ;
        const int cs = dir == 0 ? pb : N / 64 - 1 - pb;
        const int item = (bh * 2 + dir) * NCH + (isctx ? cs : 4 + cs);
        const int p0 = dir == 0 ? pb * 64 : pb * 64 + 63, dp = dir == 0 ? 1 : -1;
        if (wg == 0) { const int p = p0 + dp * F.lane; const float* g0 = G + (size_t)(rb + p) * 16;
            const float liv = g0[dir * 4 + h] + b_i[dir * 4 + h], lfv = logsigmoid_f(g0[8 + dir * 4 + h] + b_f[dir * 4 + h]);
            float bc = lfv;
#pragma unroll
            for (int o = 1; o < 64; o <<= 1) { const float t = lane_get(bc, F.lane - o); if (F.lane >= o) bc += t; }
            const float lmb = liv - bc; float pm = lmb;
#pragma unroll
            for (int o = 1; o < 64; o <<= 1) { const float t = lane_get(pm, F.lane - o); if (F.lane >= o) pm = fmaxf(pm, t); }
            const float m0 = MS[item]; const float mt = bc + fmaxf(m0, pm);
            bcS[F.lane] = bc; lmbS[F.lane] = lmb; mtS[F.lane] = mt; wpS[F.lane] = __expf(bc + m0 - mt); n0S[F.lane] = NS[(size_t)item * 64 + F.lane]; }
        { const int tau = tg >> 2, d0 = (tg & 3) * 16; const int p = p0 + dp * tau; const bf16* urow = U + (size_t)(rb + p) * DU;
          float qv[16], kv[16], vv[16]; conv16(urow, p, N, C_MQ + h * 64 + d0, conv + h * 64 + d0, 1.0f, qv); conv16(urow, p, N, C_MK + h * 64 + d0, conv + 256 + h * 64 + d0, 0.125f, kv);
          const half8 v0 = __builtin_bit_cast(half8, *(const v4u*)(urow + C_MV + h * 64 + d0)), v1 = __builtin_bit_cast(half8, *(const v4u*)(urow + C_MV + h * 64 + d0 + 8));
#pragma unroll
          for (int i = 0; i < 16; ++i) vv[i] = i < 8 ? (float)v0[i] : (float)v1[i - 8];
          st_row16(Qs, tau, d0, qv); st_row16(Ks, tau, d0, kv); st_col16(VT, tau, d0, vv);
          const bf16* cg = CS + (size_t)item * 4096 + tau * 64 + d0;
          *(LAS v4u*)(Cs + tau * TP + d0 * 2) = *(const v4u*)cg; *(LAS v4u*)(Cs + tau * TP + d0 * 2 + 16) = *(const v4u*)(cg + 8); }
        __syncthreads();
        f32x16 ho;
        { const int tt = wg & 1, tv = wg >> 1; const int tau = 32 * tt + r32;
          half8 qf[4];
#pragma unroll
          for (int s = 0; s < 4; ++s) qf[s] = ld_row8(Qs, tau, 16 * s + 8 * hh);
          f32x16 st0 = {}, st1 = {};
#pragma unroll
          for (int s = 0; s < 4; ++s) { st0 = mfma32(ld_row8(Ks, r32, 16 * s + 8 * hh), qf[s], st0); st1 = mfma32(ld_row8(Ks, 32 + r32, 16 * s + 8 * hh), qf[s], st1); }
          const float ct = bcS[tau] - mtS[tau]; float dpart = 0.f;
#pragma unroll
          for (int r = 0; r < 16; ++r) { const int sg = (r & 3) + 8 * (r >> 2) + 4 * hh;
              const float w0 = sg <= tau ? __expf(ct + lmbS[sg]) : 0.f, w1 = sg + 32 <= tau ? __expf(ct + lmbS[sg + 32]) : 0.f;
              st0[r] *= w0; st1[r] *= w1; dpart += st0[r] + st1[r]; }
          float qn = 0.f;
#pragma unroll
          for (int s = 0; s < 4; ++s)
#pragma unroll
              for (int j = 0; j < 8; ++j) qn += (float)qf[s][j] * n0S[16 * s + 8 * hh + j];
          dpart += lane_xor(dpart, F.lane, 32); qn += lane_xor(qn, F.lane, 32);
          const float wp = wpS[tau], mt = mtS[tau]; const float den = dpart + wp * qn; const float inv = 1.f / fmaxf(fabsf(den), __expf(-mt));
          f32x16 an = {}, ac = {};
#pragma unroll
          for (int ks = 0; ks < 4; ++ks) { const f32x16& sx = (ks >> 1) ? st1 : st0; const int rbs = 8 * (ks & 1);
              half8 bf;
#pragma unroll
              for (int j = 0; j < 8; ++j) bf[j] = (_Float16)sx[rbs + j];
              const LAS unsigned char* vr = VT + (32 * tv + r32) * TP + (16 * ks + 4 * hh) * 2;
              const half4 a0 = *(const LAS half4*)vr, a1 = *(const LAS half4*)(vr + 16);
              const half8 af = {a0[0], a0[1], a0[2], a0[3], a1[0], a1[1], a1[2], a1[3]};
              an = mfma32(af, bf, an); }
#pragma unroll
          for (int s = 0; s < 4; ++s) ac = mfma32(ld_row8(Cs, 32 * tv + r32, 16 * s + 8 * hh), qf[s], ac);
#pragma unroll
          for (int r = 0; r < 16; ++r) ho[r] = (an[r] + wp * ac[r]) * inv;
          if (dir == 0) {
#pragma unroll
              for (int q4 = 0; q4 < 4; ++q4) { f32x4v x = {ho[4 * q4], ho[4 * q4 + 1], ho[4 * q4 + 2], ho[4 * q4 + 3]}; *(LAS f32x4v*)(HO + tau * 68 + 32 * tv + 8 * q4 + 4 * hh) = x; } } }
        __syncthreads();
        if (dir == 1) { const int tt = wg & 1, tv = wg >> 1; const int tau = 32 * tt + r32, pos = 63 - tau;
#pragma unroll
            for (int q4 = 0; q4 < 4; ++q4) { LAS f32x4v* hp = (LAS f32x4v*)(HO + pos * 68 + 32 * tv + 8 * q4 + 4 * hh); f32x4v x = *hp;
                x[0] += ho[4 * q4]; x[1] += ho[4 * q4 + 1]; x[2] += ho[4 * q4 + 2]; x[3] += ho[4 * q4 + 3]; *hp = x; } }
        __syncthreads();
        { const int orow = F.tid >> 3, ch = F.tid & 7; const size_t row = (size_t)(rb + pb * 64 + orow);
          const f32x4v x0 = *(const LAS f32x4v*)(HO + orow * 68 + 8 * ch), x1 = *(const LAS f32x4v*)(HO + orow * 68 + 8 * ch + 4);
          const half8 mo = __builtin_bit_cast(half8, *(const v4u*)(U + row * DU + C_MO + h * 64 + 8 * ch)); float o[8];
#pragma unroll
          for (int i = 0; i < 8; ++i) { const float g = 1.f / (1.f + __expf(-(float)mo[i])); o[i] = fminf(fmaxf(g * (i < 4 ? x0[i] : x1[i - 4]), -60000.f), 60000.f); }
          v4u w; w.x = pk2(o[0], o[1]); w.y = pk2(o[2], o[3]); w.z = pk2(o[4], o[5]); w.w = pk2(o[6], o[7]); *(v4u*)(Y + row * D + 768 + h * 64 + 8 * ch) = w; }
        __syncthreads();
    }
}


__device__ __forceinline__ void ph_attn(Frame& F, const float* sink, bool do_ctx) {
    const bf16* U = (const bf16*)(F.ws + WS_R); bf16* Y = (bf16*)F.out;
    const int g = F.wave >> 1, qh = F.wave & 1, r32 = F.lane & 31, hh = F.lane >> 5;
    const int lrow = F.tid >> 3, lch = F.tid & 7;
    constexpr float LOG2E = 1.4426950408889634f;
    const int nunits = 512 + (do_ctx ? 32 : 0);
    for (int uk = 0; uk < 3; ++uk) {
        int u; if (uk < 2) u = (F.bid & 7) * 64 + (F.bid >> 3) * 2 + uk; else { if (F.bid < 64 || F.bid >= 96) break; u = 512 + (F.bid - 64); }
        if (u >= nunits) break;
        const bool lat = u < 512; int b, kvh, qb;
        if (lat) { b = u >> 7; kvh = (u >> 6) & 1; qb = u & 63; } else { const int v = u - 512; b = v >> 3; kvh = (v >> 2) & 1; qb = v & 3; }
        const int head = kvh * 4 + g;
        const size_t qrow = (size_t)(lat ? b * SEQ : TL + b * CTX) + qb * 64 + qh * 32 + r32;
        half8 qf[4];
#pragma unroll
        for (int s = 0; s < 4; ++s) qf[s] = __builtin_bit_cast(half8, *(const v4u*)(U + qrow * DU + C_Q + head * 64 + 16 * s + 8 * hh));
        const int kt_lo = lat ? (qb - 2 < 0 ? 0 : qb - 2) : 0, kt_hi = lat ? (qb + 2 > 63 ? 63 : qb + 2) : -1; const int nloc = kt_hi - kt_lo + 1, nt = nloc + 4;
        float m = sink[head] * LOG2E, l = 1.f; f32x16 o0 = {}, o1 = {};
        v4u kreg, vreg;
#define ATT_TILE_ROW0(t) ((t) < nloc ? (size_t)b * SEQ + (size_t)(kt_lo + (t)) * 64 : (size_t)TL + (size_t)b * CTX + (size_t)((t) - nloc) * 64)
#define ATT_LOAD(t) do { const bf16* rp = U + (ATT_TILE_ROW0(t) + lrow) * DU + kvh * 64 + 8 * lch; kreg = *(const v4u*)(rp + C_K); vreg = *(const v4u*)(rp + C_V); } while (0)
#define ATT_STORE(buf) do { LAS unsigned char* kb = F.lds + (buf) * 9216; LAS unsigned char* vb = F.lds + 18432 + (buf) * 9216; *(LAS v4u*)(kb + lrow * TP + lch * 16) = kreg; \
        const half8 vh = __builtin_bit_cast(half8, vreg); _Pragma("unroll") for (int i = 0; i < 8; ++i) *(LAS _Float16*)(vb + (8 * lch + i) * TP + lrow * 2) = vh[i]; } while (0)
        ATT_LOAD(0); ATT_STORE(0);
        __syncthreads();
        for (int t = 0; t < nt; ++t) {
            if (t + 1 < nt) ATT_LOAD(t + 1);
            const LAS unsigned char* Kb = F.lds + (t & 1) * 9216; const LAS unsigned char* Vb = F.lds + 18432 + (t & 1) * 9216;
            f32x16 s0, s1;
#pragma unroll
            for (int r = 0; r < 16; ++r) { s0[r] = -m; s1[r] = -m; }
#pragma unroll
            for (int s = 0; s < 4; ++s) { s0 = mfma32(ld_row8(Kb, r32, 16 * s + 8 * hh), qf[s], s0); s1 = mfma32(ld_row8(Kb, 32 + r32, 16 * s + 8 * hh), qf[s], s1); }
            int ttype = 0; if (t < nloc) { const int kt = kt_lo + t; ttype = (kt == qb - 2) ? 1 : (kt == qb + 2) ? 2 : 0; }
            const int qi = qh * 32 + r32;
            if (ttype != 0) {
#pragma unroll
                for (int r = 0; r < 16; ++r) { const int jk = (r & 3) + 8 * (r >> 2) + 4 * hh;
                    const bool v0 = ttype == 1 ? (jk >= qi) : (jk <= qi), v1 = ttype == 1 ? (jk + 32 >= qi) : (jk + 32 <= qi);
                    s0[r] = v0 ? s0[r] : -INFINITY; s1[r] = v1 ? s1[r] : -INFINITY; } }
            float mx = fmaxf(s0[0], s1[0]);
#pragma unroll
            for (int r = 1; r < 16; ++r) mx = fmaxf(mx, fmaxf(s0[r], s1[r]));
            mx = fmaxf(mx, lane_xor(mx, F.lane, 32));
            if (__builtin_amdgcn_ballot_w64(mx > 0.f) != 0ull) {
                const float dl = fmaxf(mx, 0.f), alpha = __builtin_amdgcn_exp2f(-dl); m += dl; l *= alpha;
#pragma unroll
                for (int r = 0; r < 16; ++r) { s0[r] -= dl; s1[r] -= dl; o0[r] *= alpha; o1[r] *= alpha; } }
            float ls = 0.f;
#pragma unroll
            for (int r = 0; r < 16; ++r) { s0[r] = __builtin_amdgcn_exp2f(s0[r]); s1[r] = __builtin_amdgcn_exp2f(s1[r]); ls += s0[r] + s1[r]; }
            ls += lane_xor(ls, F.lane, 32); l += ls;
#pragma unroll
            for (int ks = 0; ks < 4; ++ks) { const f32x16& sx = (ks >> 1) ? s1 : s0; const int rbs = 8 * (ks & 1);
                half8 pf;
#pragma unroll
                for (int j = 0; j < 8; ++j) pf[j] = (_Float16)sx[rbs + j];
                const LAS unsigned char* v0p = Vb + r32 * TP + (16 * ks + 4 * hh) * 2; const LAS unsigned char* v1p = v0p + 32 * TP;
                const half4 a0 = *(const LAS half4*)v0p, a1 = *(const LAS half4*)(v0p + 16), c0 = *(const LAS half4*)v1p, c1 = *(const LAS half4*)(v1p + 16);
                const half8 af0 = {a0[0], a0[1], a0[2], a0[3], a1[0], a1[1], a1[2], a1[3]}, af1 = {c0[0], c0[1], c0[2], c0[3], c1[0], c1[1], c1[2], c1[3]};
                o0 = mfma32(af0, pf, o0); o1 = mfma32(af1, pf, o1); }
            if (t + 1 < nt) ATT_STORE((t + 1) & 1);
            __syncthreads();
        }
#undef ATT_TILE_ROW0
#undef ATT_LOAD
#undef ATT_STORE
        const float il = 1.f / l; LAS unsigned char* stg = F.lds + 40960 + F.wave * 4608;
#pragma unroll
        for (int q4 = 0; q4 < 4; ++q4) { typedef unsigned v2u __attribute__((ext_vector_type(2))); v2u w0, w1;
            w0.x = pk2(o0[4 * q4] * il, o0[4 * q4 + 1] * il); w0.y = pk2(o0[4 * q4 + 2] * il, o0[4 * q4 + 3] * il);
            w1.x = pk2(o1[4 * q4] * il, o1[4 * q4 + 1] * il); w1.y = pk2(o1[4 * q4 + 2] * il, o1[4 * q4 + 3] * il);
            *(LAS v2u*)(stg + r32 * TP + (8 * q4 + 4 * hh) * 2) = w0; *(LAS v2u*)(stg + r32 * TP + (32 + 8 * q4 + 4 * hh) * 2) = w1; }
        asm volatile("s_waitcnt lgkmcnt(0)" ::: "memory");
        { bf16* yb = Y + (qrow - r32) * D + 256 + head * 64;
#pragma unroll
          for (int i = 0; i < 4; ++i) { const int row = i * 8 + (F.lane >> 3), ch = F.lane & 7; *(v4u*)(yb + (size_t)row * D + ch * 8) = *(const LAS v4u*)(stg + row * TP + ch * 16); } }
    }
}


constexpr int FP = 272;
__device__ __forceinline__ void ph_fft_consts(Frame& F) {
    bf16* M1 = (bf16*)(F.ws + WS_FM1); bf16* M3 = (bf16*)(F.ws + WS_FM3); float2* TW = (float2*)(F.ws + WS_TW); float2* CT = (float2*)(F.ws + WS_CT);
    for (int i = F.bid * NTHREADS + F.tid; i < 16384 + 8192 + 4096 + 256; i += F.G * NTHREADS) {
        float s, c;
        if (i < 16384) { const int row = i >> 7, col = i & 127, pr = row >> 6, k1 = row & 63, pc = col >> 6, n1 = col & 63; sincospif((float)((k1 * n1) & 63) * (1.f / 32.f), &s, &c);
            M1[i] = (bf16)f2bf(pr == pc ? c : (pr == 0 ? s : -s)); }
        else if (i < 16384 + 8192) { const int j = i - 16384, k2 = j >> 7, col = j & 127, pc = col >> 6, n2 = col & 63; sincospif((float)((k2 * n2) & 63) * (1.f / 32.f), &s, &c); M3[j] = (bf16)f2bf(pc == 0 ? c : s); }
        else if (i < 16384 + 8192 + 4096) { const int j = i - 16384 - 8192; sincospif((float)j * (1.f / 2048.f), &s, &c); TW[j] = make_float2(c, s); }
        else { const int j = i - 16384 - 8192 - 4096; sincospif((float)j * (1.f / 128.f), &s, &c); CT[j] = make_float2(c, s); }
    }
    bf16* DMC = (bf16*)(F.ws + WS_DMC);
    for (int i = F.bid * NTHREADS + F.tid; i < 256 * 512; i += F.G * NTHREADS) { const int k = i >> 9, pn = i & 511, n = pn & 255; float s, c; sincospif((float)((k * n) & 255) * (1.f / 128.f), &s, &c); DMC[i] = (bf16)f2bf(4.f * (pn < 256 ? c : s)); }
}
__device__ __forceinline__ void ph_fold(Frame& F, const Params& P, int l, int bid0, int nb) {
    const float* w_in = P.in[9]; const float* wfo = P.in[11]; bf16* Win_t = (bf16*)(F.ws + WS_WIN);
    float* Wx = (float*)F.ldsg; float* ct = Wx + 4096; float* st = ct + 64;
    if (F.bid < bid0 || F.bid >= bid0 + nb) return;
    for (int it = F.bid - bid0; it < 128; it += nb) {
        const int g = (it >> 5) & 3, part = (it >> 4) & 1, kb = it & 15;
        __syncthreads();
        if (F.tid < 64) { float s, c; sincospif((float)F.tid * (1.f / 32.f), &s, &c); ct[F.tid] = c; st[F.tid] = s; }
        __syncthreads();
        const float* wf = wfo + ((size_t)l * 4 + g) * 4096;
        { const int e = F.tid & 63, c0 = F.tid >> 6; float wfc[64];
#pragma unroll
          for (int m = 0; m < 64; ++m) wfc[m] = wf[m * 64 + e];
          const float* tb = part == 0 ? ct : st; const float sg = part == 0 ? (1.f / 512.f) : (-1.f / 512.f);
#pragma unroll 1
          for (int i = 0; i < 8; ++i) { const int c = c0 + 8 * i; float a = 0.f;
#pragma unroll
              for (int m = 0; m < 64; ++m) a += tb[(m * c) & 63] * wfc[m];
              Wx[c * 64 + e] = a * sg; } }
        __syncthreads();
        const int k = kb * 64 + (F.tid >> 3), e0 = (F.tid & 7) * 8; const float* wr = w_in + ((size_t)l * D + k) * DIN + g * 64;
        float acc[8];
#pragma unroll
        for (int j = 0; j < 8; ++j) acc[j] = 0.f;
        float4 av[16];
#pragma unroll
        for (int c4 = 0; c4 < 16; ++c4) av[c4] = ((const float4*)wr)[c4];
#pragma unroll
        for (int c4 = 0; c4 < 16; ++c4) { const float aa[4] = {av[c4].x, av[c4].y, av[c4].z, av[c4].w};
#pragma unroll
            for (int ci = 0; ci < 4; ++ci) { const float* wx = Wx + (4 * c4 + ci) * 64 + e0; const float4 w0 = *(const float4*)wx, w1 = *(const float4*)(wx + 4);
                acc[0] += aa[ci] * w0.x; acc[1] += aa[ci] * w0.y; acc[2] += aa[ci] * w0.z; acc[3] += aa[ci] * w0.w; acc[4] += aa[ci] * w1.x; acc[5] += aa[ci] * w1.y; acc[6] += aa[ci] * w1.z; acc[7] += aa[ci] * w1.w; } }
#pragma unroll
        for (int j = 0; j < 8; ++j) Win_t[((size_t)l * DU + part * 256 + g * 64 + e0 + j) * D + k] = (bf16)f2bf(acc[j]);
    }
    __syncthreads();
}
__device__ __forceinline__ void ph_fft(Frame& F) {
    const bf16* U = (const bf16*)(F.ws + WS_R); bf16* Y = (bf16*)F.out; const float2* TW = (const float2*)(F.ws + WS_TW);
    LAS unsigned char* BUF = F.lds; LAS unsigned char* M1s = F.lds + 69632; LAS unsigned char* M3s = F.lds + 69632 + 34816;
    const int r32 = F.lane & 31, hh = F.lane >> 5, w = F.wave;
    __syncthreads();
    if (F.bid < 256) {
        const v4u* m1 = (const v4u*)(F.ws + WS_FM1); const v4u* m3 = (const v4u*)(F.ws + WS_FM3);
        for (int i = F.tid; i < 128 * 16; i += NTHREADS) *(LAS v4u*)(M1s + (i >> 4) * FP + (i & 15) * 16) = m1[i];
        for (int i = F.tid; i < 64 * 16; i += NTHREADS) *(LAS v4u*)(M3s + (i >> 4) * FP + (i & 15) * 16) = m3[i];
    }
    for (int itb = F.bid; itb < 256; itb += F.G) {
        const int it = (((itb & 7) * 4 + (itb >> 6)) << 3) | ((itb >> 3) & 7);
        const int b = it >> 6, cg = it & 63;
        __syncthreads();
        for (int q = w; q < 128; q += NWAVES) { const int n2 = q >> 1, part = q & 1, n1 = F.lane;
            const half4 x = *(const half4*)(U + (size_t)(b * SEQ + 64 * n1 + n2) * DU + part * 256 + cg * 4);
#pragma unroll
            for (int i = 0; i < 4; ++i) *(LAS _Float16*)(BUF + (n2 * 4 + i) * FP + (part * 64 + n1) * 2) = x[i]; }
        __syncthreads();
        f32x16 acc[4] = {};
#pragma unroll
        for (int s = 0; s < 8; ++s) { const half8 bf = __builtin_bit_cast(half8, *(const LAS v4u*)(BUF + (32 * w + r32) * FP + (16 * s + 8 * hh) * 2));
#pragma unroll
            for (int tm = 0; tm < 4; ++tm) acc[tm] = mfma32(__builtin_bit_cast(half8, *(const LAS v4u*)(M1s + (32 * tm + r32) * FP + (16 * s + 8 * hh) * 2)), bf, acc[tm]); }
        int nidx = 32 * w + r32; asm volatile("" : "+v"(nidx));
        const int n2 = nidx >> 2, col = nidx & 3;
        __syncthreads();
#pragma unroll
        for (int tm = 0; tm < 2; ++tm)
#pragma unroll
            for (int r = 0; r < 16; ++r) { const int k1 = 32 * tm + (r & 3) + 8 * (r >> 2) + 4 * hh; const float2 t = *(const float2*)((const char*)TW + ((unsigned)((k1 * n2) & 4095) << 3));
                const float re = acc[tm][r], im = acc[tm + 2][r];
                *(LAS _Float16*)(BUF + (k1 * 4 + col) * FP + n2 * 2) = (_Float16)(re * t.x + im * t.y);
                *(LAS _Float16*)(BUF + (k1 * 4 + col) * FP + (64 + n2) * 2) = (_Float16)(im * t.x - re * t.y); }
        __syncthreads();
        f32x16 y0 = {}, y1 = {};
#pragma unroll
        for (int s = 0; s < 8; ++s) { const half8 bf = __builtin_bit_cast(half8, *(const LAS v4u*)(BUF + (32 * w + r32) * FP + (16 * s + 8 * hh) * 2));
            y0 = mfma32(__builtin_bit_cast(half8, *(const LAS v4u*)(M3s + r32 * FP + (16 * s + 8 * hh) * 2)), bf, y0);
            y1 = mfma32(__builtin_bit_cast(half8, *(const LAS v4u*)(M3s + (32 + r32) * FP + (16 * s + 8 * hh) * 2)), bf, y1); }
        const int k1o = nidx >> 2; bf16* yb = Y + (size_t)(b * SEQ) * D + cg * 4 + col;
#pragma unroll
        for (int rep = 0; rep < (PROBE_ID == 316 ? 3 : 1); ++rep) {
#pragma unroll
        for (int r = 0; r < 16; ++r) { const int k2 = (r & 3) + 8 * (r >> 2) + 4 * hh;
            yb[(size_t)(k1o + 64 * k2) * D] = (bf16)f2bf(y0[r]); yb[(size_t)(k1o + 64 * (k2 + 32)) * D] = (bf16)f2bf(y1[r]); }
        asm volatile("s_waitcnt vmcnt(0)" ::: "memory"); }
    }
    __syncthreads();
}
__device__ __forceinline__ void ph_ctx_dft(Frame& F) {
    const bf16* U = (const bf16*)(F.ws + WS_R); bf16* Y = (bf16*)F.out; const bf16* Dm = (const bf16*)(F.ws + WS_DMC);
    constexpr int GP = 1040;
    LAS unsigned char* Gt = F.lds; const int r32 = F.lane & 31, hh = F.lane >> 5;
    for (int it = (F.bid + 160) & 255; it < NB * 8; it += 256) {
        const int b = it >> 3, cg = it & 7;
        __syncthreads();
        for (int q = F.tid; q < 2 * CTX * 4; q += NTHREADS) { const int part = q >> 10, n = (q >> 2) & 255, c8 = q & 3;
            const half8 x = __builtin_bit_cast(half8, *(const v4u*)(U + (size_t)(TL + b * CTX + n) * DU + part * 256 + cg * 32 + c8 * 8));
#pragma unroll
            for (int i = 0; i < 8; ++i) *(LAS _Float16*)(Gt + (c8 * 8 + i) * GP + (part * 256 + n) * 2) = x[i]; }
        __syncthreads();
        f32x16 acc = {}; const bf16* dr = Dm + (size_t)(32 * F.wave + r32) * 512 + 8 * hh; const LAS unsigned char* gr = Gt + r32 * GP + 16 * hh;
#pragma unroll 8
        for (int s = 0; s < 32; ++s) acc = mfma32(__builtin_bit_cast(half8, *(const v4u*)(dr + 16 * s)), __builtin_bit_cast(half8, *(const LAS v4u*)(gr + 32 * s)), acc);
        bf16* yb = Y + (size_t)(TL + b * CTX) * D + cg * 32 + r32;
#pragma unroll
        for (int r = 0; r < 16; ++r) yb[(size_t)(32 * F.wave + (r & 3) + 8 * (r >> 2) + 4 * hh) * D] = (bf16)f2bf(acc[r]);
    }
    __syncthreads();
}

__device__ __forceinline__ void ph_ctx_resid_gemm(Frame& F, const bf16* A  , const bf16* Bt  , int K, const float* xsrc, const float* ng, int gate_off, int nscale_off, float coef) {
    bf16* x16 = (bf16*)(F.ws + WS_X16) + (size_t)TL * D; const float* gate = (const float*)(F.ws + WS_MOD) + gate_off + (size_t)NB * MODW; const float* nscale = (const float*)(F.ws + WS_MOD) + nscale_off + (size_t)NB * MODW;
    bf16* hraw = (bf16*)(F.ws + WS_HB) + (size_t)TL * D; float* rowss = (float*)(F.ws + WS_RS) + (size_t)TL * 16;
    const int r32 = F.lane & 31, hh = F.lane >> 5; const int kc = K >> 3;
    LAS float* red = (LAS float*)F.lds;
    for (int pc = F.bid; pc < 256; pc += F.G) {
        const int xq = pc & 7, jq = pc >> 3; const int rt = (xq >> 1) * 4 + (jq >> 3), ct = (xq & 1) * 8 + (jq & 7);
        const bf16* ap = A + (size_t)(TL + rt * 64 + r32) * K + F.wave * kc + 8 * hh;
        const bf16* bp = Bt + (size_t)(ct * 64 + r32) * K + F.wave * kc + 8 * hh;
        f32x16 acc[2][2] = {};
        constexpr int PB = 8; const int nst = kc / 16;
        v4u lb0[PB], lb1[PB], la0[PB], la1[PB];
#pragma unroll
        for (int i = 0; i < PB; ++i) { const int s = i < nst ? i : 0; lb0[i] = *(const v4u*)(bp + 16 * s); lb1[i] = *(const v4u*)(bp + (size_t)32 * K + 16 * s); la0[i] = *(const v4u*)(ap + 16 * s); la1[i] = *(const v4u*)(ap + (size_t)32 * K + 16 * s); }
        for (int s0 = 0; s0 < nst; s0 += PB) {
#pragma unroll
            for (int i = 0; i < PB; ++i) {
                const half8 b0 = __builtin_bit_cast(half8, lb0[i]), b1 = __builtin_bit_cast(half8, lb1[i]), a0 = __builtin_bit_cast(half8, la0[i]), a1 = __builtin_bit_cast(half8, la1[i]);
                const int sn = s0 + PB + i;
                const int sl = sn < nst ? sn : nst - 1;
                lb0[i] = *(const v4u*)(bp + 16 * sl); lb1[i] = *(const v4u*)(bp + (size_t)32 * K + 16 * sl); la0[i] = *(const v4u*)(ap + 16 * sl); la1[i] = *(const v4u*)(ap + (size_t)32 * K + 16 * sl);
                if (s0 + i < nst) { acc[0][0] = mfma32(b0, a0, acc[0][0]); acc[0][1] = mfma32(b0, a1, acc[0][1]); acc[1][0] = mfma32(b1, a0, acc[1][0]); acc[1][1] = mfma32(b1, a1, acc[1][1]); } } }
        __syncthreads();
#pragma unroll
        for (int ti = 0; ti < 2; ++ti)
#pragma unroll
            for (int tj = 0; tj < 2; ++tj) { const int row = 32 * tj + r32;
#pragma unroll
                for (int q4 = 0; q4 < 4; ++q4) { const int chunk = 8 * ti + 2 * q4 + hh; f32x4v v = {acc[ti][tj][4 * q4], acc[ti][tj][4 * q4 + 1], acc[ti][tj][4 * q4 + 2], acc[ti][tj][4 * q4 + 3]};
                    *(LAS f32x4v*)(red + ((F.wave * 64 + row) * 16 + (chunk ^ (row & 15))) * 4) = v; } }
        __syncthreads();
        { const int row = F.tid >> 3, cg8 = F.tid & 7; f32x4v s0 = {0.f, 0.f, 0.f, 0.f}, s1 = s0;
#pragma unroll
          for (int w8 = 0; w8 < 8; ++w8) { s0 += *(const LAS f32x4v*)(red + ((w8 * 64 + row) * 16 + ((2 * cg8) ^ (row & 15))) * 4); s1 += *(const LAS f32x4v*)(red + ((w8 * 64 + row) * 16 + ((2 * cg8 + 1) ^ (row & 15))) * 4); }
          const int grow = rt * 64 + row, c = ct * 64 + cg8 * 8; float ssq = 0.f;
          { const size_t off = (size_t)grow * D + c; f32x4v xo0, xo1;
            if (xsrc) { xo0 = *(const f32x4v*)(xsrc + off); xo1 = *(const f32x4v*)(xsrc + off + 4); }
            else { const half8 hx = __builtin_bit_cast(half8, *(const v4u*)(x16 + off)); xo0 = (f32x4v){(float)hx[0], (float)hx[1], (float)hx[2], (float)hx[3]}; xo1 = (f32x4v){(float)hx[4], (float)hx[5], (float)hx[6], (float)hx[7]}; }
            const f32x4v x0 = xo0 + *(const f32x4v*)(gate + c) * coef * s0, x1 = xo1 + *(const f32x4v*)(gate + c + 4) * coef * s1;
            { v4u w; w.x = pk2(x0[0], x0[1]); w.y = pk2(x0[2], x0[3]); w.z = pk2(x1[0], x1[1]); w.w = pk2(x1[2], x1[3]); *(v4u*)(x16 + off) = w; }
            ssq += ((x0[0] * x0[0] + x0[1] * x0[1]) + (x0[2] * x0[2] + x0[3] * x0[3])) + ((x1[0] * x1[0] + x1[1] * x1[1]) + (x1[2] * x1[2] + x1[3] * x1[3]));
            if (ng) { const f32x4v h0 = x0 * (*(const f32x4v*)(ng + c) * (*(const f32x4v*)(nscale + c) + 1.f)), h1 = x1 * (*(const f32x4v*)(ng + c + 4) * (*(const f32x4v*)(nscale + c + 4) + 1.f));
                v4u w; w.x = pk2(h0[0], h0[1]); w.y = pk2(h0[2], h0[3]); w.z = pk2(h1[0], h1[1]); w.w = pk2(h1[2], h1[3]); *(v4u*)(hraw + off) = w; } }
          ssq += lane_xor(ssq, F.lane, 1); ssq += lane_xor(ssq, F.lane, 2); ssq += lane_xor(ssq, F.lane, 4);
          if (cg8 == 0) rowss[(size_t)grow * 16 + ct] = ssq; }
    }
    __syncthreads();
}

template <class Epi> __device__ __forceinline__ void run_gemm(Frame& F, const bf16* A, const bf16* Bt, int M, int N, int K, const Epi& E) {
    pg8::Gemm g{A, Bt, M, N, K}; pg8::StaticOrder S; S.init(M, N, F.G, F.bid);
    pg8::gemm_phase<Epi, pg8::StaticOrder, true, true>(F.lds, g, S, E, F.tid);
}
template <class Epi> __device__ __forceinline__ void run_gemm_normed(Frame& F, const bf16* A, const bf16* Bt, int M, int N, int K, const Epi& E, const float* sw) {
    pg8::Gemm g{A, Bt, M, N, K}; RstdOrder S; S.init(M, N, F.G, F.bid); S.rowss = (const float*)(F.ws + WS_RS); S.tab = (LAS float*)(F.lds + RSTD_TAB_OFF); S.tid = F.tid; S.cnt = 0; S.sw = sw; S.ncols = N;
    pg8::gemm_phase<Epi, RstdOrder, true, true>(F.lds, g, S, E, F.tid);
}
__device__ __forceinline__ Frame make_frame(const Params& P, unsigned char* lds_raw) {
    Frame F; int t = threadIdx.x; asm volatile("" : "+v"(t));
    F.lds = (LAS unsigned char*)lds_raw; F.ldsg = lds_raw;
    F.tid = t; F.lane = t & 63; F.wave = __builtin_amdgcn_readfirstlane(t >> 6);
    int g = gridDim.x, b = blockIdx.x; asm volatile("" : "+s"(g), "+s"(b));
    F.G = g; F.bid = b; F.gw = b * NWAVES + F.wave; F.NGW = g * NWAVES;
    unsigned char* ws = P.ws; float* out = P.out; asm volatile("" : "+s"(ws), "+s"(out));
    F.out = out; F.ws = ws;
    return F;
}
__device__ __forceinline__ void grid_bar(const Params& P, unsigned char* lds_raw) {
    unsigned char* ws = P.ws; asm volatile("" : "+s"(ws));
    XcdBarrier b; b.bar = (unsigned*)(ws + WS_CTL) + CW_BAR; b.x = xb_xcc_id(); b.st = (volatile LAS unsigned*)((LAS unsigned char*)lds_raw + MISC_OFF) + 8;
    xcd_barrier(b);
}
__global__ void __launch_bounds__(NTHREADS, 2) mega_fwd(Params P) {
    extern __shared__ __attribute__((aligned(16))) unsigned char lds_raw[];
    { const int tid = threadIdx.x;
      for (int u = tid; u < (LDS_BYTES - MISC_OFF) / 4; u += NTHREADS) ((LAS unsigned*)((LAS unsigned char*)lds_raw + MISC_OFF))[u] = 0u;
      __syncthreads();
      (void)xcd_barrier_post((unsigned*)(P.ws + WS_CTL) + CW_BAR, (volatile LAS unsigned*)((LAS unsigned char*)lds_raw + MISC_OFF) + 8); }
#define GRID_BAR() grid_bar(P, lds_raw)
    unsigned long long tacc = 0, t0 = 0; (void)tacc; (void)t0;
#define T_ON(id) do { if (PROBE_ID == (id)) t0 = __builtin_amdgcn_s_memrealtime(); } while (0)
#define T_OFF(id) do { if (PROBE_ID == (id)) { const unsigned long long t1 = __builtin_amdgcn_s_memrealtime(); tacc += t1 - t0; \
        if (blockIdx.x == PROBE_WG) { const unsigned long long tgt = t1 + 4ull * (t1 - t0); while (__builtin_amdgcn_s_memrealtime() < tgt) __builtin_amdgcn_s_sleep(8); } } } while (0)
#define FRAME() Frame F = make_frame(P, lds_raw); Ptrs p{F.out, (float*)(F.ws + WS_XC)}; (void)p

    T_ON(1); T_ON(11); T_ON(9);
    T_ON(111);
    { FRAME(); ph_mod(F, P); }
    T_OFF(111); T_ON(112);
    { FRAME(); constexpr int NCV = 9856, NMODWG = DEPTH * (MODW / 128);
      constexpr int NA1 = 1792;
      if (F.G == 256) { if (F.bid < 256 - NMODWG) { const int rk = F.bid * NWAVES + F.wave, nw = (256 - NMODWG) * NWAVES; ph_convert(F, P, 0, 0, NCV, rk, nw); ph_convert(F, P, 1, 0, NA1, rk, nw); }
                        else { const int rk = (F.bid - (256 - NMODWG)) * NWAVES + F.wave, nw = NMODWG * NWAVES; ph_convert(F, P, 1, NA1, NCV, rk, nw); } }
      else { ph_convert(F, P, 0, 0, NCV, F.gw, F.NGW); ph_convert(F, P, 1, 0, NCV, F.gw, F.NGW); } }
    T_OFF(112); T_ON(113);
    { FRAME(); ph_fold(F, P, 0, 0, 128); ph_fold(F, P, 1, 128, 128); }
    T_OFF(113); T_ON(114);
    { FRAME(); ph_fft_consts(F); ph_rope_table(F, P); }
    T_OFF(114);
    GRID_BAR(); T_OFF(11); T_ON(12);
    T_ON(121);
    { FRAME(); ph_first(F, P); }
    T_OFF(121); T_ON(122);
    { FRAME(); ph_bias(F, P, 0); ph_bias(F, P, 1); }
    T_OFF(122);
    GRID_BAR(); T_OFF(1); T_OFF(12);
#pragma unroll 1
    for (int l = 0; l < DEPTH; ++l) {
#pragma unroll 1
        for (int half = 0; half < 2; ++half) {
            const int sub = half * 2, f = half;
            if (half == 1) {
                T_ON(2); T_ON(23);
                { FRAME(); EpiUProj E{F.ws, l, (LAS float*)(F.lds + RSTD_TAB_OFF), 0};
                  run_gemm_normed(F, (const bf16*)(F.ws + WS_HB), (const bf16*)(F.ws + WS_WIN) + (size_t)l * DU * D, T, DU, D, E, (const float*)(F.ws + WS_SWIN) + (size_t)l * NR * DU); }
                { FRAME(); ph_gates(F, l); }
                GRID_BAR(); T_OFF(2); T_OFF(23); T_ON(3); T_ON(31);
                T_ON(311);
                { FRAME(); ph_mlstm_m1(F, P.in[13] + (size_t)l * 3 * 512, P.in[14] + l * 8, P.in[15] + l * 8); }
                T_OFF(311); T_ON(312);
                { FRAME(); ph_attn(F, P.in[12] + l * 8, l + 1 < DEPTH); }
                T_OFF(312); T_ON(313); T_ON(316);
                { FRAME(); ph_fft(F); }
                T_OFF(313); T_OFF(316);
                if (PROBE_ID == 315) { T_ON(315); { FRAME(); ph_fft(F); } T_OFF(315); }
                T_ON(314);
                { FRAME(); if (l + 1 < DEPTH) ph_ctx_dft(F); }
                T_OFF(314);
                GRID_BAR(); T_OFF(31); T_ON(32);
                { FRAME(); ph_mlstm_m2(F); }
                GRID_BAR(); T_OFF(32); T_ON(33);
                { FRAME(); ph_mlstm_m3(F, P.in[13] + (size_t)l * 3 * 512, P.in[14] + l * 8, P.in[15] + l * 8, l + 1 < DEPTH); }
                GRID_BAR(); T_OFF(3); T_OFF(33); T_ON(2); T_ON(24);
                { FRAME(); const bool ctx_piece = l + 1 < DEPTH, piece_first = (F.bid & 1) == 0;
                  if (ctx_piece && piece_first) ph_ctx_resid_gemm(F, (const bf16*)F.out, (const bf16*)(F.ws + WS_WOUT) + (size_t)l * D * D, D, nullptr, P.in[6] + ((size_t)l * 3 + 2) * D, l * NR * MODW + 5 * D, l * NR * MODW + 7 * D, 1.0f);
                  { EpiResid E{F.ws, nullptr, P.in[6] + ((size_t)l * 3 + 2) * D, l * NR * MODW + 5 * D, l * NR * MODW + 7 * D, 1.0f};
                    run_gemm(F, (const bf16*)F.out, (const bf16*)(F.ws + WS_WOUT) + (size_t)l * D * D, TL, D, D, E); }
                  if (ctx_piece && !piece_first) ph_ctx_resid_gemm(F, (const bf16*)F.out, (const bf16*)(F.ws + WS_WOUT) + (size_t)l * D * D, D, nullptr, P.in[6] + ((size_t)l * 3 + 2) * D, l * NR * MODW + 5 * D, l * NR * MODW + 7 * D, 1.0f); }
                GRID_BAR(); T_OFF(2); T_OFF(24);
            }
            T_ON(2); T_ON(21);
            { FRAME(); EpiSwiglu E{F.ws, l * 2 + f, (LAS float*)(F.lds + RSTD_TAB_OFF), 0};
              run_gemm_normed(F, (const bf16*)(F.ws + WS_HB), (const bf16*)(F.ws + WS_WI) + (size_t)(l * 2 + f) * 2 * DFF * D, T, 2 * DFF, D, E, (const float*)(F.ws + WS_SWFI) + (size_t)(l * 2 + f) * NR * 2 * DFF); }
            GRID_BAR(); T_OFF(21); T_ON(22);
            { FRAME();
              const bool has_next = (half == 0) || (l + 1 < DEPTH);
              const float* ngp = half == 0 ? P.in[6] + ((size_t)l * 3 + 1) * D : P.in[6] + ((size_t)(l + 1) * 3 + 0) * D;
              const int nsc = half == 0 ? l * NR * MODW + 4 * D : (l + 1) * NR * MODW + 1 * D;
              const bool first = (l == 0 && half == 0);
              const bool ctx_piece = (half == 0 || l + 1 < DEPTH); const bool piece_first = (F.bid & 1) == 0;
              if (ctx_piece && piece_first) ph_ctx_resid_gemm(F, (const bf16*)(F.ws + WS_R), (const bf16*)(F.ws + WS_WO) + (size_t)(l * 2 + f) * D * DFF, DFF, first ? P.in[2] : nullptr, has_next ? ngp : nullptr, l * NR * MODW + (3 * sub + 2) * D, nsc, 0.5f);
              { EpiResid E{F.ws, first ? P.in[0] : nullptr, has_next ? ngp : nullptr, l * NR * MODW + (3 * sub + 2) * D, nsc, 0.5f};
                run_gemm(F, (const bf16*)(F.ws + WS_R), (const bf16*)(F.ws + WS_WO) + (size_t)(l * 2 + f) * D * DFF, TL, D, DFF, E); }
              if (ctx_piece && !piece_first) ph_ctx_resid_gemm(F, (const bf16*)(F.ws + WS_R), (const bf16*)(F.ws + WS_WO) + (size_t)(l * 2 + f) * D * DFF, DFF, first ? P.in[2] : nullptr, has_next ? ngp : nullptr, l * NR * MODW + (3 * sub + 2) * D, nsc, 0.5f); }
            GRID_BAR(); T_OFF(2); T_OFF(22);
        }
    }
    if (PROBE_ID == 77) { GRID_BAR(); GRID_BAR(); GRID_BAR(); GRID_BAR(); GRID_BAR(); GRID_BAR(); GRID_BAR(); GRID_BAR(); }
    T_ON(4);
    { FRAME(); ph_final(F, P); }
    if (PROBE_ID == 4 || PROBE_ID == 9) { GRID_BAR(); T_OFF(4); T_OFF(9); GRID_BAR(); }
}
}

extern "C" void kernel_launch(void* const* d_in, const int* in_sizes, int n_in, void* d_out, int out_size, void* d_ws, size_t ws_size, hipStream_t stream) {
    static int grid = 0;
    if (grid == 0) {
        if (n_in != 17 || ws_size < WS_END) { fprintf(stderr, "kernel_launch: need 17 inputs and %zu bytes of workspace; got %d inputs, %zu bytes\n", (size_t)WS_END, n_in, ws_size); grid = -1; return; }
        int dev = 0, cus = 0, per_cu = 0;
        if (hipGetDevice(&dev) != hipSuccess || hipDeviceGetAttribute(&cus, hipDeviceAttributeMultiprocessorCount, dev) != hipSuccess) { grid = -1; return; }
        if (hipFuncSetAttribute((const void*)mega_fwd, hipFuncAttributeMaxDynamicSharedMemorySize, LDS_BYTES) != hipSuccess) { fprintf(stderr, "kernel_launch: hipFuncSetAttribute failed\n"); grid = -1; return; }
        if (hipOccupancyMaxActiveBlocksPerMultiprocessor(&per_cu, (const void*)mega_fwd, NTHREADS, LDS_BYTES) != hipSuccess || per_cu < 1) { fprintf(stderr, "kernel_launch: occupancy query says %d workgroups per CU\n", per_cu); (void)hipGetLastError(); grid = -1; return; }
        if (cus != 256) { fprintf(stderr, "kernel_launch: this kernel is laid out for a 256-CU device (got %d); nothing launched\n", cus); grid = -1; return; }
        grid = cus;
    }
    if (grid < 0) return;
    (void)hipMemsetAsync((char*)d_ws + WS_CTL, 0, CTL_ZERO_BYTES, stream);
    Params P{};
    for (int i = 0; i < 17; ++i) P.in[i] = (const float*)d_in[i];
    P.out = (float*)d_out; P.ws = (unsigned char*)d_ws;
    hipLaunchKernelGGL(mega_fwd, dim3(grid), dim3(NTHREADS), LDS_BYTES, stream, P);
}
```

```cpp
#include <hip/hip_runtime.h>
#include <cstdio>
#include <cstdint>
#ifndef PROBE_ID
#define PROBE_ID 0
#endif
#ifndef PROBE_WG
#define PROBE_WG 0
#endif
namespace pg8 {
#define PG8_LAS __attribute__((address_space(3)))
typedef unsigned short bf16_t;
typedef short bf16x8 __attribute__((ext_vector_type(8)));
typedef float f32x4 __attribute__((ext_vector_type(4)));
typedef unsigned u32x4 __attribute__((ext_vector_type(4)));
typedef _Float16 half8 __attribute__((ext_vector_type(8)));
constexpr int BM = 256, BK = 64, HALF = 128, HTB = HALF * BK * 2  , STAGE_BYTES = 8 * HTB, NXCD = 8, WGM = 8;

__host__ __device__ __forceinline__ int lds_byte(int r, int c) { const int st = (r >> 4) * 2 + (c >> 5), rr = r & 15, cc = c & 31, ob = rr * 64 + cc * 2; return st * 1024 + (ob ^ (((ob >> 9) & 1) << 5)); }
__host__ __device__ __forceinline__ void stage_rc(int b, int& R, int& C) { const int st = b / 1024, sb = b % 1024, swz = sb ^ (((sb >> 9) & 1) << 5); R = (st >> 1) * 16 + swz / 64; C = (st & 1) * 32 + (swz % 64) / 2; }
__host__ __device__ __forceinline__ int perm32(int rho) { const int n = rho >> 4, i = rho & 15; return 8 * (i >> 2) + 4 * n + (i & 3); }

struct Unit { int pm, pn; };
struct Gemm { const bf16_t* A; const bf16_t* Bt; int M, N, K; };

struct StaticOrder {
    int nM, nN, nwg, G, c;
    __host__ __device__ void init(int M, int N, int G_, int c_) { nM = M / BM; nN = N / BM; nwg = nM * nN; G = G_; c = c_; }
    __host__ __device__ bool next(int i, Unit& u) const {
        const long L = (long)i * G + c; if (L >= nwg) return false;
        int wgid = (int)L; { const int q = nwg / NXCD, r = nwg % NXCD, xcd = wgid % NXCD, off = wgid / NXCD; wgid = (xcd < r ? xcd * (q + 1) : r * (q + 1) + (xcd - r) * q) + off; }
        const int nig = WGM * nN, gid = wgid / nig, fm = gid * WGM, gsz = (nM - fm) < WGM ? (nM - fm) : WGM;
        u.pm = fm + ((wgid % nig) % gsz); u.pn = (wgid % nig) / gsz; return true;
    }
    __device__ __forceinline__ void a_ready(const Unit&) const {}
    __device__ __forceinline__ void done(const Unit&) const {}
};
template <class Epi, class Sched, bool ALIGN_EPI = false, bool SP2 = false>
__device__ __forceinline__ void gemm_phase(PG8_LAS unsigned char* lds, const Gemm g, const Sched& S, const Epi& E, const int tid  ) {
    const int wid = __builtin_amdgcn_readfirstlane(tid >> 6), lane = tid & 63, wr = wid >> 2, wc = wid & 3, fr = lane & 15, fq = lane >> 4;
    const int K = g.K, nt = K / BK;
    unsigned voffA[2], voffB[2];
#pragma unroll
    for (int i = 0; i < 2; ++i) { int R, C; stage_rc(tid * 16 + i * 8192, R, C); const int Rb = Epi::PERM ? ((R & ~31) + perm32(R & 31)) : R;
        voffA[i] = (unsigned)(R * K + C) * 2u; voffB[i] = (unsigned)(Rb * K + C) * 2u; }
    const size_t kstep = (size_t)(BK * 2);
    const size_t hstep = (size_t)HALF * K * 2;
    const size_t tstep = 2 * hstep;
    const unsigned ldsw = (unsigned)wid * 1024u;
    const int aoff = lds_byte(wr * 64 + fr, fq * 8), boff = lds_byte(wc * 32 + fr, fq * 8);
#define PG8_SA(b, h) (((b) * 2 + (h)) * HTB)
#define PG8_SB(b, h) ((4 + (b) * 2 + (h)) * HTB)
#define PG8_STAGE(bufoff, gbase, voff) do { _Pragma("unroll") for (int _i = 0; _i < 2; ++_i) \
        __builtin_amdgcn_global_load_lds((const unsigned*)((const char*)(gbase) + (voff)[_i]), (PG8_LAS unsigned*)(lds + (bufoff) + ldsw + _i * 8192), 16, 0, 0); } while (0)
#define PG8_LDA(dst, b, h) do { _Pragma("unroll") for (int m = 0; m < 4; ++m) _Pragma("unroll") for (int k = 0; k < 2; ++k) dst[m][k] = *(const PG8_LAS bf16x8*)(lds + PG8_SA(b, h) + aoff + m * 2048 + k * 1024); } while (0)
#define PG8_LDB(dst, b, h) do { _Pragma("unroll") for (int n = 0; n < 2; ++n) _Pragma("unroll") for (int k = 0; k < 2; ++k) dst[n][k] = *(const PG8_LAS bf16x8*)(lds + PG8_SB(b, h) + boff + n * 2048 + k * 1024); } while (0)
#define PG8_MMA(ai, bj, At, Bt) do { __builtin_amdgcn_s_setprio(1); _Pragma("unroll") for (int m = 0; m < 4; ++m) _Pragma("unroll") for (int n = 0; n < 2; ++n) _Pragma("unroll") for (int k = 0; k < 2; ++k) \
        acc[ai][bj][m][n] = __builtin_amdgcn_mfma_f32_16x16x32_f16(__builtin_bit_cast(half8, Bt[n][k]), __builtin_bit_cast(half8, At[m][k]), acc[ai][bj][m][n], 0, 0, 0); __builtin_amdgcn_s_setprio(0); } while (0)
#define PG8_WAIT_V(n) asm volatile("s_waitcnt vmcnt(" #n ")" ::: "memory")
#define PG8_WAIT_L(n) asm volatile("s_waitcnt lgkmcnt(" #n ")" ::: "memory")
#define PG8_BAR __builtin_amdgcn_s_barrier()
#define PG8_SCHED __builtin_amdgcn_sched_barrier(0)
    Unit cur, nxt; int ui = 0;
    if (!S.next(0, cur)) return;
    f32x4 acc[2][2][4][2];
#pragma unroll
    for (int a = 0; a < 2; ++a)
#pragma unroll
        for (int b = 0; b < 2; ++b)
#pragma unroll
            for (int m = 0; m < 4; ++m)
#pragma unroll
                for (int n = 0; n < 2; ++n) acc[a][b][m][n] = (f32x4){0.f, 0.f, 0.f, 0.f};
    bf16x8 At[4][2], B0[2][2], B1[2][2];
    const char* cA = (const char*)g.A + (size_t)cur.pm * tstep; const char* cB = (const char*)g.Bt + (size_t)cur.pn * tstep;
    S.a_ready(cur);
    if constexpr (SP2) {
        PG8_STAGE(PG8_SB(0, 0), cB, voffB); PG8_STAGE(PG8_SB(0, 1), cB + hstep, voffB); PG8_STAGE(PG8_SA(0, 0), cA, voffA); PG8_STAGE(PG8_SA(0, 1), cA + hstep, voffA);
        if (wr == 1) PG8_BAR;
        PG8_WAIT_V(2); PG8_BAR;
        PG8_STAGE(PG8_SB(1, 0), cB + kstep, voffB); PG8_STAGE(PG8_SA(1, 0), cA + kstep, voffA); PG8_STAGE(PG8_SB(1, 1), cB + hstep + kstep, voffB);
        PG8_WAIT_V(6); PG8_BAR;
    } else {
        PG8_STAGE(PG8_SB(0, 0), cB, voffB); PG8_STAGE(PG8_SA(0, 0), cA, voffA); PG8_STAGE(PG8_SB(0, 1), cB + hstep, voffB); PG8_STAGE(PG8_SA(0, 1), cA + hstep, voffA);
        if (wr == 1) PG8_BAR;
        PG8_WAIT_V(4); PG8_BAR;
        PG8_STAGE(PG8_SB(1, 0), cB + kstep, voffB); PG8_STAGE(PG8_SA(1, 0), cA + kstep, voffA); PG8_STAGE(PG8_SB(1, 1), cB + hstep + kstep, voffB);
        PG8_WAIT_V(6); PG8_BAR;
    }
    for (;;) {
        const bool has_next = S.next(ui + 1, nxt);
        const char* nA = has_next ? (const char*)g.A + (size_t)nxt.pm * tstep : cA; const char* nB = has_next ? (const char*)g.Bt + (size_t)nxt.pn * tstep : cB;
        for (int t = 0; t < nt; t += 2) {
            const bool last = (t == nt - 2);
            const char* a1 = cA + (size_t)(t + 1) * kstep;
            const char* a2 = last ? nA : cA + (size_t)(t + 2) * kstep; const char* b2 = last ? nB : cB + (size_t)(t + 2) * kstep;
            const char* a3 = a2 + kstep; const char* b3 = b2 + kstep;
            if (last && has_next) S.a_ready(nxt);
            if constexpr (SP2) {
            PG8_LDB(B0, 0, 0); PG8_LDB(B1, 0, 1); PG8_SCHED; PG8_LDA(At, 0, 0); PG8_STAGE(PG8_SA(1, 1), a1 + hstep, voffA);
            PG8_WAIT_V(8); PG8_WAIT_L(0); PG8_BAR; PG8_MMA(0, 0, At, B0); PG8_MMA(0, 1, At, B1); PG8_BAR; PG8_SCHED;
            PG8_LDA(At, 0, 1); PG8_STAGE(PG8_SB(0, 0), b2, voffB); PG8_STAGE(PG8_SB(0, 1), b2 + hstep, voffB); PG8_STAGE(PG8_SA(0, 0), a2, voffA);
            PG8_WAIT_V(8); PG8_WAIT_L(0); PG8_BAR; PG8_MMA(1, 0, At, B0); PG8_MMA(1, 1, At, B1); PG8_BAR; PG8_SCHED;
            PG8_LDB(B0, 1, 0); PG8_LDB(B1, 1, 1); PG8_SCHED; PG8_LDA(At, 1, 0); PG8_STAGE(PG8_SA(0, 1), a2 + hstep, voffA);
            PG8_WAIT_V(8); PG8_WAIT_L(0); PG8_BAR; PG8_MMA(0, 0, At, B0); PG8_MMA(0, 1, At, B1); PG8_BAR; PG8_SCHED;
            PG8_LDA(At, 1, 1); PG8_STAGE(PG8_SB(1, 0), b3, voffB); PG8_STAGE(PG8_SB(1, 1), b3 + hstep, voffB); PG8_STAGE(PG8_SA(1, 0), a3, voffA);
            PG8_WAIT_V(8); PG8_WAIT_L(0); PG8_BAR; PG8_MMA(1, 0, At, B0); PG8_MMA(1, 1, At, B1); PG8_BAR; PG8_SCHED;
            } else {
            PG8_LDB(B0, 0, 0); PG8_SCHED; PG8_LDA(At, 0, 0); PG8_STAGE(PG8_SA(1, 1), a1 + hstep, voffA);
            PG8_WAIT_L(8); PG8_BAR; PG8_WAIT_L(0); PG8_MMA(0, 0, At, B0); PG8_BAR; PG8_SCHED;
            PG8_LDB(B1, 0, 1); PG8_STAGE(PG8_SB(0, 0), b2, voffB);
            PG8_BAR; PG8_WAIT_L(0); PG8_MMA(0, 1, At, B1); PG8_BAR;
            PG8_LDA(At, 0, 1); PG8_STAGE(PG8_SA(0, 0), a2, voffA);
            PG8_BAR; PG8_WAIT_L(0); PG8_MMA(1, 0, At, B0); PG8_BAR; PG8_SCHED;
            PG8_STAGE(PG8_SB(0, 1), b2 + hstep, voffB);
            PG8_WAIT_V(6); PG8_BAR; PG8_MMA(1, 1, At, B1); PG8_BAR;
            PG8_LDB(B0, 1, 0); PG8_SCHED; PG8_LDA(At, 1, 0); PG8_STAGE(PG8_SA(0, 1), a2 + hstep, voffA);
            PG8_WAIT_L(8); PG8_BAR; PG8_WAIT_L(0); PG8_MMA(0, 0, At, B0); PG8_BAR; PG8_SCHED;
            PG8_LDB(B1, 1, 1); PG8_STAGE(PG8_SB(1, 0), b3, voffB);
            PG8_BAR; PG8_WAIT_L(0); PG8_MMA(0, 1, At, B1); PG8_BAR;
            PG8_LDA(At, 1, 1); PG8_STAGE(PG8_SA(1, 0), a3, voffA);
            PG8_BAR; PG8_WAIT_L(0); PG8_MMA(1, 0, At, B0); PG8_BAR; PG8_SCHED;
            PG8_STAGE(PG8_SB(1, 1), b3 + hstep, voffB);
            PG8_WAIT_V(6); PG8_BAR; PG8_MMA(1, 1, At, B1); PG8_BAR;
            }
        }
        if constexpr (ALIGN_EPI) { if (wr == 0) PG8_BAR; }
        if constexpr (!Epi::AFTER_DRAIN) { E(acc, cur, wr, wc, fr, fq); S.done(cur); }
        if (!has_next) break;
#pragma unroll
        for (int a = 0; a < 2; ++a)
#pragma unroll
            for (int b = 0; b < 2; ++b)
#pragma unroll
                for (int m = 0; m < 4; ++m)
#pragma unroll
                    for (int n = 0; n < 2; ++n) acc[a][b][m][n] = (f32x4){0.f, 0.f, 0.f, 0.f};
        cur = nxt; cA = nA; cB = nB; ++ui;
        if constexpr (ALIGN_EPI) { if (wr == 1) PG8_BAR; }
    }
    PG8_WAIT_V(0);
    if constexpr (!ALIGN_EPI) { if (wr == 0) PG8_BAR; }
    PG8_BAR;
    if constexpr (Epi::AFTER_DRAIN) { E.fused(acc, cur, wr, wc, fr, fq, lds, wid, lane); S.done(cur); }
#undef PG8_SA
#undef PG8_SB
#undef PG8_STAGE
#undef PG8_LDA
#undef PG8_LDB
#undef PG8_MMA
#undef PG8_WAIT_V
#undef PG8_WAIT_L
#undef PG8_BAR
#undef PG8_SCHED
}
}

namespace {
#define LAS __attribute__((address_space(3)))
#define GAS __attribute__((address_space(1)))
typedef unsigned short bf16;
typedef unsigned v4u __attribute__((ext_vector_type(4)));
typedef GAS unsigned gu32;
constexpr int D = 1024, NB = 4, SEQ = 4096, CTX = 256, DEPTH = 2;
constexpr int TL = NB * SEQ, TC = NB * CTX, T = TL + TC;
constexpr int DFF = 2816, DIN = 2064, DU = 2304, NMOD = 9, MODW = NMOD * D;
constexpr int NR = NB + 1;
constexpr float EPS = 1e-6f;
constexpr int C_GA = 0, C_GB = 256, C_Q = 512, C_K = 1024, C_V = 1152, C_MQ = 1280, C_MK = 1536, C_MV = 1792, C_MO = 2048;
constexpr int SRC_COL0 = 256, SRC_GATE = 2048;
constexpr int NWAVES = 8, NTHREADS = 512;
constexpr int RING_BYTES = 131072, MISC_OFF = RING_BYTES, LDS_BYTES = 147456;
constexpr size_t al256(size_t x) { return (x + 255) & ~(size_t)255; }
constexpr size_t WS_CTL = 0, CTL_ZERO_BYTES = 65536;
constexpr int CW_BAR = 1024;
constexpr size_t WS_MOD = 1u << 20;
constexpr size_t WS_WI = al256(WS_MOD + (size_t)DEPTH * NR * MODW * 4);
constexpr size_t WS_WO = al256(WS_WI + (size_t)4 * 2 * DFF * D * 2);
constexpr size_t WS_WIN = al256(WS_WO + (size_t)4 * D * DFF * 2);
constexpr size_t WS_WOUT = al256(WS_WIN + (size_t)2 * DU * D * 2);
constexpr size_t WS_XC = al256(WS_WOUT + (size_t)2 * D * D * 2);
constexpr size_t WS_G = al256(WS_XC + (size_t)TC * D * 4);
constexpr size_t WS_HB = al256(WS_G + (size_t)T * 16 * 4);
constexpr size_t WS_X16 = al256(WS_HB + (size_t)T * D * 2);
constexpr size_t WS_Y_UNUSED = WS_X16;
constexpr size_t WS_R = al256(WS_X16 + (size_t)T * D * 2);
constexpr size_t WS_HS = al256(WS_R + (size_t)T * DFF * 2);
constexpr size_t WS_NL = al256(WS_HS + (size_t)2 * T * 256 * 4);
constexpr size_t WS_AM = al256(WS_NL + (size_t)32 * 68 * 64 * 4);
constexpr size_t WS_MS = al256(WS_AM + (size_t)32 * 68 * 2 * 4);
constexpr size_t WS_FM1 = al256(WS_MS + (size_t)32 * 68 * 4);
constexpr size_t WS_FM3 = al256(WS_FM1 + 128 * 128 * 2);
constexpr size_t WS_TW = al256(WS_FM3 + 64 * 128 * 2);
constexpr size_t WS_CT = al256(WS_TW + 4096 * 8);
constexpr size_t WS_RS = al256(WS_CT + 256 * 8);
constexpr size_t WS_SWFI = al256(WS_RS + (size_t)T * 16 * 4);
constexpr size_t WS_SWIN = al256(WS_SWFI + (size_t)4 * NR * 2 * DFF * 4);
constexpr size_t WS_SWG = al256(WS_SWIN + (size_t)2 * NR * DU * 4);
constexpr size_t WS_ROPE = al256(WS_SWG + (size_t)2 * NR * 16 * 4);
constexpr size_t WS_WGT = al256(WS_ROPE + 64 * 16 * 8);
constexpr size_t WS_DMC = al256(WS_WGT + (size_t)DEPTH * 32 * D * 2);
constexpr size_t WS_PROBE = al256(WS_DMC + 256 * 512 * 2);
constexpr size_t WS_END = al256(WS_PROBE + 256);

struct Ptrs { float* xl; float* xc; };
__device__ __forceinline__ int mod_row(int r) { return r < TL ? r / SEQ : NB; }
__device__ __forceinline__ float* xrow(const Ptrs& p, int r) { return r < TL ? p.xl + (size_t)r * D : p.xc + (size_t)(r - TL) * D; }
__device__ __forceinline__ float silu_f(float x) { return x / (1.f + expf(-x)); }
__device__ __forceinline__ float sigmoid_f(float x) { return 1.f / (1.f + expf(-x)); }
__device__ __forceinline__ float logsigmoid_f(float x) { return fminf(x, 0.f) - log1pf(expf(-fabsf(x))); }
__device__ __forceinline__ float bf2f(bf16 b) { return (float)__builtin_bit_cast(_Float16, b); }
__device__ __forceinline__ unsigned f2bf(float f) { return (unsigned)__builtin_bit_cast(unsigned short, (_Float16)f); }
__device__ __forceinline__ unsigned pk2(float lo, float hi) { return f2bf(lo) | (f2bf(hi) << 16); }
__device__ __forceinline__ float lane_xor(float v, int lane, int o) { return __int_as_float(__builtin_amdgcn_ds_bpermute((lane ^ o) << 2, __float_as_int(v))); }
__device__ __forceinline__ float lane_get(float v, int src) { return __int_as_float(__builtin_amdgcn_ds_bpermute(src << 2, __float_as_int(v))); }
__device__ __forceinline__ float wave_sum(float v, int lane) {
#pragma unroll
    for (int o = 1; o < 64; o <<= 1) v += lane_xor(v, lane, o);
    return v; }
#define RLX_AGENT __ATOMIC_RELAXED, __HIP_MEMORY_SCOPE_AGENT
struct Params { const float* in[17]; float* out; unsigned char* ws; };
typedef _Float16 half8 __attribute__((ext_vector_type(8)));
typedef _Float16 half4 __attribute__((ext_vector_type(4)));
typedef float f32x16 __attribute__((ext_vector_type(16)));
typedef float f32x4v __attribute__((ext_vector_type(4)));

using pg8::half8; using pg8::f32x4; using pg8::u32x4; using pg8::Unit; using pg8::bf16_t; using pg8::BM; using pg8::HALF;
__device__ __forceinline__ unsigned cvt_pk_bf16(float lo, float hi) { typedef float f2_t __attribute__((ext_vector_type(2))); typedef _Float16 h2_t __attribute__((ext_vector_type(2))); const f2_t v = {lo, hi}; return __builtin_bit_cast(unsigned, __builtin_convertvector(v, h2_t)); }
__device__ __forceinline__ float silu_fast(float x) { return x * __builtin_amdgcn_rcpf(1.f + __expf(-x)); }
__device__ __forceinline__ float rstd_row(const float* rowss, int row) {
    const f32x4 a = *(const f32x4*)(rowss + (size_t)row * 16), b = *(const f32x4*)(rowss + (size_t)row * 16 + 4), c = *(const f32x4*)(rowss + (size_t)row * 16 + 8), d = *(const f32x4*)(rowss + (size_t)row * 16 + 12);
    const f32x4 s = (a + b) + (c + d); return __builtin_amdgcn_rsqf(((s[0] + s[1]) + (s[2] + s[3])) * (1.f / 1024.f) + 1e-6f); }
typedef unsigned u32x2e __attribute__((ext_vector_type(2)));
constexpr int RSTD_TAB_OFF = MISC_OFF + 1024;
constexpr int BIAS_TAB_OFF = RSTD_TAB_OFF + 2048;
struct RstdOrder : pg8::StaticOrder {
    const float* rowss; LAS float* tab; int tid; mutable int cnt; const float* sw; int ncols;
    __device__ __forceinline__ void a_ready(const Unit& u) const { const int par = cnt & 1; ++cnt;
        if (tid < 256) tab[par * 256 + tid] = rstd_row(rowss, u.pm * BM + tid);
        else if (tid < 320) { const int mr = u.pm < TL / 256 ? u.pm / (SEQ / 256) : 4; *(LAS f32x4*)(tab + 512 + par * 256 + (tid - 256) * 4) = *(const f32x4*)(sw + (size_t)mr * ncols + u.pn * BM + (tid - 256) * 4); } }
};

struct EpiSwiglu {
    static constexpr bool PERM = true, AFTER_DRAIN = false;
    unsigned char* ws; int mat; LAS float* tab; mutable int cnt;
    __device__ __forceinline__ void operator()(const f32x4 (&acc)[2][2][4][2], const Unit& u, int wr, int wc, int fr, int fq) const {
        bf16_t* O = (bf16_t*)(ws + WS_R); constexpr int ldc = DFF;
        const LAS float* rt = tab + (cnt & 1) * 256 + wr * 64 + fr;
        const int row0 = u.pm * BM + wr * 64 + fr, col0 = u.pn * HALF + wc * 32 + 8 * fq;
        const LAS float* bs = tab + 512 + (cnt & 1) * 256 + wc * 32 + 8 * fq;
        const f32x4 bg0 = *(const LAS f32x4*)bs, bg1 = *(const LAS f32x4*)(bs + 4), bu0 = *(const LAS f32x4*)(bs + HALF), bu1 = *(const LAS f32x4*)(bs + HALF + 4); ++cnt;
#pragma unroll
        for (int ai = 0; ai < 2; ++ai)
#pragma unroll
            for (int m = 0; m < 4; ++m) { const int row = row0 + ai * HALF + m * 16; const float rs = rt[ai * HALF + m * 16]; bf16_t* rowp = O + (size_t)row * ldc + col0;
                const f32x4 g0 = acc[ai][0][m][0] * rs + bg0, g1 = acc[ai][0][m][1] * rs + bg1, u0 = acc[ai][1][m][0] * rs + bu0, u1 = acc[ai][1][m][1] * rs + bu1;
                f32x4 h0, h1;
#pragma unroll
                for (int i = 0; i < 4; ++i) { h0[i] = silu_fast(g0[i]) * u0[i]; h1[i] = silu_fast(g1[i]) * u1[i]; }
                u32x4 w; w.x = cvt_pk_bf16(h0[0], h0[1]); w.y = cvt_pk_bf16(h0[2], h0[3]); w.z = cvt_pk_bf16(h1[0], h1[1]); w.w = cvt_pk_bf16(h1[2], h1[3]);
                *(u32x4*)rowp = w; }
    }
};
struct EpiUProj {
    static constexpr bool PERM = true, AFTER_DRAIN = false;
    unsigned char* ws; int l; LAS float* tab; mutable int cnt;
    __device__ __forceinline__ void operator()(const f32x4 (&acc)[2][2][4][2], const Unit& u, int wr, int wc, int fr, int fq) const {
        bf16_t* O = (bf16_t*)(ws + WS_R); constexpr int ldc = DU, tl_panels = TL / 256; constexpr float qscale = 0.125f * 1.4426950408889634f;
        const float* rope = (const float*)(ws + WS_ROPE);
        const LAS float* rt = tab + (cnt & 1) * 256 + wr * 64 + fr; const LAS float* bs = tab + 512 + (cnt & 1) * 256 + wc * 32 + 8 * fq; ++cnt;
        const int row0 = u.pm * BM + wr * 64 + fr, col0 = u.pn * BM + wc * 32 + 8 * fq; const bool lat = u.pm < tl_panels;
        f32x4 bv[2][2];
#pragma unroll
        for (int bj = 0; bj < 2; ++bj)
#pragma unroll
            for (int n = 0; n < 2; ++n) bv[bj][n] = *(const LAS f32x4*)(bs + bj * HALF + n * 4);
        const bool isq = (u.pn == 2 || u.pn == 3); const bool isk = (u.pn == 4); const bool upper = fq >= 2;
#pragma unroll
        for (int ai = 0; ai < 2; ++ai)
#pragma unroll
            for (int m = 0; m < 4; ++m) { const int row = row0 + ai * HALF + m * 16; const float rs = rt[ai * HALF + m * 16]; bf16_t* rowp = O + (size_t)row * ldc + col0;
                f32x4 v[2][2];
#pragma unroll
                for (int bj = 0; bj < 2; ++bj)
#pragma unroll
                    for (int n = 0; n < 2; ++n) v[bj][n] = acc[ai][bj][m][n] * rs + bv[bj][n];
                if (isq || isk) {
                    if (lat) { const int pos = row & 4095; const int p = (wc & 1) ? (pos & 63) : (pos >> 6); const float* rp = rope + (size_t)(p * 16 + 8 * (fq & 1)) * 2;
                        const f32x4 cs0 = *(const f32x4*)rp, cs1 = *(const f32x4*)(rp + 4), cs2 = *(const f32x4*)(rp + 8), cs3 = *(const f32x4*)(rp + 12);
                        const f32x4 cc[2] = {{cs0[0], cs0[2], cs1[0], cs1[2]}, {cs2[0], cs2[2], cs3[0], cs3[2]}}, ss[2] = {{cs0[1], cs0[3], cs1[1], cs1[3]}, {cs2[1], cs2[3], cs3[1], cs3[3]}};
#pragma unroll
                        for (int bj = 0; bj < 2; ++bj) if (isq || bj == 0) {
#pragma unroll
                            for (int n = 0; n < 2; ++n) { f32x4 pv;
#pragma unroll
                                for (int i = 0; i < 4; ++i) { const unsigned xv = __float_as_uint(v[bj][n][i]); const auto sw = __builtin_amdgcn_permlane32_swap(xv, xv, false, false); pv[i] = __uint_as_float(upper ? sw[0] : sw[1]); }
                                v[bj][n] = upper ? (v[bj][n] * cc[n] + pv * ss[n]) : (v[bj][n] * cc[n] - pv * ss[n]); } } }
                    if (isq) {
#pragma unroll
                        for (int bj = 0; bj < 2; ++bj) { v[bj][0] = v[bj][0] * qscale; v[bj][1] = v[bj][1] * qscale; } } }
#pragma unroll
                for (int bj = 0; bj < 2; ++bj) { u32x4 w; w.x = cvt_pk_bf16(v[bj][0][0], v[bj][0][1]); w.y = cvt_pk_bf16(v[bj][0][2], v[bj][0][3]); w.z = cvt_pk_bf16(v[bj][1][0], v[bj][1][1]); w.w = cvt_pk_bf16(v[bj][1][2], v[bj][1][3]);
                    *(u32x4*)(rowp + bj * HALF) = w; } }
    }
};
struct EpiResid {
    static constexpr bool PERM = true, AFTER_DRAIN = false;
    unsigned char* ws; const float* xsrc32; const float* ng; int gate_off, nscale_off; float coef;
    __device__ __forceinline__ void operator()(const f32x4 (&acc)[2][2][4][2], const Unit& u, int wr, int wc, int fr, int fq) const {
        constexpr int ppb = SEQ / 256, mod_stride = MODW; const float* gate = (const float*)(ws + WS_MOD) + gate_off; const float* nscale = (const float*)(ws + WS_MOD) + nscale_off;
        bf16_t* hraw = (bf16_t*)(ws + WS_HB); float* rowss = (float*)(ws + WS_RS); bf16_t* x16 = (bf16_t*)(ws + WS_X16);
        const int prow = u.pm * BM; const int mr = u.pm / ppb;
        const int row0 = wr * 64 + fr, col0 = u.pn * BM + wc * 32 + 8 * fq;
        float ssq[2][4];
#pragma unroll
        for (int ai = 0; ai < 2; ++ai)
#pragma unroll
            for (int m = 0; m < 4; ++m) ssq[ai][m] = 0.f;
#pragma unroll
        for (int bj = 0; bj < 2; ++bj) { const int c = col0 + bj * HALF;
            const f32x4 gv0 = *(const f32x4*)(gate + (size_t)mr * mod_stride + c) * coef, gv1 = *(const f32x4*)(gate + (size_t)mr * mod_stride + c + 4) * coef;
            f32x4 hs0 = {0.f, 0.f, 0.f, 0.f}, hs1 = hs0;
            if (ng) { hs0 = *(const f32x4*)(ng + c) * (*(const f32x4*)(nscale + (size_t)mr * mod_stride + c) + 1.f); hs1 = *(const f32x4*)(ng + c + 4) * (*(const f32x4*)(nscale + (size_t)mr * mod_stride + c + 4) + 1.f); }
#pragma unroll
            for (int ai = 0; ai < 2; ++ai)
#pragma unroll
                for (int m = 0; m < 4; ++m) { const int rl = row0 + ai * HALF + m * 16; const size_t off = (size_t)(prow + rl) * 1024 + c;
                    f32x4 xo0, xo1;
                    if (xsrc32) { xo0 = *(const f32x4*)(xsrc32 + off); xo1 = *(const f32x4*)(xsrc32 + off + 4); }
                    else { const half8 hx = __builtin_bit_cast(half8, *(const u32x4*)(x16 + off)); xo0 = (f32x4){(float)hx[0], (float)hx[1], (float)hx[2], (float)hx[3]}; xo1 = (f32x4){(float)hx[4], (float)hx[5], (float)hx[6], (float)hx[7]}; }
                    const f32x4 x0 = xo0 + gv0 * acc[ai][bj][m][0], x1 = xo1 + gv1 * acc[ai][bj][m][1];
                    { u32x4 w; w.x = cvt_pk_bf16(x0[0], x0[1]); w.y = cvt_pk_bf16(x0[2], x0[3]); w.z = cvt_pk_bf16(x1[0], x1[1]); w.w = cvt_pk_bf16(x1[2], x1[3]); *(u32x4*)(x16 + off) = w; }
                    ssq[ai][m] += ((x0[0] * x0[0] + x0[1] * x0[1]) + (x0[2] * x0[2] + x0[3] * x0[3])) + ((x1[0] * x1[0] + x1[1] * x1[1]) + (x1[2] * x1[2] + x1[3] * x1[3]));
                    if (ng) { const f32x4 h0 = x0 * hs0, h1 = x1 * hs1; u32x4 w; w.x = cvt_pk_bf16(h0[0], h0[1]); w.y = cvt_pk_bf16(h0[2], h0[3]); w.z = cvt_pk_bf16(h1[0], h1[1]); w.w = cvt_pk_bf16(h1[2], h1[3]); *(u32x4*)(hraw + off) = w; } } }
        const int lane = fq * 16 + fr;
#pragma unroll
        for (int ai = 0; ai < 2; ++ai)
#pragma unroll
            for (int m = 0; m < 4; ++m) { float q = ssq[ai][m];
                q += __int_as_float(__builtin_amdgcn_ds_bpermute((lane ^ 16) << 2, __float_as_int(q)));
                q += __int_as_float(__builtin_amdgcn_ds_bpermute((lane ^ 32) << 2, __float_as_int(q)));
                if (fq == 0) rowss[(size_t)(prow + row0 + ai * HALF + m * 16) * 16 + u.pn * 4 + wc] = q; }
    }
};
#define XB_TMO      128
#define XB_XCNT(j)  (256  + 64 * (j))
#define XB_XSUB(j)  (1280 + 64 * (j))
#define XB_XGEN(j)  (2304 + 64 * (j))
#define XB_TOP      3328
#define XB_TOPGEN   3392
#define XCD_BAR_WORDS 3456
#define XB_SPIN_CAP (1u << 18)

__device__ __forceinline__ unsigned xb_ld(unsigned* p)              { return __hip_atomic_load(p, __ATOMIC_RELAXED, __HIP_MEMORY_SCOPE_AGENT); }
__device__ __forceinline__ unsigned xb_add(unsigned* p, unsigned v) { return __hip_atomic_fetch_add(p, v, __ATOMIC_RELAXED, __HIP_MEMORY_SCOPE_AGENT); }
__device__ __forceinline__ unsigned xb_xcc_id() { return (unsigned)__builtin_amdgcn_s_getreg((3 << 11) | 20) & 0xFu; }
#define XB_SPIN(cond, bar) do { unsigned _sp = 0; while (cond) { __builtin_amdgcn_s_sleep(1); \
    if ((++_sp & 255u) == 0u) { if (xb_ld(&(bar)[XB_TMO])) break; if (_sp > XB_SPIN_CAP) { atomicAdd(&(bar)[XB_TMO], 1u); break; } } } } while (0)

struct XcdBarrier {
    unsigned* bar; unsigned x;
    volatile LAS unsigned* st;
};

__device__ __forceinline__ XcdBarrier xcd_barrier_post(unsigned* bar, volatile LAS unsigned* st) {
    XcdBarrier b; b.bar = bar; b.x = xb_xcc_id(); b.st = st;
    if (threadIdx.x == 0) (void)xb_add(&bar[XB_XCNT(b.x)], 1u);
    return b;
}
__device__ __forceinline__ void xcd_barrier_complete(unsigned* bar, unsigned x, unsigned& nloc, unsigned& nx) {
    const unsigned G = gridDim.x * gridDim.y * gridDim.z;
    unsigned sum, cnt, mine, sp = 0u;
    for (;;) {
        sum = 0u; cnt = 0u; mine = 0u;
#pragma unroll
        for (unsigned j = 0; j < 16; ++j) { const unsigned c = xb_ld(&bar[XB_XCNT(j)]); sum += c; cnt += (c > 0u) ? 1u : 0u; mine = (j == x) ? c : mine; }
        if (sum == G) break;
        __builtin_amdgcn_s_sleep(1);
        if ((++sp & 255u) == 0u) { if (xb_ld(&bar[XB_TMO])) break; if (sp > XB_SPIN_CAP) { atomicAdd(&bar[XB_TMO], 1u); break; } }
    }
    nloc = mine > 0u ? mine : 1u; nx = cnt > 0u ? cnt : 1u;
}

__device__ __forceinline__ void xcd_barrier(const XcdBarrier& b) {
    asm volatile("s_waitcnt vmcnt(0)" ::: "memory");
    __syncthreads();
    if (threadIdx.x == 0) {
        unsigned* bar = b.bar;
        __builtin_amdgcn_s_waitcnt(0);
        unsigned nloc = b.st[0], nx = b.st[1];
        if (nloc == 0u) { xcd_barrier_complete(bar, b.x, nloc, nx); b.st[0] = nloc; b.st[1] = nx; }
        const unsigned old = xb_add(&bar[XB_XSUB(b.x)], 1u);
        const unsigned gen = old / nloc;
        if (old + 1u == (gen + 1u) * nloc) {
            __builtin_amdgcn_fence(__ATOMIC_RELEASE, "agent");
            asm volatile("s_waitcnt vmcnt(0)" ::: "memory");
            const unsigned og = xb_add(&bar[XB_TOP], 1u);
            const unsigned tg = og / nx;
            if (og + 1u == (tg + 1u) * nx) xb_add(&bar[XB_TOPGEN], 1u);
            else XB_SPIN(xb_ld(&bar[XB_TOPGEN]) == tg, bar);
            __builtin_amdgcn_fence(__ATOMIC_ACQUIRE, "agent");
            xb_add(&bar[XB_XGEN(b.x)], 1u);
            asm volatile("s_waitcnt vmcnt(0)" ::: "memory");
        } else {
            XB_SPIN(xb_ld(&bar[XB_XGEN(b.x)]) == gen, bar);
            __builtin_amdgcn_fence(__ATOMIC_ACQUIRE, "agent");
            asm volatile("s_waitcnt vmcnt(0)" ::: "memory");
        }
    }
    __syncthreads();
}

struct Frame {
    LAS unsigned char* lds; unsigned char* ldsg;
    int tid, lane, wave, G, bid, gw, NGW;
    float* out; unsigned char* ws;
};

__device__ __forceinline__ void ph_mod(Frame& F, const Params& P) {
    const float* c = P.in[1]; const float* cctx = P.in[3]; const float* w_ada = P.in[4]; const float* b_ada = P.in[5]; float* MOD = (float*)(F.ws + WS_MOD);
    float* s = (float*)F.ldsg; float* red = s + NR * D;
    constexpr int NMODIT = DEPTH * (MODW / 128); const int mb = F.bid - (F.G - NMODIT);
    if (mb >= 0) { for (int i = F.tid; i < NR * D; i += NTHREADS) { const int r = i / D, k = i % D; const float v = r < NB ? c[r * D + k] : cctx[k]; s[i] = silu_f(v); } }
    for (int it = mb; it >= 0 && it < NMODIT; it += F.G) {
        const int l = it / (MODW / 128), j = (it % (MODW / 128)) * 128 + 2 * F.lane;
        __syncthreads();
        float a0[NR], a1[NR];
#pragma unroll
        for (int r = 0; r < NR; ++r) { a0[r] = 0.f; a1[r] = 0.f; }
        const float* w = w_ada + ((size_t)l * D + 128 * F.wave) * MODW + j;
#pragma unroll 16
        for (int k = 0; k < 128; ++k) { const float2 wv = *(const float2*)(w + (size_t)k * MODW);
#pragma unroll
            for (int r = 0; r < NR; ++r) { const float sv = s[r * D + 128 * F.wave + k]; a0[r] += sv * wv.x; a1[r] += sv * wv.y; } }
#pragma unroll
        for (int r = 0; r < NR; ++r) { red[(F.wave * NR + r) * 128 + 2 * F.lane] = a0[r]; red[(F.wave * NR + r) * 128 + 2 * F.lane + 1] = a1[r]; }
        __syncthreads();
        for (int idx = F.tid; idx < NR * 128; idx += NTHREADS) { const int r = idx >> 7, cc = idx & 127; float a = 0.f;
#pragma unroll
            for (int w8 = 0; w8 < 8; ++w8) a += red[(w8 * NR + r) * 128 + cc];
            const int jj = (it % (MODW / 128)) * 128 + cc; MOD[((size_t)l * NR + r) * MODW + jj] = a + b_ada[l * MODW + jj]; }
    }
    __syncthreads();
}
__device__ __forceinline__ void transpose_item(const float* W, int ldw, int K, bf16* WT, int dst_row0, int k0, int n0, LAS float* scr, int lane) {
#pragma unroll
    for (int i = 0; i < 8; ++i) { const int kk = 8 * i + (lane >> 3), nq = (lane & 7) * 4; const float4 v = *(const float4*)(W + (size_t)(k0 + kk) * ldw + n0 + nq);
        scr[kk * 33 + nq] = v.x; scr[kk * 33 + nq + 1] = v.y; scr[kk * 33 + nq + 2] = v.z; scr[kk * 33 + nq + 3] = v.w; }
    asm volatile("s_waitcnt lgkmcnt(0)" ::: "memory");
    const int c = lane & 7;
#pragma unroll
    for (int j = 0; j < 4; ++j) { const int n = (lane >> 3) + 8 * j; const LAS float* s = scr + (8 * c) * 33 + n;
        v4u o; o.x = pk2(s[0 * 33], s[1 * 33]); o.y = pk2(s[2 * 33], s[3 * 33]); o.z = pk2(s[4 * 33], s[5 * 33]); o.w = pk2(s[6 * 33], s[7 * 33]);
        *(v4u*)(WT + (size_t)(dst_row0 + n) * K + k0 + 8 * c) = o; }
    asm volatile("s_waitcnt lgkmcnt(0)" ::: "memory");
}
__device__ __forceinline__ void ph_convert(Frame& F, const Params& P, int l, int it0, int it1, int rank, int nw) {
    const float* w_ffn_in = P.in[7]; const float* w_ffn_out = P.in[8]; const float* w_in = P.in[9]; const float* w_out = P.in[10];
    bf16* Wi_t = (bf16*)(F.ws + WS_WI); bf16* Wo_t = (bf16*)(F.ws + WS_WO); bf16* Win_t = (bf16*)(F.ws + WS_WIN); bf16* Wout_t = (bf16*)(F.ws + WS_WOUT);
    LAS float* scr = (LAS float*)(F.lds + F.wave * 16384);
    constexpr int NSRC = SRC_GATE - SRC_COL0; constexpr int I_FI = (D / 64) * (2 * DFF / 32), I_FO = (DFF / 64) * (D / 32), I_IN = (D / 64) * (NSRC / 32), I_OUT = (D / 64) * (D / 32);
    constexpr int NITEMS = 2 * I_FI + 2 * I_FO + I_IN + I_OUT;
    if (it1 > NITEMS) it1 = NITEMS;
    for (int it = it0 + rank; it < it1; it += nw) {
        int r = it;
        if (r < 2 * I_FI) { const int mat = 2 * l + r / I_FI; r %= I_FI; const int nblk = 2 * DFF / 32, kb = r / nblk, nb = r % nblk, n0 = 32 * nb;
            const int nn = n0 < DFF ? n0 : n0 - DFF; const int drow = 256 * (nn / 128) + (n0 < DFF ? 0 : 128) + (nn % 128);
            transpose_item(w_ffn_in + (size_t)mat * D * 2 * DFF, 2 * DFF, D, Wi_t + (size_t)mat * 2 * DFF * D, drow, 64 * kb, n0, scr, F.lane); continue; }
        r -= 2 * I_FI;
        if (r < 2 * I_FO) { const int mat = 2 * l + r / I_FO; r %= I_FO; const int nblk = D / 32, kb = r / nblk, nb = r % nblk;
            transpose_item(w_ffn_out + (size_t)mat * DFF * D, D, DFF, Wo_t + (size_t)mat * D * DFF, 32 * nb, 64 * kb, 32 * nb, scr, F.lane); continue; }
        r -= 2 * I_FO;
        if (r < I_IN) { const int nblk = NSRC / 32, kb = r / nblk, nb = r % nblk;
            transpose_item(w_in + (size_t)l * D * DIN, DIN, D, Win_t + (size_t)l * DU * D, 512 + 32 * nb, 64 * kb, SRC_COL0 + 32 * nb, scr, F.lane); continue; }
        r -= I_IN;
        { const int nblk = D / 32, kb = r / nblk, nb = r % nblk;
            transpose_item(w_out + (size_t)l * D * D, D, D, Wout_t + (size_t)l * D * D, 32 * nb, 64 * kb, 32 * nb, scr, F.lane); }
    }
}
__device__ __forceinline__ void ph_first(Frame& F, const Params& P) {
    const float* xin = P.in[0]; const float* cin = P.in[2]; const float* g = P.in[6]; const float* MOD = (const float*)(F.ws + WS_MOD);
    bf16* H = (bf16*)(F.ws + WS_HB); float* RS = (float*)(F.ws + WS_RS);
    constexpr int RB = 4;
    for (int r0 = F.gw * RB; r0 < T; r0 += F.NGW * RB) {
        float4 v[RB][4];
#pragma unroll
        for (int i = 0; i < RB; ++i) { const int r = r0 + i; const float* src = r < TL ? xin + (size_t)r * D : cin + (size_t)(r - TL) * D;
#pragma unroll
            for (int j = 0; j < 4; ++j) v[i][j] = ((const float4*)src)[F.lane + 64 * j]; }
        const int mr = mod_row(r0);
        float4 gs[4];
#pragma unroll
        for (int j = 0; j < 4; ++j) { const int q = F.lane + 64 * j; const float4 gv = ((const float4*)g)[q], sc = ((const float4*)(MOD + (size_t)mr * MODW + 1 * D))[q]; gs[j] = make_float4(gv.x * (1.f + sc.x), gv.y * (1.f + sc.y), gv.z * (1.f + sc.z), gv.w * (1.f + sc.w)); }
        float ss[RB];
#pragma unroll
        for (int i = 0; i < RB; ++i) { const int r = r0 + i; ss[i] = 0.f;
#pragma unroll
            for (int j = 0; j < 4; ++j) { const float4 x = v[i][j]; ss[i] += x.x * x.x + x.y * x.y + x.z * x.z + x.w * x.w;
                uint2 o; o.x = pk2(x.x * gs[j].x, x.y * gs[j].y); o.y = pk2(x.z * gs[j].z, x.w * gs[j].w); ((uint2*)(H + (size_t)r * D))[F.lane + 64 * j] = o; } }
#pragma unroll
        for (int i = 0; i < RB; ++i) ss[i] = wave_sum(ss[i], F.lane);
#pragma unroll
        for (int i = 0; i < RB; ++i) if (F.lane < 16) RS[(size_t)(r0 + i) * 16 + F.lane] = F.lane == 0 ? ss[i] : 0.f;
    }
}
__device__ __forceinline__ void ph_bias(Frame& F, const Params& P, int l) {
    const float* MOD = (const float*)(F.ws + WS_MOD); const bf16* Wi_t = (const bf16*)(F.ws + WS_WI); const bf16* Win_t = (const bf16*)(F.ws + WS_WIN);
    float* SWFI = (float*)(F.ws + WS_SWFI); float* SWIN = (float*)(F.ws + WS_SWIN); float* SWG = (float*)(F.ws + WS_SWG);
#pragma unroll 1
    for (int mg = 0; mg < 4; ++mg) {
        const bool fi = mg < 2; const int mat = fi ? 2 * l + mg : l, sidx = fi ? (mg ? 6 : 0) : 3, nrows = fi ? 2 * DFF : (mg == 2 ? DU : 16);
        float sh[NR][16];
#pragma unroll
        for (int r = 0; r < NR; ++r) { const float4* sp = (const float4*)(MOD + ((size_t)l * NR + r) * MODW + sidx * D + F.lane * 16);
#pragma unroll
            for (int q4 = 0; q4 < 4; ++q4) { const float4 s4 = sp[q4]; sh[r][4 * q4] = s4.x; sh[r][4 * q4 + 1] = s4.y; sh[r][4 * q4 + 2] = s4.z; sh[r][4 * q4 + 3] = s4.w; } }
        const bf16* wbase = fi ? Wi_t + (size_t)mat * 2 * DFF * D : (mg == 2 ? Win_t + (size_t)mat * DU * D : (const bf16*)(F.ws + WS_WGT) + (size_t)l * 32 * D);
        float* obase = fi ? SWFI + (size_t)mat * NR * 2 * DFF : (mg == 2 ? SWIN + (size_t)mat * NR * DU : SWG + (size_t)l * NR * 16);
        for (int row = F.gw; row < nrows; row += F.NGW) {
            const bf16* wr = wbase + (size_t)row * D + F.lane * 16;
            const half8 w0 = __builtin_bit_cast(half8, *(const v4u*)wr), w1 = __builtin_bit_cast(half8, *(const v4u*)(wr + 8));
            float x[16];
#pragma unroll
            for (int i = 0; i < 16; ++i) x[i] = i < 8 ? (float)w0[i] : (float)w1[i - 8];
#pragma unroll
            for (int r = 0; r < NR; ++r) { float a = 0.f;
#pragma unroll
                for (int i = 0; i < 16; ++i) a += sh[r][i] * x[i];
                a = wave_sum(a, F.lane); if (F.lane == 0) obase[(size_t)r * nrows + row] = a; }
        }
    }
}
__device__ __forceinline__ void ph_rope_table(Frame& F, const Params& P) {
    float2* RT = (float2*)(F.ws + WS_ROPE); bf16* WgT = (bf16*)(F.ws + WS_WGT);
    for (int i = F.bid * NTHREADS + F.tid; i < DEPTH * 32 * D; i += F.G * NTHREADS) { const int l = i / (32 * D), j = (i / D) & 31, k = i % D; WgT[i] = (bf16)(j < 16 ? f2bf(P.in[9][((size_t)l * D + k) * DIN + SRC_GATE + j]) : 0u); }
    for (int i = F.bid + F.G * F.tid; i < 64 * 16 && F.tid < 8; i += F.G * 8) { const int p = i >> 4, f = i & 15;     const float ang = (float)p * powf(10000.f, -(float)f / 16.f); RT[i] = make_float2(cosf(ang), sinf(ang)); }
}
__device__ __forceinline__ void ph_final(Frame& F, const Params& P) {
    const float* g = P.in[16]; const float* RS = (const float*)(F.ws + WS_RS); const bf16* X16 = (const bf16*)(F.ws + WS_X16);
    constexpr int RB = 4;
    float4 gv[4];
#pragma unroll
    for (int j = 0; j < 4; ++j) gv[j] = ((const float4*)g)[F.lane + 64 * j];
    for (int r0 = F.gw * RB; r0 < TL; r0 += F.NGW * RB) {
        half4 hx[RB][4]; float rstd[RB];
#pragma unroll
        for (int i = 0; i < RB; ++i) { rstd[i] = rstd_row(RS, r0 + i);
#pragma unroll
            for (int j = 0; j < 4; ++j) hx[i][j] = *(const half4*)(X16 + (size_t)(r0 + i) * D + 4 * (F.lane + 64 * j)); }
#pragma unroll
        for (int i = 0; i < RB; ++i) { float* o = F.out + (size_t)(r0 + i) * D;
#pragma unroll
            for (int j = 0; j < 4; ++j) ((float4*)o)[F.lane + 64 * j] = make_float4((float)hx[i][j][0] * rstd[i] * gv[j].x, (float)hx[i][j][1] * rstd[i] * gv[j].y, (float)hx[i][j][2] * rstd[i] * gv[j].z, (float)hx[i][j][3] * rstd[i] * gv[j].w); }
    }
}
__device__ __forceinline__ void ph_gates(Frame& F, int l) {
    const bf16* H = (const bf16*)(F.ws + WS_HB); float* G = (float*)(F.ws + WS_G); const float* RS = (const float*)(F.ws + WS_RS); const float* SWG = (const float*)(F.ws + WS_SWG) + l * NR * 16;
    const bf16* WgT = (const bf16*)(F.ws + WS_WGT) + (size_t)l * 32 * D;
    const int r32 = F.lane & 31, hh = F.lane >> 5;
    for (int rb = (F.gw + F.NGW - 100 * NWAVES) % F.NGW; rb < T / 32; rb += F.NGW) {
        const bf16* hp = H + (size_t)(rb * 32 + r32) * D + 8 * hh; const bf16* wp = WgT + (size_t)r32 * D + 8 * hh;
        f32x16 acc = {};
#pragma unroll 8
        for (int s = 0; s < 64; ++s) acc = __builtin_amdgcn_mfma_f32_32x32x16_f16(__builtin_bit_cast(half8, *(const v4u*)(wp + 16 * s)), __builtin_bit_cast(half8, *(const v4u*)(hp + 16 * s)), acc, 0, 0, 0);
        const int row = rb * 32 + r32; const float rstd = rstd_row(RS, row); const float* sb = SWG + mod_row(row) * 16;
#pragma unroll
        for (int q4 = 0; q4 < 2; ++q4) { const int j0 = 8 * q4 + 4 * hh; f32x4v o;
#pragma unroll
            for (int i = 0; i < 4; ++i) o[i] = acc[4 * q4 + i] * rstd + sb[j0 + i];
            *(f32x4v*)(G + (size_t)row * 16 + j0) = o; }
    }
}
constexpr int TP = 144;
constexpr int NCH = 68, NCHAIN = 32, NITEM = NCHAIN * NCH;
__device__ __forceinline__ f32x16 mfma32(half8 a, half8 b, f32x16 c) { return __builtin_amdgcn_mfma_f32_32x32x16_f16(a, b, c, 0, 0, 0); }
__device__ __forceinline__ float wave_max(float v, int lane) {
#pragma unroll
    for (int o = 1; o < 64; o <<= 1) v = fmaxf(v, lane_xor(v, lane, o));
    return v; }
struct ChunkGeo { int N, rb, p0, dp; };
__device__ __forceinline__ ChunkGeo chunk_geo(int b, int dir, int c  ) {
    ChunkGeo g; const bool isctx = c < 4; const int cc = isctx ? c : c - 4; g.N = isctx ? CTX : SEQ; g.rb = isctx ? TL + b * CTX : b * SEQ;
    if (dir == 0) { g.p0 = cc * 64; g.dp = 1; } else { g.p0 = g.N - 1 - cc * 64; g.dp = -1; }
    return g; }
__device__ __forceinline__ void conv16(const bf16* urow  , int p, int N, int colbase, const float* cw, float scale, float (&out)[16]) {
    const v4u c0 = *(const v4u*)(urow + colbase), c1 = *(const v4u*)(urow + colbase + 8);
    v4u m0 = {0u, 0u, 0u, 0u}, m1 = m0, n0 = m0, n1 = m0;
    if (p > 0) { m0 = *(const v4u*)(urow - DU + colbase); m1 = *(const v4u*)(urow - DU + colbase + 8); }
    if (p < N - 1) { n0 = *(const v4u*)(urow + DU + colbase); n1 = *(const v4u*)(urow + DU + colbase + 8); }
    const half8 hc0 = __builtin_bit_cast(half8, c0), hc1 = __builtin_bit_cast(half8, c1), hm0 = __builtin_bit_cast(half8, m0), hm1 = __builtin_bit_cast(half8, m1), hn0 = __builtin_bit_cast(half8, n0), hn1 = __builtin_bit_cast(half8, n1);
#pragma unroll
    for (int i = 0; i < 16; ++i) { const float xm = i < 8 ? (float)hm0[i] : (float)hm1[i - 8], xc = i < 8 ? (float)hc0[i] : (float)hc1[i - 8], xn = i < 8 ? (float)hn0[i] : (float)hn1[i - 8];
        const float a = xm * cw[i] + xc * cw[512 + i] + xn * cw[1024 + i]; out[i] = a * __builtin_amdgcn_rcpf(1.f + __expf(-a)) * scale; }
}
__device__ __forceinline__ void st_row16(LAS unsigned char* tile, int row, int c0, const float (&v)[16]) {
    v4u a, b; a.x = pk2(v[0], v[1]); a.y = pk2(v[2], v[3]); a.z = pk2(v[4], v[5]); a.w = pk2(v[6], v[7]); b.x = pk2(v[8], v[9]); b.y = pk2(v[10], v[11]); b.z = pk2(v[12], v[13]); b.w = pk2(v[14], v[15]);
    *(LAS v4u*)(tile + row * TP + c0 * 2) = a; *(LAS v4u*)(tile + row * TP + c0 * 2 + 16) = b; }
__device__ __forceinline__ void st_col16(LAS unsigned char* tile, int col, int r0, const float (&v)[16]) {
#pragma unroll
    for (int i = 0; i < 16; ++i) *(LAS unsigned short*)(tile + (r0 + i) * TP + col * 2) = (unsigned short)f2bf(v[i]); }
__device__ __forceinline__ half8 ld_row8(const LAS unsigned char* tile, int row, int c0) { return __builtin_bit_cast(half8, *(const LAS v4u*)(tile + row * TP + c0 * 2)); }

__device__ __forceinline__ void ph_mlstm_m1(Frame& F, const float* conv, const float* b_i, const float* b_f) {
    const bf16* U = (const bf16*)(F.ws + WS_R); const float* G = (const float*)(F.ws + WS_G);
    bf16* CL = (bf16*)(F.ws + WS_HS); float* NL = (float*)(F.ws + WS_NL); float* AM = (float*)(F.ws + WS_AM);
    const int dir = F.wave >> 2, wg = F.wave & 3, tg = F.tid & 255, r32 = F.lane & 31, hh = F.lane >> 5;
    LAS unsigned char* base = F.lds + dir * 24576; LAS unsigned char* KT = base; LAS unsigned char* VT = base + 9216; LAS float* wS = (LAS float*)(base + 18432);
    for (int it = F.bid; it < 16 * NCH; it += F.G) {
        const int bh = it / NCH, c = it % NCH, b = bh >> 2, h = bh & 3; const ChunkGeo g = chunk_geo(b, dir, c); const int item = (bh * 2 + dir) * NCH + c;
        if (wg == 0) { const int p = g.p0 + g.dp * F.lane; const float* g0 = G + (size_t)(g.rb + p) * 16;
            const float liv = g0[dir * 4 + h] + b_i[dir * 4 + h], lfv = logsigmoid_f(g0[8 + dir * 4 + h] + b_f[dir * 4 + h]);
            float bc = lfv;
#pragma unroll
            for (int o = 1; o < 64; o <<= 1) { const float t = lane_get(bc, F.lane - o); if (F.lane >= o) bc += t; }
            const float a = lane_get(bc, 63); const float dl = a - bc + liv; const float ml = wave_max(dl, F.lane);
            wS[F.lane] = __expf(dl - ml);
            if (F.lane == 0) { AM[item * 2] = a; AM[item * 2 + 1] = ml; } }
        __syncthreads();
        { const int tau = tg >> 2, d0 = (tg & 3) * 16; const int p = g.p0 + g.dp * tau; const bf16* urow = U + (size_t)(g.rb + p) * DU;
          float kv[16], vv[16]; conv16(urow, p, g.N, C_MK + h * 64 + d0, conv + 256 + h * 64 + d0, 0.125f, kv);
          const float w = wS[tau]; const half8 v0 = __builtin_bit_cast(half8, *(const v4u*)(urow + C_MV + h * 64 + d0)), v1 = __builtin_bit_cast(half8, *(const v4u*)(urow + C_MV + h * 64 + d0 + 8));
#pragma unroll
          for (int i = 0; i < 16; ++i) vv[i] = (i < 8 ? (float)v0[i] : (float)v1[i - 8]) * w;
          st_col16(KT, tau, d0, kv); st_col16(VT, tau, d0, vv); }
        __syncthreads();
        { const int tm = wg >> 1, tn = wg & 1; f32x16 acc = {};
#pragma unroll
          for (int s = 0; s < 4; ++s) acc = mfma32(ld_row8(VT, 32 * tm + r32, 16 * s + 8 * hh), ld_row8(KT, 32 * tn + r32, 16 * s + 8 * hh), acc);
          bf16* cl = CL + (size_t)item * 4096 + 32 * tn + r32;
#pragma unroll
          for (int r = 0; r < 16; ++r) cl[(size_t)(32 * tm + (r & 3) + 8 * (r >> 2) + 4 * hh) * 64] = (bf16)f2bf(acc[r]);
          if (tg < 64) { float a = 0.f; const LAS unsigned char* kr = KT + tg * TP;
#pragma unroll 8
              for (int s = 0; s < 64; ++s) a += wS[s] * bf2f(*(const LAS unsigned short*)(kr + s * 2));
              NL[(size_t)item * 64 + tg] = a; } }
        __syncthreads();
    }
}
__device__ __forceinline__ void ph_mlstm_m2(Frame& F) {
    bf16* CL = (bf16*)(F.ws + WS_HS); float* NL = (float*)(F.ws + WS_NL); const float* AM = (const float*)(F.ws + WS_AM); float* MS = (float*)(F.ws + WS_MS);
    for (int vb = F.bid; vb < NCHAIN * 8; vb += F.G) {
        const int chain = vb >> 3, sl = vb & 7, e = sl * NTHREADS + F.tid; const bool don = (sl == 0 && F.tid < 64);
        bf16* cp = CL + (size_t)chain * NCH * 4096 + e; float* np = NL + (size_t)chain * NCH * 64 + (F.tid & 63); const float* am = AM + (size_t)chain * NCH * 2;
        float cl[NCH];
#pragma unroll
        for (int c = 0; c < NCH; ++c) cl[c] = bf2f(cp[(size_t)c * 4096]);
        { float C = 0.f, m = 0.f;
#pragma unroll
          for (int c = 0; c < NCH; ++c) { const float a = am[c * 2], ml = am[c * 2 + 1]; const float mn = fmaxf(a + m, ml), al = __expf(a + m - mn), be = __expf(ml - mn);
              cp[(size_t)c * 4096] = (bf16)f2bf(fminf(fmaxf(C, -60000.f), 60000.f)); C = al * C + be * cl[c];
              if (sl == 0 && F.tid == 0) MS[chain * NCH + c] = m;
              m = mn; } }
        if (don) {
#pragma unroll
            for (int c = 0; c < NCH; ++c) cl[c] = np[c * 64];
            float nvv = 0.f, m = 0.f;
#pragma unroll
            for (int c = 0; c < NCH; ++c) { const float a = am[c * 2], ml = am[c * 2 + 1]; const float mn = fmaxf(a + m, ml), al = __expf(a + m - mn), be = __expf(ml - mn);
                np[c * 64] = nvv; nvv = al * nvv + be * cl[c]; m = mn; } }
    }
}
__device__ __forceinline__ void ph_mlstm_m3(Frame& F, const float* conv, const float* b_i, const float* b_f, bool do_ctx) {
    const bf16* U = (const bf16*)(F.ws + WS_R); const float* G = (const float*)(F.ws + WS_G); bf16* Y = (bf16*)F.out;
    const bf16* CS = (const bf16*)(F.ws + WS_HS); const float* NS = (const float*)(F.ws + WS_NL); const float* MS = (const float*)(F.ws + WS_MS);
    const int dir = F.wave >> 2, wg = F.wave & 3, tg = F.tid & 255, r32 = F.lane & 31, hh = F.lane >> 5;
    LAS unsigned char* base = F.lds + dir * 40960; LAS unsigned char* Qs = base; LAS unsigned char* Ks = base + 9216; LAS unsigned char* VT = base + 18432; LAS unsigned char* Cs = base + 27648;
    LAS float* fa = (LAS float*)(base + 36864); LAS float* bcS = fa; LAS float* lmbS = fa + 64; LAS float* mtS = fa + 128; LAS float* wpS = fa + 192; LAS float* n0S = fa + 256;
    LAS float* HO = (LAS float*)(F.lds + 81920);
    const int nblk = do_ctx ? NCH : NCH - 4;
    for (int it = F.bid; it < 16 * nblk; it += F.G) {
        const int bh = it / nblk, pbi = it % nblk + (do_ctx ? 0 : 4), b = bh >> 2, h = bh & 3;
        const bool isctx = pbi < 4; const int pb = isctx ? pbi : pbi - 4, N = isctx ? CTX : SEQ, rb = isctx ? TL + b * CTX : b * SEQ;
        const int cs = dir == 0 ? pb : N / 64 - 1 - pb;
        const int item = (bh * 2 + dir) * NCH + (isctx ? cs : 4 + cs);
        const int p0 = dir == 0 ? pb * 64 : pb * 64 + 63, dp = dir == 0 ? 1 : -1;
        if (wg == 0) { const int p = p0 + dp * F.lane; const float* g0 = G + (size_t)(rb + p) * 16;
            const float liv = g0[dir * 4 + h] + b_i[dir * 4 + h], lfv = logsigmoid_f(g0[8 + dir * 4 + h] + b_f[dir * 4 + h]);
            float bc = lfv;
#pragma unroll
            for (int o = 1; o < 64; o <<= 1) { const float t = lane_get(bc, F.lane - o); if (F.lane >= o) bc += t; }
            const float lmb = liv - bc; float pm = lmb;
#pragma unroll
            for (int o = 1; o < 64; o <<= 1) { const float t = lane_get(pm, F.lane - o); if (F.lane >= o) pm = fmaxf(pm, t); }
            const float m0 = MS[item]; const float mt = bc + fmaxf(m0, pm);
            bcS[F.lane] = bc; lmbS[F.lane] = lmb; mtS[F.lane] = mt; wpS[F.lane] = __expf(bc + m0 - mt); n0S[F.lane] = NS[(size_t)item * 64 + F.lane]; }
        { const int tau = tg >> 2, d0 = (tg & 3) * 16; const int p = p0 + dp * tau; const bf16* urow = U + (size_t)(rb + p) * DU;
          float qv[16], kv[16], vv[16]; conv16(urow, p, N, C_MQ + h * 64 + d0, conv + h * 64 + d0, 1.0f, qv); conv16(urow, p, N, C_MK + h * 64 + d0, conv + 256 + h * 64 + d0, 0.125f, kv);
          const half8 v0 = __builtin_bit_cast(half8, *(const v4u*)(urow + C_MV + h * 64 + d0)), v1 = __builtin_bit_cast(half8, *(const v4u*)(urow + C_MV + h * 64 + d0 + 8));
#pragma unroll
          for (int i = 0; i < 16; ++i) vv[i] = i < 8 ? (float)v0[i] : (float)v1[i - 8];
          st_row16(Qs, tau, d0, qv); st_row16(Ks, tau, d0, kv); st_col16(VT, tau, d0, vv);
          const bf16* cg = CS + (size_t)item * 4096 + tau * 64 + d0;
          *(LAS v4u*)(Cs + tau * TP + d0 * 2) = *(const v4u*)cg; *(LAS v4u*)(Cs + tau * TP + d0 * 2 + 16) = *(const v4u*)(cg + 8); }
        __syncthreads();
        f32x16 ho;
        { const int tt = wg & 1, tv = wg >> 1; const int tau = 32 * tt + r32;
          half8 qf[4];
#pragma unroll
          for (int s = 0; s < 4; ++s) qf[s] = ld_row8(Qs, tau, 16 * s + 8 * hh);
          f32x16 st0 = {}, st1 = {};
#pragma unroll
          for (int s = 0; s < 4; ++s) { st0 = mfma32(ld_row8(Ks, r32, 16 * s + 8 * hh), qf[s], st0); st1 = mfma32(ld_row8(Ks, 32 + r32, 16 * s + 8 * hh), qf[s], st1); }
          const float ct = bcS[tau] - mtS[tau]; float dpart = 0.f;
#pragma unroll
          for (int r = 0; r < 16; ++r) { const int sg = (r & 3) + 8 * (r >> 2) + 4 * hh;
              const float w0 = sg <= tau ? __expf(ct + lmbS[sg]) : 0.f, w1 = sg + 32 <= tau ? __expf(ct + lmbS[sg + 32]) : 0.f;
              st0[r] *= w0; st1[r] *= w1; dpart += st0[r] + st1[r]; }
          float qn = 0.f;
#pragma unroll
          for (int s = 0; s < 4; ++s)
#pragma unroll
              for (int j = 0; j < 8; ++j) qn += (float)qf[s][j] * n0S[16 * s + 8 * hh + j];
          dpart += lane_xor(dpart, F.lane, 32); qn += lane_xor(qn, F.lane, 32);
          const float wp = wpS[tau], mt = mtS[tau]; const float den = dpart + wp * qn; const float inv = 1.f / fmaxf(fabsf(den), __expf(-mt));
          f32x16 an = {}, ac = {};
#pragma unroll
          for (int ks = 0; ks < 4; ++ks) { const f32x16& sx = (ks >> 1) ? st1 : st0; const int rbs = 8 * (ks & 1);
              half8 bf;
#pragma unroll
              for (int j = 0; j < 8; ++j) bf[j] = (_Float16)sx[rbs + j];
              const LAS unsigned char* vr = VT + (32 * tv + r32) * TP + (16 * ks + 4 * hh) * 2;
              const half4 a0 = *(const LAS half4*)vr, a1 = *(const LAS half4*)(vr + 16);
              const half8 af = {a0[0], a0[1], a0[2], a0[3], a1[0], a1[1], a1[2], a1[3]};
              an = mfma32(af, bf, an); }
#pragma unroll
          for (int s = 0; s < 4; ++s) ac = mfma32(ld_row8(Cs, 32 * tv + r32, 16 * s + 8 * hh), qf[s], ac);
#pragma unroll
          for (int r = 0; r < 16; ++r) ho[r] = (an[r] + wp * ac[r]) * inv;
          if (dir == 0) {
#pragma unroll
              for (int q4 = 0; q4 < 4; ++q4) { f32x4v x = {ho[4 * q4], ho[4 * q4 + 1], ho[4 * q4 + 2], ho[4 * q4 + 3]}; *(LAS f32x4v*)(HO + tau * 68 + 32 * tv + 8 * q4 + 4 * hh) = x; } } }
        __syncthreads();
        if (dir == 1) { const int tt = wg & 1, tv = wg >> 1; const int tau = 32 * tt + r32, pos = 63 - tau; const size_t row = (size_t)(rb + pb * 64 + pos);
#pragma unroll
            for (int q4 = 0; q4 < 4; ++q4) { const int v0 = 32 * tv + 8 * q4 + 4 * hh; const f32x4v x = *(const LAS f32x4v*)(HO + pos * 68 + v0);
                const half4 mo = *(const half4*)(U + row * DU + C_MO + h * 64 + v0); float o[4];
#pragma unroll
                for (int i = 0; i < 4; ++i) { const float g = 1.f / (1.f + __expf(-(float)mo[i])); o[i] = fminf(fmaxf(g * (x[i] + ho[4 * q4 + i]), -60000.f), 60000.f); }
                uint2 w; w.x = pk2(o[0], o[1]); w.y = pk2(o[2], o[3]); *(uint2*)(Y + row * D + 768 + h * 64 + v0) = w; } }
        __syncthreads();
    }
}


__device__ __forceinline__ void ph_attn(Frame& F, const float* sink, bool do_ctx) {
    const bf16* U = (const bf16*)(F.ws + WS_R); bf16* Y = (bf16*)F.out;
    const int g = F.wave >> 1, qh = F.wave & 1, r32 = F.lane & 31, hh = F.lane >> 5;
    const int lrow = F.tid >> 3, lch = F.tid & 7;
    constexpr float LOG2E = 1.4426950408889634f;
    const int nunits = 512 + (do_ctx ? 32 : 0);
    for (int uk = 0; uk < 3; ++uk) {
        int u; if (uk < 2) u = (F.bid & 7) * 64 + (F.bid >> 3) * 2 + uk; else { if (F.bid < 64 || F.bid >= 96) break; u = 512 + (F.bid - 64); }
        if (u >= nunits) break;
        const bool lat = u < 512; int b, kvh, qb;
        if (lat) { b = u >> 7; kvh = (u >> 6) & 1; qb = u & 63; } else { const int v = u - 512; b = v >> 3; kvh = (v >> 2) & 1; qb = v & 3; }
        const int head = kvh * 4 + g;
        const size_t qrow = (size_t)(lat ? b * SEQ : TL + b * CTX) + qb * 64 + qh * 32 + r32;
        half8 qf[4];
#pragma unroll
        for (int s = 0; s < 4; ++s) qf[s] = __builtin_bit_cast(half8, *(const v4u*)(U + qrow * DU + C_Q + head * 64 + 16 * s + 8 * hh));
        const int kt_lo = lat ? (qb - 2 < 0 ? 0 : qb - 2) : 0, kt_hi = lat ? (qb + 2 > 63 ? 63 : qb + 2) : -1; const int nloc = kt_hi - kt_lo + 1, nt = nloc + 4;
        float m = sink[head] * LOG2E, l = 1.f; f32x16 o0 = {}, o1 = {};
        v4u kreg, vreg;
#define ATT_TILE_ROW0(t) ((t) < nloc ? (size_t)b * SEQ + (size_t)(kt_lo + (t)) * 64 : (size_t)TL + (size_t)b * CTX + (size_t)((t) - nloc) * 64)
#define ATT_LOAD(t) do { const bf16* rp = U + (ATT_TILE_ROW0(t) + lrow) * DU + kvh * 64 + 8 * lch; kreg = *(const v4u*)(rp + C_K); vreg = *(const v4u*)(rp + C_V); } while (0)
#define ATT_STORE(buf) do { LAS unsigned char* kb = F.lds + (buf) * 9216; LAS unsigned char* vb = F.lds + 18432 + (buf) * 9216; *(LAS v4u*)(kb + lrow * TP + lch * 16) = kreg; \
        const half8 vh = __builtin_bit_cast(half8, vreg); _Pragma("unroll") for (int i = 0; i < 8; ++i) *(LAS _Float16*)(vb + (8 * lch + i) * TP + lrow * 2) = vh[i]; } while (0)
        ATT_LOAD(0); ATT_STORE(0);
        __syncthreads();
        for (int t = 0; t < nt; ++t) {
            if (t + 1 < nt) ATT_LOAD(t + 1);
            const LAS unsigned char* Kb = F.lds + (t & 1) * 9216; const LAS unsigned char* Vb = F.lds + 18432 + (t & 1) * 9216;
            f32x16 s0, s1;
#pragma unroll
            for (int r = 0; r < 16; ++r) { s0[r] = -m; s1[r] = -m; }
#pragma unroll
            for (int s = 0; s < 4; ++s) { s0 = mfma32(ld_row8(Kb, r32, 16 * s + 8 * hh), qf[s], s0); s1 = mfma32(ld_row8(Kb, 32 + r32, 16 * s + 8 * hh), qf[s], s1); }
            int ttype = 0; if (t < nloc) { const int kt = kt_lo + t; ttype = (kt == qb - 2) ? 1 : (kt == qb + 2) ? 2 : 0; }
            const int qi = qh * 32 + r32;
            if (ttype != 0) {
#pragma unroll
                for (int r = 0; r < 16; ++r) { const int jk = (r & 3) + 8 * (r >> 2) + 4 * hh;
                    const bool v0 = ttype == 1 ? (jk >= qi) : (jk <= qi), v1 = ttype == 1 ? (jk + 32 >= qi) : (jk + 32 <= qi);
                    s0[r] = v0 ? s0[r] : -INFINITY; s1[r] = v1 ? s1[r] : -INFINITY; } }
            float mx = fmaxf(s0[0], s1[0]);
#pragma unroll
            for (int r = 1; r < 16; ++r) mx = fmaxf(mx, fmaxf(s0[r], s1[r]));
            mx = fmaxf(mx, lane_xor(mx, F.lane, 32));
            if (__builtin_amdgcn_ballot_w64(mx > 0.f) != 0ull) {
                const float dl = fmaxf(mx, 0.f), alpha = __builtin_amdgcn_exp2f(-dl); m += dl; l *= alpha;
#pragma unroll
                for (int r = 0; r < 16; ++r) { s0[r] -= dl; s1[r] -= dl; o0[r] *= alpha; o1[r] *= alpha; } }
            float ls = 0.f;
#pragma unroll
            for (int r = 0; r < 16; ++r) { s0[r] = __builtin_amdgcn_exp2f(s0[r]); s1[r] = __builtin_amdgcn_exp2f(s1[r]); ls += s0[r] + s1[r]; }
            ls += lane_xor(ls, F.lane, 32); l += ls;
#pragma unroll
            for (int ks = 0; ks < 4; ++ks) { const f32x16& sx = (ks >> 1) ? s1 : s0; const int rbs = 8 * (ks & 1);
                half8 pf;
#pragma unroll
                for (int j = 0; j < 8; ++j) pf[j] = (_Float16)sx[rbs + j];
                const LAS unsigned char* v0p = Vb + r32 * TP + (16 * ks + 4 * hh) * 2; const LAS unsigned char* v1p = v0p + 32 * TP;
                const half4 a0 = *(const LAS half4*)v0p, a1 = *(const LAS half4*)(v0p + 16), c0 = *(const LAS half4*)v1p, c1 = *(const LAS half4*)(v1p + 16);
                const half8 af0 = {a0[0], a0[1], a0[2], a0[3], a1[0], a1[1], a1[2], a1[3]}, af1 = {c0[0], c0[1], c0[2], c0[3], c1[0], c1[1], c1[2], c1[3]};
                o0 = mfma32(af0, pf, o0); o1 = mfma32(af1, pf, o1); }
            if (t + 1 < nt) ATT_STORE((t + 1) & 1);
            __syncthreads();
        }
#undef ATT_TILE_ROW0
#undef ATT_LOAD
#undef ATT_STORE
        const float il = 1.f / l; LAS unsigned char* stg = F.lds + 40960 + F.wave * 4608;
#pragma unroll
        for (int q4 = 0; q4 < 4; ++q4) { typedef unsigned v2u __attribute__((ext_vector_type(2))); v2u w0, w1;
            w0.x = pk2(o0[4 * q4] * il, o0[4 * q4 + 1] * il); w0.y = pk2(o0[4 * q4 + 2] * il, o0[4 * q4 + 3] * il);
            w1.x = pk2(o1[4 * q4] * il, o1[4 * q4 + 1] * il); w1.y = pk2(o1[4 * q4 + 2] * il, o1[4 * q4 + 3] * il);
            *(LAS v2u*)(stg + r32 * TP + (8 * q4 + 4 * hh) * 2) = w0; *(LAS v2u*)(stg + r32 * TP + (32 + 8 * q4 + 4 * hh) * 2) = w1; }
        asm volatile("s_waitcnt lgkmcnt(0)" ::: "memory");
        { bf16* yb = Y + (qrow - r32) * D + 256 + head * 64;
#pragma unroll
          for (int i = 0; i < 4; ++i) { const int row = i * 8 + (F.lane >> 3), ch = F.lane & 7; *(v4u*)(yb + (size_t)row * D + ch * 8) = *(const LAS v4u*)(stg + row * TP + ch * 16); } }
    }
}


constexpr int FP = 272;
__device__ __forceinline__ void ph_fft_consts(Frame& F) {
    bf16* M1 = (bf16*)(F.ws + WS_FM1); bf16* M3 = (bf16*)(F.ws + WS_FM3); float2* TW = (float2*)(F.ws + WS_TW); float2* CT = (float2*)(F.ws + WS_CT);
    for (int i = F.bid * NTHREADS + F.tid; i < 16384 + 8192 + 4096 + 256; i += F.G * NTHREADS) {
        float s, c;
        if (i < 16384) { const int row = i >> 7, col = i & 127, pr = row >> 6, k1 = row & 63, pc = col >> 6, n1 = col & 63; sincospif((float)((k1 * n1) & 63) * (1.f / 32.f), &s, &c);
            M1[i] = (bf16)f2bf(pr == pc ? c : (pr == 0 ? s : -s)); }
        else if (i < 16384 + 8192) { const int j = i - 16384, k2 = j >> 7, col = j & 127, pc = col >> 6, n2 = col & 63; sincospif((float)((k2 * n2) & 63) * (1.f / 32.f), &s, &c); M3[j] = (bf16)f2bf(pc == 0 ? c : s); }
        else if (i < 16384 + 8192 + 4096) { const int j = i - 16384 - 8192; sincospif((float)j * (1.f / 2048.f), &s, &c); TW[j] = make_float2(c, s); }
        else { const int j = i - 16384 - 8192 - 4096; sincospif((float)j * (1.f / 128.f), &s, &c); CT[j] = make_float2(c, s); }
    }
    bf16* DMC = (bf16*)(F.ws + WS_DMC);
    for (int i = F.bid * NTHREADS + F.tid; i < 256 * 512; i += F.G * NTHREADS) { const int k = i >> 9, pn = i & 511, n = pn & 255; float s, c; sincospif((float)((k * n) & 255) * (1.f / 128.f), &s, &c); DMC[i] = (bf16)f2bf(4.f * (pn < 256 ? c : s)); }
}
__device__ __forceinline__ void ph_fold(Frame& F, const Params& P, int l, int bid0, int nb) {
    const float* w_in = P.in[9]; const float* wfo = P.in[11]; bf16* Win_t = (bf16*)(F.ws + WS_WIN);
    float* Wx = (float*)F.ldsg; float* ct = Wx + 4096; float* st = ct + 64;
    if (F.bid < bid0 || F.bid >= bid0 + nb) return;
    for (int it = F.bid - bid0; it < 128; it += nb) {
        const int g = (it >> 5) & 3, part = (it >> 4) & 1, kb = it & 15;
        __syncthreads();
        if (F.tid < 64) { float s, c; sincospif((float)F.tid * (1.f / 32.f), &s, &c); ct[F.tid] = c; st[F.tid] = s; }
        __syncthreads();
        const float* wf = wfo + ((size_t)l * 4 + g) * 4096;
        { const int e = F.tid & 63, c0 = F.tid >> 6; float wfc[64];
#pragma unroll
          for (int m = 0; m < 64; ++m) wfc[m] = wf[m * 64 + e];
          const float* tb = part == 0 ? ct : st; const float sg = part == 0 ? (1.f / 512.f) : (-1.f / 512.f);
#pragma unroll 1
          for (int i = 0; i < 8; ++i) { const int c = c0 + 8 * i; float a = 0.f;
#pragma unroll
              for (int m = 0; m < 64; ++m) a += tb[(m * c) & 63] * wfc[m];
              Wx[c * 64 + e] = a * sg; } }
        __syncthreads();
        const int k = kb * 64 + (F.tid >> 3), e0 = (F.tid & 7) * 8; const float* wr = w_in + ((size_t)l * D + k) * DIN + g * 64;
        float acc[8];
#pragma unroll
        for (int j = 0; j < 8; ++j) acc[j] = 0.f;
        float4 av[16];
#pragma unroll
        for (int c4 = 0; c4 < 16; ++c4) av[c4] = ((const float4*)wr)[c4];
#pragma unroll
        for (int c4 = 0; c4 < 16; ++c4) { const float aa[4] = {av[c4].x, av[c4].y, av[c4].z, av[c4].w};
#pragma unroll
            for (int ci = 0; ci < 4; ++ci) { const float* wx = Wx + (4 * c4 + ci) * 64 + e0; const float4 w0 = *(const float4*)wx, w1 = *(const float4*)(wx + 4);
                acc[0] += aa[ci] * w0.x; acc[1] += aa[ci] * w0.y; acc[2] += aa[ci] * w0.z; acc[3] += aa[ci] * w0.w; acc[4] += aa[ci] * w1.x; acc[5] += aa[ci] * w1.y; acc[6] += aa[ci] * w1.z; acc[7] += aa[ci] * w1.w; } }
#pragma unroll
        for (int j = 0; j < 8; ++j) Win_t[((size_t)l * DU + part * 256 + g * 64 + e0 + j) * D + k] = (bf16)f2bf(acc[j]);
    }
    __syncthreads();
}
__device__ __forceinline__ void ph_fft(Frame& F) {
    const bf16* U = (const bf16*)(F.ws + WS_R); bf16* Y = (bf16*)F.out; const float2* TW = (const float2*)(F.ws + WS_TW);
    LAS unsigned char* BUF = F.lds; LAS unsigned char* M1s = F.lds + 69632; LAS unsigned char* M3s = F.lds + 69632 + 34816;
    const int r32 = F.lane & 31, hh = F.lane >> 5, w = F.wave;
    __syncthreads();
    if (F.bid < 256) {
        const v4u* m1 = (const v4u*)(F.ws + WS_FM1); const v4u* m3 = (const v4u*)(F.ws + WS_FM3);
        for (int i = F.tid; i < 128 * 16; i += NTHREADS) *(LAS v4u*)(M1s + (i >> 4) * FP + (i & 15) * 16) = m1[i];
        for (int i = F.tid; i < 64 * 16; i += NTHREADS) *(LAS v4u*)(M3s + (i >> 4) * FP + (i & 15) * 16) = m3[i];
    }
    for (int itb = F.bid; itb < 256; itb += F.G) {
        const int it = (((itb & 7) * 4 + (itb >> 6)) << 3) | ((itb >> 3) & 7);
        const int b = it >> 6, cg = it & 63;
        __syncthreads();
        for (int q = w; q < 128; q += NWAVES) { const int n2 = q >> 1, part = q & 1, n1 = F.lane;
            const half4 x = *(const half4*)(U + (size_t)(b * SEQ + 64 * n1 + n2) * DU + part * 256 + cg * 4);
#pragma unroll
            for (int i = 0; i < 4; ++i) *(LAS _Float16*)(BUF + (n2 * 4 + i) * FP + (part * 64 + n1) * 2) = x[i]; }
        __syncthreads();
        f32x16 acc[4] = {};
#pragma unroll
        for (int s = 0; s < 8; ++s) { const half8 bf = __builtin_bit_cast(half8, *(const LAS v4u*)(BUF + (32 * w + r32) * FP + (16 * s + 8 * hh) * 2));
#pragma unroll
            for (int tm = 0; tm < 4; ++tm) acc[tm] = mfma32(__builtin_bit_cast(half8, *(const LAS v4u*)(M1s + (32 * tm + r32) * FP + (16 * s + 8 * hh) * 2)), bf, acc[tm]); }
        int nidx = 32 * w + r32; asm volatile("" : "+v"(nidx));
        const int n2 = nidx >> 2, col = nidx & 3;
        __syncthreads();
#pragma unroll
        for (int tm = 0; tm < 2; ++tm)
#pragma unroll
            for (int r = 0; r < 16; ++r) { const int k1 = 32 * tm + (r & 3) + 8 * (r >> 2) + 4 * hh; const float2 t = *(const float2*)((const char*)TW + ((unsigned)((k1 * n2) & 4095) << 3));
                const float re = acc[tm][r], im = acc[tm + 2][r];
                *(LAS _Float16*)(BUF + (k1 * 4 + col) * FP + n2 * 2) = (_Float16)(re * t.x + im * t.y);
                *(LAS _Float16*)(BUF + (k1 * 4 + col) * FP + (64 + n2) * 2) = (_Float16)(im * t.x - re * t.y); }
        __syncthreads();
        f32x16 y0 = {}, y1 = {};
#pragma unroll
        for (int s = 0; s < 8; ++s) { const half8 bf = __builtin_bit_cast(half8, *(const LAS v4u*)(BUF + (32 * w + r32) * FP + (16 * s + 8 * hh) * 2));
            y0 = mfma32(__builtin_bit_cast(half8, *(const LAS v4u*)(M3s + r32 * FP + (16 * s + 8 * hh) * 2)), bf, y0);
            y1 = mfma32(__builtin_bit_cast(half8, *(const LAS v4u*)(M3s + (32 + r32) * FP + (16 * s + 8 * hh) * 2)), bf, y1); }
        const int k1o = nidx >> 2; bf16* yb = Y + (size_t)(b * SEQ) * D + cg * 4 + col;
#pragma unroll
        for (int rep = 0; rep < (PROBE_ID == 316 ? 3 : 1); ++rep) {
#pragma unroll
        for (int r = 0; r < 16; ++r) { const int k2 = (r & 3) + 8 * (r >> 2) + 4 * hh;
            yb[(size_t)(k1o + 64 * k2) * D] = (bf16)f2bf(y0[r]); yb[(size_t)(k1o + 64 * (k2 + 32)) * D] = (bf16)f2bf(y1[r]); }
        asm volatile("s_waitcnt vmcnt(0)" ::: "memory"); }
    }
    __syncthreads();
}
__device__ __forceinline__ void ph_ctx_dft(Frame& F) {
    const bf16* U = (const bf16*)(F.ws + WS_R); bf16* Y = (bf16*)F.out; const bf16* Dm = (const bf16*)(F.ws + WS_DMC);
    constexpr int GP = 1040;
    LAS unsigned char* Gt = F.lds; const int r32 = F.lane & 31, hh = F.lane >> 5;
    for (int it = (F.bid + 160) & 255; it < NB * 8; it += 256) {
        const int b = it >> 3, cg = it & 7;
        __syncthreads();
        for (int q = F.tid; q < 2 * CTX * 4; q += NTHREADS) { const int part = q >> 10, n = (q >> 2) & 255, c8 = q & 3;
            const half8 x = __builtin_bit_cast(half8, *(const v4u*)(U + (size_t)(TL + b * CTX + n) * DU + part * 256 + cg * 32 + c8 * 8));
#pragma unroll
            for (int i = 0; i < 8; ++i) *(LAS _Float16*)(Gt + (c8 * 8 + i) * GP + (part * 256 + n) * 2) = x[i]; }
        __syncthreads();
        f32x16 acc = {}; const bf16* dr = Dm + (size_t)(32 * F.wave + r32) * 512 + 8 * hh; const LAS unsigned char* gr = Gt + r32 * GP + 16 * hh;
#pragma unroll 8
        for (int s = 0; s < 32; ++s) acc = mfma32(__builtin_bit_cast(half8, *(const v4u*)(dr + 16 * s)), __builtin_bit_cast(half8, *(const LAS v4u*)(gr + 32 * s)), acc);
        bf16* yb = Y + (size_t)(TL + b * CTX) * D + cg * 32 + r32;
#pragma unroll
        for (int r = 0; r < 16; ++r) yb[(size_t)(32 * F.wave + (r & 3) + 8 * (r >> 2) + 4 * hh) * D] = (bf16)f2bf(acc[r]);
    }
    __syncthreads();
}

__device__ __forceinline__ void ph_ctx_resid_gemm(Frame& F, const bf16* A  , const bf16* Bt  , int K, const float* xsrc, const float* ng, int gate_off, int nscale_off, float coef) {
    bf16* x16 = (bf16*)(F.ws + WS_X16) + (size_t)TL * D; const float* gate = (const float*)(F.ws + WS_MOD) + gate_off + (size_t)NB * MODW; const float* nscale = (const float*)(F.ws + WS_MOD) + nscale_off + (size_t)NB * MODW;
    bf16* hraw = (bf16*)(F.ws + WS_HB) + (size_t)TL * D; float* rowss = (float*)(F.ws + WS_RS) + (size_t)TL * 16;
    const int r16 = F.lane & 15, fq = F.lane >> 4; const int kc = K >> 3;
    LAS float* red = (LAS float*)F.lds;
    for (int pc = F.bid; pc < 256; pc += F.G) {
        const int xq = pc & 7, jq = pc >> 3; const int rt = (xq >> 1) * 4 + (jq >> 3), ct = (xq & 1) * 8 + (jq & 7);
        const bf16* ap = A + (size_t)(TL + rt * 64 + r16) * K + F.wave * kc + 8 * fq;
        const bf16* bp = Bt + (size_t)(ct * 64 + r16) * K + F.wave * kc + 8 * fq;
        pg8::f32x4 acc[4][4];
#pragma unroll
        for (int ci = 0; ci < 4; ++ci)
#pragma unroll
            for (int tj = 0; tj < 4; ++tj) acc[ci][tj] = (pg8::f32x4){0.f, 0.f, 0.f, 0.f};
        constexpr int PB = 4; const int nst = kc / 32;
        v4u lb[PB][4], la[PB][4];
#pragma unroll
        for (int i = 0; i < PB; ++i) { const int s = i < nst ? i : 0;
#pragma unroll
            for (int q = 0; q < 4; ++q) { lb[i][q] = *(const v4u*)(bp + (size_t)(16 * q) * K + 32 * s); la[i][q] = *(const v4u*)(ap + (size_t)(16 * q) * K + 32 * s); } }
        for (int s0 = 0; s0 < nst; s0 += PB) {
#pragma unroll
            for (int i = 0; i < PB; ++i) {
                half8 bfr[4], afr[4];
#pragma unroll
                for (int q = 0; q < 4; ++q) { bfr[q] = __builtin_bit_cast(half8, lb[i][q]); afr[q] = __builtin_bit_cast(half8, la[i][q]); }
                const int sn = s0 + PB + i; const int sl = sn < nst ? sn : nst - 1;
#pragma unroll
                for (int q = 0; q < 4; ++q) { lb[i][q] = *(const v4u*)(bp + (size_t)(16 * q) * K + 32 * sl); la[i][q] = *(const v4u*)(ap + (size_t)(16 * q) * K + 32 * sl); }
                if (s0 + i < nst) {
#pragma unroll
                    for (int ci = 0; ci < 4; ++ci)
#pragma unroll
                        for (int tj = 0; tj < 4; ++tj) acc[ci][tj] = __builtin_amdgcn_mfma_f32_16x16x32_f16(bfr[ci], afr[tj], acc[ci][tj], 0, 0, 0); } } }
        __syncthreads();
#pragma unroll
        for (int ci = 0; ci < 4; ++ci)
#pragma unroll
            for (int tj = 0; tj < 4; ++tj) { const int row = 16 * tj + r16, chunk = 4 * ci + fq; f32x4v v = {acc[ci][tj][0], acc[ci][tj][1], acc[ci][tj][2], acc[ci][tj][3]};
                *(LAS f32x4v*)(red + ((F.wave * 64 + row) * 16 + (chunk ^ (row & 15))) * 4) = v; }
        __syncthreads();
        { const int row = F.tid >> 3, cg8 = F.tid & 7; f32x4v s0 = {0.f, 0.f, 0.f, 0.f}, s1 = s0;
#pragma unroll
          for (int w8 = 0; w8 < 8; ++w8) { s0 += *(const LAS f32x4v*)(red + ((w8 * 64 + row) * 16 + ((2 * cg8) ^ (row & 15))) * 4); s1 += *(const LAS f32x4v*)(red + ((w8 * 64 + row) * 16 + ((2 * cg8 + 1) ^ (row & 15))) * 4); }
          const int grow = rt * 64 + row, c = ct * 64 + cg8 * 8; float ssq = 0.f;
          { const size_t off = (size_t)grow * D + c; f32x4v xo0, xo1;
            if (xsrc) { xo0 = *(const f32x4v*)(xsrc + off); xo1 = *(const f32x4v*)(xsrc + off + 4); }
            else { const half8 hx = __builtin_bit_cast(half8, *(const v4u*)(x16 + off)); xo0 = (f32x4v){(float)hx[0], (float)hx[1], (float)hx[2], (float)hx[3]}; xo1 = (f32x4v){(float)hx[4], (float)hx[5], (float)hx[6], (float)hx[7]}; }
            const f32x4v x0 = xo0 + *(const f32x4v*)(gate + c) * coef * s0, x1 = xo1 + *(const f32x4v*)(gate + c + 4) * coef * s1;
            { v4u w; w.x = pk2(x0[0], x0[1]); w.y = pk2(x0[2], x0[3]); w.z = pk2(x1[0], x1[1]); w.w = pk2(x1[2], x1[3]); *(v4u*)(x16 + off) = w; }
            ssq += ((x0[0] * x0[0] + x0[1] * x0[1]) + (x0[2] * x0[2] + x0[3] * x0[3])) + ((x1[0] * x1[0] + x1[1] * x1[1]) + (x1[2] * x1[2] + x1[3] * x1[3]));
            if (ng) { const f32x4v h0 = x0 * (*(const f32x4v*)(ng + c) * (*(const f32x4v*)(nscale + c) + 1.f)), h1 = x1 * (*(const f32x4v*)(ng + c + 4) * (*(const f32x4v*)(nscale + c + 4) + 1.f));
                v4u w; w.x = pk2(h0[0], h0[1]); w.y = pk2(h0[2], h0[3]); w.z = pk2(h1[0], h1[1]); w.w = pk2(h1[2], h1[3]); *(v4u*)(hraw + off) = w; } }
          ssq += lane_xor(ssq, F.lane, 1); ssq += lane_xor(ssq, F.lane, 2); ssq += lane_xor(ssq, F.lane, 4);
          if (cg8 == 0) rowss[(size_t)grow * 16 + ct] = ssq; }
    }
    __syncthreads();
}

template <class Epi> __device__ __forceinline__ void run_gemm(Frame& F, const bf16* A, const bf16* Bt, int M, int N, int K, const Epi& E) {
    pg8::Gemm g{A, Bt, M, N, K}; pg8::StaticOrder S; S.init(M, N, F.G, F.bid);
    pg8::gemm_phase<Epi, pg8::StaticOrder, true, true>(F.lds, g, S, E, F.tid);
}
template <class Epi> __device__ __forceinline__ void run_gemm_normed(Frame& F, const bf16* A, const bf16* Bt, int M, int N, int K, const Epi& E, const float* sw) {
    pg8::Gemm g{A, Bt, M, N, K}; RstdOrder S; S.init(M, N, F.G, F.bid); S.rowss = (const float*)(F.ws + WS_RS); S.tab = (LAS float*)(F.lds + RSTD_TAB_OFF); S.tid = F.tid; S.cnt = 0; S.sw = sw; S.ncols = N;
    pg8::gemm_phase<Epi, RstdOrder, true, true>(F.lds, g, S, E, F.tid);
}
__device__ __forceinline__ Frame make_frame(const Params& P, unsigned char* lds_raw) {
    Frame F; int t = threadIdx.x; asm volatile("" : "+v"(t));
    F.lds = (LAS unsigned char*)lds_raw; F.ldsg = lds_raw;
    F.tid = t; F.lane = t & 63; F.wave = __builtin_amdgcn_readfirstlane(t >> 6);
    int g = gridDim.x, b = blockIdx.x; asm volatile("" : "+s"(g), "+s"(b));
    F.G = g; F.bid = b; F.gw = b * NWAVES + F.wave; F.NGW = g * NWAVES;
    unsigned char* ws = P.ws; float* out = P.out; asm volatile("" : "+s"(ws), "+s"(out));
    F.out = out; F.ws = ws;
    return F;
}
__device__ __forceinline__ void grid_bar(const Params& P, unsigned char* lds_raw) {
    unsigned char* ws = P.ws; asm volatile("" : "+s"(ws));
    XcdBarrier b; b.bar = (unsigned*)(ws + WS_CTL) + CW_BAR; b.x = xb_xcc_id(); b.st = (volatile LAS unsigned*)((LAS unsigned char*)lds_raw + MISC_OFF) + 8;
    xcd_barrier(b);
}
__global__ void __launch_bounds__(NTHREADS, 2) mega_fwd(Params P) {
    extern __shared__ __attribute__((aligned(16))) unsigned char lds_raw[];
    { const int tid = threadIdx.x;
      for (int u = tid; u < (LDS_BYTES - MISC_OFF) / 4; u += NTHREADS) ((LAS unsigned*)((LAS unsigned char*)lds_raw + MISC_OFF))[u] = 0u;
      __syncthreads();
      (void)xcd_barrier_post((unsigned*)(P.ws + WS_CTL) + CW_BAR, (volatile LAS unsigned*)((LAS unsigned char*)lds_raw + MISC_OFF) + 8); }
#define GRID_BAR() grid_bar(P, lds_raw)
    unsigned long long tacc = 0, t0 = 0; (void)tacc; (void)t0;
#define T_ON(id) do { if (PROBE_ID == (id)) t0 = __builtin_amdgcn_s_memrealtime(); } while (0)
#define T_OFF(id) do { if (PROBE_ID == (id)) { const unsigned long long t1 = __builtin_amdgcn_s_memrealtime(); tacc += t1 - t0; \
        if (blockIdx.x == PROBE_WG) { const unsigned long long tgt = t1 + 4ull * (t1 - t0); while (__builtin_amdgcn_s_memrealtime() < tgt) __builtin_amdgcn_s_sleep(8); } } } while (0)
#define FRAME() Frame F = make_frame(P, lds_raw); Ptrs p{F.out, (float*)(F.ws + WS_XC)}; (void)p

    T_ON(1); T_ON(11); T_ON(9);
    T_ON(111);
    { FRAME(); ph_mod(F, P); }
    T_OFF(111); T_ON(112);
    { FRAME(); constexpr int NCV = 9856, NMODWG = DEPTH * (MODW / 128);
      constexpr int NA1 = 1792;
      if (F.G == 256) { if (F.bid < 256 - NMODWG) { const int rk = F.bid * NWAVES + F.wave, nw = (256 - NMODWG) * NWAVES; ph_convert(F, P, 0, 0, NCV, rk, nw); ph_convert(F, P, 1, 0, NA1, rk, nw); }
                        else { const int rk = (F.bid - (256 - NMODWG)) * NWAVES + F.wave, nw = NMODWG * NWAVES; ph_convert(F, P, 1, NA1, NCV, rk, nw); } }
      else { ph_convert(F, P, 0, 0, NCV, F.gw, F.NGW); ph_convert(F, P, 1, 0, NCV, F.gw, F.NGW); } }
    T_OFF(112); T_ON(113);
    { FRAME(); ph_fold(F, P, 0, 0, 128); ph_fold(F, P, 1, 128, 128); }
    T_OFF(113); T_ON(114);
    { FRAME(); ph_fft_consts(F); ph_rope_table(F, P); }
    T_OFF(114);
    GRID_BAR(); T_OFF(11); T_ON(12);
    T_ON(121);
    { FRAME(); ph_first(F, P); }
    T_OFF(121); T_ON(122);
    { FRAME(); ph_bias(F, P, 0); ph_bias(F, P, 1); }
    T_OFF(122);
    GRID_BAR(); T_OFF(1); T_OFF(12);
#pragma unroll 1
    for (int l = 0; l < DEPTH; ++l) {
#pragma unroll 1
        for (int half = 0; half < 2; ++half) {
            const int sub = half * 2, f = half;
            if (half == 1) {
                T_ON(2); T_ON(23);
                { FRAME(); EpiUProj E{F.ws, l, (LAS float*)(F.lds + RSTD_TAB_OFF), 0};
                  run_gemm_normed(F, (const bf16*)(F.ws + WS_HB), (const bf16*)(F.ws + WS_WIN) + (size_t)l * DU * D, T, DU, D, E, (const float*)(F.ws + WS_SWIN) + (size_t)l * NR * DU); }
                { FRAME(); ph_gates(F, l); }
                GRID_BAR(); T_OFF(2); T_OFF(23); T_ON(3); T_ON(31);
                T_ON(311);
                { FRAME(); ph_mlstm_m1(F, P.in[13] + (size_t)l * 3 * 512, P.in[14] + l * 8, P.in[15] + l * 8); }
                T_OFF(311); T_ON(312);
                { FRAME(); ph_attn(F, P.in[12] + l * 8, l + 1 < DEPTH); }
                T_OFF(312); T_ON(313); T_ON(316);
                { FRAME(); ph_fft(F); }
                T_OFF(313); T_OFF(316);
                if (PROBE_ID == 315) { T_ON(315); { FRAME(); ph_fft(F); } T_OFF(315); }
                T_ON(314);
                { FRAME(); if (l + 1 < DEPTH) ph_ctx_dft(F); }
                T_OFF(314);
                GRID_BAR(); T_OFF(31); T_ON(32);
                { FRAME(); ph_mlstm_m2(F); }
                GRID_BAR(); T_OFF(32); T_ON(33);
                { FRAME(); ph_mlstm_m3(F, P.in[13] + (size_t)l * 3 * 512, P.in[14] + l * 8, P.in[15] + l * 8, l + 1 < DEPTH); }
                GRID_BAR(); T_OFF(3); T_OFF(33); T_ON(2); T_ON(24);
                { FRAME(); const bool ctx_piece = l + 1 < DEPTH, piece_first = (F.bid & 1) == 0;
                  if (ctx_piece && piece_first) ph_ctx_resid_gemm(F, (const bf16*)F.out, (const bf16*)(F.ws + WS_WOUT) + (size_t)l * D * D, D, nullptr, P.in[6] + ((size_t)l * 3 + 2) * D, l * NR * MODW + 5 * D, l * NR * MODW + 7 * D, 1.0f);
                  { EpiResid E{F.ws, nullptr, P.in[6] + ((size_t)l * 3 + 2) * D, l * NR * MODW + 5 * D, l * NR * MODW + 7 * D, 1.0f};
                    run_gemm(F, (const bf16*)F.out, (const bf16*)(F.ws + WS_WOUT) + (size_t)l * D * D, TL, D, D, E); }
                  if (ctx_piece && !piece_first) ph_ctx_resid_gemm(F, (const bf16*)F.out, (const bf16*)(F.ws + WS_WOUT) + (size_t)l * D * D, D, nullptr, P.in[6] + ((size_t)l * 3 + 2) * D, l * NR * MODW + 5 * D, l * NR * MODW + 7 * D, 1.0f); }
                GRID_BAR(); T_OFF(2); T_OFF(24);
            }
            T_ON(2); T_ON(21);
            { FRAME(); EpiSwiglu E{F.ws, l * 2 + f, (LAS float*)(F.lds + RSTD_TAB_OFF), 0};
              run_gemm_normed(F, (const bf16*)(F.ws + WS_HB), (const bf16*)(F.ws + WS_WI) + (size_t)(l * 2 + f) * 2 * DFF * D, T, 2 * DFF, D, E, (const float*)(F.ws + WS_SWFI) + (size_t)(l * 2 + f) * NR * 2 * DFF); }
            GRID_BAR(); T_OFF(21); T_ON(22);
            { FRAME();
              const bool has_next = (half == 0) || (l + 1 < DEPTH);
              const float* ngp = half == 0 ? P.in[6] + ((size_t)l * 3 + 1) * D : P.in[6] + ((size_t)(l + 1) * 3 + 0) * D;
              const int nsc = half == 0 ? l * NR * MODW + 4 * D : (l + 1) * NR * MODW + 1 * D;
              const bool first = (l == 0 && half == 0);
              const bool ctx_piece = (half == 0 || l + 1 < DEPTH); const bool piece_first = (F.bid & 1) == 0;
              if (ctx_piece && piece_first) ph_ctx_resid_gemm(F, (const bf16*)(F.ws + WS_R), (const bf16*)(F.ws + WS_WO) + (size_t)(l * 2 + f) * D * DFF, DFF, first ? P.in[2] : nullptr, has_next ? ngp : nullptr, l * NR * MODW + (3 * sub + 2) * D, nsc, 0.5f);
              { EpiResid E{F.ws, first ? P.in[0] : nullptr, has_next ? ngp : nullptr, l * NR * MODW + (3 * sub + 2) * D, nsc, 0.5f};
                run_gemm(F, (const bf16*)(F.ws + WS_R), (const bf16*)(F.ws + WS_WO) + (size_t)(l * 2 + f) * D * DFF, TL, D, DFF, E); }
              if (ctx_piece && !piece_first) ph_ctx_resid_gemm(F, (const bf16*)(F.ws + WS_R), (const bf16*)(F.ws + WS_WO) + (size_t)(l * 2 + f) * D * DFF, DFF, first ? P.in[2] : nullptr, has_next ? ngp : nullptr, l * NR * MODW + (3 * sub + 2) * D, nsc, 0.5f); }
            GRID_BAR(); T_OFF(2); T_OFF(22);
        }
    }
    if (PROBE_ID == 77) { GRID_BAR(); GRID_BAR(); GRID_BAR(); GRID_BAR(); GRID_BAR(); GRID_BAR(); GRID_BAR(); GRID_BAR(); }
    T_ON(4);
    { FRAME(); ph_final(F, P); }
    if (PROBE_ID == 4 || PROBE_ID == 9) { GRID_BAR(); T_OFF(4); T_OFF(9); GRID_BAR(); }
}
}

extern "C" void kernel_launch(void* const* d_in, const int* in_sizes, int n_in, void* d_out, int out_size, void* d_ws, size_t ws_size, hipStream_t stream) {
    static int grid = 0;
    if (grid == 0) {
        if (n_in != 17 || ws_size < WS_END) { fprintf(stderr, "kernel_launch: need 17 inputs and %zu bytes of workspace; got %d inputs, %zu bytes\n", (size_t)WS_END, n_in, ws_size); grid = -1; return; }
        int dev = 0, cus = 0, per_cu = 0;
        if (hipGetDevice(&dev) != hipSuccess || hipDeviceGetAttribute(&cus, hipDeviceAttributeMultiprocessorCount, dev) != hipSuccess) { grid = -1; return; }
        if (hipFuncSetAttribute((const void*)mega_fwd, hipFuncAttributeMaxDynamicSharedMemorySize, LDS_BYTES) != hipSuccess) { fprintf(stderr, "kernel_launch: hipFuncSetAttribute failed\n"); grid = -1; return; }
        if (hipOccupancyMaxActiveBlocksPerMultiprocessor(&per_cu, (const void*)mega_fwd, NTHREADS, LDS_BYTES) != hipSuccess || per_cu < 1) { fprintf(stderr, "kernel_launch: occupancy query says %d workgroups per CU\n", per_cu); (void)hipGetLastError(); grid = -1; return; }
        if (cus != 256) { fprintf(stderr, "kernel_launch: this kernel is laid out for a 256-CU device (got %d); nothing launched\n", cus); grid = -1; return; }
        grid = cus;
    }
    if (grid < 0) return;
    (void)hipMemsetAsync((char*)d_ws + WS_CTL, 0, CTL_ZERO_BYTES, stream);
    Params P{};
    for (int i = 0; i < 17; ++i) P.in[i] = (const float*)d_in[i];
    P.out = (float*)d_out; P.ws = (unsigned char*)d_ws;
    hipLaunchKernelGGL(mega_fwd, dim3(grid), dim3(NTHREADS), LDS_BYTES, stream, P);
}
```

```cpp
#include <hip/hip_runtime.h>
#include <cstdio>
#include <cstdint>
#ifndef PROBE_ID
#define PROBE_ID 0
#endif
#ifndef PROBE_WG
#define PROBE_WG 0
#endif
namespace pg8 {
#define PG8_LAS __attribute__((address_space(3)))
typedef unsigned short bf16_t;
typedef short bf16x8 __attribute__((ext_vector_type(8)));
typedef float f32x4 __attribute__((ext_vector_type(4)));
typedef unsigned u32x4 __attribute__((ext_vector_type(4)));
typedef _Float16 half8 __attribute__((ext_vector_type(8)));
constexpr int BM = 256, BK = 64, HALF = 128, HTB = HALF * BK * 2  , STAGE_BYTES = 8 * HTB, NXCD = 8, WGM = 8;

__host__ __device__ __forceinline__ int lds_byte(int r, int c) { const int st = (r >> 4) * 2 + (c >> 5), rr = r & 15, cc = c & 31, ob = rr * 64 + cc * 2; return st * 1024 + (ob ^ (((ob >> 9) & 1) << 5)); }
__host__ __device__ __forceinline__ void stage_rc(int b, int& R, int& C) { const int st = b / 1024, sb = b % 1024, swz = sb ^ (((sb >> 9) & 1) << 5); R = (st >> 1) * 16 + swz / 64; C = (st & 1) * 32 + (swz % 64) / 2; }
__host__ __device__ __forceinline__ int perm32(int rho) { const int n = rho >> 4, i = rho & 15; return 8 * (i >> 2) + 4 * n + (i & 3); }

struct Unit { int pm, pn; };
struct Gemm { const bf16_t* A; const bf16_t* Bt; int M, N, K; };

struct StaticOrder {
    int nM, nN, nwg, G, c;
    __host__ __device__ void init(int M, int N, int G_, int c_) { nM = M / BM; nN = N / BM; nwg = nM * nN; G = G_; c = c_; }
    __host__ __device__ bool next(int i, Unit& u) const {
        const long L = (long)i * G + c; if (L >= nwg) return false;
        int wgid = (int)L; { const int q = nwg / NXCD, r = nwg % NXCD, xcd = wgid % NXCD, off = wgid / NXCD; wgid = (xcd < r ? xcd * (q + 1) : r * (q + 1) + (xcd - r) * q) + off; }
        const int nig = WGM * nN, gid = wgid / nig, fm = gid * WGM, gsz = (nM - fm) < WGM ? (nM - fm) : WGM;
        u.pm = fm + ((wgid % nig) % gsz); u.pn = (wgid % nig) / gsz; return true;
    }
    __device__ __forceinline__ void a_ready(const Unit&) const {}
    __device__ __forceinline__ void done(const Unit&) const {}
};
template <class Epi, class Sched, bool ALIGN_EPI = false, bool SP2 = false>
__device__ __forceinline__ void gemm_phase(PG8_LAS unsigned char* lds, const Gemm g, const Sched& S, const Epi& E, const int tid  ) {
    const int wid = __builtin_amdgcn_readfirstlane(tid >> 6), lane = tid & 63, wr = wid >> 2, wc = wid & 3, fr = lane & 15, fq = lane >> 4;
    const int K = g.K, nt = K / BK;
    unsigned voffA[2], voffB[2];
#pragma unroll
    for (int i = 0; i < 2; ++i) { int R, C; stage_rc(tid * 16 + i * 8192, R, C); const int Rb = Epi::PERM ? ((R & ~31) + perm32(R & 31)) : R;
        voffA[i] = (unsigned)(R * K + C) * 2u; voffB[i] = (unsigned)(Rb * K + C) * 2u; }
    const size_t kstep = (size_t)(BK * 2);
    const size_t hstep = (size_t)HALF * K * 2;
    const size_t tstep = 2 * hstep;
    const unsigned ldsw = (unsigned)wid * 1024u;
    const int aoff = lds_byte(wr * 64 + fr, fq * 8), boff = lds_byte(wc * 32 + fr, fq * 8);
#define PG8_SA(b, h) (((b) * 2 + (h)) * HTB)
#define PG8_SB(b, h) ((4 + (b) * 2 + (h)) * HTB)
#define PG8_STAGE(bufoff, gbase, voff) do { _Pragma("unroll") for (int _i = 0; _i < 2; ++_i) \
        __builtin_amdgcn_global_load_lds((const unsigned*)((const char*)(gbase) + (voff)[_i]), (PG8_LAS unsigned*)(lds + (bufoff) + ldsw + _i * 8192), 16, 0, 0); } while (0)
#define PG8_LDA(dst, b, h) do { _Pragma("unroll") for (int m = 0; m < 4; ++m) _Pragma("unroll") for (int k = 0; k < 2; ++k) dst[m][k] = *(const PG8_LAS bf16x8*)(lds + PG8_SA(b, h) + aoff + m * 2048 + k * 1024); } while (0)
#define PG8_LDB(dst, b, h) do { _Pragma("unroll") for (int n = 0; n < 2; ++n) _Pragma("unroll") for (int k = 0; k < 2; ++k) dst[n][k] = *(const PG8_LAS bf16x8*)(lds + PG8_SB(b, h) + boff + n * 2048 + k * 1024); } while (0)
#define PG8_MMA(ai, bj, At, Bt) do { __builtin_amdgcn_s_setprio(1); _Pragma("unroll") for (int m = 0; m < 4; ++m) _Pragma("unroll") for (int n = 0; n < 2; ++n) _Pragma("unroll") for (int k = 0; k < 2; ++k) \
        acc[ai][bj][m][n] = __builtin_amdgcn_mfma_f32_16x16x32_f16(__builtin_bit_cast(half8, Bt[n][k]), __builtin_bit_cast(half8, At[m][k]), acc[ai][bj][m][n], 0, 0, 0); __builtin_amdgcn_s_setprio(0); } while (0)
#define PG8_WAIT_V(n) asm volatile("s_waitcnt vmcnt(" #n ")" ::: "memory")
#define PG8_WAIT_L(n) asm volatile("s_waitcnt lgkmcnt(" #n ")" ::: "memory")
#define PG8_BAR __builtin_amdgcn_s_barrier()
#define PG8_SCHED __builtin_amdgcn_sched_barrier(0)
    Unit cur, nxt; int ui = 0;
    if (!S.next(0, cur)) return;
    f32x4 acc[2][2][4][2];
#pragma unroll
    for (int a = 0; a < 2; ++a)
#pragma unroll
        for (int b = 0; b < 2; ++b)
#pragma unroll
            for (int m = 0; m < 4; ++m)
#pragma unroll
                for (int n = 0; n < 2; ++n) acc[a][b][m][n] = (f32x4){0.f, 0.f, 0.f, 0.f};
    bf16x8 At[4][2], B0[2][2], B1[2][2];
    const char* cA = (const char*)g.A + (size_t)cur.pm * tstep; const char* cB = (const char*)g.Bt + (size_t)cur.pn * tstep;
    S.a_ready(cur);
    if constexpr (SP2) {
        PG8_STAGE(PG8_SB(0, 0), cB, voffB); PG8_STAGE(PG8_SB(0, 1), cB + hstep, voffB); PG8_STAGE(PG8_SA(0, 0), cA, voffA); PG8_STAGE(PG8_SA(0, 1), cA + hstep, voffA);
        if (wr == 1) PG8_BAR;
        PG8_WAIT_V(2); PG8_BAR;
        PG8_STAGE(PG8_SB(1, 0), cB + kstep, voffB); PG8_STAGE(PG8_SA(1, 0), cA + kstep, voffA); PG8_STAGE(PG8_SB(1, 1), cB + hstep + kstep, voffB);
        PG8_WAIT_V(6); PG8_BAR;
    } else {
        PG8_STAGE(PG8_SB(0, 0), cB, voffB); PG8_STAGE(PG8_SA(0, 0), cA, voffA); PG8_STAGE(PG8_SB(0, 1), cB + hstep, voffB); PG8_STAGE(PG8_SA(0, 1), cA + hstep, voffA);
        if (wr == 1) PG8_BAR;
        PG8_WAIT_V(4); PG8_BAR;
        PG8_STAGE(PG8_SB(1, 0), cB + kstep, voffB); PG8_STAGE(PG8_SA(1, 0), cA + kstep, voffA); PG8_STAGE(PG8_SB(1, 1), cB + hstep + kstep, voffB);
        PG8_WAIT_V(6); PG8_BAR;
    }
    for (;;) {
        const bool has_next = S.next(ui + 1, nxt);
        const char* nA = has_next ? (const char*)g.A + (size_t)nxt.pm * tstep : cA; const char* nB = has_next ? (const char*)g.Bt + (size_t)nxt.pn * tstep : cB;
        for (int t = 0; t < nt; t += 2) {
            const bool last = (t == nt - 2);
            const char* a1 = cA + (size_t)(t + 1) * kstep;
            const char* a2 = last ? nA : cA + (size_t)(t + 2) * kstep; const char* b2 = last ? nB : cB + (size_t)(t + 2) * kstep;
            const char* a3 = a2 + kstep; const char* b3 = b2 + kstep;
            if (last && has_next) S.a_ready(nxt);
            if constexpr (SP2) {
            PG8_LDB(B0, 0, 0); PG8_LDB(B1, 0, 1); PG8_SCHED; PG8_LDA(At, 0, 0); PG8_STAGE(PG8_SA(1, 1), a1 + hstep, voffA);
            PG8_WAIT_V(8); PG8_WAIT_L(0); PG8_BAR; PG8_MMA(0, 0, At, B0); PG8_MMA(0, 1, At, B1); PG8_BAR; PG8_SCHED;
            PG8_LDA(At, 0, 1); PG8_STAGE(PG8_SB(0, 0), b2, voffB); PG8_STAGE(PG8_SB(0, 1), b2 + hstep, voffB); PG8_STAGE(PG8_SA(0, 0), a2, voffA);
            PG8_WAIT_V(8); PG8_WAIT_L(0); PG8_BAR; PG8_MMA(1, 0, At, B0); PG8_MMA(1, 1, At, B1); PG8_BAR; PG8_SCHED;
            PG8_LDB(B0, 1, 0); PG8_LDB(B1, 1, 1); PG8_SCHED; PG8_LDA(At, 1, 0); PG8_STAGE(PG8_SA(0, 1), a2 + hstep, voffA);
            PG8_WAIT_V(8); PG8_WAIT_L(0); PG8_BAR; PG8_MMA(0, 0, At, B0); PG8_MMA(0, 1, At, B1); PG8_BAR; PG8_SCHED;
            PG8_LDA(At, 1, 1); PG8_STAGE(PG8_SB(1, 0), b3, voffB); PG8_STAGE(PG8_SB(1, 1), b3 + hstep, voffB); PG8_STAGE(PG8_SA(1, 0), a3, voffA);
            PG8_WAIT_V(8); PG8_WAIT_L(0); PG8_BAR; PG8_MMA(1, 0, At, B0); PG8_MMA(1, 1, At, B1); PG8_BAR; PG8_SCHED;
            } else {
            PG8_LDB(B0, 0, 0); PG8_SCHED; PG8_LDA(At, 0, 0); PG8_STAGE(PG8_SA(1, 1), a1 + hstep, voffA);
            PG8_WAIT_L(8); PG8_BAR; PG8_WAIT_L(0); PG8_MMA(0, 0, At, B0); PG8_BAR; PG8_SCHED;
            PG8_LDB(B1, 0, 1); PG8_STAGE(PG8_SB(0, 0), b2, voffB);
            PG8_BAR; PG8_WAIT_L(0); PG8_MMA(0, 1, At, B1); PG8_BAR;
            PG8_LDA(At, 0, 1); PG8_STAGE(PG8_SA(0, 0), a2, voffA);
            PG8_BAR; PG8_WAIT_L(0); PG8_MMA(1, 0, At, B0); PG8_BAR; PG8_SCHED;
            PG8_STAGE(PG8_SB(0, 1), b2 + hstep, voffB);
            PG8_WAIT_V(6); PG8_BAR; PG8_MMA(1, 1, At, B1); PG8_BAR;
            PG8_LDB(B0, 1, 0); PG8_SCHED; PG8_LDA(At, 1, 0); PG8_STAGE(PG8_SA(0, 1), a2 + hstep, voffA);
            PG8_WAIT_L(8); PG8_BAR; PG8_WAIT_L(0); PG8_MMA(0, 0, At, B0); PG8_BAR; PG8_SCHED;
            PG8_LDB(B1, 1, 1); PG8_STAGE(PG8_SB(1, 0), b3, voffB);
            PG8_BAR; PG8_WAIT_L(0); PG8_MMA(0, 1, At, B1); PG8_BAR;
            PG8_LDA(At, 1, 1); PG8_STAGE(PG8_SA(1, 0), a3, voffA);
            PG8_BAR; PG8_WAIT_L(0); PG8_MMA(1, 0, At, B0); PG8_BAR; PG8_SCHED;
            PG8_STAGE(PG8_SB(1, 1), b3 + hstep, voffB);
            PG8_WAIT_V(6); PG8_BAR; PG8_MMA(1, 1, At, B1); PG8_BAR;
            }
        }
        if constexpr (ALIGN_EPI) { if (wr == 0) PG8_BAR; }
        if constexpr (!Epi::AFTER_DRAIN) { E(acc, cur, wr, wc, fr, fq); S.done(cur); }
        if (!has_next) break;
#pragma unroll
        for (int a = 0; a < 2; ++a)
#pragma unroll
            for (int b = 0; b < 2; ++b)
#pragma unroll
                for (int m = 0; m < 4; ++m)
#pragma unroll
                    for (int n = 0; n < 2; ++n) acc[a][b][m][n] = (f32x4){0.f, 0.f, 0.f, 0.f};
        cur = nxt; cA = nA; cB = nB; ++ui;
        if constexpr (ALIGN_EPI) { if (wr == 1) PG8_BAR; }
    }
    PG8_WAIT_V(0);
    if constexpr (!ALIGN_EPI) { if (wr == 0) PG8_BAR; }
    PG8_BAR;
    if constexpr (Epi::AFTER_DRAIN) { E.fused(acc, cur, wr, wc, fr, fq, lds, wid, lane); S.done(cur); }
#undef PG8_SA
#undef PG8_SB
#undef PG8_STAGE
#undef PG8_LDA
#undef PG8_LDB
#undef PG8_MMA
#undef PG8_WAIT_V
#undef PG8_WAIT_L
#undef PG8_BAR
#undef PG8_SCHED
}
}

namespace {
#define LAS __attribute__((address_space(3)))
#define GAS __attribute__((address_space(1)))
typedef unsigned short bf16;
typedef unsigned v4u __attribute__((ext_vector_type(4)));
typedef GAS unsigned gu32;
typedef float v2f __attribute__((ext_vector_type(2)));
constexpr int D = 1024, NB = 4, SEQ = 4096, CTX = 256, DEPTH = 2;
constexpr int TL = NB * SEQ, TC = NB * CTX, T = TL + TC;
constexpr int DFF = 2816, DIN = 2064, DU = 2304, NMOD = 9, MODW = NMOD * D;
constexpr int NR = NB + 1;
constexpr float EPS = 1e-6f;
constexpr int C_GA = 0, C_GB = 256, C_Q = 512, C_K = 1024, C_V = 1152, C_MQ = 1280, C_MK = 1536, C_MV = 1792, C_MO = 2048;
constexpr int SRC_COL0 = 256, SRC_GATE = 2048;
constexpr int NWAVES = 8, NTHREADS = 512;
constexpr int RING_BYTES = 131072, MISC_OFF = RING_BYTES, LDS_BYTES = 147456;
constexpr size_t al256(size_t x) { return (x + 255) & ~(size_t)255; }
constexpr size_t WS_CTL = 0, CTL_ZERO_BYTES = 65536;
constexpr int CW_BAR = 1024;
constexpr size_t WS_MOD = 1u << 20;
constexpr size_t WS_WI = al256(WS_MOD + (size_t)DEPTH * NR * MODW * 4);
constexpr size_t WS_WO = al256(WS_WI + (size_t)4 * 2 * DFF * D * 2);
constexpr size_t WS_WIN = al256(WS_WO + (size_t)4 * D * DFF * 2);
constexpr size_t WS_WOUT = al256(WS_WIN + (size_t)2 * DU * D * 2);
constexpr size_t WS_XC = al256(WS_WOUT + (size_t)2 * D * D * 2);
constexpr size_t WS_G = al256(WS_XC + (size_t)TC * D * 4);
constexpr size_t WS_HB = al256(WS_G + (size_t)T * 16 * 4);
constexpr size_t WS_X16 = al256(WS_HB + (size_t)T * D * 2);
constexpr size_t WS_Y_UNUSED = WS_X16;
constexpr size_t WS_R = al256(WS_X16 + (size_t)T * D * 2);
constexpr size_t WS_HS = al256(WS_R + (size_t)T * DFF * 2);
constexpr size_t WS_NL = al256(WS_HS + (size_t)2 * T * 256 * 4);
constexpr size_t WS_AM = al256(WS_NL + (size_t)32 * 68 * 64 * 4);
constexpr size_t WS_MS = al256(WS_AM + (size_t)32 * 68 * 2 * 4);
constexpr size_t WS_FM1 = al256(WS_MS + (size_t)32 * 68 * 4);
constexpr size_t WS_FM3 = al256(WS_FM1 + 128 * 128 * 2);
constexpr size_t WS_TW = al256(WS_FM3 + 64 * 128 * 2);
constexpr size_t WS_CT = al256(WS_TW + 4096 * 8);
constexpr size_t WS_RS = al256(WS_CT + 256 * 8);
constexpr size_t WS_SWFI = al256(WS_RS + (size_t)T * 16 * 4);
constexpr size_t WS_SWIN = al256(WS_SWFI + (size_t)4 * NR * 2 * DFF * 4);
constexpr size_t WS_SWG = al256(WS_SWIN + (size_t)2 * NR * DU * 4);
constexpr size_t WS_ROPE = al256(WS_SWG + (size_t)2 * NR * 16 * 4);
constexpr size_t WS_WGT = al256(WS_ROPE + 64 * 16 * 8);
constexpr size_t WS_DMC = al256(WS_WGT + (size_t)DEPTH * 32 * D * 2);
constexpr size_t WS_PROBE = al256(WS_DMC + 256 * 512 * 2);
constexpr size_t WS_NS2 = al256(WS_PROBE + 256);
constexpr size_t WS_MS2 = al256(WS_NS2 + (size_t)32 * 68 * 64 * 4);
constexpr size_t WS_END = al256(WS_MS2 + (size_t)32 * 68 * 4);

struct Ptrs { float* xl; float* xc; };
__device__ __forceinline__ int mod_row(int r) { return r < TL ? r / SEQ : NB; }
__device__ __forceinline__ float* xrow(const Ptrs& p, int r) { return r < TL ? p.xl + (size_t)r * D : p.xc + (size_t)(r - TL) * D; }
__device__ __forceinline__ float silu_f(float x) { return x / (1.f + expf(-x)); }
__device__ __forceinline__ float sigmoid_f(float x) { return 1.f / (1.f + expf(-x)); }
__device__ __forceinline__ float logsigmoid_f(float x) { return fminf(x, 0.f) - log1pf(expf(-fabsf(x))); }
__device__ __forceinline__ float bf2f(bf16 b) { return (float)__builtin_bit_cast(_Float16, b); }
__device__ __forceinline__ unsigned f2bf(float f) { return (unsigned)__builtin_bit_cast(unsigned short, (_Float16)f); }
__device__ __forceinline__ unsigned pk2(float lo, float hi) { return f2bf(lo) | (f2bf(hi) << 16); }
__device__ __forceinline__ float lane_xor(float v, int lane, int o) { return __int_as_float(__builtin_amdgcn_ds_bpermute((lane ^ o) << 2, __float_as_int(v))); }
__device__ __forceinline__ float lane_get(float v, int src) { return __int_as_float(__builtin_amdgcn_ds_bpermute(src << 2, __float_as_int(v))); }
__device__ __forceinline__ float wave_sum(float v, int lane) {
#pragma unroll
    for (int o = 1; o < 64; o <<= 1) v += lane_xor(v, lane, o);
    return v; }
#define RLX_AGENT __ATOMIC_RELAXED, __HIP_MEMORY_SCOPE_AGENT
struct Params { const float* in[17]; float* out; unsigned char* ws; };
typedef _Float16 half8 __attribute__((ext_vector_type(8)));
typedef _Float16 half4 __attribute__((ext_vector_type(4)));
typedef float f32x16 __attribute__((ext_vector_type(16)));
typedef float f32x4v __attribute__((ext_vector_type(4)));

using pg8::half8; using pg8::f32x4; using pg8::u32x4; using pg8::Unit; using pg8::bf16_t; using pg8::BM; using pg8::HALF;
__device__ __forceinline__ unsigned cvt_pk_bf16(float lo, float hi) { typedef float f2_t __attribute__((ext_vector_type(2))); typedef _Float16 h2_t __attribute__((ext_vector_type(2))); const f2_t v = {lo, hi}; return __builtin_bit_cast(unsigned, __builtin_convertvector(v, h2_t)); }
__device__ __forceinline__ float silu_fast(float x) { return x * __builtin_amdgcn_rcpf(1.f + __expf(-x)); }
__device__ __forceinline__ float rstd_row(const float* rowss, int row) {
    const f32x4 a = *(const f32x4*)(rowss + (size_t)row * 16), b = *(const f32x4*)(rowss + (size_t)row * 16 + 4), c = *(const f32x4*)(rowss + (size_t)row * 16 + 8), d = *(const f32x4*)(rowss + (size_t)row * 16 + 12);
    const f32x4 s = (a + b) + (c + d); return __builtin_amdgcn_rsqf(((s[0] + s[1]) + (s[2] + s[3])) * (1.f / 1024.f) + 1e-6f); }
typedef unsigned u32x2e __attribute__((ext_vector_type(2)));
constexpr int RSTD_TAB_OFF = MISC_OFF + 1024;
constexpr int BIAS_TAB_OFF = RSTD_TAB_OFF + 2048;
struct RstdOrder : pg8::StaticOrder {
    const float* rowss; LAS float* tab; int tid; mutable int cnt; const float* sw; int ncols;
    __device__ __forceinline__ void a_ready(const Unit& u) const { const int par = cnt & 1; ++cnt;
        if (tid < 256) tab[par * 256 + tid] = rstd_row(rowss, u.pm * BM + tid);
        else if (tid < 320) { const int mr = u.pm < TL / 256 ? u.pm / (SEQ / 256) : 4; *(LAS f32x4*)(tab + 512 + par * 256 + (tid - 256) * 4) = *(const f32x4*)(sw + (size_t)mr * ncols + u.pn * BM + (tid - 256) * 4); } }
};

struct EpiSwiglu {
    static constexpr bool PERM = true, AFTER_DRAIN = false;
    unsigned char* ws; int mat; LAS float* tab; mutable int cnt;
    __device__ __forceinline__ void operator()(const f32x4 (&acc)[2][2][4][2], const Unit& u, int wr, int wc, int fr, int fq) const {
        bf16_t* O = (bf16_t*)(ws + WS_R); constexpr int ldc = DFF;
        const LAS float* rt = tab + (cnt & 1) * 256 + wr * 64 + fr;
        const int row0 = u.pm * BM + wr * 64 + fr, col0 = u.pn * HALF + wc * 32 + 8 * fq;
        const LAS float* bs = tab + 512 + (cnt & 1) * 256 + wc * 32 + 8 * fq;
        const f32x4 bg0 = *(const LAS f32x4*)bs, bg1 = *(const LAS f32x4*)(bs + 4), bu0 = *(const LAS f32x4*)(bs + HALF), bu1 = *(const LAS f32x4*)(bs + HALF + 4); ++cnt;
#pragma unroll
        for (int ai = 0; ai < 2; ++ai)
#pragma unroll
            for (int m = 0; m < 4; ++m) { const int row = row0 + ai * HALF + m * 16; const float rs = rt[ai * HALF + m * 16]; bf16_t* rowp = O + (size_t)row * ldc + col0;
                const f32x4 g0 = acc[ai][0][m][0] * rs + bg0, g1 = acc[ai][0][m][1] * rs + bg1, u0 = acc[ai][1][m][0] * rs + bu0, u1 = acc[ai][1][m][1] * rs + bu1;
                f32x4 h0, h1;
#pragma unroll
                for (int i = 0; i < 4; ++i) { h0[i] = silu_fast(g0[i]) * u0[i]; h1[i] = silu_fast(g1[i]) * u1[i]; }
                u32x4 w; w.x = cvt_pk_bf16(h0[0], h0[1]); w.y = cvt_pk_bf16(h0[2], h0[3]); w.z = cvt_pk_bf16(h1[0], h1[1]); w.w = cvt_pk_bf16(h1[2], h1[3]);
                *(u32x4*)rowp = w; }
    }
};
struct EpiUProj {
    static constexpr bool PERM = true, AFTER_DRAIN = false;
    unsigned char* ws; int l; LAS float* tab; mutable int cnt;
    __device__ __forceinline__ void operator()(const f32x4 (&acc)[2][2][4][2], const Unit& u, int wr, int wc, int fr, int fq) const {
        bf16_t* O = (bf16_t*)(ws + WS_R); constexpr int ldc = DU, tl_panels = TL / 256; constexpr float qscale = 0.125f * 1.4426950408889634f;
        const float* rope = (const float*)(ws + WS_ROPE);
        const LAS float* rt = tab + (cnt & 1) * 256 + wr * 64 + fr; const LAS float* bs = tab + 512 + (cnt & 1) * 256 + wc * 32 + 8 * fq; ++cnt;
        const int row0 = u.pm * BM + wr * 64 + fr, col0 = u.pn * BM + wc * 32 + 8 * fq; const bool lat = u.pm < tl_panels;
        f32x4 bv[2][2];
#pragma unroll
        for (int bj = 0; bj < 2; ++bj)
#pragma unroll
            for (int n = 0; n < 2; ++n) bv[bj][n] = *(const LAS f32x4*)(bs + bj * HALF + n * 4);
        const bool isq = (u.pn == 2 || u.pn == 3); const bool isk = (u.pn == 4); const bool upper = fq >= 2;
#pragma unroll
        for (int ai = 0; ai < 2; ++ai)
#pragma unroll
            for (int m = 0; m < 4; ++m) { const int row = row0 + ai * HALF + m * 16; const float rs = rt[ai * HALF + m * 16]; bf16_t* rowp = O + (size_t)row * ldc + col0;
                f32x4 v[2][2];
#pragma unroll
                for (int bj = 0; bj < 2; ++bj)
#pragma unroll
                    for (int n = 0; n < 2; ++n) v[bj][n] = acc[ai][bj][m][n] * rs + bv[bj][n];
                if (isq || isk) {
                    if (lat) { const int pos = row & 4095; const int p = (wc & 1) ? (pos & 63) : (pos >> 6); const float* rp = rope + (size_t)(p * 16 + 8 * (fq & 1)) * 2;
                        const f32x4 cs0 = *(const f32x4*)rp, cs1 = *(const f32x4*)(rp + 4), cs2 = *(const f32x4*)(rp + 8), cs3 = *(const f32x4*)(rp + 12);
                        const f32x4 cc[2] = {{cs0[0], cs0[2], cs1[0], cs1[2]}, {cs2[0], cs2[2], cs3[0], cs3[2]}}, ss[2] = {{cs0[1], cs0[3], cs1[1], cs1[3]}, {cs2[1], cs2[3], cs3[1], cs3[3]}};
#pragma unroll
                        for (int bj = 0; bj < 2; ++bj) if (isq || bj == 0) {
#pragma unroll
                            for (int n = 0; n < 2; ++n) { f32x4 pv;
#pragma unroll
                                for (int i = 0; i < 4; ++i) { const unsigned xv = __float_as_uint(v[bj][n][i]); const auto sw = __builtin_amdgcn_permlane32_swap(xv, xv, false, false); pv[i] = __uint_as_float(upper ? sw[0] : sw[1]); }
                                v[bj][n] = upper ? (v[bj][n] * cc[n] + pv * ss[n]) : (v[bj][n] * cc[n] - pv * ss[n]); } } }
                    if (isq) {
#pragma unroll
                        for (int bj = 0; bj < 2; ++bj) { v[bj][0] = v[bj][0] * qscale; v[bj][1] = v[bj][1] * qscale; } } }
#pragma unroll
                for (int bj = 0; bj < 2; ++bj) { u32x4 w; w.x = cvt_pk_bf16(v[bj][0][0], v[bj][0][1]); w.y = cvt_pk_bf16(v[bj][0][2], v[bj][0][3]); w.z = cvt_pk_bf16(v[bj][1][0], v[bj][1][1]); w.w = cvt_pk_bf16(v[bj][1][2], v[bj][1][3]);
                    *(u32x4*)(rowp + bj * HALF) = w; } }
    }
};
struct EpiResid {
    static constexpr bool PERM = true, AFTER_DRAIN = false;
    unsigned char* ws; const float* xsrc32; const float* ng; int gate_off, nscale_off; float coef;
    __device__ __forceinline__ void operator()(const f32x4 (&acc)[2][2][4][2], const Unit& u, int wr, int wc, int fr, int fq) const {
        constexpr int ppb = SEQ / 256, mod_stride = MODW; const float* gate = (const float*)(ws + WS_MOD) + gate_off; const float* nscale = (const float*)(ws + WS_MOD) + nscale_off;
        bf16_t* hraw = (bf16_t*)(ws + WS_HB); float* rowss = (float*)(ws + WS_RS); bf16_t* x16 = (bf16_t*)(ws + WS_X16);
        const int prow = u.pm * BM; const int mr = u.pm / ppb;
        const int row0 = wr * 64 + fr, col0 = u.pn * BM + wc * 32 + 8 * fq;
        float ssq[2][4];
#pragma unroll
        for (int ai = 0; ai < 2; ++ai)
#pragma unroll
            for (int m = 0; m < 4; ++m) ssq[ai][m] = 0.f;
#pragma unroll
        for (int bj = 0; bj < 2; ++bj) { const int c = col0 + bj * HALF;
            const f32x4 gv0 = *(const f32x4*)(gate + (size_t)mr * mod_stride + c) * coef, gv1 = *(const f32x4*)(gate + (size_t)mr * mod_stride + c + 4) * coef;
            f32x4 hs0 = {0.f, 0.f, 0.f, 0.f}, hs1 = hs0;
            if (ng) { hs0 = *(const f32x4*)(ng + c) * (*(const f32x4*)(nscale + (size_t)mr * mod_stride + c) + 1.f); hs1 = *(const f32x4*)(ng + c + 4) * (*(const f32x4*)(nscale + (size_t)mr * mod_stride + c + 4) + 1.f); }
#pragma unroll
            for (int ai = 0; ai < 2; ++ai)
#pragma unroll
                for (int m = 0; m < 4; ++m) { const int rl = row0 + ai * HALF + m * 16; const size_t off = (size_t)(prow + rl) * 1024 + c;
                    f32x4 xo0, xo1;
                    if (xsrc32) { xo0 = *(const f32x4*)(xsrc32 + off); xo1 = *(const f32x4*)(xsrc32 + off + 4); }
                    else { const half8 hx = __builtin_bit_cast(half8, *(const u32x4*)(x16 + off)); xo0 = (f32x4){(float)hx[0], (float)hx[1], (float)hx[2], (float)hx[3]}; xo1 = (f32x4){(float)hx[4], (float)hx[5], (float)hx[6], (float)hx[7]}; }
                    const f32x4 x0 = xo0 + gv0 * acc[ai][bj][m][0], x1 = xo1 + gv1 * acc[ai][bj][m][1];
                    { u32x4 w; w.x = cvt_pk_bf16(x0[0], x0[1]); w.y = cvt_pk_bf16(x0[2], x0[3]); w.z = cvt_pk_bf16(x1[0], x1[1]); w.w = cvt_pk_bf16(x1[2], x1[3]); *(u32x4*)(x16 + off) = w; }
                    ssq[ai][m] += ((x0[0] * x0[0] + x0[1] * x0[1]) + (x0[2] * x0[2] + x0[3] * x0[3])) + ((x1[0] * x1[0] + x1[1] * x1[1]) + (x1[2] * x1[2] + x1[3] * x1[3]));
                    if (ng) { const f32x4 h0 = x0 * hs0, h1 = x1 * hs1; u32x4 w; w.x = cvt_pk_bf16(h0[0], h0[1]); w.y = cvt_pk_bf16(h0[2], h0[3]); w.z = cvt_pk_bf16(h1[0], h1[1]); w.w = cvt_pk_bf16(h1[2], h1[3]); *(u32x4*)(hraw + off) = w; } } }
        const int lane = fq * 16 + fr;
#pragma unroll
        for (int ai = 0; ai < 2; ++ai)
#pragma unroll
            for (int m = 0; m < 4; ++m) { float q = ssq[ai][m];
                q += __int_as_float(__builtin_amdgcn_ds_bpermute((lane ^ 16) << 2, __float_as_int(q)));
                q += __int_as_float(__builtin_amdgcn_ds_bpermute((lane ^ 32) << 2, __float_as_int(q)));
                if (fq == 0) rowss[(size_t)(prow + row0 + ai * HALF + m * 16) * 16 + u.pn * 4 + wc] = q; }
    }
};
#define XB_TMO      128
#define XB_XCNT(j)  (256  + 64 * (j))
#define XB_XSUB(j)  (1280 + 64 * (j))
#define XB_XGEN(j)  (2304 + 64 * (j))
#define XB_TOP      3328
#define XB_TOPGEN   3392
#define XCD_BAR_WORDS 3456
#define XB_SPIN_CAP (1u << 18)

__device__ __forceinline__ unsigned xb_ld(unsigned* p)              { return __hip_atomic_load(p, __ATOMIC_RELAXED, __HIP_MEMORY_SCOPE_AGENT); }
__device__ __forceinline__ unsigned xb_add(unsigned* p, unsigned v) { return __hip_atomic_fetch_add(p, v, __ATOMIC_RELAXED, __HIP_MEMORY_SCOPE_AGENT); }
__device__ __forceinline__ unsigned xb_xcc_id() { return (unsigned)__builtin_amdgcn_s_getreg((3 << 11) | 20) & 0xFu; }
#define XB_SPIN(cond, bar) do { unsigned _sp = 0; while (cond) { __builtin_amdgcn_s_sleep(1); \
    if ((++_sp & 255u) == 0u) { if (xb_ld(&(bar)[XB_TMO])) break; if (_sp > XB_SPIN_CAP) { atomicAdd(&(bar)[XB_TMO], 1u); break; } } } } while (0)

struct XcdBarrier {
    unsigned* bar; unsigned x;
    volatile LAS unsigned* st;
};

__device__ __forceinline__ XcdBarrier xcd_barrier_post(unsigned* bar, volatile LAS unsigned* st) {
    XcdBarrier b; b.bar = bar; b.x = xb_xcc_id(); b.st = st;
    if (threadIdx.x == 0) (void)xb_add(&bar[XB_XCNT(b.x)], 1u);
    return b;
}
__device__ __forceinline__ void xcd_barrier_complete(unsigned* bar, unsigned x, unsigned& nloc, unsigned& nx) {
    const unsigned G = gridDim.x * gridDim.y * gridDim.z;
    unsigned sum, cnt, mine, sp = 0u;
    for (;;) {
        sum = 0u; cnt = 0u; mine = 0u;
#pragma unroll
        for (unsigned j = 0; j < 16; ++j) { const unsigned c = xb_ld(&bar[XB_XCNT(j)]); sum += c; cnt += (c > 0u) ? 1u : 0u; mine = (j == x) ? c : mine; }
        if (sum == G) break;
        __builtin_amdgcn_s_sleep(1);
        if ((++sp & 255u) == 0u) { if (xb_ld(&bar[XB_TMO])) break; if (sp > XB_SPIN_CAP) { atomicAdd(&bar[XB_TMO], 1u); break; } }
    }
    nloc = mine > 0u ? mine : 1u; nx = cnt > 0u ? cnt : 1u;
}

__device__ __forceinline__ void xcd_barrier(const XcdBarrier& b) {
    asm volatile("s_waitcnt vmcnt(0)" ::: "memory");
    __syncthreads();
    if (threadIdx.x == 0) {
        unsigned* bar = b.bar;
        __builtin_amdgcn_s_waitcnt(0);
        unsigned nloc = b.st[0], nx = b.st[1];
        if (nloc == 0u) { xcd_barrier_complete(bar, b.x, nloc, nx); b.st[0] = nloc; b.st[1] = nx; }
        const unsigned old = xb_add(&bar[XB_XSUB(b.x)], 1u);
        const unsigned gen = old / nloc;
        if (old + 1u == (gen + 1u) * nloc) {
            __builtin_amdgcn_fence(__ATOMIC_RELEASE, "agent");
            asm volatile("s_waitcnt vmcnt(0)" ::: "memory");
            const unsigned og = xb_add(&bar[XB_TOP], 1u);
            const unsigned tg = og / nx;
            if (og + 1u == (tg + 1u) * nx) xb_add(&bar[XB_TOPGEN], 1u);
            else XB_SPIN(xb_ld(&bar[XB_TOPGEN]) == tg, bar);
            __builtin_amdgcn_fence(__ATOMIC_ACQUIRE, "agent");
            xb_add(&bar[XB_XGEN(b.x)], 1u);
            asm volatile("s_waitcnt vmcnt(0)" ::: "memory");
        } else {
            XB_SPIN(xb_ld(&bar[XB_XGEN(b.x)]) == gen, bar);
            __builtin_amdgcn_fence(__ATOMIC_ACQUIRE, "agent");
            asm volatile("s_waitcnt vmcnt(0)" ::: "memory");
        }
    }
    __syncthreads();
}

struct Frame {
    LAS unsigned char* lds; unsigned char* ldsg;
    int tid, lane, wave, G, bid, gw, NGW;
    float* out; unsigned char* ws;
};

__device__ __forceinline__ void ph_mod(Frame& F, const Params& P) {
    const float* c = P.in[1]; const float* cctx = P.in[3]; const float* w_ada = P.in[4]; const float* b_ada = P.in[5]; float* MOD = (float*)(F.ws + WS_MOD);
    float* s = (float*)F.ldsg; float* red = s + NR * D;
    constexpr int NMODIT = DEPTH * (MODW / 128); const int mb = F.bid - (F.G - NMODIT);
    if (mb >= 0) { for (int i = F.tid; i < NR * D; i += NTHREADS) { const int r = i / D, k = i % D; const float v = r < NB ? c[r * D + k] : cctx[k]; s[i] = silu_f(v); } }
    for (int it = mb; it >= 0 && it < NMODIT; it += F.G) {
        const int l = it / (MODW / 128), j = (it % (MODW / 128)) * 128 + 2 * F.lane;
        __syncthreads();
        float a0[NR], a1[NR];
#pragma unroll
        for (int r = 0; r < NR; ++r) { a0[r] = 0.f; a1[r] = 0.f; }
        const float* w = w_ada + ((size_t)l * D + 128 * F.wave) * MODW + j;
#pragma unroll 16
        for (int k = 0; k < 128; ++k) { const float2 wv = *(const float2*)(w + (size_t)k * MODW);
#pragma unroll
            for (int r = 0; r < NR; ++r) { const float sv = s[r * D + 128 * F.wave + k]; a0[r] += sv * wv.x; a1[r] += sv * wv.y; } }
#pragma unroll
        for (int r = 0; r < NR; ++r) { red[(F.wave * NR + r) * 128 + 2 * F.lane] = a0[r]; red[(F.wave * NR + r) * 128 + 2 * F.lane + 1] = a1[r]; }
        __syncthreads();
        for (int idx = F.tid; idx < NR * 128; idx += NTHREADS) { const int r = idx >> 7, cc = idx & 127; float a = 0.f;
#pragma unroll
            for (int w8 = 0; w8 < 8; ++w8) a += red[(w8 * NR + r) * 128 + cc];
            const int jj = (it % (MODW / 128)) * 128 + cc; MOD[((size_t)l * NR + r) * MODW + jj] = a + b_ada[l * MODW + jj]; }
    }
    __syncthreads();
}
__device__ __forceinline__ void transpose_item(const float* W, int ldw, int K, bf16* WT, int dst_row0, int k0, int n0, LAS float* scr, int lane) {
#pragma unroll
    for (int i = 0; i < 8; ++i) { const int kk = 8 * i + (lane >> 3), nq = (lane & 7) * 4; const float4 v = *(const float4*)(W + (size_t)(k0 + kk) * ldw + n0 + nq);
        scr[kk * 33 + nq] = v.x; scr[kk * 33 + nq + 1] = v.y; scr[kk * 33 + nq + 2] = v.z; scr[kk * 33 + nq + 3] = v.w; }
    asm volatile("s_waitcnt lgkmcnt(0)" ::: "memory");
    const int c = lane & 7;
#pragma unroll
    for (int j = 0; j < 4; ++j) { const int n = (lane >> 3) + 8 * j; const LAS float* s = scr + (8 * c) * 33 + n;
        v4u o; o.x = pk2(s[0 * 33], s[1 * 33]); o.y = pk2(s[2 * 33], s[3 * 33]); o.z = pk2(s[4 * 33], s[5 * 33]); o.w = pk2(s[6 * 33], s[7 * 33]);
        *(v4u*)(WT + (size_t)(dst_row0 + n) * K + k0 + 8 * c) = o; }
    asm volatile("s_waitcnt lgkmcnt(0)" ::: "memory");
}
__device__ __forceinline__ void ph_convert(Frame& F, const Params& P, int l, int it0, int it1, int rank, int nw) {
    const float* w_ffn_in = P.in[7]; const float* w_ffn_out = P.in[8]; const float* w_in = P.in[9]; const float* w_out = P.in[10];
    bf16* Wi_t = (bf16*)(F.ws + WS_WI); bf16* Wo_t = (bf16*)(F.ws + WS_WO); bf16* Win_t = (bf16*)(F.ws + WS_WIN); bf16* Wout_t = (bf16*)(F.ws + WS_WOUT);
    LAS float* scr = (LAS float*)(F.lds + F.wave * 16384);
    constexpr int NSRC = SRC_GATE - SRC_COL0; constexpr int I_FI = (D / 64) * (2 * DFF / 32), I_FO = (DFF / 64) * (D / 32), I_IN = (D / 64) * (NSRC / 32), I_OUT = (D / 64) * (D / 32);
    constexpr int NITEMS = 2 * I_FI + 2 * I_FO + I_IN + I_OUT;
    if (it1 > NITEMS) it1 = NITEMS;
    for (int it = it0 + rank; it < it1; it += nw) {
        int r = it;
        if (r < 2 * I_FI) { const int mat = 2 * l + r / I_FI; r %= I_FI; const int nblk = 2 * DFF / 32, kb = r / nblk, nb = r % nblk, n0 = 32 * nb;
            const int nn = n0 < DFF ? n0 : n0 - DFF; const int drow = 256 * (nn / 128) + (n0 < DFF ? 0 : 128) + (nn % 128);
            transpose_item(w_ffn_in + (size_t)mat * D * 2 * DFF, 2 * DFF, D, Wi_t + (size_t)mat * 2 * DFF * D, drow, 64 * kb, n0, scr, F.lane); continue; }
        r -= 2 * I_FI;
        if (r < 2 * I_FO) { const int mat = 2 * l + r / I_FO; r %= I_FO; const int nblk = D / 32, kb = r / nblk, nb = r % nblk;
            transpose_item(w_ffn_out + (size_t)mat * DFF * D, D, DFF, Wo_t + (size_t)mat * D * DFF, 32 * nb, 64 * kb, 32 * nb, scr, F.lane); continue; }
        r -= 2 * I_FO;
        if (r < I_IN) { const int nblk = NSRC / 32, kb = r / nblk, nb = r % nblk;
            transpose_item(w_in + (size_t)l * D * DIN, DIN, D, Win_t + (size_t)l * DU * D, 512 + 32 * nb, 64 * kb, SRC_COL0 + 32 * nb, scr, F.lane); continue; }
        r -= I_IN;
        { const int nblk = D / 32, kb = r / nblk, nb = r % nblk;
            transpose_item(w_out + (size_t)l * D * D, D, D, Wout_t + (size_t)l * D * D, 32 * nb, 64 * kb, 32 * nb, scr, F.lane); }
    }
}
__device__ __forceinline__ void ph_first(Frame& F, const Params& P) {
    const float* xin = P.in[0]; const float* cin = P.in[2]; const float* g = P.in[6]; const float* MOD = (const float*)(F.ws + WS_MOD);
    bf16* H = (bf16*)(F.ws + WS_HB); float* RS = (float*)(F.ws + WS_RS);
    constexpr int RB = 4;
    for (int r0 = F.gw * RB; r0 < T; r0 += F.NGW * RB) {
        float4 v[RB][4];
#pragma unroll
        for (int i = 0; i < RB; ++i) { const int r = r0 + i; const float* src = r < TL ? xin + (size_t)r * D : cin + (size_t)(r - TL) * D;
#pragma unroll
            for (int j = 0; j < 4; ++j) v[i][j] = ((const float4*)src)[F.lane + 64 * j]; }
        const int mr = mod_row(r0);
        float4 gs[4];
#pragma unroll
        for (int j = 0; j < 4; ++j) { const int q = F.lane + 64 * j; const float4 gv = ((const float4*)g)[q], sc = ((const float4*)(MOD + (size_t)mr * MODW + 1 * D))[q]; gs[j] = make_float4(gv.x * (1.f + sc.x), gv.y * (1.f + sc.y), gv.z * (1.f + sc.z), gv.w * (1.f + sc.w)); }
        float ss[RB];
#pragma unroll
        for (int i = 0; i < RB; ++i) { const int r = r0 + i; ss[i] = 0.f;
#pragma unroll
            for (int j = 0; j < 4; ++j) { const float4 x = v[i][j]; ss[i] += x.x * x.x + x.y * x.y + x.z * x.z + x.w * x.w;
                uint2 o; o.x = pk2(x.x * gs[j].x, x.y * gs[j].y); o.y = pk2(x.z * gs[j].z, x.w * gs[j].w); ((uint2*)(H + (size_t)r * D))[F.lane + 64 * j] = o; } }
#pragma unroll
        for (int i = 0; i < RB; ++i) ss[i] = wave_sum(ss[i], F.lane);
#pragma unroll
        for (int i = 0; i < RB; ++i) if (F.lane < 16) RS[(size_t)(r0 + i) * 16 + F.lane] = F.lane == 0 ? ss[i] : 0.f;
    }
}
__device__ __forceinline__ void ph_bias(Frame& F, const Params& P, int l) {
    const float* MOD = (const float*)(F.ws + WS_MOD); const bf16* Wi_t = (const bf16*)(F.ws + WS_WI); const bf16* Win_t = (const bf16*)(F.ws + WS_WIN);
    float* SWFI = (float*)(F.ws + WS_SWFI); float* SWIN = (float*)(F.ws + WS_SWIN); float* SWG = (float*)(F.ws + WS_SWG);
#pragma unroll 1
    for (int mg = 0; mg < 4; ++mg) {
        const bool fi = mg < 2; const int mat = fi ? 2 * l + mg : l, sidx = fi ? (mg ? 6 : 0) : 3, nrows = fi ? 2 * DFF : (mg == 2 ? DU : 16);
        float sh[NR][16];
#pragma unroll
        for (int r = 0; r < NR; ++r) { const float4* sp = (const float4*)(MOD + ((size_t)l * NR + r) * MODW + sidx * D + F.lane * 16);
#pragma unroll
            for (int q4 = 0; q4 < 4; ++q4) { const float4 s4 = sp[q4]; sh[r][4 * q4] = s4.x; sh[r][4 * q4 + 1] = s4.y; sh[r][4 * q4 + 2] = s4.z; sh[r][4 * q4 + 3] = s4.w; } }
        const bf16* wbase = fi ? Wi_t + (size_t)mat * 2 * DFF * D : (mg == 2 ? Win_t + (size_t)mat * DU * D : (const bf16*)(F.ws + WS_WGT) + (size_t)l * 32 * D);
        float* obase = fi ? SWFI + (size_t)mat * NR * 2 * DFF : (mg == 2 ? SWIN + (size_t)mat * NR * DU : SWG + (size_t)l * NR * 16);
        for (int row = F.gw; row < nrows; row += F.NGW) {
            const bf16* wr = wbase + (size_t)row * D + F.lane * 16;
            const half8 w0 = __builtin_bit_cast(half8, *(const v4u*)wr), w1 = __builtin_bit_cast(half8, *(const v4u*)(wr + 8));
            float x[16];
#pragma unroll
            for (int i = 0; i < 16; ++i) x[i] = i < 8 ? (float)w0[i] : (float)w1[i - 8];
#pragma unroll
            for (int r = 0; r < NR; ++r) { float a = 0.f;
#pragma unroll
                for (int i = 0; i < 16; ++i) a += sh[r][i] * x[i];
                a = wave_sum(a, F.lane); if (F.lane == 0) obase[(size_t)r * nrows + row] = a; }
        }
    }
}
__device__ __forceinline__ void ph_rope_table(Frame& F, const Params& P) {
    float2* RT = (float2*)(F.ws + WS_ROPE); bf16* WgT = (bf16*)(F.ws + WS_WGT);
    for (int i = F.bid * NTHREADS + F.tid; i < DEPTH * 32 * D; i += F.G * NTHREADS) { const int l = i / (32 * D), j = (i / D) & 31, k = i % D; WgT[i] = (bf16)(j < 16 ? f2bf(P.in[9][((size_t)l * D + k) * DIN + SRC_GATE + j]) : 0u); }
    for (int i = F.bid + F.G * F.tid; i < 64 * 16 && F.tid < 8; i += F.G * 8) { const int p = i >> 4, f = i & 15;     const float ang = (float)p * powf(10000.f, -(float)f / 16.f); RT[i] = make_float2(cosf(ang), sinf(ang)); }
}
__device__ __forceinline__ void ph_final(Frame& F, const Params& P) {
    const float* g = P.in[16]; const float* RS = (const float*)(F.ws + WS_RS); const bf16* X16 = (const bf16*)(F.ws + WS_X16);
    constexpr int RB = 4;
    float4 gv[4];
#pragma unroll
    for (int j = 0; j < 4; ++j) gv[j] = ((const float4*)g)[F.lane + 64 * j];
    for (int r0 = F.gw * RB; r0 < TL; r0 += F.NGW * RB) {
        half4 hx[RB][4]; float rstd[RB];
#pragma unroll
        for (int i = 0; i < RB; ++i) { rstd[i] = rstd_row(RS, r0 + i);
#pragma unroll
            for (int j = 0; j < 4; ++j) hx[i][j] = *(const half4*)(X16 + (size_t)(r0 + i) * D + 4 * (F.lane + 64 * j)); }
#pragma unroll
        for (int i = 0; i < RB; ++i) { float* o = F.out + (size_t)(r0 + i) * D;
#pragma unroll
            for (int j = 0; j < 4; ++j) ((float4*)o)[F.lane + 64 * j] = make_float4((float)hx[i][j][0] * rstd[i] * gv[j].x, (float)hx[i][j][1] * rstd[i] * gv[j].y, (float)hx[i][j][2] * rstd[i] * gv[j].z, (float)hx[i][j][3] * rstd[i] * gv[j].w); }
    }
}
__device__ __forceinline__ void ph_gates(Frame& F, int l) {
    const bf16* H = (const bf16*)(F.ws + WS_HB); float* G = (float*)(F.ws + WS_G); const float* RS = (const float*)(F.ws + WS_RS); const float* SWG = (const float*)(F.ws + WS_SWG) + l * NR * 16;
    const bf16* WgT = (const bf16*)(F.ws + WS_WGT) + (size_t)l * 32 * D;
    const int r32 = F.lane & 31, hh = F.lane >> 5;
    for (int rb = (F.gw + F.NGW - 100 * NWAVES) % F.NGW; rb < T / 32; rb += F.NGW) {
        const bf16* hp = H + (size_t)(rb * 32 + r32) * D + 8 * hh; const bf16* wp = WgT + (size_t)r32 * D + 8 * hh;
        f32x16 acc = {};
#pragma unroll 8
        for (int s = 0; s < 64; ++s) acc = __builtin_amdgcn_mfma_f32_32x32x16_f16(__builtin_bit_cast(half8, *(const v4u*)(wp + 16 * s)), __builtin_bit_cast(half8, *(const v4u*)(hp + 16 * s)), acc, 0, 0, 0);
        const int row = rb * 32 + r32; const float rstd = rstd_row(RS, row); const float* sb = SWG + mod_row(row) * 16;
#pragma unroll
        for (int q4 = 0; q4 < 2; ++q4) { const int j0 = 8 * q4 + 4 * hh; f32x4v o;
#pragma unroll
            for (int i = 0; i < 4; ++i) o[i] = acc[4 * q4 + i] * rstd + sb[j0 + i];
            *(f32x4v*)(G + (size_t)row * 16 + j0) = o; }
    }
}
constexpr int TP = 144;
constexpr int NCH = 68, NCHAIN = 32, NITEM = NCHAIN * NCH;
__device__ __forceinline__ f32x16 mfma32(half8 a, half8 b, f32x16 c) { return __builtin_amdgcn_mfma_f32_32x32x16_f16(a, b, c, 0, 0, 0); }
__device__ __forceinline__ float wave_max(float v, int lane) {
#pragma unroll
    for (int o = 1; o < 64; o <<= 1) v = fmaxf(v, lane_xor(v, lane, o));
    return v; }
struct ChunkGeo { int N, rb, p0, dp; };
__device__ __forceinline__ ChunkGeo chunk_geo(int b, int dir, int c  ) {
    ChunkGeo g; const bool isctx = c < 4; const int cc = isctx ? c : c - 4; g.N = isctx ? CTX : SEQ; g.rb = isctx ? TL + b * CTX : b * SEQ;
    if (dir == 0) { g.p0 = cc * 64; g.dp = 1; } else { g.p0 = g.N - 1 - cc * 64; g.dp = -1; }
    return g; }
__device__ __forceinline__ void conv16(const bf16* urow  , int p, int N, int colbase, const float* cw, float scale, float (&out)[16]) {
    const v4u c0 = *(const v4u*)(urow + colbase), c1 = *(const v4u*)(urow + colbase + 8);
    v4u m0 = {0u, 0u, 0u, 0u}, m1 = m0, n0 = m0, n1 = m0;
    if (p > 0) { m0 = *(const v4u*)(urow - DU + colbase); m1 = *(const v4u*)(urow - DU + colbase + 8); }
    if (p < N - 1) { n0 = *(const v4u*)(urow + DU + colbase); n1 = *(const v4u*)(urow + DU + colbase + 8); }
    const half8 hc0 = __builtin_bit_cast(half8, c0), hc1 = __builtin_bit_cast(half8, c1), hm0 = __builtin_bit_cast(half8, m0), hm1 = __builtin_bit_cast(half8, m1), hn0 = __builtin_bit_cast(half8, n0), hn1 = __builtin_bit_cast(half8, n1);
#pragma unroll
    for (int i = 0; i < 16; ++i) { const float xm = i < 8 ? (float)hm0[i] : (float)hm1[i - 8], xc = i < 8 ? (float)hc0[i] : (float)hc1[i - 8], xn = i < 8 ? (float)hn0[i] : (float)hn1[i - 8];
        const float a = xm * cw[i] + xc * cw[512 + i] + xn * cw[1024 + i]; out[i] = a * __builtin_amdgcn_rcpf(1.f + __expf(-a)) * scale; }
}
__device__ __forceinline__ void st_row16(LAS unsigned char* tile, int row, int c0, const float (&v)[16]) {
    v4u a, b; a.x = pk2(v[0], v[1]); a.y = pk2(v[2], v[3]); a.z = pk2(v[4], v[5]); a.w = pk2(v[6], v[7]); b.x = pk2(v[8], v[9]); b.y = pk2(v[10], v[11]); b.z = pk2(v[12], v[13]); b.w = pk2(v[14], v[15]);
    *(LAS v4u*)(tile + row * TP + c0 * 2) = a; *(LAS v4u*)(tile + row * TP + c0 * 2 + 16) = b; }
__device__ __forceinline__ void st_col16(LAS unsigned char* tile, int col, int r0, const float (&v)[16]) {
#pragma unroll
    for (int i = 0; i < 16; ++i) *(LAS unsigned short*)(tile + (r0 + i) * TP + col * 2) = (unsigned short)f2bf(v[i]); }
__device__ __forceinline__ half8 ld_row8(const LAS unsigned char* tile, int row, int c0) { return __builtin_bit_cast(half8, *(const LAS v4u*)(tile + row * TP + c0 * 2)); }

__device__ __forceinline__ void ph_mlstm_m1(Frame& F, const float* conv, const float* b_i, const float* b_f) {
    const bf16* U = (const bf16*)(F.ws + WS_R); const float* G = (const float*)(F.ws + WS_G);
    bf16* CL = (bf16*)(F.ws + WS_HS); float* NL = (float*)(F.ws + WS_NL); float* AM = (float*)(F.ws + WS_AM);
    const int dir = F.wave >> 2, wg = F.wave & 3, tg = F.tid & 255, r32 = F.lane & 31, hh = F.lane >> 5;
    LAS unsigned char* base = F.lds + dir * 24576; LAS unsigned char* KT = base; LAS unsigned char* VT = base + 9216; LAS float* wS = (LAS float*)(base + 18432);
    for (int it = F.bid; it < 16 * NCH; it += F.G) {
        const int bh = it / NCH, c = it % NCH, b = bh >> 2, h = bh & 3; const ChunkGeo g = chunk_geo(b, dir, c); const int item = (bh * 2 + dir) * NCH + c;
        if (wg == 0) { const int p = g.p0 + g.dp * F.lane; const float* g0 = G + (size_t)(g.rb + p) * 16;
            const float liv = g0[dir * 4 + h] + b_i[dir * 4 + h], lfv = logsigmoid_f(g0[8 + dir * 4 + h] + b_f[dir * 4 + h]);
            float bc = lfv;
#pragma unroll
            for (int o = 1; o < 64; o <<= 1) { const float t = lane_get(bc, F.lane - o); if (F.lane >= o) bc += t; }
            const float a = lane_get(bc, 63); const float dl = a - bc + liv; const float ml = wave_max(dl, F.lane);
            wS[F.lane] = __expf(dl - ml);
            if (F.lane == 0) { AM[item * 2] = a; AM[item * 2 + 1] = ml; } }
        __syncthreads();
        { const int tau = tg >> 2, d0 = (tg & 3) * 16; const int p = g.p0 + g.dp * tau; const bf16* urow = U + (size_t)(g.rb + p) * DU;
          float kv[16], vv[16]; conv16(urow, p, g.N, C_MK + h * 64 + d0, conv + 256 + h * 64 + d0, 0.125f, kv);
          const float w = wS[tau]; const half8 v0 = __builtin_bit_cast(half8, *(const v4u*)(urow + C_MV + h * 64 + d0)), v1 = __builtin_bit_cast(half8, *(const v4u*)(urow + C_MV + h * 64 + d0 + 8));
#pragma unroll
          for (int i = 0; i < 16; ++i) vv[i] = (i < 8 ? (float)v0[i] : (float)v1[i - 8]) * w;
          st_col16(KT, tau, d0, kv); st_col16(VT, tau, d0, vv); }
        __syncthreads();
        { const int tm = wg >> 1, tn = wg & 1; f32x16 acc = {};
#pragma unroll
          for (int s = 0; s < 4; ++s) acc = mfma32(ld_row8(VT, 32 * tm + r32, 16 * s + 8 * hh), ld_row8(KT, 32 * tn + r32, 16 * s + 8 * hh), acc);
          bf16* cl = CL + (size_t)item * 4096 + 32 * tn + r32;
#pragma unroll
          for (int r = 0; r < 16; ++r) cl[(size_t)(32 * tm + (r & 3) + 8 * (r >> 2) + 4 * hh) * 64] = (bf16)f2bf(acc[r]);
          if (tg < 64) { float a = 0.f; const LAS unsigned char* kr = KT + tg * TP;
#pragma unroll 8
              for (int s = 0; s < 64; ++s) a += wS[s] * bf2f(*(const LAS unsigned short*)(kr + s * 2));
              NL[(size_t)item * 64 + tg] = a; } }
        __syncthreads();
    }
}
__device__ __forceinline__ void ph_mlstm_m2(Frame& F) {
    bf16* CL = (bf16*)(F.ws + WS_HS); float* NL = (float*)(F.ws + WS_NL); const float* AM = (const float*)(F.ws + WS_AM); float* MS = (float*)(F.ws + WS_MS);
    for (int vb = F.bid; vb < NCHAIN * 8; vb += F.G) {
        const int chain = vb >> 3, sl = vb & 7, e = sl * NTHREADS + F.tid; const bool don = (sl == 0 && F.tid < 64);
        bf16* cp = CL + (size_t)chain * NCH * 4096 + e; float* np = NL + (size_t)chain * NCH * 64 + (F.tid & 63); const float* am = AM + (size_t)chain * NCH * 2;
        float cl[NCH];
#pragma unroll
        for (int c = 0; c < NCH; ++c) cl[c] = bf2f(cp[(size_t)c * 4096]);
        { float C = 0.f, m = 0.f;
#pragma unroll
          for (int c = 0; c < NCH; ++c) { const float a = am[c * 2], ml = am[c * 2 + 1]; const float mn = fmaxf(a + m, ml), al = __expf(a + m - mn), be = __expf(ml - mn);
              cp[(size_t)c * 4096] = (bf16)f2bf(fminf(fmaxf(C, -60000.f), 60000.f)); C = al * C + be * cl[c];
              if (sl == 0 && F.tid == 0) MS[chain * NCH + c] = m;
              m = mn; } }
        if (don) {
#pragma unroll
            for (int c = 0; c < NCH; ++c) cl[c] = np[c * 64];
            float nvv = 0.f, m = 0.f;
#pragma unroll
            for (int c = 0; c < NCH; ++c) { const float a = am[c * 2], ml = am[c * 2 + 1]; const float mn = fmaxf(a + m, ml), al = __expf(a + m - mn), be = __expf(ml - mn);
                np[c * 64] = nvv; nvv = al * nvv + be * cl[c]; m = mn; } }
    }
}
__device__ __forceinline__ void ph_mlstm_m3(Frame& F, const float* conv, const float* b_i, const float* b_f, bool do_ctx) {
    const bf16* U = (const bf16*)(F.ws + WS_R); const float* G = (const float*)(F.ws + WS_G); bf16* Y = (bf16*)F.out;
    const bf16* CL = (const bf16*)(F.ws + WS_HS); const float* NL = (const float*)(F.ws + WS_NL); const float* AM = (const float*)(F.ws + WS_AM);
    bf16* CS = (bf16*)(F.ws + WS_HS) + (size_t)NITEM * 4096; float* NS = (float*)(F.ws + WS_NS2); float* MS = (float*)(F.ws + WS_MS2);
    const int dir = F.wave >> 2, wg = F.wave & 3, tg = F.tid & 255, r32 = F.lane & 31, hh = F.lane >> 5;
    LAS unsigned char* base = F.lds + dir * 40960; LAS unsigned char* Qs = base; LAS unsigned char* Ks = base + 9216; LAS unsigned char* VT = base + 18432; LAS unsigned char* Cs = base + 27648;
    LAS float* fa = (LAS float*)(base + 36864); LAS float* bcS = fa; LAS float* lmbS = fa + 64; LAS float* mtS = fa + 128; LAS float* wpS = fa + 192; LAS float* n0S = fa + 256;
    LAS float* HO = (LAS float*)(F.lds + 81920);
    if (F.bid >= 256) return;
    const int bh = (F.bid & 7) * 2 + ((F.bid >> 3) & 1), sg = F.bid >> 4, b = bh >> 2, h = bh & 3;     const bool has_ctx = do_ctx && sg < 4;
    {
      const int chain = bh * 2 + dir; const int lo = 4 + (dir ? 60 - 4 * sg : 4 * sg), last = lo + 3;
      const int cown = has_ctx ? (dir ? 3 - sg : sg) : -1;
      const bf16* cp = CL + (size_t)chain * NCH * 4096 + tg * 16; const float* np = NL + (size_t)chain * NCH * 64 + (tg & 63); const float* am = AM + (size_t)chain * NCH * 2;
      float C[16]; float nvv = 0.f, m = 0.f;
#pragma unroll
      for (int i = 0; i < 16; ++i) C[i] = 0.f;
      constexpr int PF = 8; v4u pl0[PF], pl1[PF]; float pnl[PF]; v2f pam[PF];
#pragma unroll
      for (int i = 0; i < PF; ++i) { pl0[i] = *(const v4u*)(cp + (size_t)i * 4096); pl1[i] = *(const v4u*)(cp + (size_t)i * 4096 + 8); pnl[i] = np[i * 64]; pam[i] = *(const v2f*)(am + i * 2); }
      for (int c0 = 0; c0 <= last; c0 += PF) {
#pragma unroll
          for (int i = 0; i < PF; ++i) { const int cs = c0 + i;
              const half8 x0 = __builtin_bit_cast(half8, pl0[i]), x1 = __builtin_bit_cast(half8, pl1[i]); const float xn = pnl[i]; const v2f xa = pam[i];
              { const int cn = cs + PF < NCH ? cs + PF : NCH - 1; pl0[i] = *(const v4u*)(cp + (size_t)cn * 4096); pl1[i] = *(const v4u*)(cp + (size_t)cn * 4096 + 8); pnl[i] = np[cn * 64]; pam[i] = *(const v2f*)(am + cn * 2); }
              if (cs <= last) {
                  if (cs >= lo || cs == cown) {
                      #define CK(i) fminf(fmaxf(C[i], -60000.f), 60000.f)
                      v4u w0, w1; w0.x = pk2(CK(0), CK(1)); w0.y = pk2(CK(2), CK(3)); w0.z = pk2(CK(4), CK(5)); w0.w = pk2(CK(6), CK(7)); w1.x = pk2(CK(8), CK(9)); w1.y = pk2(CK(10), CK(11)); w1.z = pk2(CK(12), CK(13)); w1.w = pk2(CK(14), CK(15));
#undef CK
                      bf16* cq = CS + ((size_t)chain * NCH + cs) * 4096 + tg * 16; *(v4u*)cq = w0; *(v4u*)(cq + 8) = w1;
                      if (tg < 64) NS[((size_t)chain * NCH + cs) * 64 + tg] = nvv;
                      if (tg == 0) MS[chain * NCH + cs] = m; }
                  if (cs < last) { const float a = xa.x, ml = xa.y; const float mn = fmaxf(a + m, ml), al = __expf(a + m - mn), be = __expf(ml - mn);
#pragma unroll
                      for (int e = 0; e < 16; ++e) C[e] = al * C[e] + be * (e < 8 ? (float)x0[e] : (float)x1[e - 8]);
                      nvv = al * nvv + be * xn; m = mn; } } } }
      asm volatile("s_waitcnt vmcnt(0)" ::: "memory"); }
    __syncthreads();
    for (int ii = has_ctx ? -1 : 0; ii < 4; ++ii) {
        const bool isctx = ii < 0; const int pb = isctx ? sg : 4 * sg + ii, N = isctx ? CTX : SEQ, rb = isctx ? TL + b * CTX : b * SEQ;
        const int cs = dir == 0 ? pb : N / 64 - 1 - pb;
        const int item = (bh * 2 + dir) * NCH + (isctx ? cs : 4 + cs);
        const int p0 = dir == 0 ? pb * 64 : pb * 64 + 63, dp = dir == 0 ? 1 : -1;
        if (wg == 0) { const int p = p0 + dp * F.lane; const float* g0 = G + (size_t)(rb + p) * 16;
            const float liv = g0[dir * 4 + h] + b_i[dir * 4 + h], lfv = logsigmoid_f(g0[8 + dir * 4 + h] + b_f[dir * 4 + h]);
            float bc = lfv;
#pragma unroll
            for (int o = 1; o < 64; o <<= 1) { const float t = lane_get(bc, F.lane - o); if (F.lane >= o) bc += t; }
            const float lmb = liv - bc; float pm = lmb;
#pragma unroll
            for (int o = 1; o < 64; o <<= 1) { const float t = lane_get(pm, F.lane - o); if (F.lane >= o) pm = fmaxf(pm, t); }
            const float m0 = MS[item]; const float mt = bc + fmaxf(m0, pm);
            bcS[F.lane] = bc; lmbS[F.lane] = lmb; mtS[F.lane] = mt; wpS[F.lane] = __expf(bc + m0 - mt); n0S[F.lane] = NS[(size_t)item * 64 + F.lane]; }
        { const int tau = tg >> 2, d0 = (tg & 3) * 16; const int p = p0 + dp * tau; const bf16* urow = U + (size_t)(rb + p) * DU;
          float qv[16], kv[16], vv[16]; conv16(urow, p, N, C_MQ + h * 64 + d0, conv + h * 64 + d0, 1.0f, qv); conv16(urow, p, N, C_MK + h * 64 + d0, conv + 256 + h * 64 + d0, 0.125f, kv);
          const half8 v0 = __builtin_bit_cast(half8, *(const v4u*)(urow + C_MV + h * 64 + d0)), v1 = __builtin_bit_cast(half8, *(const v4u*)(urow + C_MV + h * 64 + d0 + 8));
#pragma unroll
          for (int i = 0; i < 16; ++i) vv[i] = i < 8 ? (float)v0[i] : (float)v1[i - 8];
          st_row16(Qs, tau, d0, qv); st_row16(Ks, tau, d0, kv); st_col16(VT, tau, d0, vv);
          const bf16* cg = CS + (size_t)item * 4096 + tau * 64 + d0;
          *(LAS v4u*)(Cs + tau * TP + d0 * 2) = *(const v4u*)cg; *(LAS v4u*)(Cs + tau * TP + d0 * 2 + 16) = *(const v4u*)(cg + 8); }
        __syncthreads();
        f32x16 ho;
        { const int tt = wg & 1, tv = wg >> 1; const int tau = 32 * tt + r32;
          half8 qf[4];
#pragma unroll
          for (int s = 0; s < 4; ++s) qf[s] = ld_row8(Qs, tau, 16 * s + 8 * hh);
          f32x16 st0 = {}, st1 = {};
#pragma unroll
          for (int s = 0; s < 4; ++s) { st0 = mfma32(ld_row8(Ks, r32, 16 * s + 8 * hh), qf[s], st0); st1 = mfma32(ld_row8(Ks, 32 + r32, 16 * s + 8 * hh), qf[s], st1); }
          const float ct = bcS[tau] - mtS[tau]; float dpart = 0.f;
#pragma unroll
          for (int r = 0; r < 16; ++r) { const int sg = (r & 3) + 8 * (r >> 2) + 4 * hh;
              const float w0 = sg <= tau ? __expf(ct + lmbS[sg]) : 0.f, w1 = sg + 32 <= tau ? __expf(ct + lmbS[sg + 32]) : 0.f;
              st0[r] *= w0; st1[r] *= w1; dpart += st0[r] + st1[r]; }
          float qn = 0.f;
#pragma unroll
          for (int s = 0; s < 4; ++s)
#pragma unroll
              for (int j = 0; j < 8; ++j) qn += (float)qf[s][j] * n0S[16 * s + 8 * hh + j];
          dpart += lane_xor(dpart, F.lane, 32); qn += lane_xor(qn, F.lane, 32);
          const float wp = wpS[tau], mt = mtS[tau]; const float den = dpart + wp * qn; const float inv = 1.f / fmaxf(fabsf(den), __expf(-mt));
          f32x16 an = {}, ac = {};
#pragma unroll
          for (int ks = 0; ks < 4; ++ks) { const f32x16& sx = (ks >> 1) ? st1 : st0; const int rbs = 8 * (ks & 1);
              half8 bf;
#pragma unroll
              for (int j = 0; j < 8; ++j) bf[j] = (_Float16)sx[rbs + j];
              const LAS unsigned char* vr = VT + (32 * tv + r32) * TP + (16 * ks + 4 * hh) * 2;
              const half4 a0 = *(const LAS half4*)vr, a1 = *(const LAS half4*)(vr + 16);
              const half8 af = {a0[0], a0[1], a0[2], a0[3], a1[0], a1[1], a1[2], a1[3]};
              an = mfma32(af, bf, an); }
#pragma unroll
          for (int s = 0; s < 4; ++s) ac = mfma32(ld_row8(Cs, 32 * tv + r32, 16 * s + 8 * hh), qf[s], ac);
#pragma unroll
          for (int r = 0; r < 16; ++r) ho[r] = (an[r] + wp * ac[r]) * inv;
          if (dir == 0) {
#pragma unroll
              for (int q4 = 0; q4 < 4; ++q4) { f32x4v x = {ho[4 * q4], ho[4 * q4 + 1], ho[4 * q4 + 2], ho[4 * q4 + 3]}; *(LAS f32x4v*)(HO + tau * 68 + 32 * tv + 8 * q4 + 4 * hh) = x; } } }
        __syncthreads();
        if (dir == 1) { const int tt = wg & 1, tv = wg >> 1; const int tau = 32 * tt + r32, pos = 63 - tau; const size_t row = (size_t)(rb + pb * 64 + pos);
#pragma unroll
            for (int q4 = 0; q4 < 4; ++q4) { const int v0 = 32 * tv + 8 * q4 + 4 * hh; const f32x4v x = *(const LAS f32x4v*)(HO + pos * 68 + v0);
                const half4 mo = *(const half4*)(U + row * DU + C_MO + h * 64 + v0); float o[4];
#pragma unroll
                for (int i = 0; i < 4; ++i) { const float g = 1.f / (1.f + __expf(-(float)mo[i])); o[i] = fminf(fmaxf(g * (x[i] + ho[4 * q4 + i]), -60000.f), 60000.f); }
                uint2 w; w.x = pk2(o[0], o[1]); w.y = pk2(o[2], o[3]); *(uint2*)(Y + row * D + 768 + h * 64 + v0) = w; } }
        __syncthreads();
    }
}


__device__ __forceinline__ void ph_attn(Frame& F, const float* sink, bool do_ctx) {
    const bf16* U = (const bf16*)(F.ws + WS_R); bf16* Y = (bf16*)F.out;
    const int g = F.wave >> 1, qh = F.wave & 1, r32 = F.lane & 31, hh = F.lane >> 5;
    const int lrow = F.tid >> 3, lch = F.tid & 7;
    constexpr float LOG2E = 1.4426950408889634f;
    const int nunits = 512 + (do_ctx ? 32 : 0);
    for (int uk = 0; uk < 3; ++uk) {
        int u; if (uk < 2) u = (F.bid & 7) * 64 + (F.bid >> 3) * 2 + uk; else { if (F.bid < 64 || F.bid >= 96) break; u = 512 + (F.bid - 64); }
        if (u >= nunits) break;
        const bool lat = u < 512; int b, kvh, qb;
        if (lat) { b = u >> 7; kvh = (u >> 6) & 1; qb = u & 63; } else { const int v = u - 512; b = v >> 3; kvh = (v >> 2) & 1; qb = v & 3; }
        const int head = kvh * 4 + g;
        const size_t qrow = (size_t)(lat ? b * SEQ : TL + b * CTX) + qb * 64 + qh * 32 + r32;
        half8 qf[4];
#pragma unroll
        for (int s = 0; s < 4; ++s) qf[s] = __builtin_bit_cast(half8, *(const v4u*)(U + qrow * DU + C_Q + head * 64 + 16 * s + 8 * hh));
        const int kt_lo = lat ? (qb - 2 < 0 ? 0 : qb - 2) : 0, kt_hi = lat ? (qb + 2 > 63 ? 63 : qb + 2) : -1; const int nloc = kt_hi - kt_lo + 1, nt = nloc + 4;
        float m = sink[head] * LOG2E, l = 1.f; f32x16 o0 = {}, o1 = {};
        v4u kreg, vreg;
#define ATT_TILE_ROW0(t) ((t) < nloc ? (size_t)b * SEQ + (size_t)(kt_lo + (t)) * 64 : (size_t)TL + (size_t)b * CTX + (size_t)((t) - nloc) * 64)
#define ATT_LOAD(t) do { const bf16* rp = U + (ATT_TILE_ROW0(t) + lrow) * DU + kvh * 64 + 8 * lch; kreg = *(const v4u*)(rp + C_K); vreg = *(const v4u*)(rp + C_V); } while (0)
#define ATT_STORE(buf) do { LAS unsigned char* kb = F.lds + (buf) * 9216; LAS unsigned char* vb = F.lds + 18432 + (buf) * 9216; *(LAS v4u*)(kb + lrow * TP + lch * 16) = kreg; \
        const half8 vh = __builtin_bit_cast(half8, vreg); _Pragma("unroll") for (int i = 0; i < 8; ++i) *(LAS _Float16*)(vb + (8 * lch + i) * TP + lrow * 2) = vh[i]; } while (0)
        ATT_LOAD(0); ATT_STORE(0);
        __syncthreads();
        for (int t = 0; t < nt; ++t) {
            if (t + 1 < nt) ATT_LOAD(t + 1);
            const LAS unsigned char* Kb = F.lds + (t & 1) * 9216; const LAS unsigned char* Vb = F.lds + 18432 + (t & 1) * 9216;
            f32x16 s0, s1;
#pragma unroll
            for (int r = 0; r < 16; ++r) { s0[r] = -m; s1[r] = -m; }
#pragma unroll
            for (int s = 0; s < 4; ++s) { s0 = mfma32(ld_row8(Kb, r32, 16 * s + 8 * hh), qf[s], s0); s1 = mfma32(ld_row8(Kb, 32 + r32, 16 * s + 8 * hh), qf[s], s1); }
            int ttype = 0; if (t < nloc) { const int kt = kt_lo + t; ttype = (kt == qb - 2) ? 1 : (kt == qb + 2) ? 2 : 0; }
            const int qi = qh * 32 + r32;
            if (ttype != 0) {
#pragma unroll
                for (int r = 0; r < 16; ++r) { const int jk = (r & 3) + 8 * (r >> 2) + 4 * hh;
                    const bool v0 = ttype == 1 ? (jk >= qi) : (jk <= qi), v1 = ttype == 1 ? (jk + 32 >= qi) : (jk + 32 <= qi);
                    s0[r] = v0 ? s0[r] : -INFINITY; s1[r] = v1 ? s1[r] : -INFINITY; } }
            float mx = fmaxf(s0[0], s1[0]);
#pragma unroll
            for (int r = 1; r < 16; ++r) mx = fmaxf(mx, fmaxf(s0[r], s1[r]));
            mx = fmaxf(mx, lane_xor(mx, F.lane, 32));
            if (__builtin_amdgcn_ballot_w64(mx > 0.f) != 0ull) {
                const float dl = fmaxf(mx, 0.f), alpha = __builtin_amdgcn_exp2f(-dl); m += dl; l *= alpha;
#pragma unroll
                for (int r = 0; r < 16; ++r) { s0[r] -= dl; s1[r] -= dl; o0[r] *= alpha; o1[r] *= alpha; } }
            float ls = 0.f;
#pragma unroll
            for (int r = 0; r < 16; ++r) { s0[r] = __builtin_amdgcn_exp2f(s0[r]); s1[r] = __builtin_amdgcn_exp2f(s1[r]); ls += s0[r] + s1[r]; }
            ls += lane_xor(ls, F.lane, 32); l += ls;
#pragma unroll
            for (int ks = 0; ks < 4; ++ks) { const f32x16& sx = (ks >> 1) ? s1 : s0; const int rbs = 8 * (ks & 1);
                half8 pf;
#pragma unroll
                for (int j = 0; j < 8; ++j) pf[j] = (_Float16)sx[rbs + j];
                const LAS unsigned char* v0p = Vb + r32 * TP + (16 * ks + 4 * hh) * 2; const LAS unsigned char* v1p = v0p + 32 * TP;
                const half4 a0 = *(const LAS half4*)v0p, a1 = *(const LAS half4*)(v0p + 16), c0 = *(const LAS half4*)v1p, c1 = *(const LAS half4*)(v1p + 16);
                const half8 af0 = {a0[0], a0[1], a0[2], a0[3], a1[0], a1[1], a1[2], a1[3]}, af1 = {c0[0], c0[1], c0[2], c0[3], c1[0], c1[1], c1[2], c1[3]};
                o0 = mfma32(af0, pf, o0); o1 = mfma32(af1, pf, o1); }
            if (t + 1 < nt) ATT_STORE((t + 1) & 1);
            __syncthreads();
        }
#undef ATT_TILE_ROW0
#undef ATT_LOAD
#undef ATT_STORE
        const float il = 1.f / l; LAS unsigned char* stg = F.lds + 40960 + F.wave * 4608;
#pragma unroll
        for (int q4 = 0; q4 < 4; ++q4) { typedef unsigned v2u __attribute__((ext_vector_type(2))); v2u w0, w1;
            w0.x = pk2(o0[4 * q4] * il, o0[4 * q4 + 1] * il); w0.y = pk2(o0[4 * q4 + 2] * il, o0[4 * q4 + 3] * il);
            w1.x = pk2(o1[4 * q4] * il, o1[4 * q4 + 1] * il); w1.y = pk2(o1[4 * q4 + 2] * il, o1[4 * q4 + 3] * il);
            *(LAS v2u*)(stg + r32 * TP + (8 * q4 + 4 * hh) * 2) = w0; *(LAS v2u*)(stg + r32 * TP + (32 + 8 * q4 + 4 * hh) * 2) = w1; }
        asm volatile("s_waitcnt lgkmcnt(0)" ::: "memory");
        { bf16* yb = Y + (qrow - r32) * D + 256 + head * 64;
#pragma unroll
          for (int i = 0; i < 4; ++i) { const int row = i * 8 + (F.lane >> 3), ch = F.lane & 7; *(v4u*)(yb + (size_t)row * D + ch * 8) = *(const LAS v4u*)(stg + row * TP + ch * 16); } }
    }
}


constexpr int FP = 272;
__device__ __forceinline__ void ph_fft_consts(Frame& F) {
    bf16* M1 = (bf16*)(F.ws + WS_FM1); bf16* M3 = (bf16*)(F.ws + WS_FM3); float2* TW = (float2*)(F.ws + WS_TW); float2* CT = (float2*)(F.ws + WS_CT);
    for (int i = F.bid * NTHREADS + F.tid; i < 16384 + 8192 + 4096 + 256; i += F.G * NTHREADS) {
        float s, c;
        if (i < 16384) { const int row = i >> 7, col = i & 127, pr = row >> 6, k1 = row & 63, pc = col >> 6, n1 = col & 63; sincospif((float)((k1 * n1) & 63) * (1.f / 32.f), &s, &c);
            M1[i] = (bf16)f2bf(pr == pc ? c : (pr == 0 ? s : -s)); }
        else if (i < 16384 + 8192) { const int j = i - 16384, k2 = j >> 7, col = j & 127, pc = col >> 6, n2 = col & 63; sincospif((float)((k2 * n2) & 63) * (1.f / 32.f), &s, &c); M3[j] = (bf16)f2bf(pc == 0 ? c : s); }
        else if (i < 16384 + 8192 + 4096) { const int j = i - 16384 - 8192; sincospif((float)j * (1.f / 2048.f), &s, &c); TW[j] = make_float2(c, s); }
        else { const int j = i - 16384 - 8192 - 4096; sincospif((float)j * (1.f / 128.f), &s, &c); CT[j] = make_float2(c, s); }
    }
    bf16* DMC = (bf16*)(F.ws + WS_DMC);
    for (int i = F.bid * NTHREADS + F.tid; i < 256 * 512; i += F.G * NTHREADS) { const int k = i >> 9, pn = i & 511, n = pn & 255; float s, c; sincospif((float)((k * n) & 255) * (1.f / 128.f), &s, &c); DMC[i] = (bf16)f2bf(4.f * (pn < 256 ? c : s)); }
}
__device__ __forceinline__ void ph_fold(Frame& F, const Params& P, int l, int bid0, int nb) {
    const float* w_in = P.in[9]; const float* wfo = P.in[11]; bf16* Win_t = (bf16*)(F.ws + WS_WIN);
    float* Wx = (float*)F.ldsg; float* ct = Wx + 4096; float* st = ct + 64;
    if (F.bid < bid0 || F.bid >= bid0 + nb) return;
    for (int it = F.bid - bid0; it < 128; it += nb) {
        const int g = (it >> 5) & 3, part = (it >> 4) & 1, kb = it & 15;
        __syncthreads();
        if (F.tid < 64) { float s, c; sincospif((float)F.tid * (1.f / 32.f), &s, &c); ct[F.tid] = c; st[F.tid] = s; }
        __syncthreads();
        const float* wf = wfo + ((size_t)l * 4 + g) * 4096;
        { const int e = F.tid & 63, c0 = F.tid >> 6; float wfc[64];
#pragma unroll
          for (int m = 0; m < 64; ++m) wfc[m] = wf[m * 64 + e];
          const float* tb = part == 0 ? ct : st; const float sg = part == 0 ? (1.f / 512.f) : (-1.f / 512.f);
#pragma unroll 1
          for (int i = 0; i < 8; ++i) { const int c = c0 + 8 * i; float a = 0.f;
#pragma unroll
              for (int m = 0; m < 64; ++m) a += tb[(m * c) & 63] * wfc[m];
              Wx[c * 64 + e] = a * sg; } }
        __syncthreads();
        const int k = kb * 64 + (F.tid >> 3), e0 = (F.tid & 7) * 8; const float* wr = w_in + ((size_t)l * D + k) * DIN + g * 64;
        float acc[8];
#pragma unroll
        for (int j = 0; j < 8; ++j) acc[j] = 0.f;
        float4 av[16];
#pragma unroll
        for (int c4 = 0; c4 < 16; ++c4) av[c4] = ((const float4*)wr)[c4];
#pragma unroll
        for (int c4 = 0; c4 < 16; ++c4) { const float aa[4] = {av[c4].x, av[c4].y, av[c4].z, av[c4].w};
#pragma unroll
            for (int ci = 0; ci < 4; ++ci) { const float* wx = Wx + (4 * c4 + ci) * 64 + e0; const float4 w0 = *(const float4*)wx, w1 = *(const float4*)(wx + 4);
                acc[0] += aa[ci] * w0.x; acc[1] += aa[ci] * w0.y; acc[2] += aa[ci] * w0.z; acc[3] += aa[ci] * w0.w; acc[4] += aa[ci] * w1.x; acc[5] += aa[ci] * w1.y; acc[6] += aa[ci] * w1.z; acc[7] += aa[ci] * w1.w; } }
#pragma unroll
        for (int j = 0; j < 8; ++j) Win_t[((size_t)l * DU + part * 256 + g * 64 + e0 + j) * D + k] = (bf16)f2bf(acc[j]);
    }
    __syncthreads();
}
__device__ __forceinline__ void ph_fft(Frame& F) {
    const bf16* U = (const bf16*)(F.ws + WS_R); bf16* Y = (bf16*)F.out; const float2* TW = (const float2*)(F.ws + WS_TW);
    LAS unsigned char* BUF = F.lds; LAS unsigned char* M1s = F.lds + 69632; LAS unsigned char* M3s = F.lds + 69632 + 34816;
    const int r32 = F.lane & 31, hh = F.lane >> 5, w = F.wave;
    __syncthreads();
    if (F.bid < 256) {
        const v4u* m1 = (const v4u*)(F.ws + WS_FM1); const v4u* m3 = (const v4u*)(F.ws + WS_FM3);
        for (int i = F.tid; i < 128 * 16; i += NTHREADS) *(LAS v4u*)(M1s + (i >> 4) * FP + (i & 15) * 16) = m1[i];
        for (int i = F.tid; i < 64 * 16; i += NTHREADS) *(LAS v4u*)(M3s + (i >> 4) * FP + (i & 15) * 16) = m3[i];
    }
    for (int itb = F.bid; itb < 256; itb += F.G) {
        const int it = (((itb & 7) * 4 + (itb >> 6)) << 3) | ((itb >> 3) & 7);
        const int b = it >> 6, cg = it & 63;
        __syncthreads();
        for (int q = w; q < 128; q += NWAVES) { const int n2 = q >> 1, part = q & 1, n1 = F.lane;
            const half4 x = *(const half4*)(U + (size_t)(b * SEQ + 64 * n1 + n2) * DU + part * 256 + cg * 4);
#pragma unroll
            for (int i = 0; i < 4; ++i) *(LAS _Float16*)(BUF + (n2 * 4 + i) * FP + (part * 64 + n1) * 2) = x[i]; }
        __syncthreads();
        f32x16 acc[4] = {};
#pragma unroll
        for (int s = 0; s < 8; ++s) { const half8 bf = __builtin_bit_cast(half8, *(const LAS v4u*)(BUF + (32 * w + r32) * FP + (16 * s + 8 * hh) * 2));
#pragma unroll
            for (int tm = 0; tm < 4; ++tm) acc[tm] = mfma32(__builtin_bit_cast(half8, *(const LAS v4u*)(M1s + (32 * tm + r32) * FP + (16 * s + 8 * hh) * 2)), bf, acc[tm]); }
        int nidx = 32 * w + r32; asm volatile("" : "+v"(nidx));
        const int n2 = nidx >> 2, col = nidx & 3;
        __syncthreads();
#pragma unroll
        for (int tm = 0; tm < 2; ++tm)
#pragma unroll
            for (int r = 0; r < 16; ++r) { const int k1 = 32 * tm + (r & 3) + 8 * (r >> 2) + 4 * hh; const float2 t = *(const float2*)((const char*)TW + ((unsigned)((k1 * n2) & 4095) << 3));
                const float re = acc[tm][r], im = acc[tm + 2][r];
                *(LAS _Float16*)(BUF + (k1 * 4 + col) * FP + n2 * 2) = (_Float16)(re * t.x + im * t.y);
                *(LAS _Float16*)(BUF + (k1 * 4 + col) * FP + (64 + n2) * 2) = (_Float16)(im * t.x - re * t.y); }
        __syncthreads();
        f32x16 y0 = {}, y1 = {};
#pragma unroll
        for (int s = 0; s < 8; ++s) { const half8 bf = __builtin_bit_cast(half8, *(const LAS v4u*)(BUF + (32 * w + r32) * FP + (16 * s + 8 * hh) * 2));
            y0 = mfma32(__builtin_bit_cast(half8, *(const LAS v4u*)(M3s + r32 * FP + (16 * s + 8 * hh) * 2)), bf, y0);
            y1 = mfma32(__builtin_bit_cast(half8, *(const LAS v4u*)(M3s + (32 + r32) * FP + (16 * s + 8 * hh) * 2)), bf, y1); }
        const int k1o = nidx >> 2; bf16* yb = Y + (size_t)(b * SEQ) * D + cg * 4 + col;
#pragma unroll
        for (int rep = 0; rep < (PROBE_ID == 316 ? 3 : 1); ++rep) {
#pragma unroll
        for (int r = 0; r < 16; ++r) { const int k2 = (r & 3) + 8 * (r >> 2) + 4 * hh;
            yb[(size_t)(k1o + 64 * k2) * D] = (bf16)f2bf(y0[r]); yb[(size_t)(k1o + 64 * (k2 + 32)) * D] = (bf16)f2bf(y1[r]); }
        asm volatile("s_waitcnt vmcnt(0)" ::: "memory"); }
    }
    __syncthreads();
}
__device__ __forceinline__ void ph_ctx_dft(Frame& F) {
    const bf16* U = (const bf16*)(F.ws + WS_R); bf16* Y = (bf16*)F.out; const bf16* Dm = (const bf16*)(F.ws + WS_DMC);
    constexpr int GP = 1040;
    LAS unsigned char* Gt = F.lds; const int r32 = F.lane & 31, hh = F.lane >> 5;
    for (int it = (F.bid + 160) & 255; it < NB * 8; it += 256) {
        const int b = it >> 3, cg = it & 7;
        __syncthreads();
        for (int q = F.tid; q < 2 * CTX * 4; q += NTHREADS) { const int part = q >> 10, n = (q >> 2) & 255, c8 = q & 3;
            const half8 x = __builtin_bit_cast(half8, *(const v4u*)(U + (size_t)(TL + b * CTX + n) * DU + part * 256 + cg * 32 + c8 * 8));
#pragma unroll
            for (int i = 0; i < 8; ++i) *(LAS _Float16*)(Gt + (c8 * 8 + i) * GP + (part * 256 + n) * 2) = x[i]; }
        __syncthreads();
        f32x16 acc = {}; const bf16* dr = Dm + (size_t)(32 * F.wave + r32) * 512 + 8 * hh; const LAS unsigned char* gr = Gt + r32 * GP + 16 * hh;
#pragma unroll 8
        for (int s = 0; s < 32; ++s) acc = mfma32(__builtin_bit_cast(half8, *(const v4u*)(dr + 16 * s)), __builtin_bit_cast(half8, *(const LAS v4u*)(gr + 32 * s)), acc);
        bf16* yb = Y + (size_t)(TL + b * CTX) * D + cg * 32 + r32;
#pragma unroll
        for (int r = 0; r < 16; ++r) yb[(size_t)(32 * F.wave + (r & 3) + 8 * (r >> 2) + 4 * hh) * D] = (bf16)f2bf(acc[r]);
    }
    __syncthreads();
}

__device__ __forceinline__ void ph_ctx_resid_gemm(Frame& F, const bf16* A  , const bf16* Bt  , int K, const float* xsrc, const float* ng, int gate_off, int nscale_off, float coef) {
    bf16* x16 = (bf16*)(F.ws + WS_X16) + (size_t)TL * D; const float* gate = (const float*)(F.ws + WS_MOD) + gate_off + (size_t)NB * MODW; const float* nscale = (const float*)(F.ws + WS_MOD) + nscale_off + (size_t)NB * MODW;
    bf16* hraw = (bf16*)(F.ws + WS_HB) + (size_t)TL * D; float* rowss = (float*)(F.ws + WS_RS) + (size_t)TL * 16;
    const int r16 = F.lane & 15, fq = F.lane >> 4; const int kc = K >> 3;
    LAS float* red = (LAS float*)F.lds;
    for (int pc = F.bid; pc < 256; pc += F.G) {
        const int xq = pc & 7, jq = pc >> 3; const int rt = (xq >> 1) * 4 + (jq >> 3), ct = (xq & 1) * 8 + (jq & 7);
        const bf16* ap = A + (size_t)(TL + rt * 64 + r16) * K + F.wave * kc + 8 * fq;
        const bf16* bp = Bt + (size_t)(ct * 64 + r16) * K + F.wave * kc + 8 * fq;
        pg8::f32x4 acc[4][4];
#pragma unroll
        for (int ci = 0; ci < 4; ++ci)
#pragma unroll
            for (int tj = 0; tj < 4; ++tj) acc[ci][tj] = (pg8::f32x4){0.f, 0.f, 0.f, 0.f};
        constexpr int PB = 4; const int nst = kc / 32;
        v4u lb[PB][4], la[PB][4];
#pragma unroll
        for (int i = 0; i < PB; ++i) { const int s = i < nst ? i : 0;
#pragma unroll
            for (int q = 0; q < 4; ++q) { lb[i][q] = *(const v4u*)(bp + (size_t)(16 * q) * K + 32 * s); la[i][q] = *(const v4u*)(ap + (size_t)(16 * q) * K + 32 * s); } }
        for (int s0 = 0; s0 < nst; s0 += PB) {
#pragma unroll
            for (int i = 0; i < PB; ++i) {
                half8 bfr[4], afr[4];
#pragma unroll
                for (int q = 0; q < 4; ++q) { bfr[q] = __builtin_bit_cast(half8, lb[i][q]); afr[q] = __builtin_bit_cast(half8, la[i][q]); }
                const int sn = s0 + PB + i; const int sl = sn < nst ? sn : nst - 1;
#pragma unroll
                for (int q = 0; q < 4; ++q) { lb[i][q] = *(const v4u*)(bp + (size_t)(16 * q) * K + 32 * sl); la[i][q] = *(const v4u*)(ap + (size_t)(16 * q) * K + 32 * sl); }
                if (s0 + i < nst) {
#pragma unroll
                    for (int ci = 0; ci < 4; ++ci)
#pragma unroll
                        for (int tj = 0; tj < 4; ++tj) acc[ci][tj] = __builtin_amdgcn_mfma_f32_16x16x32_f16(bfr[ci], afr[tj], acc[ci][tj], 0, 0, 0); } } }
        __syncthreads();
#pragma unroll
        for (int ci = 0; ci < 4; ++ci)
#pragma unroll
            for (int tj = 0; tj < 4; ++tj) { const int row = 16 * tj + r16, chunk = 4 * ci + fq; f32x4v v = {acc[ci][tj][0], acc[ci][tj][1], acc[ci][tj][2], acc[ci][tj][3]};
                *(LAS f32x4v*)(red + ((F.wave * 64 + row) * 16 + (chunk ^ (row & 15))) * 4) = v; }
        __syncthreads();
        { const int row = F.tid >> 3, cg8 = F.tid & 7; f32x4v s0 = {0.f, 0.f, 0.f, 0.f}, s1 = s0;
#pragma unroll
          for (int w8 = 0; w8 < 8; ++w8) { s0 += *(const LAS f32x4v*)(red + ((w8 * 64 + row) * 16 + ((2 * cg8) ^ (row & 15))) * 4); s1 += *(const LAS f32x4v*)(red + ((w8 * 64 + row) * 16 + ((2 * cg8 + 1) ^ (row & 15))) * 4); }
          const int grow = rt * 64 + row, c = ct * 64 + cg8 * 8; float ssq = 0.f;
          { const size_t off = (size_t)grow * D + c; f32x4v xo0, xo1;
            if (xsrc) { xo0 = *(const f32x4v*)(xsrc + off); xo1 = *(const f32x4v*)(xsrc + off + 4); }
            else { const half8 hx = __builtin_bit_cast(half8, *(const v4u*)(x16 + off)); xo0 = (f32x4v){(float)hx[0], (float)hx[1], (float)hx[2], (float)hx[3]}; xo1 = (f32x4v){(float)hx[4], (float)hx[5], (float)hx[6], (float)hx[7]}; }
            const f32x4v x0 = xo0 + *(const f32x4v*)(gate + c) * coef * s0, x1 = xo1 + *(const f32x4v*)(gate + c + 4) * coef * s1;
            { v4u w; w.x = pk2(x0[0], x0[1]); w.y = pk2(x0[2], x0[3]); w.z = pk2(x1[0], x1[1]); w.w = pk2(x1[2], x1[3]); *(v4u*)(x16 + off) = w; }
            ssq += ((x0[0] * x0[0] + x0[1] * x0[1]) + (x0[2] * x0[2] + x0[3] * x0[3])) + ((x1[0] * x1[0] + x1[1] * x1[1]) + (x1[2] * x1[2] + x1[3] * x1[3]));
            if (ng) { const f32x4v h0 = x0 * (*(const f32x4v*)(ng + c) * (*(const f32x4v*)(nscale + c) + 1.f)), h1 = x1 * (*(const f32x4v*)(ng + c + 4) * (*(const f32x4v*)(nscale + c + 4) + 1.f));
                v4u w; w.x = pk2(h0[0], h0[1]); w.y = pk2(h0[2], h0[3]); w.z = pk2(h1[0], h1[1]); w.w = pk2(h1[2], h1[3]); *(v4u*)(hraw + off) = w; } }
          ssq += lane_xor(ssq, F.lane, 1); ssq += lane_xor(ssq, F.lane, 2); ssq += lane_xor(ssq, F.lane, 4);
          if (cg8 == 0) rowss[(size_t)grow * 16 + ct] = ssq; }
    }
    __syncthreads();
}

template <class Epi> __device__ __forceinline__ void run_gemm(Frame& F, const bf16* A, const bf16* Bt, int M, int N, int K, const Epi& E) {
    pg8::Gemm g{A, Bt, M, N, K}; pg8::StaticOrder S; S.init(M, N, F.G, F.bid);
    pg8::gemm_phase<Epi, pg8::StaticOrder, true, true>(F.lds, g, S, E, F.tid);
}
template <class Epi> __device__ __forceinline__ void run_gemm_normed(Frame& F, const bf16* A, const bf16* Bt, int M, int N, int K, const Epi& E, const float* sw) {
    pg8::Gemm g{A, Bt, M, N, K}; RstdOrder S; S.init(M, N, F.G, F.bid); S.rowss = (const float*)(F.ws + WS_RS); S.tab = (LAS float*)(F.lds + RSTD_TAB_OFF); S.tid = F.tid; S.cnt = 0; S.sw = sw; S.ncols = N;
    pg8::gemm_phase<Epi, RstdOrder, true, true>(F.lds, g, S, E, F.tid);
}
__device__ __forceinline__ Frame make_frame(const Params& P, unsigned char* lds_raw) {
    Frame F; int t = threadIdx.x; asm volatile("" : "+v"(t));
    F.lds = (LAS unsigned char*)lds_raw; F.ldsg = lds_raw;
    F.tid = t; F.lane = t & 63; F.wave = __builtin_amdgcn_readfirstlane(t >> 6);
    int g = gridDim.x, b = blockIdx.x; asm volatile("" : "+s"(g), "+s"(b));
    F.G = g; F.bid = b; F.gw = b * NWAVES + F.wave; F.NGW = g * NWAVES;
    GAS unsigned char* ws = (GAS unsigned char*)P.ws; GAS float* out = (GAS float*)P.out; asm volatile("" : "+s"(ws), "+s"(out));
    F.out = (float*)out; F.ws = (unsigned char*)ws;
    return F;
}
__device__ __forceinline__ void grid_bar(const Params& P, unsigned char* lds_raw) {
    GAS unsigned char* wsg = (GAS unsigned char*)P.ws; asm volatile("" : "+s"(wsg)); unsigned char* ws = (unsigned char*)wsg;
    XcdBarrier b; b.bar = (unsigned*)(ws + WS_CTL) + CW_BAR; b.x = xb_xcc_id(); b.st = (volatile LAS unsigned*)((LAS unsigned char*)lds_raw + MISC_OFF) + 8;
    xcd_barrier(b);
}
__global__ void __launch_bounds__(NTHREADS, 2) mega_fwd(Params P) {
    extern __shared__ __attribute__((aligned(16))) unsigned char lds_raw[];
    { const int tid = threadIdx.x;
      for (int u = tid; u < (LDS_BYTES - MISC_OFF) / 4; u += NTHREADS) ((LAS unsigned*)((LAS unsigned char*)lds_raw + MISC_OFF))[u] = 0u;
      __syncthreads();
      (void)xcd_barrier_post((unsigned*)(P.ws + WS_CTL) + CW_BAR, (volatile LAS unsigned*)((LAS unsigned char*)lds_raw + MISC_OFF) + 8); }
#define GRID_BAR() grid_bar(P, lds_raw)
    unsigned long long tacc = 0, t0 = 0; (void)tacc; (void)t0;
#define T_ON(id) do { if (PROBE_ID == (id)) t0 = __builtin_amdgcn_s_memrealtime(); } while (0)
#define T_OFF(id) do { if (PROBE_ID == (id)) { const unsigned long long t1 = __builtin_amdgcn_s_memrealtime(); tacc += t1 - t0; \
        if (blockIdx.x == PROBE_WG) { const unsigned long long tgt = t1 + 4ull * (t1 - t0); while (__builtin_amdgcn_s_memrealtime() < tgt) __builtin_amdgcn_s_sleep(8); } } } while (0)
#define FRAME() Frame F = make_frame(P, lds_raw); Ptrs p{F.out, (float*)(F.ws + WS_XC)}; (void)p

    T_ON(1); T_ON(11); T_ON(9);
    T_ON(111);
    { FRAME(); ph_mod(F, P); }
    T_OFF(111); T_ON(112);
    { FRAME(); constexpr int NCV = 9856, NMODWG = DEPTH * (MODW / 128);
      constexpr int NA1 = 1792;
      if (F.G == 256) { if (F.bid < 256 - NMODWG) { const int rk = F.bid * NWAVES + F.wave, nw = (256 - NMODWG) * NWAVES; ph_convert(F, P, 0, 0, NCV, rk, nw); ph_convert(F, P, 1, 0, NA1, rk, nw); }
                        else { const int rk = (F.bid - (256 - NMODWG)) * NWAVES + F.wave, nw = NMODWG * NWAVES; ph_convert(F, P, 1, NA1, NCV, rk, nw); } }
      else { ph_convert(F, P, 0, 0, NCV, F.gw, F.NGW); ph_convert(F, P, 1, 0, NCV, F.gw, F.NGW); } }
    T_OFF(112); T_ON(113);
    { FRAME(); ph_fold(F, P, 0, 0, 128); ph_fold(F, P, 1, 128, 128); }
    T_OFF(113); T_ON(114);
    { FRAME(); ph_fft_consts(F); ph_rope_table(F, P); }
    T_OFF(114);
    GRID_BAR(); T_OFF(11); T_ON(12);
    T_ON(121);
    { FRAME(); ph_first(F, P); }
    T_OFF(121); T_ON(122);
    { FRAME(); ph_bias(F, P, 0); ph_bias(F, P, 1); }
    T_OFF(122);
    GRID_BAR(); T_OFF(1); T_OFF(12);
#pragma unroll 1
    for (int l = 0; l < DEPTH; ++l) {
#pragma unroll 1
        for (int half = 0; half < 2; ++half) {
            const int sub = half * 2, f = half;
            if (half == 1) {
                T_ON(2); T_ON(23);
                { FRAME(); EpiUProj E{F.ws, l, (LAS float*)(F.lds + RSTD_TAB_OFF), 0};
                  run_gemm_normed(F, (const bf16*)(F.ws + WS_HB), (const bf16*)(F.ws + WS_WIN) + (size_t)l * DU * D, T, DU, D, E, (const float*)(F.ws + WS_SWIN) + (size_t)l * NR * DU); }
                { FRAME(); ph_gates(F, l); }
                GRID_BAR(); T_OFF(2); T_OFF(23); T_ON(3); T_ON(31);
                T_ON(311);
                { FRAME(); ph_mlstm_m1(F, P.in[13] + (size_t)l * 3 * 512, P.in[14] + l * 8, P.in[15] + l * 8); }
                T_OFF(311); T_ON(312);
                { FRAME(); ph_attn(F, P.in[12] + l * 8, l + 1 < DEPTH); }
                T_OFF(312); T_ON(313); T_ON(316);
                { FRAME(); ph_fft(F); }
                T_OFF(313); T_OFF(316);
                if (PROBE_ID == 315) { T_ON(315); { FRAME(); ph_fft(F); } T_OFF(315); }
                T_ON(314);
                { FRAME(); if (l + 1 < DEPTH) ph_ctx_dft(F); }
                T_OFF(314);
                GRID_BAR(); T_OFF(31); T_ON(33);
                { FRAME(); ph_mlstm_m3(F, P.in[13] + (size_t)l * 3 * 512, P.in[14] + l * 8, P.in[15] + l * 8, l + 1 < DEPTH); }
                GRID_BAR(); T_OFF(3); T_OFF(33); T_ON(2); T_ON(24);
                { FRAME(); const bool ctx_piece = l + 1 < DEPTH, piece_first = (F.bid & 1) == 0;
                  if (ctx_piece && piece_first) ph_ctx_resid_gemm(F, (const bf16*)F.out, (const bf16*)(F.ws + WS_WOUT) + (size_t)l * D * D, D, nullptr, P.in[6] + ((size_t)l * 3 + 2) * D, l * NR * MODW + 5 * D, l * NR * MODW + 7 * D, 1.0f);
                  { EpiResid E{F.ws, nullptr, P.in[6] + ((size_t)l * 3 + 2) * D, l * NR * MODW + 5 * D, l * NR * MODW + 7 * D, 1.0f};
                    run_gemm(F, (const bf16*)F.out, (const bf16*)(F.ws + WS_WOUT) + (size_t)l * D * D, TL, D, D, E); }
                  if (ctx_piece && !piece_first) ph_ctx_resid_gemm(F, (const bf16*)F.out, (const bf16*)(F.ws + WS_WOUT) + (size_t)l * D * D, D, nullptr, P.in[6] + ((size_t)l * 3 + 2) * D, l * NR * MODW + 5 * D, l * NR * MODW + 7 * D, 1.0f); }
                GRID_BAR(); T_OFF(2); T_OFF(24);
            }
            T_ON(2); T_ON(21);
            { FRAME(); EpiSwiglu E{F.ws, l * 2 + f, (LAS float*)(F.lds + RSTD_TAB_OFF), 0};
              run_gemm_normed(F, (const bf16*)(F.ws + WS_HB), (const bf16*)(F.ws + WS_WI) + (size_t)(l * 2 + f) * 2 * DFF * D, T, 2 * DFF, D, E, (const float*)(F.ws + WS_SWFI) + (size_t)(l * 2 + f) * NR * 2 * DFF); }
            GRID_BAR(); T_OFF(21); T_ON(22);
            { FRAME();
              const bool has_next = (half == 0) || (l + 1 < DEPTH);
              const float* ngp = half == 0 ? P.in[6] + ((size_t)l * 3 + 1) * D : P.in[6] + ((size_t)(l + 1) * 3 + 0) * D;
              const int nsc = half == 0 ? l * NR * MODW + 4 * D : (l + 1) * NR * MODW + 1 * D;
              const bool first = (l == 0 && half == 0);
              const bool ctx_piece = (half == 0 || l + 1 < DEPTH); const bool piece_first = (F.bid & 1) == 0;
              if (ctx_piece && piece_first) ph_ctx_resid_gemm(F, (const bf16*)(F.ws + WS_R), (const bf16*)(F.ws + WS_WO) + (size_t)(l * 2 + f) * D * DFF, DFF, first ? P.in[2] : nullptr, has_next ? ngp : nullptr, l * NR * MODW + (3 * sub + 2) * D, nsc, 0.5f);
              { EpiResid E{F.ws, first ? P.in[0] : nullptr, has_next ? ngp : nullptr, l * NR * MODW + (3 * sub + 2) * D, nsc, 0.5f};
                run_gemm(F, (const bf16*)(F.ws + WS_R), (const bf16*)(F.ws + WS_WO) + (size_t)(l * 2 + f) * D * DFF, TL, D, DFF, E); }
              if (ctx_piece && !piece_first) ph_ctx_resid_gemm(F, (const bf16*)(F.ws + WS_R), (const bf16*)(F.ws + WS_WO) + (size_t)(l * 2 + f) * D * DFF, DFF, first ? P.in[2] : nullptr, has_next ? ngp : nullptr, l * NR * MODW + (3 * sub + 2) * D, nsc, 0.5f); }
            GRID_BAR(); T_OFF(2); T_OFF(22);
        }
    }
    if (PROBE_ID == 77) { GRID_BAR(); GRID_BAR(); GRID_BAR(); GRID_BAR(); GRID_BAR(); GRID_BAR(); GRID_BAR(); GRID_BAR(); }
    T_ON(4);
    { FRAME(); ph_final(F, P); }
    if (PROBE_ID == 4 || PROBE_ID == 9) { GRID_BAR(); T_OFF(4); T_OFF(9); GRID_BAR(); }
}
}

extern "C" void kernel_launch(void* const* d_in, const int* in_sizes, int n_in, void* d_out, int out_size, void* d_ws, size_t ws_size, hipStream_t stream) {
    static int grid = 0;
    if (grid == 0) {
        if (n_in != 17 || ws_size < WS_END) { fprintf(stderr, "kernel_launch: need 17 inputs and %zu bytes of workspace; got %d inputs, %zu bytes\n", (size_t)WS_END, n_in, ws_size); grid = -1; return; }
        int dev = 0, cus = 0, per_cu = 0;
        if (hipGetDevice(&dev) != hipSuccess || hipDeviceGetAttribute(&cus, hipDeviceAttributeMultiprocessorCount, dev) != hipSuccess) { grid = -1; return; }
        if (hipFuncSetAttribute((const void*)mega_fwd, hipFuncAttributeMaxDynamicSharedMemorySize, LDS_BYTES) != hipSuccess) { fprintf(stderr, "kernel_launch: hipFuncSetAttribute failed\n"); grid = -1; return; }
        if (hipOccupancyMaxActiveBlocksPerMultiprocessor(&per_cu, (const void*)mega_fwd, NTHREADS, LDS_BYTES) != hipSuccess || per_cu < 1) { fprintf(stderr, "kernel_launch: occupancy query says %d workgroups per CU\n", per_cu); (void)hipGetLastError(); grid = -1; return; }
        if (cus != 256) { fprintf(stderr, "kernel_launch: this kernel is laid out for a 256-CU device (got %d); nothing launched\n", cus); grid = -1; return; }
        grid = cus;
    }
    if (grid < 0) return;
    (void)hipMemsetAsync((char*)d_ws + WS_CTL, 0, CTL_ZERO_BYTES, stream);
    Params P{};
    for (int i = 0; i < 17; ++i) P.in[i] = (const float*)d_in[i];
    P.out = (float*)d_out; P.ws = (unsigned char*)d_ws;
    hipLaunchKernelGGL(mega_fwd, dim3(grid), dim3(NTHREADS), LDS_BYTES, stream, P);
}
```

```cpp
#include <hip/hip_runtime.h>
#include <cstdio>
#include <cstdint>
#ifndef PROBE_ID
#define PROBE_ID 0
#endif
#ifndef PROBE_WG
#define PROBE_WG 0
#endif
namespace pg8 {
#define PG8_LAS __attribute__((address_space(3)))
typedef unsigned short bf16_t;
typedef short bf16x8 __attribute__((ext_vector_type(8)));
typedef float f32x4 __attribute__((ext_vector_type(4)));
typedef unsigned u32x4 __attribute__((ext_vector_type(4)));
typedef _Float16 half8 __attribute__((ext_vector_type(8)));
constexpr int BM = 256, BK = 64, HALF = 128, HTB = HALF * BK * 2  , STAGE_BYTES = 8 * HTB, NXCD = 8, WGM = 8;

__host__ __device__ __forceinline__ int lds_byte(int r, int c) { const int st = (r >> 4) * 2 + (c >> 5), rr = r & 15, cc = c & 31, ob = rr * 64 + cc * 2; return st * 1024 + (ob ^ (((ob >> 9) & 1) << 5)); }
__host__ __device__ __forceinline__ void stage_rc(int b, int& R, int& C) { const int st = b / 1024, sb = b % 1024, swz = sb ^ (((sb >> 9) & 1) << 5); R = (st >> 1) * 16 + swz / 64; C = (st & 1) * 32 + (swz % 64) / 2; }
__host__ __device__ __forceinline__ int perm32(int rho) { const int n = rho >> 4, i = rho & 15; return 8 * (i >> 2) + 4 * n + (i & 3); }

struct Unit { int pm, pn; };
struct Gemm { const bf16_t* A; const bf16_t* Bt; int M, N, K; };

struct StaticOrder {
    int nM, nN, nwg, G, c;
    __host__ __device__ void init(int M, int N, int G_, int c_) { nM = M / BM; nN = N / BM; nwg = nM * nN; G = G_; c = c_; }
    __host__ __device__ bool next(int i, Unit& u) const {
        const long L = (long)i * G + c; if (L >= nwg) return false;
        int wgid = (int)L; { const int q = nwg / NXCD, r = nwg % NXCD, xcd = wgid % NXCD, off = wgid / NXCD; wgid = (xcd < r ? xcd * (q + 1) : r * (q + 1) + (xcd - r) * q) + off; }
        const int nig = WGM * nN, gid = wgid / nig, fm = gid * WGM, gsz = (nM - fm) < WGM ? (nM - fm) : WGM;
        u.pm = fm + ((wgid % nig) % gsz); u.pn = (wgid % nig) / gsz; return true;
    }
    __device__ __forceinline__ void a_ready(const Unit&) const {}
    __device__ __forceinline__ void done(const Unit&) const {}
};
template <class Epi, class Sched, bool ALIGN_EPI = false, bool SP2 = false>
__device__ __forceinline__ void gemm_phase(PG8_LAS unsigned char* lds, const Gemm g, const Sched& S, const Epi& E, const int tid  ) {
    const int wid = __builtin_amdgcn_readfirstlane(tid >> 6), lane = tid & 63, wr = wid >> 2, wc = wid & 3, fr = lane & 15, fq = lane >> 4;
    const int K = g.K, nt = K / BK;
    unsigned voffA[2], voffB[2];
#pragma unroll
    for (int i = 0; i < 2; ++i) { int R, C; stage_rc(tid * 16 + i * 8192, R, C); const int Rb = Epi::PERM ? ((R & ~31) + perm32(R & 31)) : R;
        voffA[i] = (unsigned)(R * K + C) * 2u; voffB[i] = (unsigned)(Rb * K + C) * 2u; }
    const size_t kstep = (size_t)(BK * 2);
    const size_t hstep = (size_t)HALF * K * 2;
    const size_t tstep = 2 * hstep;
    const unsigned ldsw = (unsigned)wid * 1024u;
    const int aoff = lds_byte(wr * 64 + fr, fq * 8), boff = lds_byte(wc * 32 + fr, fq * 8);
#define PG8_SA(b, h) (((b) * 2 + (h)) * HTB)
#define PG8_SB(b, h) ((4 + (b) * 2 + (h)) * HTB)
#define PG8_STAGE(bufoff, gbase, voff) do { _Pragma("unroll") for (int _i = 0; _i < 2; ++_i) \
        __builtin_amdgcn_global_load_lds((const unsigned*)((const char*)(gbase) + (voff)[_i]), (PG8_LAS unsigned*)(lds + (bufoff) + ldsw + _i * 8192), 16, 0, 0); } while (0)
#define PG8_LDA(dst, b, h) do { _Pragma("unroll") for (int m = 0; m < 4; ++m) _Pragma("unroll") for (int k = 0; k < 2; ++k) dst[m][k] = *(const PG8_LAS bf16x8*)(lds + PG8_SA(b, h) + aoff + m * 2048 + k * 1024); } while (0)
#define PG8_LDB(dst, b, h) do { _Pragma("unroll") for (int n = 0; n < 2; ++n) _Pragma("unroll") for (int k = 0; k < 2; ++k) dst[n][k] = *(const PG8_LAS bf16x8*)(lds + PG8_SB(b, h) + boff + n * 2048 + k * 1024); } while (0)
#define PG8_MMA(ai, bj, At, Bt) do { __builtin_amdgcn_s_setprio(1); _Pragma("unroll") for (int m = 0; m < 4; ++m) _Pragma("unroll") for (int n = 0; n < 2; ++n) _Pragma("unroll") for (int k = 0; k < 2; ++k) \
        acc[ai][bj][m][n] = __builtin_amdgcn_mfma_f32_16x16x32_f16(__builtin_bit_cast(half8, Bt[n][k]), __builtin_bit_cast(half8, At[m][k]), acc[ai][bj][m][n], 0, 0, 0); __builtin_amdgcn_s_setprio(0); } while (0)
#define PG8_WAIT_V(n) asm volatile("s_waitcnt vmcnt(" #n ")" ::: "memory")
#define PG8_WAIT_L(n) asm volatile("s_waitcnt lgkmcnt(" #n ")" ::: "memory")
#define PG8_BAR __builtin_amdgcn_s_barrier()
#define PG8_SCHED __builtin_amdgcn_sched_barrier(0)
    Unit cur, nxt; int ui = 0;
    if (!S.next(0, cur)) return;
    f32x4 acc[2][2][4][2];
#pragma unroll
    for (int a = 0; a < 2; ++a)
#pragma unroll
        for (int b = 0; b < 2; ++b)
#pragma unroll
            for (int m = 0; m < 4; ++m)
#pragma unroll
                for (int n = 0; n < 2; ++n) acc[a][b][m][n] = (f32x4){0.f, 0.f, 0.f, 0.f};
    bf16x8 At[4][2], B0[2][2], B1[2][2];
    const char* cA = (const char*)g.A + (size_t)cur.pm * tstep; const char* cB = (const char*)g.Bt + (size_t)cur.pn * tstep;
    S.a_ready(cur);
    if constexpr (SP2) {
        PG8_STAGE(PG8_SB(0, 0), cB, voffB); PG8_STAGE(PG8_SB(0, 1), cB + hstep, voffB); PG8_STAGE(PG8_SA(0, 0), cA, voffA); PG8_STAGE(PG8_SA(0, 1), cA + hstep, voffA);
        if (wr == 1) PG8_BAR;
        PG8_WAIT_V(2); PG8_BAR;
        PG8_STAGE(PG8_SB(1, 0), cB + kstep, voffB); PG8_STAGE(PG8_SA(1, 0), cA + kstep, voffA); PG8_STAGE(PG8_SB(1, 1), cB + hstep + kstep, voffB);
        PG8_WAIT_V(6); PG8_BAR;
    } else {
        PG8_STAGE(PG8_SB(0, 0), cB, voffB); PG8_STAGE(PG8_SA(0, 0), cA, voffA); PG8_STAGE(PG8_SB(0, 1), cB + hstep, voffB); PG8_STAGE(PG8_SA(0, 1), cA + hstep, voffA);
        if (wr == 1) PG8_BAR;
        PG8_WAIT_V(4); PG8_BAR;
        PG8_STAGE(PG8_SB(1, 0), cB + kstep, voffB); PG8_STAGE(PG8_SA(1, 0), cA + kstep, voffA); PG8_STAGE(PG8_SB(1, 1), cB + hstep + kstep, voffB);
        PG8_WAIT_V(6); PG8_BAR;
    }
    for (;;) {
        const bool has_next = S.next(ui + 1, nxt);
        const char* nA = has_next ? (const char*)g.A + (size_t)nxt.pm * tstep : cA; const char* nB = has_next ? (const char*)g.Bt + (size_t)nxt.pn * tstep : cB;
        for (int t = 0; t < nt; t += 2) {
            const bool last = (t == nt - 2);
            const char* a1 = cA + (size_t)(t + 1) * kstep;
            const char* a2 = last ? nA : cA + (size_t)(t + 2) * kstep; const char* b2 = last ? nB : cB + (size_t)(t + 2) * kstep;
            const char* a3 = a2 + kstep; const char* b3 = b2 + kstep;
            if (last && has_next) S.a_ready(nxt);
            if constexpr (SP2) {
            PG8_LDB(B0, 0, 0); PG8_LDB(B1, 0, 1); PG8_SCHED; PG8_LDA(At, 0, 0); PG8_STAGE(PG8_SA(1, 1), a1 + hstep, voffA);
            PG8_WAIT_V(8); PG8_WAIT_L(0); PG8_BAR; PG8_MMA(0, 0, At, B0); PG8_MMA(0, 1, At, B1); PG8_BAR; PG8_SCHED;
            PG8_LDA(At, 0, 1); PG8_STAGE(PG8_SB(0, 0), b2, voffB); PG8_STAGE(PG8_SB(0, 1), b2 + hstep, voffB); PG8_STAGE(PG8_SA(0, 0), a2, voffA);
            PG8_WAIT_V(8); PG8_WAIT_L(0); PG8_BAR; PG8_MMA(1, 0, At, B0); PG8_MMA(1, 1, At, B1); PG8_BAR; PG8_SCHED;
            PG8_LDB(B0, 1, 0); PG8_LDB(B1, 1, 1); PG8_SCHED; PG8_LDA(At, 1, 0); PG8_STAGE(PG8_SA(0, 1), a2 + hstep, voffA);
            PG8_WAIT_V(8); PG8_WAIT_L(0); PG8_BAR; PG8_MMA(0, 0, At, B0); PG8_MMA(0, 1, At, B1); PG8_BAR; PG8_SCHED;
            PG8_LDA(At, 1, 1); PG8_STAGE(PG8_SB(1, 0), b3, voffB); PG8_STAGE(PG8_SB(1, 1), b3 + hstep, voffB); PG8_STAGE(PG8_SA(1, 0), a3, voffA);
            PG8_WAIT_V(8); PG8_WAIT_L(0); PG8_BAR; PG8_MMA(1, 0, At, B0); PG8_MMA(1, 1, At, B1); PG8_BAR; PG8_SCHED;
            } else {
            PG8_LDB(B0, 0, 0); PG8_SCHED; PG8_LDA(At, 0, 0); PG8_STAGE(PG8_SA(1, 1), a1 + hstep, voffA);
            PG8_WAIT_L(8); PG8_BAR; PG8_WAIT_L(0); PG8_MMA(0, 0, At, B0); PG8_BAR; PG8_SCHED;
            PG8_LDB(B1, 0, 1); PG8_STAGE(PG8_SB(0, 0), b2, voffB);
            PG8_BAR; PG8_WAIT_L(0); PG8_MMA(0, 1, At, B1); PG8_BAR;
            PG8_LDA(At, 0, 1); PG8_STAGE(PG8_SA(0, 0), a2, voffA);
            PG8_BAR; PG8_WAIT_L(0); PG8_MMA(1, 0, At, B0); PG8_BAR; PG8_SCHED;
            PG8_STAGE(PG8_SB(0, 1), b2 + hstep, voffB);
            PG8_WAIT_V(6); PG8_BAR; PG8_MMA(1, 1, At, B1); PG8_BAR;
            PG8_LDB(B0, 1, 0); PG8_SCHED; PG8_LDA(At, 1, 0); PG8_STAGE(PG8_SA(0, 1), a2 + hstep, voffA);
            PG8_WAIT_L(8); PG8_BAR; PG8_WAIT_L(0); PG8_MMA(0, 0, At, B0); PG8_BAR; PG8_SCHED;
            PG8_LDB(B1, 1, 1); PG8_STAGE(PG8_SB(1, 0), b3, voffB);
            PG8_BAR; PG8_WAIT_L(0); PG8_MMA(0, 1, At, B1); PG8_BAR;
            PG8_LDA(At, 1, 1); PG8_STAGE(PG8_SA(1, 0), a3, voffA);
            PG8_BAR; PG8_WAIT_L(0); PG8_MMA(1, 0, At, B0); PG8_BAR; PG8_SCHED;
            PG8_STAGE(PG8_SB(1, 1), b3 + hstep, voffB);
            PG8_WAIT_V(6); PG8_BAR; PG8_MMA(1, 1, At, B1); PG8_BAR;
            }
        }
        if constexpr (ALIGN_EPI) { if (wr == 0) PG8_BAR; }
        if constexpr (!Epi::AFTER_DRAIN) { E(acc, cur, wr, wc, fr, fq); S.done(cur); }
        if (!has_next) break;
#pragma unroll
        for (int a = 0; a < 2; ++a)
#pragma unroll
            for (int b = 0; b < 2; ++b)
#pragma unroll
                for (int m = 0; m < 4; ++m)
#pragma unroll
                    for (int n = 0; n < 2; ++n) acc[a][b][m][n] = (f32x4){0.f, 0.f, 0.f, 0.f};
        cur = nxt; cA = nA; cB = nB; ++ui;
        if constexpr (ALIGN_EPI) { if (wr == 1) PG8_BAR; }
    }
    PG8_WAIT_V(0);
    if constexpr (!ALIGN_EPI) { if (wr == 0) PG8_BAR; }
    PG8_BAR;
    if constexpr (Epi::AFTER_DRAIN) { E.fused(acc, cur, wr, wc, fr, fq, lds, wid, lane); S.done(cur); }
#undef PG8_SA
#undef PG8_SB
#undef PG8_STAGE
#undef PG8_LDA
#undef PG8_LDB
#undef PG8_MMA
#undef PG8_WAIT_V
#undef PG8_WAIT_L
#undef PG8_BAR
#undef PG8_SCHED
}
}

namespace {
#define LAS __attribute__((address_space(3)))
#define GAS __attribute__((address_space(1)))
typedef unsigned short bf16;
typedef unsigned v4u __attribute__((ext_vector_type(4)));
typedef GAS unsigned gu32;
typedef float v2f __attribute__((ext_vector_type(2)));
constexpr int D = 1024, NB = 4, SEQ = 4096, CTX = 256, DEPTH = 2;
constexpr int TL = NB * SEQ, TC = NB * CTX, T = TL + TC;
constexpr int DFF = 2816, DIN = 2064, DU = 2304, NMOD = 9, MODW = NMOD * D;
constexpr int NR = NB + 1;
constexpr float EPS = 1e-6f;
constexpr int C_GA = 0, C_GB = 256, C_Q = 512, C_K = 1024, C_V = 1152, C_MQ = 1280, C_MK = 1536, C_MV = 1792, C_MO = 2048;
constexpr int SRC_COL0 = 256, SRC_GATE = 2048;
constexpr int NWAVES = 8, NTHREADS = 512;
constexpr int RING_BYTES = 131072, MISC_OFF = RING_BYTES, LDS_BYTES = 147456;
constexpr size_t al256(size_t x) { return (x + 255) & ~(size_t)255; }
constexpr size_t WS_CTL = 0, CTL_ZERO_BYTES = 65536;
constexpr int CW_BAR = 1024;
constexpr size_t WS_MOD = 1u << 20;
constexpr size_t WS_WI = al256(WS_MOD + (size_t)DEPTH * NR * MODW * 4);
constexpr size_t WS_WO = al256(WS_WI + (size_t)4 * 2 * DFF * D * 2);
constexpr size_t WS_WIN = al256(WS_WO + (size_t)4 * D * DFF * 2);
constexpr size_t WS_WOUT = al256(WS_WIN + (size_t)2 * DU * D * 2);
constexpr size_t WS_XC = al256(WS_WOUT + (size_t)2 * D * D * 2);
constexpr size_t WS_G = al256(WS_XC + (size_t)TC * D * 4);
constexpr size_t WS_HB = al256(WS_G + (size_t)T * 16 * 4);
constexpr size_t WS_X16 = al256(WS_HB + (size_t)T * D * 2);
constexpr size_t WS_Y_UNUSED = WS_X16;
constexpr size_t WS_R = al256(WS_X16 + (size_t)T * D * 2);
constexpr size_t WS_HS = al256(WS_R + (size_t)T * DFF * 2);
constexpr size_t WS_NL = al256(WS_HS + (size_t)2 * T * 256 * 4);
constexpr size_t WS_AM = al256(WS_NL + (size_t)32 * 68 * 64 * 4);
constexpr size_t WS_MS = al256(WS_AM + (size_t)32 * 68 * 2 * 4);
constexpr size_t WS_FM1 = al256(WS_MS + (size_t)32 * 68 * 4);
constexpr size_t WS_FM3 = al256(WS_FM1 + 128 * 128 * 2);
constexpr size_t WS_TW = al256(WS_FM3 + 64 * 128 * 2);
constexpr size_t WS_CT = al256(WS_TW + 4096 * 8);
constexpr size_t WS_RS = al256(WS_CT + 256 * 8);
constexpr size_t WS_SWFI = al256(WS_RS + (size_t)T * 16 * 4);
constexpr size_t WS_SWIN = al256(WS_SWFI + (size_t)4 * NR * 2 * DFF * 4);
constexpr size_t WS_SWG = al256(WS_SWIN + (size_t)2 * NR * DU * 4);
constexpr size_t WS_ROPE = al256(WS_SWG + (size_t)2 * NR * 16 * 4);
constexpr size_t WS_WGT = al256(WS_ROPE + 64 * 16 * 8);
constexpr size_t WS_DMC = al256(WS_WGT + (size_t)DEPTH * 32 * D * 2);
constexpr size_t WS_PROBE = al256(WS_DMC + 256 * 512 * 2);
constexpr size_t WS_NS2 = al256(WS_PROBE + 256);
constexpr size_t WS_MS2 = al256(WS_NS2 + (size_t)32 * 68 * 64 * 4);
constexpr size_t WS_END = al256(WS_MS2 + (size_t)32 * 68 * 4);

struct Ptrs { float* xl; float* xc; };
__device__ __forceinline__ int mod_row(int r) { return r < TL ? r / SEQ : NB; }
__device__ __forceinline__ float* xrow(const Ptrs& p, int r) { return r < TL ? p.xl + (size_t)r * D : p.xc + (size_t)(r - TL) * D; }
__device__ __forceinline__ float silu_f(float x) { return x / (1.f + expf(-x)); }
__device__ __forceinline__ float sigmoid_f(float x) { return 1.f / (1.f + expf(-x)); }
__device__ __forceinline__ float logsigmoid_f(float x) { return fminf(x, 0.f) - log1pf(expf(-fabsf(x))); }
__device__ __forceinline__ float bf2f(bf16 b) { return (float)__builtin_bit_cast(_Float16, b); }
__device__ __forceinline__ unsigned f2bf(float f) { return (unsigned)__builtin_bit_cast(unsigned short, (_Float16)f); }
__device__ __forceinline__ unsigned pk2(float lo, float hi) { return f2bf(lo) | (f2bf(hi) << 16); }
__device__ __forceinline__ float lane_xor(float v, int lane, int o) { return __int_as_float(__builtin_amdgcn_ds_bpermute((lane ^ o) << 2, __float_as_int(v))); }
__device__ __forceinline__ float lane_get(float v, int src) { return __int_as_float(__builtin_amdgcn_ds_bpermute(src << 2, __float_as_int(v))); }
__device__ __forceinline__ float wave_sum(float v, int lane) {
#pragma unroll
    for (int o = 1; o < 64; o <<= 1) v += lane_xor(v, lane, o);
    return v; }
#define RLX_AGENT __ATOMIC_RELAXED, __HIP_MEMORY_SCOPE_AGENT
struct Params { const float* in[17]; float* out; unsigned char* ws; };
typedef _Float16 half8 __attribute__((ext_vector_type(8)));
typedef _Float16 half4 __attribute__((ext_vector_type(4)));
typedef float f32x16 __attribute__((ext_vector_type(16)));
typedef float f32x4v __attribute__((ext_vector_type(4)));

using pg8::half8; using pg8::f32x4; using pg8::u32x4; using pg8::Unit; using pg8::bf16_t; using pg8::BM; using pg8::HALF;
__device__ __forceinline__ unsigned cvt_pk_bf16(float lo, float hi) { typedef float f2_t __attribute__((ext_vector_type(2))); typedef _Float16 h2_t __attribute__((ext_vector_type(2))); const f2_t v = {lo, hi}; return __builtin_bit_cast(unsigned, __builtin_convertvector(v, h2_t)); }
__device__ __forceinline__ float silu_fast(float x) { return x * __builtin_amdgcn_rcpf(1.f + __expf(-x)); }
__device__ __forceinline__ float rstd_row(const float* rowss, int row) {
    const f32x4 a = *(const f32x4*)(rowss + (size_t)row * 16), b = *(const f32x4*)(rowss + (size_t)row * 16 + 4), c = *(const f32x4*)(rowss + (size_t)row * 16 + 8), d = *(const f32x4*)(rowss + (size_t)row * 16 + 12);
    const f32x4 s = (a + b) + (c + d); return __builtin_amdgcn_rsqf(((s[0] + s[1]) + (s[2] + s[3])) * (1.f / 1024.f) + 1e-6f); }
typedef unsigned u32x2e __attribute__((ext_vector_type(2)));
constexpr int RSTD_TAB_OFF = MISC_OFF + 1024;
constexpr int BIAS_TAB_OFF = RSTD_TAB_OFF + 2048;
struct RstdOrder : pg8::StaticOrder {
    const float* rowss; LAS float* tab; int tid; mutable int cnt; const float* sw; int ncols;
    __device__ __forceinline__ void a_ready(const Unit& u) const { const int par = cnt & 1; ++cnt;
        if (tid < 256) tab[par * 256 + tid] = rstd_row(rowss, u.pm * BM + tid);
        else if (tid < 320) { const int mr = u.pm < TL / 256 ? u.pm / (SEQ / 256) : 4; *(LAS f32x4*)(tab + 512 + par * 256 + (tid - 256) * 4) = *(const f32x4*)(sw + (size_t)mr * ncols + u.pn * BM + (tid - 256) * 4); } }
};

struct EpiSwiglu {
    static constexpr bool PERM = true, AFTER_DRAIN = false;
    unsigned char* ws; int mat; LAS float* tab; mutable int cnt;
    __device__ __forceinline__ void operator()(const f32x4 (&acc)[2][2][4][2], const Unit& u, int wr, int wc, int fr, int fq) const {
        bf16_t* O = (bf16_t*)(ws + WS_R); constexpr int ldc = DFF;
        const LAS float* rt = tab + (cnt & 1) * 256 + wr * 64 + fr;
        const int row0 = u.pm * BM + wr * 64 + fr, col0 = u.pn * HALF + wc * 32 + 8 * fq;
        const LAS float* bs = tab + 512 + (cnt & 1) * 256 + wc * 32 + 8 * fq;
        const f32x4 bg0 = *(const LAS f32x4*)bs, bg1 = *(const LAS f32x4*)(bs + 4), bu0 = *(const LAS f32x4*)(bs + HALF), bu1 = *(const LAS f32x4*)(bs + HALF + 4); ++cnt;
#pragma unroll
        for (int ai = 0; ai < 2; ++ai)
#pragma unroll
            for (int m = 0; m < 4; ++m) { const int row = row0 + ai * HALF + m * 16; const float rs = rt[ai * HALF + m * 16]; bf16_t* rowp = O + (size_t)row * ldc + col0;
                const f32x4 g0 = acc[ai][0][m][0] * rs + bg0, g1 = acc[ai][0][m][1] * rs + bg1, u0 = acc[ai][1][m][0] * rs + bu0, u1 = acc[ai][1][m][1] * rs + bu1;
                f32x4 h0, h1;
#pragma unroll
                for (int i = 0; i < 4; ++i) { h0[i] = silu_fast(g0[i]) * u0[i]; h1[i] = silu_fast(g1[i]) * u1[i]; }
                u32x4 w; w.x = cvt_pk_bf16(h0[0], h0[1]); w.y = cvt_pk_bf16(h0[2], h0[3]); w.z = cvt_pk_bf16(h1[0], h1[1]); w.w = cvt_pk_bf16(h1[2], h1[3]);
                *(u32x4*)rowp = w; }
    }
};
struct EpiUProj {
    static constexpr bool PERM = true, AFTER_DRAIN = false;
    unsigned char* ws; int l; LAS float* tab; mutable int cnt;
    __device__ __forceinline__ void operator()(const f32x4 (&acc)[2][2][4][2], const Unit& u, int wr, int wc, int fr, int fq) const {
        bf16_t* O = (bf16_t*)(ws + WS_R); constexpr int ldc = DU, tl_panels = TL / 256; constexpr float qscale = 0.125f * 1.4426950408889634f;
        const float* rope = (const float*)(ws + WS_ROPE);
        const LAS float* rt = tab + (cnt & 1) * 256 + wr * 64 + fr; const LAS float* bs = tab + 512 + (cnt & 1) * 256 + wc * 32 + 8 * fq; ++cnt;
        const int row0 = u.pm * BM + wr * 64 + fr, col0 = u.pn * BM + wc * 32 + 8 * fq; const bool lat = u.pm < tl_panels;
        f32x4 bv[2][2];
#pragma unroll
        for (int bj = 0; bj < 2; ++bj)
#pragma unroll
            for (int n = 0; n < 2; ++n) bv[bj][n] = *(const LAS f32x4*)(bs + bj * HALF + n * 4);
        const bool isq = (u.pn == 2 || u.pn == 3); const bool isk = (u.pn == 4); const bool upper = fq >= 2;
#pragma unroll
        for (int ai = 0; ai < 2; ++ai)
#pragma unroll
            for (int m = 0; m < 4; ++m) { const int row = row0 + ai * HALF + m * 16; const float rs = rt[ai * HALF + m * 16]; bf16_t* rowp = O + (size_t)row * ldc + col0;
                f32x4 v[2][2];
#pragma unroll
                for (int bj = 0; bj < 2; ++bj)
#pragma unroll
                    for (int n = 0; n < 2; ++n) v[bj][n] = acc[ai][bj][m][n] * rs + bv[bj][n];
                if (isq || isk) {
                    if (lat) { const int pos = row & 4095; const int p = (wc & 1) ? (pos & 63) : (pos >> 6); const float* rp = rope + (size_t)(p * 16 + 8 * (fq & 1)) * 2;
                        const f32x4 cs0 = *(const f32x4*)rp, cs1 = *(const f32x4*)(rp + 4), cs2 = *(const f32x4*)(rp + 8), cs3 = *(const f32x4*)(rp + 12);
                        const f32x4 cc[2] = {{cs0[0], cs0[2], cs1[0], cs1[2]}, {cs2[0], cs2[2], cs3[0], cs3[2]}}, ss[2] = {{cs0[1], cs0[3], cs1[1], cs1[3]}, {cs2[1], cs2[3], cs3[1], cs3[3]}};
#pragma unroll
                        for (int bj = 0; bj < 2; ++bj) if (isq || bj == 0) {
#pragma unroll
                            for (int n = 0; n < 2; ++n) { f32x4 pv;
#pragma unroll
                                for (int i = 0; i < 4; ++i) { const unsigned xv = __float_as_uint(v[bj][n][i]); const auto sw = __builtin_amdgcn_permlane32_swap(xv, xv, false, false); pv[i] = __uint_as_float(upper ? sw[0] : sw[1]); }
                                v[bj][n] = upper ? (v[bj][n] * cc[n] + pv * ss[n]) : (v[bj][n] * cc[n] - pv * ss[n]); } } }
                    if (isq) {
#pragma unroll
                        for (int bj = 0; bj < 2; ++bj) { v[bj][0] = v[bj][0] * qscale; v[bj][1] = v[bj][1] * qscale; } } }
#pragma unroll
                for (int bj = 0; bj < 2; ++bj) { u32x4 w; w.x = cvt_pk_bf16(v[bj][0][0], v[bj][0][1]); w.y = cvt_pk_bf16(v[bj][0][2], v[bj][0][3]); w.z = cvt_pk_bf16(v[bj][1][0], v[bj][1][1]); w.w = cvt_pk_bf16(v[bj][1][2], v[bj][1][3]);
                    *(u32x4*)(rowp + bj * HALF) = w; } }
    }
};
struct EpiResid {
    static constexpr bool PERM = true, AFTER_DRAIN = false;
    unsigned char* ws; const float* xsrc32; const float* ng; int gate_off, nscale_off; float coef;
    __device__ __forceinline__ void operator()(const f32x4 (&acc)[2][2][4][2], const Unit& u, int wr, int wc, int fr, int fq) const {
        constexpr int ppb = SEQ / 256, mod_stride = MODW; const float* gate = (const float*)(ws + WS_MOD) + gate_off; const float* nscale = (const float*)(ws + WS_MOD) + nscale_off;
        bf16_t* hraw = (bf16_t*)(ws + WS_HB); float* rowss = (float*)(ws + WS_RS); bf16_t* x16 = (bf16_t*)(ws + WS_X16);
        const int prow = u.pm * BM; const int mr = u.pm / ppb;
        const int row0 = wr * 64 + fr, col0 = u.pn * BM + wc * 32 + 8 * fq;
        float ssq[2][4];
#pragma unroll
        for (int ai = 0; ai < 2; ++ai)
#pragma unroll
            for (int m = 0; m < 4; ++m) ssq[ai][m] = 0.f;
#pragma unroll
        for (int bj = 0; bj < 2; ++bj) { const int c = col0 + bj * HALF;
            const f32x4 gv0 = *(const f32x4*)(gate + (size_t)mr * mod_stride + c) * coef, gv1 = *(const f32x4*)(gate + (size_t)mr * mod_stride + c + 4) * coef;
            f32x4 hs0 = {0.f, 0.f, 0.f, 0.f}, hs1 = hs0;
            if (ng) { hs0 = *(const f32x4*)(ng + c) * (*(const f32x4*)(nscale + (size_t)mr * mod_stride + c) + 1.f); hs1 = *(const f32x4*)(ng + c + 4) * (*(const f32x4*)(nscale + (size_t)mr * mod_stride + c + 4) + 1.f); }
#pragma unroll
            for (int ai = 0; ai < 2; ++ai)
#pragma unroll
                for (int m = 0; m < 4; ++m) { const int rl = row0 + ai * HALF + m * 16; const size_t off = (size_t)(prow + rl) * 1024 + c;
                    f32x4 xo0, xo1;
                    if (xsrc32) { xo0 = *(const f32x4*)(xsrc32 + off); xo1 = *(const f32x4*)(xsrc32 + off + 4); }
                    else { const half8 hx = __builtin_bit_cast(half8, *(const u32x4*)(x16 + off)); xo0 = (f32x4){(float)hx[0], (float)hx[1], (float)hx[2], (float)hx[3]}; xo1 = (f32x4){(float)hx[4], (float)hx[5], (float)hx[6], (float)hx[7]}; }
                    const f32x4 x0 = xo0 + gv0 * acc[ai][bj][m][0], x1 = xo1 + gv1 * acc[ai][bj][m][1];
                    { u32x4 w; w.x = cvt_pk_bf16(x0[0], x0[1]); w.y = cvt_pk_bf16(x0[2], x0[3]); w.z = cvt_pk_bf16(x1[0], x1[1]); w.w = cvt_pk_bf16(x1[2], x1[3]); *(u32x4*)(x16 + off) = w; }
                    ssq[ai][m] += ((x0[0] * x0[0] + x0[1] * x0[1]) + (x0[2] * x0[2] + x0[3] * x0[3])) + ((x1[0] * x1[0] + x1[1] * x1[1]) + (x1[2] * x1[2] + x1[3] * x1[3]));
                    if (ng) { const f32x4 h0 = x0 * hs0, h1 = x1 * hs1; u32x4 w; w.x = cvt_pk_bf16(h0[0], h0[1]); w.y = cvt_pk_bf16(h0[2], h0[3]); w.z = cvt_pk_bf16(h1[0], h1[1]); w.w = cvt_pk_bf16(h1[2], h1[3]); *(u32x4*)(hraw + off) = w; } } }
        const int lane = fq * 16 + fr;
#pragma unroll
        for (int ai = 0; ai < 2; ++ai)
#pragma unroll
            for (int m = 0; m < 4; ++m) { float q = ssq[ai][m];
                q += __int_as_float(__builtin_amdgcn_ds_bpermute((lane ^ 16) << 2, __float_as_int(q)));
                q += __int_as_float(__builtin_amdgcn_ds_bpermute((lane ^ 32) << 2, __float_as_int(q)));
                if (fq == 0) rowss[(size_t)(prow + row0 + ai * HALF + m * 16) * 16 + u.pn * 4 + wc] = q; }
    }
};
#define XB_TMO      128
#define XB_XCNT(j)  (256  + 64 * (j))
#define XB_XSUB(j)  (1280 + 64 * (j))
#define XB_XGEN(j)  (2304 + 64 * (j))
#define XB_TOP      3328
#define XB_TOPGEN   3392
#define XCD_BAR_WORDS 3456
#define XB_SPIN_CAP (1u << 18)

__device__ __forceinline__ unsigned xb_ld(unsigned* p)              { return __hip_atomic_load(p, __ATOMIC_RELAXED, __HIP_MEMORY_SCOPE_AGENT); }
__device__ __forceinline__ unsigned xb_add(unsigned* p, unsigned v) { return __hip_atomic_fetch_add(p, v, __ATOMIC_RELAXED, __HIP_MEMORY_SCOPE_AGENT); }
__device__ __forceinline__ unsigned xb_xcc_id() { return (unsigned)__builtin_amdgcn_s_getreg((3 << 11) | 20) & 0xFu; }
#define XB_SPIN(cond, bar) do { unsigned _sp = 0; while (cond) { __builtin_amdgcn_s_sleep(1); \
    if ((++_sp & 255u) == 0u) { if (xb_ld(&(bar)[XB_TMO])) break; if (_sp > XB_SPIN_CAP) { atomicAdd(&(bar)[XB_TMO], 1u); break; } } } } while (0)

struct XcdBarrier {
    unsigned* bar; unsigned x;
    volatile LAS unsigned* st;
};

__device__ __forceinline__ XcdBarrier xcd_barrier_post(unsigned* bar, volatile LAS unsigned* st) {
    XcdBarrier b; b.bar = bar; b.x = xb_xcc_id(); b.st = st;
    if (threadIdx.x == 0) (void)xb_add(&bar[XB_XCNT(b.x)], 1u);
    return b;
}
__device__ __forceinline__ void xcd_barrier_complete(unsigned* bar, unsigned x, unsigned& nloc, unsigned& nx) {
    const unsigned G = gridDim.x * gridDim.y * gridDim.z;
    unsigned sum, cnt, mine, sp = 0u;
    for (;;) {
        sum = 0u; cnt = 0u; mine = 0u;
#pragma unroll
        for (unsigned j = 0; j < 16; ++j) { const unsigned c = xb_ld(&bar[XB_XCNT(j)]); sum += c; cnt += (c > 0u) ? 1u : 0u; mine = (j == x) ? c : mine; }
        if (sum == G) break;
        __builtin_amdgcn_s_sleep(1);
        if ((++sp & 255u) == 0u) { if (xb_ld(&bar[XB_TMO])) break; if (sp > XB_SPIN_CAP) { atomicAdd(&bar[XB_TMO], 1u); break; } }
    }
    nloc = mine > 0u ? mine : 1u; nx = cnt > 0u ? cnt : 1u;
}

__device__ __forceinline__ void xcd_barrier(const XcdBarrier& b) {
    asm volatile("s_waitcnt vmcnt(0)" ::: "memory");
    __syncthreads();
    if (threadIdx.x == 0) {
        unsigned* bar = b.bar;
        __builtin_amdgcn_s_waitcnt(0);
        unsigned nloc = b.st[0], nx = b.st[1];
        if (nloc == 0u) { xcd_barrier_complete(bar, b.x, nloc, nx); b.st[0] = nloc; b.st[1] = nx; }
        const unsigned old = xb_add(&bar[XB_XSUB(b.x)], 1u);
        const unsigned gen = old / nloc;
        if (old + 1u == (gen + 1u) * nloc) {
            __builtin_amdgcn_fence(__ATOMIC_RELEASE, "agent");
            asm volatile("s_waitcnt vmcnt(0)" ::: "memory");
            const unsigned og = xb_add(&bar[XB_TOP], 1u);
            const unsigned tg = og / nx;
            if (og + 1u == (tg + 1u) * nx) xb_add(&bar[XB_TOPGEN], 1u);
            else XB_SPIN(xb_ld(&bar[XB_TOPGEN]) == tg, bar);
            __builtin_amdgcn_fence(__ATOMIC_ACQUIRE, "agent");
            xb_add(&bar[XB_XGEN(b.x)], 1u);
            asm volatile("s_waitcnt vmcnt(0)" ::: "memory");
        } else {
            XB_SPIN(xb_ld(&bar[XB_XGEN(b.x)]) == gen, bar);
            __builtin_amdgcn_fence(__ATOMIC_ACQUIRE, "agent");
            asm volatile("s_waitcnt vmcnt(0)" ::: "memory");
        }
    }
    __syncthreads();
}

struct Frame {
    LAS unsigned char* lds; unsigned char* ldsg;
    int tid, lane, wave, G, bid, gw, NGW;
    float* out; unsigned char* ws;
};

__device__ __forceinline__ void ph_mod(Frame& F, const Params& P) {
    const float* c = P.in[1]; const float* cctx = P.in[3]; const float* w_ada = P.in[4]; const float* b_ada = P.in[5]; float* MOD = (float*)(F.ws + WS_MOD);
    float* s = (float*)F.ldsg; float* red = s + NR * D;
    constexpr int NMODIT = DEPTH * (MODW / 128); const int mb = F.bid - (F.G - NMODIT);
    if (mb >= 0) { for (int i = F.tid; i < NR * D; i += NTHREADS) { const int r = i / D, k = i % D; const float v = r < NB ? c[r * D + k] : cctx[k]; s[i] = silu_f(v); } }
    for (int it = mb; it >= 0 && it < NMODIT; it += F.G) {
        const int l = it / (MODW / 128), j = (it % (MODW / 128)) * 128 + 2 * F.lane;
        __syncthreads();
        float a0[NR], a1[NR];
#pragma unroll
        for (int r = 0; r < NR; ++r) { a0[r] = 0.f; a1[r] = 0.f; }
        const float* w = w_ada + ((size_t)l * D + 128 * F.wave) * MODW + j;
#pragma unroll 16
        for (int k = 0; k < 128; ++k) { const float2 wv = *(const float2*)(w + (size_t)k * MODW);
#pragma unroll
            for (int r = 0; r < NR; ++r) { const float sv = s[r * D + 128 * F.wave + k]; a0[r] += sv * wv.x; a1[r] += sv * wv.y; } }
#pragma unroll
        for (int r = 0; r < NR; ++r) { red[(F.wave * NR + r) * 128 + 2 * F.lane] = a0[r]; red[(F.wave * NR + r) * 128 + 2 * F.lane + 1] = a1[r]; }
        __syncthreads();
        for (int idx = F.tid; idx < NR * 128; idx += NTHREADS) { const int r = idx >> 7, cc = idx & 127; float a = 0.f;
#pragma unroll
            for (int w8 = 0; w8 < 8; ++w8) a += red[(w8 * NR + r) * 128 + cc];
            const int jj = (it % (MODW / 128)) * 128 + cc; MOD[((size_t)l * NR + r) * MODW + jj] = a + b_ada[l * MODW + jj]; }
    }
    __syncthreads();
}
__device__ __forceinline__ void transpose_item(const float* W, int ldw, int K, bf16* WT, int dst_row0, int k0, int n0, LAS float* scr, int lane) {
#pragma unroll
    for (int i = 0; i < 8; ++i) { const int kk = 8 * i + (lane >> 3), nq = (lane & 7) * 4; const float4 v = *(const float4*)(W + (size_t)(k0 + kk) * ldw + n0 + nq);
        scr[kk * 33 + nq] = v.x; scr[kk * 33 + nq + 1] = v.y; scr[kk * 33 + nq + 2] = v.z; scr[kk * 33 + nq + 3] = v.w; }
    asm volatile("s_waitcnt lgkmcnt(0)" ::: "memory");
    const int c = lane & 7;
#pragma unroll
    for (int j = 0; j < 4; ++j) { const int n = (lane >> 3) + 8 * j; const LAS float* s = scr + (8 * c) * 33 + n;
        v4u o; o.x = pk2(s[0 * 33], s[1 * 33]); o.y = pk2(s[2 * 33], s[3 * 33]); o.z = pk2(s[4 * 33], s[5 * 33]); o.w = pk2(s[6 * 33], s[7 * 33]);
        *(v4u*)(WT + (size_t)(dst_row0 + n) * K + k0 + 8 * c) = o; }
    asm volatile("s_waitcnt lgkmcnt(0)" ::: "memory");
}
__device__ __forceinline__ void ph_convert(Frame& F, const Params& P, int l, int it0, int it1, int rank, int nw) {
    const float* w_ffn_in = P.in[7]; const float* w_ffn_out = P.in[8]; const float* w_in = P.in[9]; const float* w_out = P.in[10];
    bf16* Wi_t = (bf16*)(F.ws + WS_WI); bf16* Wo_t = (bf16*)(F.ws + WS_WO); bf16* Win_t = (bf16*)(F.ws + WS_WIN); bf16* Wout_t = (bf16*)(F.ws + WS_WOUT);
    LAS float* scr = (LAS float*)(F.lds + F.wave * 16384);
    constexpr int NSRC = SRC_GATE - SRC_COL0; constexpr int I_FI = (D / 64) * (2 * DFF / 32), I_FO = (DFF / 64) * (D / 32), I_IN = (D / 64) * (NSRC / 32), I_OUT = (D / 64) * (D / 32);
    constexpr int NITEMS = 2 * I_FI + 2 * I_FO + I_IN + I_OUT;
    if (it1 > NITEMS) it1 = NITEMS;
    for (int it = it0 + rank; it < it1; it += nw) {
        int r = it;
        if (r < 2 * I_FI) { const int mat = 2 * l + r / I_FI; r %= I_FI; const int nblk = 2 * DFF / 32, kb = r / nblk, nb = r % nblk, n0 = 32 * nb;
            const int nn = n0 < DFF ? n0 : n0 - DFF; const int drow = 256 * (nn / 128) + (n0 < DFF ? 0 : 128) + (nn % 128);
            transpose_item(w_ffn_in + (size_t)mat * D * 2 * DFF, 2 * DFF, D, Wi_t + (size_t)mat * 2 * DFF * D, drow, 64 * kb, n0, scr, F.lane); continue; }
        r -= 2 * I_FI;
        if (r < 2 * I_FO) { const int mat = 2 * l + r / I_FO; r %= I_FO; const int nblk = D / 32, kb = r / nblk, nb = r % nblk;
            transpose_item(w_ffn_out + (size_t)mat * DFF * D, D, DFF, Wo_t + (size_t)mat * D * DFF, 32 * nb, 64 * kb, 32 * nb, scr, F.lane); continue; }
        r -= 2 * I_FO;
        if (r < I_IN) { const int nblk = NSRC / 32, kb = r / nblk, nb = r % nblk;
            transpose_item(w_in + (size_t)l * D * DIN, DIN, D, Win_t + (size_t)l * DU * D, 512 + 32 * nb, 64 * kb, SRC_COL0 + 32 * nb, scr, F.lane); continue; }
        r -= I_IN;
        { const int nblk = D / 32, kb = r / nblk, nb = r % nblk;
            transpose_item(w_out + (size_t)l * D * D, D, D, Wout_t + (size_t)l * D * D, 32 * nb, 64 * kb, 32 * nb, scr, F.lane); }
    }
}
__device__ __forceinline__ void ph_first(Frame& F, const Params& P) {
    const float* xin = P.in[0]; const float* cin = P.in[2]; const float* g = P.in[6]; const float* MOD = (const float*)(F.ws + WS_MOD);
    bf16* H = (bf16*)(F.ws + WS_HB); float* RS = (float*)(F.ws + WS_RS);
    constexpr int RB = 4;
    for (int r0 = F.gw * RB; r0 < T; r0 += F.NGW * RB) {
        float4 v[RB][4];
#pragma unroll
        for (int i = 0; i < RB; ++i) { const int r = r0 + i; const float* src = r < TL ? xin + (size_t)r * D : cin + (size_t)(r - TL) * D;
#pragma unroll
            for (int j = 0; j < 4; ++j) v[i][j] = ((const float4*)src)[F.lane + 64 * j]; }
        const int mr = mod_row(r0);
        float4 gs[4];
#pragma unroll
        for (int j = 0; j < 4; ++j) { const int q = F.lane + 64 * j; const float4 gv = ((const float4*)g)[q], sc = ((const float4*)(MOD + (size_t)mr * MODW + 1 * D))[q]; gs[j] = make_float4(gv.x * (1.f + sc.x), gv.y * (1.f + sc.y), gv.z * (1.f + sc.z), gv.w * (1.f + sc.w)); }
        float ss[RB];
#pragma unroll
        for (int i = 0; i < RB; ++i) { const int r = r0 + i; ss[i] = 0.f;
#pragma unroll
            for (int j = 0; j < 4; ++j) { const float4 x = v[i][j]; ss[i] += x.x * x.x + x.y * x.y + x.z * x.z + x.w * x.w;
                uint2 o; o.x = pk2(x.x * gs[j].x, x.y * gs[j].y); o.y = pk2(x.z * gs[j].z, x.w * gs[j].w); ((uint2*)(H + (size_t)r * D))[F.lane + 64 * j] = o; } }
#pragma unroll
        for (int i = 0; i < RB; ++i) ss[i] = wave_sum(ss[i], F.lane);
#pragma unroll
        for (int i = 0; i < RB; ++i) if (F.lane < 16) RS[(size_t)(r0 + i) * 16 + F.lane] = F.lane == 0 ? ss[i] : 0.f;
    }
}
__device__ __forceinline__ void ph_bias(Frame& F, const Params& P, int l) {
    const float* MOD = (const float*)(F.ws + WS_MOD); const bf16* Wi_t = (const bf16*)(F.ws + WS_WI); const bf16* Win_t = (const bf16*)(F.ws + WS_WIN);
    float* SWFI = (float*)(F.ws + WS_SWFI); float* SWIN = (float*)(F.ws + WS_SWIN); float* SWG = (float*)(F.ws + WS_SWG);
#pragma unroll 1
    for (int mg = 0; mg < 4; ++mg) {
        const bool fi = mg < 2; const int mat = fi ? 2 * l + mg : l, sidx = fi ? (mg ? 6 : 0) : 3, nrows = fi ? 2 * DFF : (mg == 2 ? DU : 16);
        float sh[NR][16];
#pragma unroll
        for (int r = 0; r < NR; ++r) { const float4* sp = (const float4*)(MOD + ((size_t)l * NR + r) * MODW + sidx * D + F.lane * 16);
#pragma unroll
            for (int q4 = 0; q4 < 4; ++q4) { const float4 s4 = sp[q4]; sh[r][4 * q4] = s4.x; sh[r][4 * q4 + 1] = s4.y; sh[r][4 * q4 + 2] = s4.z; sh[r][4 * q4 + 3] = s4.w; } }
        const bf16* wbase = fi ? Wi_t + (size_t)mat * 2 * DFF * D : (mg == 2 ? Win_t + (size_t)mat * DU * D : (const bf16*)(F.ws + WS_WGT) + (size_t)l * 32 * D);
        float* obase = fi ? SWFI + (size_t)mat * NR * 2 * DFF : (mg == 2 ? SWIN + (size_t)mat * NR * DU : SWG + (size_t)l * NR * 16);
        for (int row = F.gw; row < nrows; row += F.NGW) {
            const bf16* wr = wbase + (size_t)row * D + F.lane * 16;
            const half8 w0 = __builtin_bit_cast(half8, *(const v4u*)wr), w1 = __builtin_bit_cast(half8, *(const v4u*)(wr + 8));
            float x[16];
#pragma unroll
            for (int i = 0; i < 16; ++i) x[i] = i < 8 ? (float)w0[i] : (float)w1[i - 8];
#pragma unroll
            for (int r = 0; r < NR; ++r) { float a = 0.f;
#pragma unroll
                for (int i = 0; i < 16; ++i) a += sh[r][i] * x[i];
                a = wave_sum(a, F.lane); if (F.lane == 0) obase[(size_t)r * nrows + row] = a; }
        }
    }
}
__device__ __forceinline__ void ph_rope_table(Frame& F, const Params& P) {
    float2* RT = (float2*)(F.ws + WS_ROPE); bf16* WgT = (bf16*)(F.ws + WS_WGT);
    for (int i = F.bid * NTHREADS + F.tid; i < DEPTH * 32 * D; i += F.G * NTHREADS) { const int l = i / (32 * D), j = (i / D) & 31, k = i % D; WgT[i] = (bf16)(j < 16 ? f2bf(P.in[9][((size_t)l * D + k) * DIN + SRC_GATE + j]) : 0u); }
    for (int i = F.bid + F.G * F.tid; i < 64 * 16 && F.tid < 8; i += F.G * 8) { const int p = i >> 4, f = i & 15;     const float ang = (float)p * powf(10000.f, -(float)f / 16.f); RT[i] = make_float2(cosf(ang), sinf(ang)); }
}
__device__ __forceinline__ void ph_final(Frame& F, const Params& P) {
    const float* g = P.in[16]; const float* RS = (const float*)(F.ws + WS_RS); const bf16* X16 = (const bf16*)(F.ws + WS_X16);
    constexpr int RB = 4;
    float4 gv[4];
#pragma unroll
    for (int j = 0; j < 4; ++j) gv[j] = ((const float4*)g)[F.lane + 64 * j];
    for (int r0 = F.gw * RB; r0 < TL; r0 += F.NGW * RB) {
        half4 hx[RB][4]; float rstd[RB];
#pragma unroll
        for (int i = 0; i < RB; ++i) { rstd[i] = rstd_row(RS, r0 + i);
#pragma unroll
            for (int j = 0; j < 4; ++j) hx[i][j] = *(const half4*)(X16 + (size_t)(r0 + i) * D + 4 * (F.lane + 64 * j)); }
#pragma unroll
        for (int i = 0; i < RB; ++i) { float* o = F.out + (size_t)(r0 + i) * D;
#pragma unroll
            for (int j = 0; j < 4; ++j) ((float4*)o)[F.lane + 64 * j] = make_float4((float)hx[i][j][0] * rstd[i] * gv[j].x, (float)hx[i][j][1] * rstd[i] * gv[j].y, (float)hx[i][j][2] * rstd[i] * gv[j].z, (float)hx[i][j][3] * rstd[i] * gv[j].w); }
    }
}
__device__ __forceinline__ void ph_gates(Frame& F, int l) {
    const bf16* H = (const bf16*)(F.ws + WS_HB); float* G = (float*)(F.ws + WS_G); const float* RS = (const float*)(F.ws + WS_RS); const float* SWG = (const float*)(F.ws + WS_SWG) + l * NR * 16;
    const bf16* WgT = (const bf16*)(F.ws + WS_WGT) + (size_t)l * 32 * D;
    const int r32 = F.lane & 31, hh = F.lane >> 5;
    for (int rb = (F.gw + F.NGW - 100 * NWAVES) % F.NGW; rb < T / 32; rb += F.NGW) {
        const bf16* hp = H + (size_t)(rb * 32 + r32) * D + 8 * hh; const bf16* wp = WgT + (size_t)r32 * D + 8 * hh;
        f32x16 acc = {};
#pragma unroll 8
        for (int s = 0; s < 64; ++s) acc = __builtin_amdgcn_mfma_f32_32x32x16_f16(__builtin_bit_cast(half8, *(const v4u*)(wp + 16 * s)), __builtin_bit_cast(half8, *(const v4u*)(hp + 16 * s)), acc, 0, 0, 0);
        const int row = rb * 32 + r32; const float rstd = rstd_row(RS, row); const float* sb = SWG + mod_row(row) * 16;
#pragma unroll
        for (int q4 = 0; q4 < 2; ++q4) { const int j0 = 8 * q4 + 4 * hh; f32x4v o;
#pragma unroll
            for (int i = 0; i < 4; ++i) o[i] = acc[4 * q4 + i] * rstd + sb[j0 + i];
            *(f32x4v*)(G + (size_t)row * 16 + j0) = o; }
    }
}
constexpr int TP = 144;
constexpr int NCH = 68, NCHAIN = 32, NITEM = NCHAIN * NCH;
__device__ __forceinline__ f32x16 mfma32(half8 a, half8 b, f32x16 c) { return __builtin_amdgcn_mfma_f32_32x32x16_f16(a, b, c, 0, 0, 0); }
__device__ __forceinline__ float wave_max(float v, int lane) {
#pragma unroll
    for (int o = 1; o < 64; o <<= 1) v = fmaxf(v, lane_xor(v, lane, o));
    return v; }
struct ChunkGeo { int N, rb, p0, dp; };
__device__ __forceinline__ ChunkGeo chunk_geo(int b, int dir, int c  ) {
    ChunkGeo g; const bool isctx = c < 4; const int cc = isctx ? c : c - 4; g.N = isctx ? CTX : SEQ; g.rb = isctx ? TL + b * CTX : b * SEQ;
    if (dir == 0) { g.p0 = cc * 64; g.dp = 1; } else { g.p0 = g.N - 1 - cc * 64; g.dp = -1; }
    return g; }
__device__ __forceinline__ void conv16(const bf16* urow  , int p, int N, int colbase, const float* cw, float scale, float (&out)[16]) {
    const v4u c0 = *(const v4u*)(urow + colbase), c1 = *(const v4u*)(urow + colbase + 8);
    v4u m0 = {0u, 0u, 0u, 0u}, m1 = m0, n0 = m0, n1 = m0;
    if (p > 0) { m0 = *(const v4u*)(urow - DU + colbase); m1 = *(const v4u*)(urow - DU + colbase + 8); }
    if (p < N - 1) { n0 = *(const v4u*)(urow + DU + colbase); n1 = *(const v4u*)(urow + DU + colbase + 8); }
    const half8 hc0 = __builtin_bit_cast(half8, c0), hc1 = __builtin_bit_cast(half8, c1), hm0 = __builtin_bit_cast(half8, m0), hm1 = __builtin_bit_cast(half8, m1), hn0 = __builtin_bit_cast(half8, n0), hn1 = __builtin_bit_cast(half8, n1);
#pragma unroll
    for (int i = 0; i < 16; ++i) { const float xm = i < 8 ? (float)hm0[i] : (float)hm1[i - 8], xc = i < 8 ? (float)hc0[i] : (float)hc1[i - 8], xn = i < 8 ? (float)hn0[i] : (float)hn1[i - 8];
        const float a = xm * cw[i] + xc * cw[512 + i] + xn * cw[1024 + i]; out[i] = a * __builtin_amdgcn_rcpf(1.f + __expf(-a)) * scale; }
}
__device__ __forceinline__ void st_row16(LAS unsigned char* tile, int row, int c0, const float (&v)[16]) {
    v4u a, b; a.x = pk2(v[0], v[1]); a.y = pk2(v[2], v[3]); a.z = pk2(v[4], v[5]); a.w = pk2(v[6], v[7]); b.x = pk2(v[8], v[9]); b.y = pk2(v[10], v[11]); b.z = pk2(v[12], v[13]); b.w = pk2(v[14], v[15]);
    *(LAS v4u*)(tile + row * TP + c0 * 2) = a; *(LAS v4u*)(tile + row * TP + c0 * 2 + 16) = b; }
__device__ __forceinline__ void st_col16(LAS unsigned char* tile, int col, int r0, const float (&v)[16]) {
#pragma unroll
    for (int i = 0; i < 16; ++i) *(LAS unsigned short*)(tile + (r0 + i) * TP + col * 2) = (unsigned short)f2bf(v[i]); }
__device__ __forceinline__ half8 ld_row8(const LAS unsigned char* tile, int row, int c0) { return __builtin_bit_cast(half8, *(const LAS v4u*)(tile + row * TP + c0 * 2)); }

__device__ __forceinline__ void ph_mlstm_m1(Frame& F, const float* conv, const float* b_i, const float* b_f) {
    const bf16* U = (const bf16*)(F.ws + WS_R); const float* G = (const float*)(F.ws + WS_G);
    bf16* CL = (bf16*)(F.ws + WS_HS); float* NL = (float*)(F.ws + WS_NL); float* AM = (float*)(F.ws + WS_AM);
    const int dir = F.wave >> 2, wg = F.wave & 3, tg = F.tid & 255, r32 = F.lane & 31, hh = F.lane >> 5;
    LAS unsigned char* base = F.lds + dir * 24576; LAS unsigned char* KT = base; LAS unsigned char* VT = base + 9216; LAS float* wS = (LAS float*)(base + 18432);
    for (int it = F.bid; it < 16 * NCH; it += F.G) {
        const int bh = it / NCH, c = it % NCH, b = bh >> 2, h = bh & 3; const ChunkGeo g = chunk_geo(b, dir, c); const int item = (bh * 2 + dir) * NCH + c;
        if (wg == 0) { const int p = g.p0 + g.dp * F.lane; const float* g0 = G + (size_t)(g.rb + p) * 16;
            const float liv = g0[dir * 4 + h] + b_i[dir * 4 + h], lfv = logsigmoid_f(g0[8 + dir * 4 + h] + b_f[dir * 4 + h]);
            float bc = lfv;
#pragma unroll
            for (int o = 1; o < 64; o <<= 1) { const float t = lane_get(bc, F.lane - o); if (F.lane >= o) bc += t; }
            const float a = lane_get(bc, 63); const float dl = a - bc + liv; const float ml = wave_max(dl, F.lane);
            wS[F.lane] = __expf(dl - ml);
            if (F.lane == 0) { AM[item * 2] = a; AM[item * 2 + 1] = ml; } }
        __syncthreads();
        { const int tau = tg >> 2, d0 = (tg & 3) * 16; const int p = g.p0 + g.dp * tau; const bf16* urow = U + (size_t)(g.rb + p) * DU;
          float kv[16], vv[16]; conv16(urow, p, g.N, C_MK + h * 64 + d0, conv + 256 + h * 64 + d0, 0.125f, kv);
          const float w = wS[tau]; const half8 v0 = __builtin_bit_cast(half8, *(const v4u*)(urow + C_MV + h * 64 + d0)), v1 = __builtin_bit_cast(half8, *(const v4u*)(urow + C_MV + h * 64 + d0 + 8));
#pragma unroll
          for (int i = 0; i < 16; ++i) vv[i] = (i < 8 ? (float)v0[i] : (float)v1[i - 8]) * w;
          st_col16(KT, tau, d0, kv); st_col16(VT, tau, d0, vv); }
        __syncthreads();
        { const int tm = wg >> 1, tn = wg & 1; f32x16 acc = {};
#pragma unroll
          for (int s = 0; s < 4; ++s) acc = mfma32(ld_row8(VT, 32 * tm + r32, 16 * s + 8 * hh), ld_row8(KT, 32 * tn + r32, 16 * s + 8 * hh), acc);
          bf16* cl = CL + (size_t)item * 4096 + 32 * tn + r32;
#pragma unroll
          for (int r = 0; r < 16; ++r) cl[(size_t)(32 * tm + (r & 3) + 8 * (r >> 2) + 4 * hh) * 64] = (bf16)f2bf(acc[r]);
          if (tg < 64) { float a = 0.f; const LAS unsigned char* kr = KT + tg * TP;
#pragma unroll 8
              for (int s = 0; s < 64; ++s) a += wS[s] * bf2f(*(const LAS unsigned short*)(kr + s * 2));
              NL[(size_t)item * 64 + tg] = a; } }
        __syncthreads();
    }
}
__device__ __forceinline__ void ph_mlstm_m2(Frame& F) {
    bf16* CL = (bf16*)(F.ws + WS_HS); float* NL = (float*)(F.ws + WS_NL); const float* AM = (const float*)(F.ws + WS_AM); float* MS = (float*)(F.ws + WS_MS);
    for (int vb = F.bid; vb < NCHAIN * 8; vb += F.G) {
        const int chain = vb >> 3, sl = vb & 7, e = sl * NTHREADS + F.tid; const bool don = (sl == 0 && F.tid < 64);
        bf16* cp = CL + (size_t)chain * NCH * 4096 + e; float* np = NL + (size_t)chain * NCH * 64 + (F.tid & 63); const float* am = AM + (size_t)chain * NCH * 2;
        float cl[NCH];
#pragma unroll
        for (int c = 0; c < NCH; ++c) cl[c] = bf2f(cp[(size_t)c * 4096]);
        { float C = 0.f, m = 0.f;
#pragma unroll
          for (int c = 0; c < NCH; ++c) { const float a = am[c * 2], ml = am[c * 2 + 1]; const float mn = fmaxf(a + m, ml), al = __expf(a + m - mn), be = __expf(ml - mn);
              cp[(size_t)c * 4096] = (bf16)f2bf(fminf(fmaxf(C, -60000.f), 60000.f)); C = al * C + be * cl[c];
              if (sl == 0 && F.tid == 0) MS[chain * NCH + c] = m;
              m = mn; } }
        if (don) {
#pragma unroll
            for (int c = 0; c < NCH; ++c) cl[c] = np[c * 64];
            float nvv = 0.f, m = 0.f;
#pragma unroll
            for (int c = 0; c < NCH; ++c) { const float a = am[c * 2], ml = am[c * 2 + 1]; const float mn = fmaxf(a + m, ml), al = __expf(a + m - mn), be = __expf(ml - mn);
                np[c * 64] = nvv; nvv = al * nvv + be * cl[c]; m = mn; } }
    }
}
__device__ __forceinline__ void ph_mlstm_m3(Frame& F, const float* conv, const float* b_i, const float* b_f, bool do_ctx) {
    const bf16* U = (const bf16*)(F.ws + WS_R); const float* G = (const float*)(F.ws + WS_G); bf16* Y = (bf16*)F.out;
    const bf16* CL = (const bf16*)(F.ws + WS_HS); const float* NL = (const float*)(F.ws + WS_NL); const float* AM = (const float*)(F.ws + WS_AM);
    bf16* CS = (bf16*)(F.ws + WS_HS) + (size_t)NITEM * 4096; float* NS = (float*)(F.ws + WS_NS2); float* MS = (float*)(F.ws + WS_MS2);
    const int dir = F.wave >> 2, wg = F.wave & 3, tg = F.tid & 255, r32 = F.lane & 31, hh = F.lane >> 5;
    LAS unsigned char* base = F.lds + dir * 40960; LAS unsigned char* Qs = base; LAS unsigned char* Ks = base + 9216; LAS unsigned char* VT = base + 18432; LAS unsigned char* Cs = base + 27648;
    LAS float* fa = (LAS float*)(base + 36864); LAS float* bcS = fa; LAS float* lmbS = fa + 64; LAS float* mtS = fa + 128; LAS float* wpS = fa + 192; LAS float* n0S = fa + 256;
    LAS float* HO = (LAS float*)(F.lds + 81920);
    if (F.bid >= 256) return;
    const int bh = (F.bid & 7) * 2 + ((F.bid >> 3) & 1), sg = F.bid >> 4, b = bh >> 2, h = bh & 3;     const bool has_ctx = do_ctx && sg < 4;
    {
      const int chain = bh * 2 + dir; const int lo = 4 + (dir ? 60 - 4 * sg : 4 * sg), last = lo + 3;
      const int cown = has_ctx ? (dir ? 3 - sg : sg) : -1;
      const bf16* cp = CL + (size_t)chain * NCH * 4096 + tg * 16; const float* np = NL + (size_t)chain * NCH * 64 + (tg & 63); const float* am = AM + (size_t)chain * NCH * 2;
      float C[16]; float nvv = 0.f, m = 0.f;
#pragma unroll
      for (int i = 0; i < 16; ++i) C[i] = 0.f;
      constexpr int PF = 8; v4u pl0[PF], pl1[PF]; float pnl[PF]; v2f pam[PF];
#pragma unroll
      for (int i = 0; i < PF; ++i) { pl0[i] = *(const v4u*)(cp + (size_t)i * 4096); pl1[i] = *(const v4u*)(cp + (size_t)i * 4096 + 8); pnl[i] = np[i * 64]; pam[i] = *(const v2f*)(am + i * 2); }
      for (int c0 = 0; c0 <= last; c0 += PF) {
#pragma unroll
          for (int i = 0; i < PF; ++i) { const int cs = c0 + i;
              const half8 x0 = __builtin_bit_cast(half8, pl0[i]), x1 = __builtin_bit_cast(half8, pl1[i]); const float xn = pnl[i]; const v2f xa = pam[i];
              { const int cn = cs + PF < NCH ? cs + PF : NCH - 1; pl0[i] = *(const v4u*)(cp + (size_t)cn * 4096); pl1[i] = *(const v4u*)(cp + (size_t)cn * 4096 + 8); pnl[i] = np[cn * 64]; pam[i] = *(const v2f*)(am + cn * 2); }
              if (cs <= last) {
                  if (cs >= lo || cs == cown) {
                      #define CK(i) fminf(fmaxf(C[i], -60000.f), 60000.f)
                      v4u w0, w1; w0.x = pk2(CK(0), CK(1)); w0.y = pk2(CK(2), CK(3)); w0.z = pk2(CK(4), CK(5)); w0.w = pk2(CK(6), CK(7)); w1.x = pk2(CK(8), CK(9)); w1.y = pk2(CK(10), CK(11)); w1.z = pk2(CK(12), CK(13)); w1.w = pk2(CK(14), CK(15));
#undef CK
                      bf16* cq = CS + ((size_t)chain * NCH + cs) * 4096 + tg * 16; *(v4u*)cq = w0; *(v4u*)(cq + 8) = w1;
                      if (tg < 64) NS[((size_t)chain * NCH + cs) * 64 + tg] = nvv;
                      if (tg == 0) MS[chain * NCH + cs] = m; }
                  if (cs < last) { const float a = xa.x, ml = xa.y; const float mn = fmaxf(a + m, ml), al = __expf(a + m - mn), be = __expf(ml - mn);
#pragma unroll
                      for (int e = 0; e < 16; ++e) C[e] = al * C[e] + be * (e < 8 ? (float)x0[e] : (float)x1[e - 8]);
                      nvv = al * nvv + be * xn; m = mn; } } } }
      asm volatile("s_waitcnt vmcnt(0)" ::: "memory"); }
    __syncthreads();
    for (int ii = has_ctx ? -1 : 0; ii < 4; ++ii) {
        const bool isctx = ii < 0; const int pb = isctx ? sg : 4 * sg + ii, N = isctx ? CTX : SEQ, rb = isctx ? TL + b * CTX : b * SEQ;
        const int cs = dir == 0 ? pb : N / 64 - 1 - pb;
        const int item = (bh * 2 + dir) * NCH + (isctx ? cs : 4 + cs);
        const int p0 = dir == 0 ? pb * 64 : pb * 64 + 63, dp = dir == 0 ? 1 : -1;
        if (wg == 0) { const int p = p0 + dp * F.lane; const float* g0 = G + (size_t)(rb + p) * 16;
            const float liv = g0[dir * 4 + h] + b_i[dir * 4 + h], lfv = logsigmoid_f(g0[8 + dir * 4 + h] + b_f[dir * 4 + h]);
            float bc = lfv;
#pragma unroll
            for (int o = 1; o < 64; o <<= 1) { const float t = lane_get(bc, F.lane - o); if (F.lane >= o) bc += t; }
            const float lmb = liv - bc; float pm = lmb;
#pragma unroll
            for (int o = 1; o < 64; o <<= 1) { const float t = lane_get(pm, F.lane - o); if (F.lane >= o) pm = fmaxf(pm, t); }
            const float m0 = MS[item]; const float mt = bc + fmaxf(m0, pm);
            bcS[F.lane] = bc; lmbS[F.lane] = lmb; mtS[F.lane] = mt; wpS[F.lane] = __expf(bc + m0 - mt); n0S[F.lane] = NS[(size_t)item * 64 + F.lane]; }
        { const int tau = tg >> 2, d0 = (tg & 3) * 16; const int p = p0 + dp * tau; const bf16* urow = U + (size_t)(rb + p) * DU;
          float qv[16], kv[16], vv[16]; conv16(urow, p, N, C_MQ + h * 64 + d0, conv + h * 64 + d0, 1.0f, qv); conv16(urow, p, N, C_MK + h * 64 + d0, conv + 256 + h * 64 + d0, 0.125f, kv);
          const half8 v0 = __builtin_bit_cast(half8, *(const v4u*)(urow + C_MV + h * 64 + d0)), v1 = __builtin_bit_cast(half8, *(const v4u*)(urow + C_MV + h * 64 + d0 + 8));
#pragma unroll
          for (int i = 0; i < 16; ++i) vv[i] = i < 8 ? (float)v0[i] : (float)v1[i - 8];
          st_row16(Qs, tau, d0, qv); st_row16(Ks, tau, d0, kv); st_col16(VT, tau, d0, vv);
          const bf16* cg = CS + (size_t)item * 4096 + tau * 64 + d0;
          *(LAS v4u*)(Cs + tau * TP + d0 * 2) = *(const v4u*)cg; *(LAS v4u*)(Cs + tau * TP + d0 * 2 + 16) = *(const v4u*)(cg + 8); }
        __syncthreads();
        f32x16 ho;
        { const int tt = wg & 1, tv = wg >> 1; const int tau = 32 * tt + r32;
          half8 qf[4];
#pragma unroll
          for (int s = 0; s < 4; ++s) qf[s] = ld_row8(Qs, tau, 16 * s + 8 * hh);
          f32x16 st0 = {}, st1 = {};
#pragma unroll
          for (int s = 0; s < 4; ++s) { st0 = mfma32(ld_row8(Ks, r32, 16 * s + 8 * hh), qf[s], st0); st1 = mfma32(ld_row8(Ks, 32 + r32, 16 * s + 8 * hh), qf[s], st1); }
          const float ct = bcS[tau] - mtS[tau]; float dpart = 0.f;
#pragma unroll
          for (int r = 0; r < 16; ++r) { const int sg = (r & 3) + 8 * (r >> 2) + 4 * hh;
              const float w0 = sg <= tau ? __expf(ct + lmbS[sg]) : 0.f, w1 = sg + 32 <= tau ? __expf(ct + lmbS[sg + 32]) : 0.f;
              st0[r] *= w0; st1[r] *= w1; dpart += st0[r] + st1[r]; }
          float qn = 0.f;
#pragma unroll
          for (int s = 0; s < 4; ++s)
#pragma unroll
              for (int j = 0; j < 8; ++j) qn += (float)qf[s][j] * n0S[16 * s + 8 * hh + j];
          dpart += lane_xor(dpart, F.lane, 32); qn += lane_xor(qn, F.lane, 32);
          const float wp = wpS[tau], mt = mtS[tau]; const float den = dpart + wp * qn; const float inv = 1.f / fmaxf(fabsf(den), __expf(-mt));
          f32x16 an = {}, ac = {};
#pragma unroll
          for (int ks = 0; ks < 4; ++ks) { const f32x16& sx = (ks >> 1) ? st1 : st0; const int rbs = 8 * (ks & 1);
              half8 bf;
#pragma unroll
              for (int j = 0; j < 8; ++j) bf[j] = (_Float16)sx[rbs + j];
              const LAS unsigned char* vr = VT + (32 * tv + r32) * TP + (16 * ks + 4 * hh) * 2;
              const half4 a0 = *(const LAS half4*)vr, a1 = *(const LAS half4*)(vr + 16);
              const half8 af = {a0[0], a0[1], a0[2], a0[3], a1[0], a1[1], a1[2], a1[3]};
              an = mfma32(af, bf, an); }
#pragma unroll
          for (int s = 0; s < 4; ++s) ac = mfma32(ld_row8(Cs, 32 * tv + r32, 16 * s + 8 * hh), qf[s], ac);
#pragma unroll
          for (int r = 0; r < 16; ++r) ho[r] = (an[r] + wp * ac[r]) * inv;
          if (dir == 0) {
#pragma unroll
              for (int q4 = 0; q4 < 4; ++q4) { f32x4v x = {ho[4 * q4], ho[4 * q4 + 1], ho[4 * q4 + 2], ho[4 * q4 + 3]}; *(LAS f32x4v*)(HO + tau * 68 + 32 * tv + 8 * q4 + 4 * hh) = x; } } }
        __syncthreads();
        if (dir == 1) { const int tt = wg & 1, tv = wg >> 1; const int tau = 32 * tt + r32, pos = 63 - tau; const size_t row = (size_t)(rb + pb * 64 + pos);
#pragma unroll
            for (int q4 = 0; q4 < 4; ++q4) { const int v0 = 32 * tv + 8 * q4 + 4 * hh; const f32x4v x = *(const LAS f32x4v*)(HO + pos * 68 + v0);
                const half4 mo = *(const half4*)(U + row * DU + C_MO + h * 64 + v0); float o[4];
#pragma unroll
                for (int i = 0; i < 4; ++i) { const float g = 1.f / (1.f + __expf(-(float)mo[i])); o[i] = fminf(fmaxf(g * (x[i] + ho[4 * q4 + i]), -60000.f), 60000.f); }
                uint2 w; w.x = pk2(o[0], o[1]); w.y = pk2(o[2], o[3]); *(uint2*)(Y + row * D + 768 + h * 64 + v0) = w; } }
        __syncthreads();
    }
}


__device__ __forceinline__ void ph_attn(Frame& F, const float* sink, bool do_ctx) {
    const bf16* U = (const bf16*)(F.ws + WS_R); bf16* Y = (bf16*)F.out;
    const int g = F.wave >> 1, qh = F.wave & 1, r32 = F.lane & 31, hh = F.lane >> 5;
    const int lrow = F.tid >> 3, lch = F.tid & 7;
    constexpr float LOG2E = 1.4426950408889634f;
    const int nunits = 512 + (do_ctx ? 32 : 0);
    for (int uk = 0; uk < 3; ++uk) {
        int u; if (uk < 2) u = (F.bid & 7) * 64 + (F.bid >> 3) * 2 + uk; else { if (F.bid < 64 || F.bid >= 96) break; u = 512 + (F.bid - 64); }
        if (u >= nunits) break;
        const bool lat = u < 512; int b, kvh, qb;
        if (lat) { b = u >> 7; kvh = (u >> 6) & 1; qb = u & 63; } else { const int v = u - 512; b = v >> 3; kvh = (v >> 2) & 1; qb = v & 3; }
        const int head = kvh * 4 + g;
        const size_t qrow = (size_t)(lat ? b * SEQ : TL + b * CTX) + qb * 64 + qh * 32 + r32;
        half8 qf[4];
#pragma unroll
        for (int s = 0; s < 4; ++s) qf[s] = __builtin_bit_cast(half8, *(const v4u*)(U + qrow * DU + C_Q + head * 64 + 16 * s + 8 * hh));
        const int kt_lo = lat ? (qb - 2 < 0 ? 0 : qb - 2) : 0, kt_hi = lat ? (qb + 2 > 63 ? 63 : qb + 2) : -1; const int nloc = kt_hi - kt_lo + 1, nt = nloc + 4;
        float m = sink[head] * LOG2E, l = 1.f; f32x16 o0 = {}, o1 = {};
        v4u kreg, vreg;
#define ATT_TILE_ROW0(t) ((t) < nloc ? (size_t)b * SEQ + (size_t)(kt_lo + (t)) * 64 : (size_t)TL + (size_t)b * CTX + (size_t)((t) - nloc) * 64)
#define ATT_LOAD(t) do { const bf16* rp = U + (ATT_TILE_ROW0(t) + lrow) * DU + kvh * 64 + 8 * lch; kreg = *(const v4u*)(rp + C_K); vreg = *(const v4u*)(rp + C_V); } while (0)
#define ATT_STORE(buf) do { LAS unsigned char* kb = F.lds + (buf) * 9216; LAS unsigned char* vb = F.lds + 18432 + (buf) * 9216; *(LAS v4u*)(kb + lrow * TP + lch * 16) = kreg; \
        const half8 vh = __builtin_bit_cast(half8, vreg); _Pragma("unroll") for (int i = 0; i < 8; ++i) *(LAS _Float16*)(vb + (8 * lch + i) * TP + lrow * 2) = vh[i]; } while (0)
        ATT_LOAD(0); ATT_STORE(0);
        __syncthreads();
        for (int t = 0; t < nt; ++t) {
            if (t + 1 < nt) ATT_LOAD(t + 1);
            const LAS unsigned char* Kb = F.lds + (t & 1) * 9216; const LAS unsigned char* Vb = F.lds + 18432 + (t & 1) * 9216;
            f32x16 s0, s1;
#pragma unroll
            for (int r = 0; r < 16; ++r) { s0[r] = -m; s1[r] = -m; }
#pragma unroll
            for (int s = 0; s < 4; ++s) { s0 = mfma32(ld_row8(Kb, r32, 16 * s + 8 * hh), qf[s], s0); s1 = mfma32(ld_row8(Kb, 32 + r32, 16 * s + 8 * hh), qf[s], s1); }
            int ttype = 0; if (t < nloc) { const int kt = kt_lo + t; ttype = (kt == qb - 2) ? 1 : (kt == qb + 2) ? 2 : 0; }
            const int qi = qh * 32 + r32;
            if (ttype != 0) {
#pragma unroll
                for (int r = 0; r < 16; ++r) { const int jk = (r & 3) + 8 * (r >> 2) + 4 * hh;
                    const bool v0 = ttype == 1 ? (jk >= qi) : (jk <= qi), v1 = ttype == 1 ? (jk + 32 >= qi) : (jk + 32 <= qi);
                    s0[r] = v0 ? s0[r] : -INFINITY; s1[r] = v1 ? s1[r] : -INFINITY; } }
            float mx = fmaxf(s0[0], s1[0]);
#pragma unroll
            for (int r = 1; r < 16; ++r) mx = fmaxf(mx, fmaxf(s0[r], s1[r]));
            mx = fmaxf(mx, lane_xor(mx, F.lane, 32));
            if (__builtin_amdgcn_ballot_w64(mx > 0.f) != 0ull) {
                const float dl = fmaxf(mx, 0.f), alpha = __builtin_amdgcn_exp2f(-dl); m += dl; l *= alpha;
#pragma unroll
                for (int r = 0; r < 16; ++r) { s0[r] -= dl; s1[r] -= dl; o0[r] *= alpha; o1[r] *= alpha; } }
            float ls = 0.f;
#pragma unroll
            for (int r = 0; r < 16; ++r) { s0[r] = __builtin_amdgcn_exp2f(s0[r]); s1[r] = __builtin_amdgcn_exp2f(s1[r]); ls += s0[r] + s1[r]; }
            ls += lane_xor(ls, F.lane, 32); l += ls;
#pragma unroll
            for (int ks = 0; ks < 4; ++ks) { const f32x16& sx = (ks >> 1) ? s1 : s0; const int rbs = 8 * (ks & 1);
                half8 pf;
#pragma unroll
                for (int j = 0; j < 8; ++j) pf[j] = (_Float16)sx[rbs + j];
                const LAS unsigned char* v0p = Vb + r32 * TP + (16 * ks + 4 * hh) * 2; const LAS unsigned char* v1p = v0p + 32 * TP;
                const half4 a0 = *(const LAS half4*)v0p, a1 = *(const LAS half4*)(v0p + 16), c0 = *(const LAS half4*)v1p, c1 = *(const LAS half4*)(v1p + 16);
                const half8 af0 = {a0[0], a0[1], a0[2], a0[3], a1[0], a1[1], a1[2], a1[3]}, af1 = {c0[0], c0[1], c0[2], c0[3], c1[0], c1[1], c1[2], c1[3]};
                o0 = mfma32(af0, pf, o0); o1 = mfma32(af1, pf, o1); }
            if (t + 1 < nt) ATT_STORE((t + 1) & 1);
            __syncthreads();
        }
#undef ATT_TILE_ROW0
#undef ATT_LOAD
#undef ATT_STORE
        const float il = 1.f / l; LAS unsigned char* stg = F.lds + 40960 + F.wave * 4608;
#pragma unroll
        for (int q4 = 0; q4 < 4; ++q4) { typedef unsigned v2u __attribute__((ext_vector_type(2))); v2u w0, w1;
            w0.x = pk2(o0[4 * q4] * il, o0[4 * q4 + 1] * il); w0.y = pk2(o0[4 * q4 + 2] * il, o0[4 * q4 + 3] * il);
            w1.x = pk2(o1[4 * q4] * il, o1[4 * q4 + 1] * il); w1.y = pk2(o1[4 * q4 + 2] * il, o1[4 * q4 + 3] * il);
            *(LAS v2u*)(stg + r32 * TP + (8 * q4 + 4 * hh) * 2) = w0; *(LAS v2u*)(stg + r32 * TP + (32 + 8 * q4 + 4 * hh) * 2) = w1; }
        asm volatile("s_waitcnt lgkmcnt(0)" ::: "memory");
        { bf16* yb = Y + (qrow - r32) * D + 256 + head * 64;
#pragma unroll
          for (int i = 0; i < 4; ++i) { const int row = i * 8 + (F.lane >> 3), ch = F.lane & 7; *(v4u*)(yb + (size_t)row * D + ch * 8) = *(const LAS v4u*)(stg + row * TP + ch * 16); } }
    }
}


constexpr int FP = 272;
__device__ __forceinline__ void ph_fft_consts(Frame& F) {
    bf16* M1 = (bf16*)(F.ws + WS_FM1); bf16* M3 = (bf16*)(F.ws + WS_FM3); float2* TW = (float2*)(F.ws + WS_TW); float2* CT = (float2*)(F.ws + WS_CT);
    for (int i = F.bid * NTHREADS + F.tid; i < 16384 + 8192 + 4096 + 256; i += F.G * NTHREADS) {
        float s, c;
        if (i < 16384) { const int row = i >> 7, col = i & 127, pr = row >> 6, k1 = row & 63, pc = col >> 6, n1 = col & 63; sincospif((float)((k1 * n1) & 63) * (1.f / 32.f), &s, &c);
            M1[i] = (bf16)f2bf(pr == pc ? c : (pr == 0 ? s : -s)); }
        else if (i < 16384 + 8192) { const int j = i - 16384, k2 = j >> 7, col = j & 127, pc = col >> 6, n2 = col & 63; sincospif((float)((k2 * n2) & 63) * (1.f / 32.f), &s, &c); M3[j] = (bf16)f2bf(pc == 0 ? c : s); }
        else if (i < 16384 + 8192 + 4096) { const int j = i - 16384 - 8192; sincospif((float)j * (1.f / 2048.f), &s, &c); TW[j] = make_float2(c, s); }
        else { const int j = i - 16384 - 8192 - 4096; sincospif((float)j * (1.f / 128.f), &s, &c); CT[j] = make_float2(c, s); }
    }
    bf16* DMC = (bf16*)(F.ws + WS_DMC);
    for (int i = F.bid * NTHREADS + F.tid; i < 256 * 512; i += F.G * NTHREADS) { const int k = i >> 9, pn = i & 511, n = pn & 255; float s, c; sincospif((float)((k * n) & 255) * (1.f / 128.f), &s, &c); DMC[i] = (bf16)f2bf(4.f * (pn < 256 ? c : s)); }
}
__device__ __forceinline__ void ph_fold(Frame& F, const Params& P, int l, int bid0, int nb) {
    const float* w_in = P.in[9]; const float* wfo = P.in[11]; bf16* Win_t = (bf16*)(F.ws + WS_WIN);
    float* Wx = (float*)F.ldsg; float* ct = Wx + 4096; float* st = ct + 64;
    if (F.bid < bid0 || F.bid >= bid0 + nb) return;
    for (int it = F.bid - bid0; it < 128; it += nb) {
        const int g = (it >> 5) & 3, part = (it >> 4) & 1, kb = it & 15;
        __syncthreads();
        if (F.tid < 64) { float s, c; sincospif((float)F.tid * (1.f / 32.f), &s, &c); ct[F.tid] = c; st[F.tid] = s; }
        __syncthreads();
        const float* wf = wfo + ((size_t)l * 4 + g) * 4096;
        { const int e = F.tid & 63, c0 = F.tid >> 6; float wfc[64];
#pragma unroll
          for (int m = 0; m < 64; ++m) wfc[m] = wf[m * 64 + e];
          const float* tb = part == 0 ? ct : st; const float sg = part == 0 ? (1.f / 512.f) : (-1.f / 512.f);
#pragma unroll 1
          for (int i = 0; i < 8; ++i) { const int c = c0 + 8 * i; float a = 0.f;
#pragma unroll
              for (int m = 0; m < 64; ++m) a += tb[(m * c) & 63] * wfc[m];
              Wx[c * 64 + e] = a * sg; } }
        __syncthreads();
        const int k = kb * 64 + (F.tid >> 3), e0 = (F.tid & 7) * 8; const float* wr = w_in + ((size_t)l * D + k) * DIN + g * 64;
        float acc[8];
#pragma unroll
        for (int j = 0; j < 8; ++j) acc[j] = 0.f;
        float4 av[16];
#pragma unroll
        for (int c4 = 0; c4 < 16; ++c4) av[c4] = ((const float4*)wr)[c4];
#pragma unroll
        for (int c4 = 0; c4 < 16; ++c4) { const float aa[4] = {av[c4].x, av[c4].y, av[c4].z, av[c4].w};
#pragma unroll
            for (int ci = 0; ci < 4; ++ci) { const float* wx = Wx + (4 * c4 + ci) * 64 + e0; const float4 w0 = *(const float4*)wx, w1 = *(const float4*)(wx + 4);
                acc[0] += aa[ci] * w0.x; acc[1] += aa[ci] * w0.y; acc[2] += aa[ci] * w0.z; acc[3] += aa[ci] * w0.w; acc[4] += aa[ci] * w1.x; acc[5] += aa[ci] * w1.y; acc[6] += aa[ci] * w1.z; acc[7] += aa[ci] * w1.w; } }
#pragma unroll
        for (int j = 0; j < 8; ++j) Win_t[((size_t)l * DU + part * 256 + g * 64 + e0 + j) * D + k] = (bf16)f2bf(acc[j]);
    }
    __syncthreads();
}
#define TP_DECL unsigned long long tp0 = 0; (void)tp0
#define TP_ON(id) do { if (PROBE_ID == (id)) { __syncthreads(); tp0 = __builtin_amdgcn_s_memrealtime(); } } while (0)
#define TP_OFF(id) do { if (PROBE_ID == (id)) { asm volatile("s_waitcnt vmcnt(0)" ::: "memory"); __syncthreads(); const unsigned long long tp1 = __builtin_amdgcn_s_memrealtime(); \
        if (blockIdx.x == PROBE_WG) { const unsigned long long tgt = tp1 + 4ull * (tp1 - tp0); while (__builtin_amdgcn_s_memrealtime() < tgt) __builtin_amdgcn_s_sleep(8); } } } while (0)
__device__ __forceinline__ void ph_fft(Frame& F) {
    TP_DECL;
    const bf16* U = (const bf16*)(F.ws + WS_R); bf16* Y = (bf16*)F.out; const float2* TW = (const float2*)(F.ws + WS_TW);
    LAS unsigned char* BUF = F.lds; LAS unsigned char* M1s = F.lds + 69632; LAS unsigned char* M3s = F.lds + 69632 + 34816;
    const int r32 = F.lane & 31, hh = F.lane >> 5, w = F.wave;
    __syncthreads();
    TP_ON(3131);
    if (F.bid < 256) {
        const v4u* m1 = (const v4u*)(F.ws + WS_FM1); const v4u* m3 = (const v4u*)(F.ws + WS_FM3);
        for (int i = F.tid; i < 128 * 16; i += NTHREADS) *(LAS v4u*)(M1s + (i >> 4) * FP + (i & 15) * 16) = m1[i];
        for (int i = F.tid; i < 64 * 16; i += NTHREADS) *(LAS v4u*)(M3s + (i >> 4) * FP + (i & 15) * 16) = m3[i];
    }
    for (int itb = F.bid; itb < 256; itb += F.G) {
        const int it = (((itb & 7) * 4 + (itb >> 6)) << 3) | ((itb >> 3) & 7);
        const int b = it >> 6, cg = it & 63;
        __syncthreads();
        for (int q = w; q < 128; q += NWAVES) { const int n2 = q >> 1, part = q & 1, n1 = F.lane;
            const half4 x = *(const half4*)(U + (size_t)(b * SEQ + 64 * n1 + n2) * DU + part * 256 + cg * 4);
#pragma unroll
            for (int i = 0; i < 4; ++i) *(LAS _Float16*)(BUF + (n2 * 4 + i) * FP + (part * 64 + n1) * 2) = x[i]; }
        __syncthreads();
        TP_OFF(3131); TP_ON(3132);
        f32x16 acc[4] = {};
#pragma unroll
        for (int s = 0; s < 8; ++s) { const half8 bf = __builtin_bit_cast(half8, *(const LAS v4u*)(BUF + (32 * w + r32) * FP + (16 * s + 8 * hh) * 2));
#pragma unroll
            for (int tm = 0; tm < 4; ++tm) acc[tm] = mfma32(__builtin_bit_cast(half8, *(const LAS v4u*)(M1s + (32 * tm + r32) * FP + (16 * s + 8 * hh) * 2)), bf, acc[tm]); }
        int nidx = 32 * w + r32; asm volatile("" : "+v"(nidx));
        const int n2 = nidx >> 2, col = nidx & 3;
        __syncthreads();
#pragma unroll
        for (int tm = 0; tm < 2; ++tm)
#pragma unroll
            for (int r = 0; r < 16; ++r) { const int k1 = 32 * tm + (r & 3) + 8 * (r >> 2) + 4 * hh; const float ang = (float)((k1 * n2) & 4095) * (1.f / 4096.f); float2 t; t.x = __builtin_amdgcn_cosf(ang); t.y = __builtin_amdgcn_sinf(ang);
                const float re = acc[tm][r], im = acc[tm + 2][r];
                *(LAS _Float16*)(BUF + (k1 * 4 + col) * FP + n2 * 2) = (_Float16)(re * t.x + im * t.y);
                *(LAS _Float16*)(BUF + (k1 * 4 + col) * FP + (64 + n2) * 2) = (_Float16)(im * t.x - re * t.y); }
        __syncthreads();
        TP_OFF(3132); TP_ON(3133);
        f32x16 y0 = {}, y1 = {};
#pragma unroll
        for (int s = 0; s < 8; ++s) { const half8 bf = __builtin_bit_cast(half8, *(const LAS v4u*)(BUF + (32 * w + r32) * FP + (16 * s + 8 * hh) * 2));
            y0 = mfma32(__builtin_bit_cast(half8, *(const LAS v4u*)(M3s + r32 * FP + (16 * s + 8 * hh) * 2)), bf, y0);
            y1 = mfma32(__builtin_bit_cast(half8, *(const LAS v4u*)(M3s + (32 + r32) * FP + (16 * s + 8 * hh) * 2)), bf, y1); }
        const int k1o = nidx >> 2; bf16* yb = Y + (size_t)(b * SEQ) * D + cg * 4 + col;
#pragma unroll
        for (int rep = 0; rep < (PROBE_ID == 316 ? 3 : 1); ++rep) {
#pragma unroll
        for (int r = 0; r < 16; ++r) { const int k2 = (r & 3) + 8 * (r >> 2) + 4 * hh;
            yb[(size_t)(k1o + 64 * k2) * D] = (bf16)f2bf(y0[r]); yb[(size_t)(k1o + 64 * (k2 + 32)) * D] = (bf16)f2bf(y1[r]); }
        asm volatile("s_waitcnt vmcnt(0)" ::: "memory"); }
        TP_OFF(3133);
    }
    __syncthreads();
}
__device__ __forceinline__ void ph_ctx_dft(Frame& F) {
    const bf16* U = (const bf16*)(F.ws + WS_R); bf16* Y = (bf16*)F.out; const bf16* Dm = (const bf16*)(F.ws + WS_DMC);
    constexpr int GP = 1040;
    LAS unsigned char* Gt = F.lds; const int r32 = F.lane & 31, hh = F.lane >> 5;
    for (int it = (F.bid + 160) & 255; it < NB * 8; it += 256) {
        const int b = it >> 3, cg = it & 7;
        __syncthreads();
        for (int q = F.tid; q < 2 * CTX * 4; q += NTHREADS) { const int part = q >> 10, n = (q >> 2) & 255, c8 = q & 3;
            const half8 x = __builtin_bit_cast(half8, *(const v4u*)(U + (size_t)(TL + b * CTX + n) * DU + part * 256 + cg * 32 + c8 * 8));
#pragma unroll
            for (int i = 0; i < 8; ++i) *(LAS _Float16*)(Gt + (c8 * 8 + i) * GP + (part * 256 + n) * 2) = x[i]; }
        __syncthreads();
        f32x16 acc = {}; const bf16* dr = Dm + (size_t)(32 * F.wave + r32) * 512 + 8 * hh; const LAS unsigned char* gr = Gt + r32 * GP + 16 * hh;
#pragma unroll 8
        for (int s = 0; s < 32; ++s) acc = mfma32(__builtin_bit_cast(half8, *(const v4u*)(dr + 16 * s)), __builtin_bit_cast(half8, *(const LAS v4u*)(gr + 32 * s)), acc);
        bf16* yb = Y + (size_t)(TL + b * CTX) * D + cg * 32 + r32;
#pragma unroll
        for (int r = 0; r < 16; ++r) yb[(size_t)(32 * F.wave + (r & 3) + 8 * (r >> 2) + 4 * hh) * D] = (bf16)f2bf(acc[r]);
    }
    __syncthreads();
}

__device__ __forceinline__ void ph_ctx_resid_gemm(Frame& F, const bf16* A  , const bf16* Bt  , int K, const float* xsrc, const float* ng, int gate_off, int nscale_off, float coef) {
    bf16* x16 = (bf16*)(F.ws + WS_X16) + (size_t)TL * D; const float* gate = (const float*)(F.ws + WS_MOD) + gate_off + (size_t)NB * MODW; const float* nscale = (const float*)(F.ws + WS_MOD) + nscale_off + (size_t)NB * MODW;
    bf16* hraw = (bf16*)(F.ws + WS_HB) + (size_t)TL * D; float* rowss = (float*)(F.ws + WS_RS) + (size_t)TL * 16;
    const int r16 = F.lane & 15, fq = F.lane >> 4; const int kc = K >> 3;
    LAS float* red = (LAS float*)F.lds;
    for (int pc = F.bid; pc < 256; pc += F.G) {
        const int xq = pc & 7, jq = pc >> 3; const int rt = (xq >> 1) * 4 + (jq >> 3), ct = (xq & 1) * 8 + (jq & 7);
        const bf16* ap = A + (size_t)(TL + rt * 64 + r16) * K + F.wave * kc + 8 * fq;
        const bf16* bp = Bt + (size_t)(ct * 64 + r16) * K + F.wave * kc + 8 * fq;
        pg8::f32x4 acc[4][4];
#pragma unroll
        for (int ci = 0; ci < 4; ++ci)
#pragma unroll
            for (int tj = 0; tj < 4; ++tj) acc[ci][tj] = (pg8::f32x4){0.f, 0.f, 0.f, 0.f};
        constexpr int PB = 4; const int nst = kc / 32;
        v4u lb[PB][4], la[PB][4];
#pragma unroll
        for (int i = 0; i < PB; ++i) { const int s = i < nst ? i : 0;
#pragma unroll
            for (int q = 0; q < 4; ++q) { lb[i][q] = *(const v4u*)(bp + (size_t)(16 * q) * K + 32 * s); la[i][q] = *(const v4u*)(ap + (size_t)(16 * q) * K + 32 * s); } }
        for (int s0 = 0; s0 < nst; s0 += PB) {
#pragma unroll
            for (int i = 0; i < PB; ++i) {
                half8 bfr[4], afr[4];
#pragma unroll
                for (int q = 0; q < 4; ++q) { bfr[q] = __builtin_bit_cast(half8, lb[i][q]); afr[q] = __builtin_bit_cast(half8, la[i][q]); }
                const int sn = s0 + PB + i; const int sl = sn < nst ? sn : nst - 1;
#pragma unroll
                for (int q = 0; q < 4; ++q) { lb[i][q] = *(const v4u*)(bp + (size_t)(16 * q) * K + 32 * sl); la[i][q] = *(const v4u*)(ap + (size_t)(16 * q) * K + 32 * sl); }
                if (s0 + i < nst) {
#pragma unroll
                    for (int ci = 0; ci < 4; ++ci)
#pragma unroll
                        for (int tj = 0; tj < 4; ++tj) acc[ci][tj] = __builtin_amdgcn_mfma_f32_16x16x32_f16(bfr[ci], afr[tj], acc[ci][tj], 0, 0, 0); } } }
        __syncthreads();
#pragma unroll
        for (int ci = 0; ci < 4; ++ci)
#pragma unroll
            for (int tj = 0; tj < 4; ++tj) { const int row = 16 * tj + r16, chunk = 4 * ci + fq; f32x4v v = {acc[ci][tj][0], acc[ci][tj][1], acc[ci][tj][2], acc[ci][tj][3]};
                *(LAS f32x4v*)(red + ((F.wave * 64 + row) * 16 + (chunk ^ (row & 15))) * 4) = v; }
        __syncthreads();
        { const int row = F.tid >> 3, cg8 = F.tid & 7; f32x4v s0 = {0.f, 0.f, 0.f, 0.f}, s1 = s0;
#pragma unroll
          for (int w8 = 0; w8 < 8; ++w8) { s0 += *(const LAS f32x4v*)(red + ((w8 * 64 + row) * 16 + ((2 * cg8) ^ (row & 15))) * 4); s1 += *(const LAS f32x4v*)(red + ((w8 * 64 + row) * 16 + ((2 * cg8 + 1) ^ (row & 15))) * 4); }
          const int grow = rt * 64 + row, c = ct * 64 + cg8 * 8; float ssq = 0.f;
          { const size_t off = (size_t)grow * D + c; f32x4v xo0, xo1;
            if (xsrc) { xo0 = *(const f32x4v*)(xsrc + off); xo1 = *(const f32x4v*)(xsrc + off + 4); }
            else { const half8 hx = __builtin_bit_cast(half8, *(const v4u*)(x16 + off)); xo0 = (f32x4v){(float)hx[0], (float)hx[1], (float)hx[2], (float)hx[3]}; xo1 = (f32x4v){(float)hx[4], (float)hx[5], (float)hx[6], (float)hx[7]}; }
            const f32x4v x0 = xo0 + *(const f32x4v*)(gate + c) * coef * s0, x1 = xo1 + *(const f32x4v*)(gate + c + 4) * coef * s1;
            { v4u w; w.x = pk2(x0[0], x0[1]); w.y = pk2(x0[2], x0[3]); w.z = pk2(x1[0], x1[1]); w.w = pk2(x1[2], x1[3]); *(v4u*)(x16 + off) = w; }
            ssq += ((x0[0] * x0[0] + x0[1] * x0[1]) + (x0[2] * x0[2] + x0[3] * x0[3])) + ((x1[0] * x1[0] + x1[1] * x1[1]) + (x1[2] * x1[2] + x1[3] * x1[3]));
            if (ng) { const f32x4v h0 = x0 * (*(const f32x4v*)(ng + c) * (*(const f32x4v*)(nscale + c) + 1.f)), h1 = x1 * (*(const f32x4v*)(ng + c + 4) * (*(const f32x4v*)(nscale + c + 4) + 1.f));
                v4u w; w.x = pk2(h0[0], h0[1]); w.y = pk2(h0[2], h0[3]); w.z = pk2(h1[0], h1[1]); w.w = pk2(h1[2], h1[3]); *(v4u*)(hraw + off) = w; } }
          ssq += lane_xor(ssq, F.lane, 1); ssq += lane_xor(ssq, F.lane, 2); ssq += lane_xor(ssq, F.lane, 4);
          if (cg8 == 0) rowss[(size_t)grow * 16 + ct] = ssq; }
    }
    __syncthreads();
}

template <class Epi> __device__ __forceinline__ void run_gemm(Frame& F, const bf16* A, const bf16* Bt, int M, int N, int K, const Epi& E) {
    pg8::Gemm g{A, Bt, M, N, K}; pg8::StaticOrder S; S.init(M, N, F.G, F.bid);
    pg8::gemm_phase<Epi, pg8::StaticOrder, true, true>(F.lds, g, S, E, F.tid);
}
template <class Epi> __device__ __forceinline__ void run_gemm_normed(Frame& F, const bf16* A, const bf16* Bt, int M, int N, int K, const Epi& E, const float* sw) {
    pg8::Gemm g{A, Bt, M, N, K}; RstdOrder S; S.init(M, N, F.G, F.bid); S.rowss = (const float*)(F.ws + WS_RS); S.tab = (LAS float*)(F.lds + RSTD_TAB_OFF); S.tid = F.tid; S.cnt = 0; S.sw = sw; S.ncols = N;
    pg8::gemm_phase<Epi, RstdOrder, true, true>(F.lds, g, S, E, F.tid);
}
__device__ __forceinline__ Frame make_frame(const Params& P, unsigned char* lds_raw) {
    Frame F; int t = threadIdx.x; asm volatile("" : "+v"(t));
    F.lds = (LAS unsigned char*)lds_raw; F.ldsg = lds_raw;
    F.tid = t; F.lane = t & 63; F.wave = __builtin_amdgcn_readfirstlane(t >> 6);
    int g = gridDim.x, b = blockIdx.x; asm volatile("" : "+s"(g), "+s"(b));
    F.G = g; F.bid = b; F.gw = b * NWAVES + F.wave; F.NGW = g * NWAVES;
    GAS unsigned char* ws = (GAS unsigned char*)P.ws; GAS float* out = (GAS float*)P.out; asm volatile("" : "+s"(ws), "+s"(out));
    F.out = (float*)out; F.ws = (unsigned char*)ws;
    return F;
}
__device__ __forceinline__ void grid_bar(const Params& P, unsigned char* lds_raw) {
    GAS unsigned char* wsg = (GAS unsigned char*)P.ws; asm volatile("" : "+s"(wsg)); unsigned char* ws = (unsigned char*)wsg;
    XcdBarrier b; b.bar = (unsigned*)(ws + WS_CTL) + CW_BAR; b.x = xb_xcc_id(); b.st = (volatile LAS unsigned*)((LAS unsigned char*)lds_raw + MISC_OFF) + 8;
    xcd_barrier(b);
}
__global__ void __launch_bounds__(NTHREADS, 2) mega_fwd(Params P) {
    extern __shared__ __attribute__((aligned(16))) unsigned char lds_raw[];
    { const int tid = threadIdx.x;
      for (int u = tid; u < (LDS_BYTES - MISC_OFF) / 4; u += NTHREADS) ((LAS unsigned*)((LAS unsigned char*)lds_raw + MISC_OFF))[u] = 0u;
      __syncthreads();
      (void)xcd_barrier_post((unsigned*)(P.ws + WS_CTL) + CW_BAR, (volatile LAS unsigned*)((LAS unsigned char*)lds_raw + MISC_OFF) + 8); }
#define GRID_BAR() grid_bar(P, lds_raw)
    unsigned long long tacc = 0, t0 = 0; (void)tacc; (void)t0;
#define T_ON(id) do { if (PROBE_ID == (id)) t0 = __builtin_amdgcn_s_memrealtime(); } while (0)
#define T_OFF(id) do { if (PROBE_ID == (id)) { const unsigned long long t1 = __builtin_amdgcn_s_memrealtime(); tacc += t1 - t0; \
        if (blockIdx.x == PROBE_WG) { const unsigned long long tgt = t1 + 4ull * (t1 - t0); while (__builtin_amdgcn_s_memrealtime() < tgt) __builtin_amdgcn_s_sleep(8); } } } while (0)
#define FRAME() Frame F = make_frame(P, lds_raw); Ptrs p{F.out, (float*)(F.ws + WS_XC)}; (void)p

    T_ON(1); T_ON(11); T_ON(9);
    T_ON(111);
    { FRAME(); ph_mod(F, P); }
    T_OFF(111); T_ON(112);
    { FRAME(); constexpr int NCV = 9856, NMODWG = DEPTH * (MODW / 128);
      constexpr int NA1 = 1792;
      if (F.G == 256) { if (F.bid < 256 - NMODWG) { const int rk = F.bid * NWAVES + F.wave, nw = (256 - NMODWG) * NWAVES; ph_convert(F, P, 0, 0, NCV, rk, nw); ph_convert(F, P, 1, 0, NA1, rk, nw); }
                        else { const int rk = (F.bid - (256 - NMODWG)) * NWAVES + F.wave, nw = NMODWG * NWAVES; ph_convert(F, P, 1, NA1, NCV, rk, nw); } }
      else { ph_convert(F, P, 0, 0, NCV, F.gw, F.NGW); ph_convert(F, P, 1, 0, NCV, F.gw, F.NGW); } }
    T_OFF(112); T_ON(113);
    { FRAME(); ph_fold(F, P, 0, 0, 128); ph_fold(F, P, 1, 128, 128); }
    T_OFF(113); T_ON(114);
    { FRAME(); ph_fft_consts(F); ph_rope_table(F, P); }
    T_OFF(114);
    GRID_BAR(); T_OFF(11); T_ON(12);
    T_ON(121);
    { FRAME(); ph_first(F, P); }
    T_OFF(121); T_ON(122);
    { FRAME(); ph_bias(F, P, 0); ph_bias(F, P, 1); }
    T_OFF(122);
    GRID_BAR(); T_OFF(1); T_OFF(12);
#pragma unroll 1
    for (int l = 0; l < DEPTH; ++l) {
#pragma unroll 1
        for (int half = 0; half < 2; ++half) {
            const int sub = half * 2, f = half;
            if (half == 1) {
                T_ON(2); T_ON(23);
                { FRAME(); EpiUProj E{F.ws, l, (LAS float*)(F.lds + RSTD_TAB_OFF), 0};
                  run_gemm_normed(F, (const bf16*)(F.ws + WS_HB), (const bf16*)(F.ws + WS_WIN) + (size_t)l * DU * D, T, DU, D, E, (const float*)(F.ws + WS_SWIN) + (size_t)l * NR * DU); }
                { FRAME(); ph_gates(F, l); }
                GRID_BAR(); T_OFF(2); T_OFF(23); T_ON(3); T_ON(31);
                T_ON(311);
                { FRAME(); ph_mlstm_m1(F, P.in[13] + (size_t)l * 3 * 512, P.in[14] + l * 8, P.in[15] + l * 8); }
                T_OFF(311); T_ON(312);
                { FRAME(); ph_attn(F, P.in[12] + l * 8, l + 1 < DEPTH); }
                T_OFF(312); T_ON(313); T_ON(316);
                { FRAME(); ph_fft(F); }
                T_OFF(313); T_OFF(316);
                if (PROBE_ID == 315) { T_ON(315); { FRAME(); ph_fft(F); } T_OFF(315); }
                T_ON(314);
                { FRAME(); if (l + 1 < DEPTH) ph_ctx_dft(F); }
                T_OFF(314);
                GRID_BAR(); T_OFF(31); T_ON(33);
                { FRAME(); ph_mlstm_m3(F, P.in[13] + (size_t)l * 3 * 512, P.in[14] + l * 8, P.in[15] + l * 8, l + 1 < DEPTH); }
                GRID_BAR(); T_OFF(3); T_OFF(33); T_ON(2); T_ON(24);
                { FRAME(); const bool ctx_piece = l + 1 < DEPTH, piece_first = (F.bid & 1) == 0;
                  if (ctx_piece && piece_first) ph_ctx_resid_gemm(F, (const bf16*)F.out, (const bf16*)(F.ws + WS_WOUT) + (size_t)l * D * D, D, nullptr, P.in[6] + ((size_t)l * 3 + 2) * D, l * NR * MODW + 5 * D, l * NR * MODW + 7 * D, 1.0f);
                  { EpiResid E{F.ws, nullptr, P.in[6] + ((size_t)l * 3 + 2) * D, l * NR * MODW + 5 * D, l * NR * MODW + 7 * D, 1.0f};
                    run_gemm(F, (const bf16*)F.out, (const bf16*)(F.ws + WS_WOUT) + (size_t)l * D * D, TL, D, D, E); }
                  if (ctx_piece && !piece_first) ph_ctx_resid_gemm(F, (const bf16*)F.out, (const bf16*)(F.ws + WS_WOUT) + (size_t)l * D * D, D, nullptr, P.in[6] + ((size_t)l * 3 + 2) * D, l * NR * MODW + 5 * D, l * NR * MODW + 7 * D, 1.0f); }
                GRID_BAR(); T_OFF(2); T_OFF(24);
            }
            T_ON(2); T_ON(21);
            { FRAME(); EpiSwiglu E{F.ws, l * 2 + f, (LAS float*)(F.lds + RSTD_TAB_OFF), 0};
              run_gemm_normed(F, (const bf16*)(F.ws + WS_HB), (const bf16*)(F.ws + WS_WI) + (size_t)(l * 2 + f) * 2 * DFF * D, T, 2 * DFF, D, E, (const float*)(F.ws + WS_SWFI) + (size_t)(l * 2 + f) * NR * 2 * DFF); }
            GRID_BAR(); T_OFF(21); T_ON(22);
            { FRAME();
              const bool has_next = (half == 0) || (l + 1 < DEPTH);
              const float* ngp = half == 0 ? P.in[6] + ((size_t)l * 3 + 1) * D : P.in[6] + ((size_t)(l + 1) * 3 + 0) * D;
              const int nsc = half == 0 ? l * NR * MODW + 4 * D : (l + 1) * NR * MODW + 1 * D;
              const bool first = (l == 0 && half == 0);
              const bool ctx_piece = (half == 0 || l + 1 < DEPTH); const bool piece_first = (F.bid & 1) == 0;
              if (ctx_piece && piece_first) ph_ctx_resid_gemm(F, (const bf16*)(F.ws + WS_R), (const bf16*)(F.ws + WS_WO) + (size_t)(l * 2 + f) * D * DFF, DFF, first ? P.in[2] : nullptr, has_next ? ngp : nullptr, l * NR * MODW + (3 * sub + 2) * D, nsc, 0.5f);
              { EpiResid E{F.ws, first ? P.in[0] : nullptr, has_next ? ngp : nullptr, l * NR * MODW + (3 * sub + 2) * D, nsc, 0.5f};
                run_gemm(F, (const bf16*)(F.ws + WS_R), (const bf16*)(F.ws + WS_WO) + (size_t)(l * 2 + f) * D * DFF, TL, D, DFF, E); }
              if (ctx_piece && !piece_first) ph_ctx_resid_gemm(F, (const bf16*)(F.ws + WS_R), (const bf16*)(F.ws + WS_WO) + (size_t)(l * 2 + f) * D * DFF, DFF, first ? P.in[2] : nullptr, has_next ? ngp : nullptr, l * NR * MODW + (3 * sub + 2) * D, nsc, 0.5f); }
            GRID_BAR(); T_OFF(2); T_OFF(22);
        }
    }
    if (PROBE_ID == 77) { GRID_BAR(); GRID_BAR(); GRID_BAR(); GRID_BAR(); GRID_BAR(); GRID_BAR(); GRID_BAR(); GRID_BAR(); }
    T_ON(4);
    { FRAME(); ph_final(F, P); }
    if (PROBE_ID == 4 || PROBE_ID == 9) { GRID_BAR(); T_OFF(4); T_OFF(9); GRID_BAR(); }
}
}

extern "C" void kernel_launch(void* const* d_in, const int* in_sizes, int n_in, void* d_out, int out_size, void* d_ws, size_t ws_size, hipStream_t stream) {
    static int grid = 0;
    if (grid == 0) {
        if (n_in != 17 || ws_size < WS_END) { fprintf(stderr, "kernel_launch: need 17 inputs and %zu bytes of workspace; got %d inputs, %zu bytes\n", (size_t)WS_END, n_in, ws_size); grid = -1; return; }
        int dev = 0, cus = 0, per_cu = 0;
        if (hipGetDevice(&dev) != hipSuccess || hipDeviceGetAttribute(&cus, hipDeviceAttributeMultiprocessorCount, dev) != hipSuccess) { grid = -1; return; }
        if (hipFuncSetAttribute((const void*)mega_fwd, hipFuncAttributeMaxDynamicSharedMemorySize, LDS_BYTES) != hipSuccess) { fprintf(stderr, "kernel_launch: hipFuncSetAttribute failed\n"); grid = -1; return; }
        if (hipOccupancyMaxActiveBlocksPerMultiprocessor(&per_cu, (const void*)mega_fwd, NTHREADS, LDS_BYTES) != hipSuccess || per_cu < 1) { fprintf(stderr, "kernel_launch: occupancy query says %d workgroups per CU\n", per_cu); (void)hipGetLastError(); grid = -1; return; }
        if (cus != 256) { fprintf(stderr, "kernel_launch: this kernel is laid out for a 256-CU device (got %d); nothing launched\n", cus); grid = -1; return; }
        grid = cus;
    }
    if (grid < 0) return;
    (void)hipMemsetAsync((char*)d_ws + WS_CTL, 0, CTL_ZERO_BYTES, stream);
    Params P{};
    for (int i = 0; i < 17; ++i) P.in[i] = (const float*)d_in[i];
    P.out = (float*)d_out; P.ws = (unsigned char*)d_ws;
    hipLaunchKernelGGL(mega_fwd, dim3(grid), dim3(NTHREADS), LDS_BYTES, stream, P);
}
```

```cpp
#include <hip/hip_runtime.h>
#include <cstdio>
#include <cstdint>
#ifndef PROBE_ID
#define PROBE_ID 0
#endif
#ifndef PROBE_WG
#define PROBE_WG 0
#endif
namespace pg8 {
#define PG8_LAS __attribute__((address_space(3)))
typedef unsigned short bf16_t;
typedef short bf16x8 __attribute__((ext_vector_type(8)));
typedef float f32x4 __attribute__((ext_vector_type(4)));
typedef unsigned u32x4 __attribute__((ext_vector_type(4)));
typedef _Float16 half8 __attribute__((ext_vector_type(8)));
constexpr int BM = 256, BK = 64, HALF = 128, HTB = HALF * BK * 2  , STAGE_BYTES = 8 * HTB, NXCD = 8, WGM = 8;

__host__ __device__ __forceinline__ int lds_byte(int r, int c) { const int st = (r >> 4) * 2 + (c >> 5), rr = r & 15, cc = c & 31, ob = rr * 64 + cc * 2; return st * 1024 + (ob ^ (((ob >> 9) & 1) << 5)); }
__host__ __device__ __forceinline__ void stage_rc(int b, int& R, int& C) { const int st = b / 1024, sb = b % 1024, swz = sb ^ (((sb >> 9) & 1) << 5); R = (st >> 1) * 16 + swz / 64; C = (st & 1) * 32 + (swz % 64) / 2; }
__host__ __device__ __forceinline__ int perm32(int rho) { const int n = rho >> 4, i = rho & 15; return 8 * (i >> 2) + 4 * n + (i & 3); }

struct Unit { int pm, pn; };
struct Gemm { const bf16_t* A; const bf16_t* Bt; int M, N, K; };

struct StaticOrder {
    int nM, nN, nwg, G, c;
    __host__ __device__ void init(int M, int N, int G_, int c_) { nM = M / BM; nN = N / BM; nwg = nM * nN; G = G_; c = c_; }
    __host__ __device__ bool next(int i, Unit& u) const {
        const long L = (long)i * G + c; if (L >= nwg) return false;
        int wgid = (int)L; { const int q = nwg / NXCD, r = nwg % NXCD, xcd = wgid % NXCD, off = wgid / NXCD; wgid = (xcd < r ? xcd * (q + 1) : r * (q + 1) + (xcd - r) * q) + off; }
        const int nig = WGM * nN, gid = wgid / nig, fm = gid * WGM, gsz = (nM - fm) < WGM ? (nM - fm) : WGM;
        u.pm = fm + ((wgid % nig) % gsz); u.pn = (wgid % nig) / gsz; return true;
    }
    __device__ __forceinline__ void a_ready(const Unit&) const {}
    __device__ __forceinline__ void done(const Unit&) const {}
};
template <class Epi, class Sched, bool ALIGN_EPI = false, bool SP2 = false>
__device__ __forceinline__ void gemm_phase(PG8_LAS unsigned char* lds, const Gemm g, const Sched& S, const Epi& E, const int tid  ) {
    const int wid = __builtin_amdgcn_readfirstlane(tid >> 6), lane = tid & 63, wr = wid >> 2, wc = wid & 3, fr = lane & 15, fq = lane >> 4;
    const int K = g.K, nt = K / BK;
    unsigned voffA[2], voffB[2];
#pragma unroll
    for (int i = 0; i < 2; ++i) { int R, C; stage_rc(tid * 16 + i * 8192, R, C); const int Rb = Epi::PERM ? ((R & ~31) + perm32(R & 31)) : R;
        voffA[i] = (unsigned)(R * K + C) * 2u; voffB[i] = (unsigned)(Rb * K + C) * 2u; }
    const size_t kstep = (size_t)(BK * 2);
    const size_t hstep = (size_t)HALF * K * 2;
    const size_t tstep = 2 * hstep;
    const unsigned ldsw = (unsigned)wid * 1024u;
    const int aoff = lds_byte(wr * 64 + fr, fq * 8), boff = lds_byte(wc * 32 + fr, fq * 8);
#define PG8_SA(b, h) (((b) * 2 + (h)) * HTB)
#define PG8_SB(b, h) ((4 + (b) * 2 + (h)) * HTB)
#define PG8_STAGE(bufoff, gbase, voff) do { _Pragma("unroll") for (int _i = 0; _i < 2; ++_i) \
        __builtin_amdgcn_global_load_lds((const unsigned*)((const char*)(gbase) + (voff)[_i]), (PG8_LAS unsigned*)(lds + (bufoff) + ldsw + _i * 8192), 16, 0, 0); } while (0)
#define PG8_LDA(dst, b, h) do { _Pragma("unroll") for (int m = 0; m < 4; ++m) _Pragma("unroll") for (int k = 0; k < 2; ++k) dst[m][k] = *(const PG8_LAS bf16x8*)(lds + PG8_SA(b, h) + aoff + m * 2048 + k * 1024); } while (0)
#define PG8_LDB(dst, b, h) do { _Pragma("unroll") for (int n = 0; n < 2; ++n) _Pragma("unroll") for (int k = 0; k < 2; ++k) dst[n][k] = *(const PG8_LAS bf16x8*)(lds + PG8_SB(b, h) + boff + n * 2048 + k * 1024); } while (0)
#define PG8_MMA(ai, bj, At, Bt) do { __builtin_amdgcn_s_setprio(1); _Pragma("unroll") for (int m = 0; m < 4; ++m) _Pragma("unroll") for (int n = 0; n < 2; ++n) _Pragma("unroll") for (int k = 0; k < 2; ++k) \
        acc[ai][bj][m][n] = __builtin_amdgcn_mfma_f32_16x16x32_f16(__builtin_bit_cast(half8, Bt[n][k]), __builtin_bit_cast(half8, At[m][k]), acc[ai][bj][m][n], 0, 0, 0); __builtin_amdgcn_s_setprio(0); } while (0)
#define PG8_WAIT_V(n) asm volatile("s_waitcnt vmcnt(" #n ")" ::: "memory")
#define PG8_WAIT_L(n) asm volatile("s_waitcnt lgkmcnt(" #n ")" ::: "memory")
#define PG8_BAR __builtin_amdgcn_s_barrier()
#define PG8_SCHED __builtin_amdgcn_sched_barrier(0)
    Unit cur, nxt; int ui = 0;
    if (!S.next(0, cur)) return;
    f32x4 acc[2][2][4][2];
#pragma unroll
    for (int a = 0; a < 2; ++a)
#pragma unroll
        for (int b = 0; b < 2; ++b)
#pragma unroll
            for (int m = 0; m < 4; ++m)
#pragma unroll
                for (int n = 0; n < 2; ++n) acc[a][b][m][n] = (f32x4){0.f, 0.f, 0.f, 0.f};
    bf16x8 At[4][2], B0[2][2], B1[2][2];
    const char* cA = (const char*)g.A + (size_t)cur.pm * tstep; const char* cB = (const char*)g.Bt + (size_t)cur.pn * tstep;
    S.a_ready(cur);
    if constexpr (SP2) {
        PG8_STAGE(PG8_SB(0, 0), cB, voffB); PG8_STAGE(PG8_SB(0, 1), cB + hstep, voffB); PG8_STAGE(PG8_SA(0, 0), cA, voffA); PG8_STAGE(PG8_SA(0, 1), cA + hstep, voffA);
        if (wr == 1) PG8_BAR;
        PG8_WAIT_V(2); PG8_BAR;
        PG8_STAGE(PG8_SB(1, 0), cB + kstep, voffB); PG8_STAGE(PG8_SA(1, 0), cA + kstep, voffA); PG8_STAGE(PG8_SB(1, 1), cB + hstep + kstep, voffB);
        PG8_WAIT_V(6); PG8_BAR;
    } else {
        PG8_STAGE(PG8_SB(0, 0), cB, voffB); PG8_STAGE(PG8_SA(0, 0), cA, voffA); PG8_STAGE(PG8_SB(0, 1), cB + hstep, voffB); PG8_STAGE(PG8_SA(0, 1), cA + hstep, voffA);
        if (wr == 1) PG8_BAR;
        PG8_WAIT_V(4); PG8_BAR;
        PG8_STAGE(PG8_SB(1, 0), cB + kstep, voffB); PG8_STAGE(PG8_SA(1, 0), cA + kstep, voffA); PG8_STAGE(PG8_SB(1, 1), cB + hstep + kstep, voffB);
        PG8_WAIT_V(6); PG8_BAR;
    }
    for (;;) {
        const bool has_next = S.next(ui + 1, nxt);
        const char* nA = has_next ? (const char*)g.A + (size_t)nxt.pm * tstep : cA; const char* nB = has_next ? (const char*)g.Bt + (size_t)nxt.pn * tstep : cB;
        for (int t = 0; t < nt; t += 2) {
            const bool last = (t == nt - 2);
            const char* a1 = cA + (size_t)(t + 1) * kstep;
            const char* a2 = last ? nA : cA + (size_t)(t + 2) * kstep; const char* b2 = last ? nB : cB + (size_t)(t + 2) * kstep;
            const char* a3 = a2 + kstep; const char* b3 = b2 + kstep;
            if (last && has_next) S.a_ready(nxt);
            if constexpr (SP2) {
            PG8_LDB(B0, 0, 0); PG8_LDB(B1, 0, 1); PG8_SCHED; PG8_LDA(At, 0, 0); PG8_STAGE(PG8_SA(1, 1), a1 + hstep, voffA);
            PG8_WAIT_V(8); PG8_WAIT_L(0); PG8_BAR; PG8_MMA(0, 0, At, B0); PG8_MMA(0, 1, At, B1); PG8_BAR; PG8_SCHED;
            PG8_LDA(At, 0, 1); PG8_STAGE(PG8_SB(0, 0), b2, voffB); PG8_STAGE(PG8_SB(0, 1), b2 + hstep, voffB); PG8_STAGE(PG8_SA(0, 0), a2, voffA);
            PG8_WAIT_V(8); PG8_WAIT_L(0); PG8_BAR; PG8_MMA(1, 0, At, B0); PG8_MMA(1, 1, At, B1); PG8_BAR; PG8_SCHED;
            PG8_LDB(B0, 1, 0); PG8_LDB(B1, 1, 1); PG8_SCHED; PG8_LDA(At, 1, 0); PG8_STAGE(PG8_SA(0, 1), a2 + hstep, voffA);
            PG8_WAIT_V(8); PG8_WAIT_L(0); PG8_BAR; PG8_MMA(0, 0, At, B0); PG8_MMA(0, 1, At, B1); PG8_BAR; PG8_SCHED;
            PG8_LDA(At, 1, 1); PG8_STAGE(PG8_SB(1, 0), b3, voffB); PG8_STAGE(PG8_SB(1, 1), b3 + hstep, voffB); PG8_STAGE(PG8_SA(1, 0), a3, voffA);
            PG8_WAIT_V(8); PG8_WAIT_L(0); PG8_BAR; PG8_MMA(1, 0, At, B0); PG8_MMA(1, 1, At, B1); PG8_BAR; PG8_SCHED;
            } else {
            PG8_LDB(B0, 0, 0); PG8_SCHED; PG8_LDA(At, 0, 0); PG8_STAGE(PG8_SA(1, 1), a1 + hstep, voffA);
            PG8_WAIT_L(8); PG8_BAR; PG8_WAIT_L(0); PG8_MMA(0, 0, At, B0); PG8_BAR; PG8_SCHED;
            PG8_LDB(B1, 0, 1); PG8_STAGE(PG8_SB(0, 0), b2, voffB);
            PG8_BAR; PG8_WAIT_L(0); PG8_MMA(0, 1, At, B1); PG8_BAR;
            PG8_LDA(At, 0, 1); PG8_STAGE(PG8_SA(0, 0), a2, voffA);
            PG8_BAR; PG8_WAIT_L(0); PG8_MMA(1, 0, At, B0); PG8_BAR; PG8_SCHED;
            PG8_STAGE(PG8_SB(0, 1), b2 + hstep, voffB);
            PG8_WAIT_V(6); PG8_BAR; PG8_MMA(1, 1, At, B1); PG8_BAR;
            PG8_LDB(B0, 1, 0); PG8_SCHED; PG8_LDA(At, 1, 0); PG8_STAGE(PG8_SA(0, 1), a2 + hstep, voffA);
            PG8_WAIT_L(8); PG8_BAR; PG8_WAIT_L(0); PG8_MMA(0, 0, At, B0); PG8_BAR; PG8_SCHED;
            PG8_LDB(B1, 1, 1); PG8_STAGE(PG8_SB(1, 0), b3, voffB);
            PG8_BAR; PG8_WAIT_L(0); PG8_MMA(0, 1, At, B1); PG8_BAR;
            PG8_LDA(At, 1, 1); PG8_STAGE(PG8_SA(1, 0), a3, voffA);
            PG8_BAR; PG8_WAIT_L(0); PG8_MMA(1, 0, At, B0); PG8_BAR; PG8_SCHED;
            PG8_STAGE(PG8_SB(1, 1), b3 + hstep, voffB);
            PG8_WAIT_V(6); PG8_BAR; PG8_MMA(1, 1, At, B1); PG8_BAR;
            }
        }
        if constexpr (ALIGN_EPI) { if (wr == 0) PG8_BAR; }
        if constexpr (!Epi::AFTER_DRAIN) { E(acc, cur, wr, wc, fr, fq); S.done(cur); }
        if (!has_next) break;
#pragma unroll
        for (int a = 0; a < 2; ++a)
#pragma unroll
            for (int b = 0; b < 2; ++b)
#pragma unroll
                for (int m = 0; m < 4; ++m)
#pragma unroll
                    for (int n = 0; n < 2; ++n) acc[a][b][m][n] = (f32x4){0.f, 0.f, 0.f, 0.f};
        cur = nxt; cA = nA; cB = nB; ++ui;
        if constexpr (ALIGN_EPI) { if (wr == 1) PG8_BAR; }
    }
    PG8_WAIT_V(0);
    if constexpr (!ALIGN_EPI) { if (wr == 0) PG8_BAR; }
    PG8_BAR;
    if constexpr (Epi::AFTER_DRAIN) { E.fused(acc, cur, wr, wc, fr, fq, lds, wid, lane); S.done(cur); }
#undef PG8_SA
#undef PG8_SB
#undef PG8_STAGE
#undef PG8_LDA
#undef PG8_LDB
#undef PG8_MMA
#undef PG8_WAIT_V
#undef PG8_WAIT_L
#undef PG8_BAR
#undef PG8_SCHED
}
}

namespace {
#define LAS __attribute__((address_space(3)))
#define GAS __attribute__((address_space(1)))
typedef unsigned short bf16;
typedef unsigned v4u __attribute__((ext_vector_type(4)));
typedef GAS unsigned gu32;
typedef float v2f __attribute__((ext_vector_type(2)));
constexpr int D = 1024, NB = 4, SEQ = 4096, CTX = 256, DEPTH = 2;
constexpr int TL = NB * SEQ, TC = NB * CTX, T = TL + TC;
constexpr int DFF = 2816, DIN = 2064, DU = 2304, NMOD = 9, MODW = NMOD * D;
constexpr int NR = NB + 1;
constexpr float EPS = 1e-6f;
constexpr int C_GA = 0, C_GB = 256, C_Q = 512, C_K = 1024, C_V = 1152, C_MQ = 1280, C_MK = 1536, C_MV = 1792, C_MO = 2048;
constexpr int SRC_COL0 = 256, SRC_GATE = 2048;
constexpr int NWAVES = 8, NTHREADS = 512;
constexpr int RING_BYTES = 131072, MISC_OFF = RING_BYTES, LDS_BYTES = 147456;
constexpr size_t al256(size_t x) { return (x + 255) & ~(size_t)255; }
constexpr size_t WS_CTL = 0, CTL_ZERO_BYTES = 65536;
constexpr int CW_BAR = 1024;
constexpr size_t WS_MOD = 1u << 20;
constexpr size_t WS_WI = al256(WS_MOD + (size_t)DEPTH * NR * MODW * 4);
constexpr size_t WS_WO = al256(WS_WI + (size_t)4 * 2 * DFF * D * 2);
constexpr size_t WS_WIN = al256(WS_WO + (size_t)4 * D * DFF * 2);
constexpr size_t WS_WOUT = al256(WS_WIN + (size_t)2 * DU * D * 2);
constexpr size_t WS_XC = al256(WS_WOUT + (size_t)2 * D * D * 2);
constexpr size_t WS_G = al256(WS_XC + (size_t)TC * D * 4);
constexpr size_t WS_HB = al256(WS_G + (size_t)T * 16 * 4);
constexpr size_t WS_X16 = al256(WS_HB + (size_t)T * D * 2);
constexpr size_t WS_Y_UNUSED = WS_X16;
constexpr size_t WS_R = al256(WS_X16 + (size_t)T * D * 2);
constexpr size_t WS_HS = al256(WS_R + (size_t)T * DFF * 2);
constexpr size_t WS_NL = al256(WS_HS + (size_t)2 * T * 256 * 4);
constexpr size_t WS_AM = al256(WS_NL + (size_t)32 * 68 * 64 * 4);
constexpr size_t WS_MS = al256(WS_AM + (size_t)32 * 68 * 2 * 4);
constexpr size_t WS_FM1 = al256(WS_MS + (size_t)32 * 68 * 4);
constexpr size_t WS_FM3 = al256(WS_FM1 + 128 * 128 * 2);
constexpr size_t WS_TW = al256(WS_FM3 + 64 * 128 * 2);
constexpr size_t WS_CT = al256(WS_TW + 4096 * 8);
constexpr size_t WS_RS = al256(WS_CT + 256 * 8);
constexpr size_t WS_SWFI = al256(WS_RS + (size_t)T * 16 * 4);
constexpr size_t WS_SWIN = al256(WS_SWFI + (size_t)4 * NR * 2 * DFF * 4);
constexpr size_t WS_SWG = al256(WS_SWIN + (size_t)2 * NR * DU * 4);
constexpr size_t WS_ROPE = al256(WS_SWG + (size_t)2 * NR * 16 * 4);
constexpr size_t WS_WGT = al256(WS_ROPE + 64 * 16 * 8);
constexpr size_t WS_DMC = al256(WS_WGT + (size_t)DEPTH * 32 * D * 2);
constexpr size_t WS_PROBE = al256(WS_DMC + 256 * 512 * 2);
constexpr size_t WS_NS2 = al256(WS_PROBE + 256);
constexpr size_t WS_MS2 = al256(WS_NS2 + (size_t)32 * 68 * 64 * 4);
constexpr size_t WS_END = al256(WS_MS2 + (size_t)32 * 68 * 4);

struct Ptrs { float* xl; float* xc; };
__device__ __forceinline__ int mod_row(int r) { return r < TL ? r / SEQ : NB; }
__device__ __forceinline__ float* xrow(const Ptrs& p, int r) { return r < TL ? p.xl + (size_t)r * D : p.xc + (size_t)(r - TL) * D; }
__device__ __forceinline__ float silu_f(float x) { return x / (1.f + expf(-x)); }
__device__ __forceinline__ float sigmoid_f(float x) { return 1.f / (1.f + expf(-x)); }
__device__ __forceinline__ float logsigmoid_f(float x) { return fminf(x, 0.f) - log1pf(expf(-fabsf(x))); }
__device__ __forceinline__ float bf2f(bf16 b) { return (float)__builtin_bit_cast(_Float16, b); }
__device__ __forceinline__ unsigned f2bf(float f) { return (unsigned)__builtin_bit_cast(unsigned short, (_Float16)f); }
__device__ __forceinline__ unsigned pk2(float lo, float hi) { return f2bf(lo) | (f2bf(hi) << 16); }
__device__ __forceinline__ float lane_xor(float v, int lane, int o) { return __int_as_float(__builtin_amdgcn_ds_bpermute((lane ^ o) << 2, __float_as_int(v))); }
__device__ __forceinline__ float lane_get(float v, int src) { return __int_as_float(__builtin_amdgcn_ds_bpermute(src << 2, __float_as_int(v))); }
__device__ __forceinline__ float wave_sum(float v, int lane) {
#pragma unroll
    for (int o = 1; o < 64; o <<= 1) v += lane_xor(v, lane, o);
    return v; }
#define RLX_AGENT __ATOMIC_RELAXED, __HIP_MEMORY_SCOPE_AGENT
struct Params { const float* in[17]; float* out; unsigned char* ws; };
typedef _Float16 half8 __attribute__((ext_vector_type(8)));
typedef _Float16 half4 __attribute__((ext_vector_type(4)));
typedef float f32x16 __attribute__((ext_vector_type(16)));
typedef float f32x4v __attribute__((ext_vector_type(4)));

using pg8::half8; using pg8::f32x4; using pg8::u32x4; using pg8::Unit; using pg8::bf16_t; using pg8::BM; using pg8::HALF;
__device__ __forceinline__ unsigned cvt_pk_bf16(float lo, float hi) { typedef float f2_t __attribute__((ext_vector_type(2))); typedef _Float16 h2_t __attribute__((ext_vector_type(2))); const f2_t v = {lo, hi}; return __builtin_bit_cast(unsigned, __builtin_convertvector(v, h2_t)); }
__device__ __forceinline__ float silu_fast(float x) { return x * __builtin_amdgcn_rcpf(1.f + __expf(-x)); }
__device__ __forceinline__ float rstd_row(const float* rowss, int row) {
    const f32x4 a = *(const f32x4*)(rowss + (size_t)row * 16), b = *(const f32x4*)(rowss + (size_t)row * 16 + 4), c = *(const f32x4*)(rowss + (size_t)row * 16 + 8), d = *(const f32x4*)(rowss + (size_t)row * 16 + 12);
    const f32x4 s = (a + b) + (c + d); return __builtin_amdgcn_rsqf(((s[0] + s[1]) + (s[2] + s[3])) * (1.f / 1024.f) + 1e-6f); }
typedef unsigned u32x2e __attribute__((ext_vector_type(2)));
constexpr int RSTD_TAB_OFF = MISC_OFF + 1024;
constexpr int BIAS_TAB_OFF = RSTD_TAB_OFF + 2048;
struct RstdOrder : pg8::StaticOrder {
    const float* rowss; LAS float* tab; int tid; mutable int cnt; const float* sw; int ncols;
    __device__ __forceinline__ void a_ready(const Unit& u) const { const int par = cnt & 1; ++cnt;
        if (tid < 256) tab[par * 256 + tid] = rstd_row(rowss, u.pm * BM + tid);
        else if (tid < 320) { const int mr = u.pm < TL / 256 ? u.pm / (SEQ / 256) : 4; *(LAS f32x4*)(tab + 512 + par * 256 + (tid - 256) * 4) = *(const f32x4*)(sw + (size_t)mr * ncols + u.pn * BM + (tid - 256) * 4); } }
};

struct EpiSwiglu {
    static constexpr bool PERM = true, AFTER_DRAIN = false;
    unsigned char* ws; int mat; LAS float* tab; mutable int cnt;
    __device__ __forceinline__ void operator()(const f32x4 (&acc)[2][2][4][2], const Unit& u, int wr, int wc, int fr, int fq) const {
        bf16_t* O = (bf16_t*)(ws + WS_R); constexpr int ldc = DFF;
        const LAS float* rt = tab + (cnt & 1) * 256 + wr * 64 + fr;
        const int row0 = u.pm * BM + wr * 64 + fr, col0 = u.pn * HALF + wc * 32 + 8 * fq;
        const LAS float* bs = tab + 512 + (cnt & 1) * 256 + wc * 32 + 8 * fq;
        const f32x4 bg0 = *(const LAS f32x4*)bs, bg1 = *(const LAS f32x4*)(bs + 4), bu0 = *(const LAS f32x4*)(bs + HALF), bu1 = *(const LAS f32x4*)(bs + HALF + 4); ++cnt;
#pragma unroll
        for (int ai = 0; ai < 2; ++ai)
#pragma unroll
            for (int m = 0; m < 4; ++m) { const int row = row0 + ai * HALF + m * 16; const float rs = rt[ai * HALF + m * 16]; bf16_t* rowp = O + (size_t)row * ldc + col0;
                const f32x4 g0 = acc[ai][0][m][0] * rs + bg0, g1 = acc[ai][0][m][1] * rs + bg1, u0 = acc[ai][1][m][0] * rs + bu0, u1 = acc[ai][1][m][1] * rs + bu1;
                f32x4 h0, h1;
#pragma unroll
                for (int i = 0; i < 4; ++i) { h0[i] = silu_fast(g0[i]) * u0[i]; h1[i] = silu_fast(g1[i]) * u1[i]; }
                u32x4 w; w.x = cvt_pk_bf16(h0[0], h0[1]); w.y = cvt_pk_bf16(h0[2], h0[3]); w.z = cvt_pk_bf16(h1[0], h1[1]); w.w = cvt_pk_bf16(h1[2], h1[3]);
                *(u32x4*)rowp = w; }
    }
};
struct EpiUProj {
    static constexpr bool PERM = true, AFTER_DRAIN = false;
    unsigned char* ws; int l; LAS float* tab; mutable int cnt;
    __device__ __forceinline__ void operator()(const f32x4 (&acc)[2][2][4][2], const Unit& u, int wr, int wc, int fr, int fq) const {
        bf16_t* O = (bf16_t*)(ws + WS_R); constexpr int ldc = DU, tl_panels = TL / 256; constexpr float qscale = 0.125f * 1.4426950408889634f;
        const float* rope = (const float*)(ws + WS_ROPE);
        const LAS float* rt = tab + (cnt & 1) * 256 + wr * 64 + fr; const LAS float* bs = tab + 512 + (cnt & 1) * 256 + wc * 32 + 8 * fq; ++cnt;
        const int row0 = u.pm * BM + wr * 64 + fr, col0 = u.pn * BM + wc * 32 + 8 * fq; const bool lat = u.pm < tl_panels;
        f32x4 bv[2][2];
#pragma unroll
        for (int bj = 0; bj < 2; ++bj)
#pragma unroll
            for (int n = 0; n < 2; ++n) bv[bj][n] = *(const LAS f32x4*)(bs + bj * HALF + n * 4);
        const bool isq = (u.pn == 2 || u.pn == 3); const bool isk = (u.pn == 4); const bool upper = fq >= 2;
#pragma unroll
        for (int ai = 0; ai < 2; ++ai)
#pragma unroll
            for (int m = 0; m < 4; ++m) { const int row = row0 + ai * HALF + m * 16; const float rs = rt[ai * HALF + m * 16]; bf16_t* rowp = O + (size_t)row * ldc + col0;
                f32x4 v[2][2];
#pragma unroll
                for (int bj = 0; bj < 2; ++bj)
#pragma unroll
                    for (int n = 0; n < 2; ++n) v[bj][n] = acc[ai][bj][m][n] * rs + bv[bj][n];
                if (isq || isk) {
                    if (lat) { const int pos = row & 4095; const int p = (wc & 1) ? (pos & 63) : (pos >> 6); const float* rp = rope + (size_t)(p * 16 + 8 * (fq & 1)) * 2;
                        const f32x4 cs0 = *(const f32x4*)rp, cs1 = *(const f32x4*)(rp + 4), cs2 = *(const f32x4*)(rp + 8), cs3 = *(const f32x4*)(rp + 12);
                        const f32x4 cc[2] = {{cs0[0], cs0[2], cs1[0], cs1[2]}, {cs2[0], cs2[2], cs3[0], cs3[2]}}, ss[2] = {{cs0[1], cs0[3], cs1[1], cs1[3]}, {cs2[1], cs2[3], cs3[1], cs3[3]}};
#pragma unroll
                        for (int bj = 0; bj < 2; ++bj) if (isq || bj == 0) {
#pragma unroll
                            for (int n = 0; n < 2; ++n) { f32x4 pv;
#pragma unroll
                                for (int i = 0; i < 4; ++i) { const unsigned xv = __float_as_uint(v[bj][n][i]); const auto sw = __builtin_amdgcn_permlane32_swap(xv, xv, false, false); pv[i] = __uint_as_float(upper ? sw[0] : sw[1]); }
                                v[bj][n] = upper ? (v[bj][n] * cc[n] + pv * ss[n]) : (v[bj][n] * cc[n] - pv * ss[n]); } } }
                    if (isq) {
#pragma unroll
                        for (int bj = 0; bj < 2; ++bj) { v[bj][0] = v[bj][0] * qscale; v[bj][1] = v[bj][1] * qscale; } } }
#pragma unroll
                for (int bj = 0; bj < 2; ++bj) { u32x4 w; w.x = cvt_pk_bf16(v[bj][0][0], v[bj][0][1]); w.y = cvt_pk_bf16(v[bj][0][2], v[bj][0][3]); w.z = cvt_pk_bf16(v[bj][1][0], v[bj][1][1]); w.w = cvt_pk_bf16(v[bj][1][2], v[bj][1][3]);
                    *(u32x4*)(rowp + bj * HALF) = w; } }
    }
};
struct EpiResid {
    static constexpr bool PERM = true, AFTER_DRAIN = false;
    unsigned char* ws; const float* xsrc32; const float* ng; int gate_off, nscale_off; float coef;
    __device__ __forceinline__ void operator()(const f32x4 (&acc)[2][2][4][2], const Unit& u, int wr, int wc, int fr, int fq) const {
        constexpr int ppb = SEQ / 256, mod_stride = MODW; const float* gate = (const float*)(ws + WS_MOD) + gate_off; const float* nscale = (const float*)(ws + WS_MOD) + nscale_off;
        bf16_t* hraw = (bf16_t*)(ws + WS_HB); float* rowss = (float*)(ws + WS_RS); bf16_t* x16 = (bf16_t*)(ws + WS_X16);
        const int prow = u.pm * BM; const int mr = u.pm / ppb;
        const int row0 = wr * 64 + fr, col0 = u.pn * BM + wc * 32 + 8 * fq;
        float ssq[2][4];
#pragma unroll
        for (int ai = 0; ai < 2; ++ai)
#pragma unroll
            for (int m = 0; m < 4; ++m) ssq[ai][m] = 0.f;
#pragma unroll
        for (int bj = 0; bj < 2; ++bj) { const int c = col0 + bj * HALF;
            const f32x4 gv0 = *(const f32x4*)(gate + (size_t)mr * mod_stride + c) * coef, gv1 = *(const f32x4*)(gate + (size_t)mr * mod_stride + c + 4) * coef;
            f32x4 hs0 = {0.f, 0.f, 0.f, 0.f}, hs1 = hs0;
            if (ng) { hs0 = *(const f32x4*)(ng + c) * (*(const f32x4*)(nscale + (size_t)mr * mod_stride + c) + 1.f); hs1 = *(const f32x4*)(ng + c + 4) * (*(const f32x4*)(nscale + (size_t)mr * mod_stride + c + 4) + 1.f); }
#pragma unroll
            for (int ai = 0; ai < 2; ++ai)
#pragma unroll
                for (int m = 0; m < 4; ++m) { const int rl = row0 + ai * HALF + m * 16; const size_t off = (size_t)(prow + rl) * 1024 + c;
                    f32x4 xo0, xo1;
                    if (xsrc32) { xo0 = *(const f32x4*)(xsrc32 + off); xo1 = *(const f32x4*)(xsrc32 + off + 4); }
                    else { const half8 hx = __builtin_bit_cast(half8, *(const u32x4*)(x16 + off)); xo0 = (f32x4){(float)hx[0], (float)hx[1], (float)hx[2], (float)hx[3]}; xo1 = (f32x4){(float)hx[4], (float)hx[5], (float)hx[6], (float)hx[7]}; }
                    const f32x4 x0 = xo0 + gv0 * acc[ai][bj][m][0], x1 = xo1 + gv1 * acc[ai][bj][m][1];
                    { u32x4 w; w.x = cvt_pk_bf16(x0[0], x0[1]); w.y = cvt_pk_bf16(x0[2], x0[3]); w.z = cvt_pk_bf16(x1[0], x1[1]); w.w = cvt_pk_bf16(x1[2], x1[3]); *(u32x4*)(x16 + off) = w; }
                    ssq[ai][m] += ((x0[0] * x0[0] + x0[1] * x0[1]) + (x0[2] * x0[2] + x0[3] * x0[3])) + ((x1[0] * x1[0] + x1[1] * x1[1]) + (x1[2] * x1[2] + x1[3] * x1[3]));
                    if (ng) { const f32x4 h0 = x0 * hs0, h1 = x1 * hs1; u32x4 w; w.x = cvt_pk_bf16(h0[0], h0[1]); w.y = cvt_pk_bf16(h0[2], h0[3]); w.z = cvt_pk_bf16(h1[0], h1[1]); w.w = cvt_pk_bf16(h1[2], h1[3]); *(u32x4*)(hraw + off) = w; } } }
        const int lane = fq * 16 + fr;
#pragma unroll
        for (int ai = 0; ai < 2; ++ai)
#pragma unroll
            for (int m = 0; m < 4; ++m) { float q = ssq[ai][m];
                q += __int_as_float(__builtin_amdgcn_ds_bpermute((lane ^ 16) << 2, __float_as_int(q)));
                q += __int_as_float(__builtin_amdgcn_ds_bpermute((lane ^ 32) << 2, __float_as_int(q)));
                if (fq == 0) rowss[(size_t)(prow + row0 + ai * HALF + m * 16) * 16 + u.pn * 4 + wc] = q; }
    }
};
#define XB_TMO      128
#define XB_XCNT(j)  (256  + 64 * (j))
#define XB_XSUB(j)  (1280 + 64 * (j))
#define XB_XGEN(j)  (2304 + 64 * (j))
#define XB_TOP      3328
#define XB_TOPGEN   3392
#define XCD_BAR_WORDS 3456
#define XB_SPIN_CAP (1u << 18)

__device__ __forceinline__ unsigned xb_ld(unsigned* p)              { return __hip_atomic_load(p, __ATOMIC_RELAXED, __HIP_MEMORY_SCOPE_AGENT); }
__device__ __forceinline__ unsigned xb_add(unsigned* p, unsigned v) { return __hip_atomic_fetch_add(p, v, __ATOMIC_RELAXED, __HIP_MEMORY_SCOPE_AGENT); }
__device__ __forceinline__ unsigned xb_xcc_id() { return (unsigned)__builtin_amdgcn_s_getreg((3 << 11) | 20) & 0xFu; }
#define XB_SPIN(cond, bar) do { unsigned _sp = 0; while (cond) { __builtin_amdgcn_s_sleep(1); \
    if ((++_sp & 255u) == 0u) { if (xb_ld(&(bar)[XB_TMO])) break; if (_sp > XB_SPIN_CAP) { atomicAdd(&(bar)[XB_TMO], 1u); break; } } } } while (0)

struct XcdBarrier {
    unsigned* bar; unsigned x;
    volatile LAS unsigned* st;
};

__device__ __forceinline__ XcdBarrier xcd_barrier_post(unsigned* bar, volatile LAS unsigned* st) {
    XcdBarrier b; b.bar = bar; b.x = xb_xcc_id(); b.st = st;
    if (threadIdx.x == 0) (void)xb_add(&bar[XB_XCNT(b.x)], 1u);
    return b;
}
__device__ __forceinline__ void xcd_barrier_complete(unsigned* bar, unsigned x, unsigned& nloc, unsigned& nx) {
    const unsigned G = gridDim.x * gridDim.y * gridDim.z;
    unsigned sum, cnt, mine, sp = 0u;
    for (;;) {
        sum = 0u; cnt = 0u; mine = 0u;
#pragma unroll
        for (unsigned j = 0; j < 16; ++j) { const unsigned c = xb_ld(&bar[XB_XCNT(j)]); sum += c; cnt += (c > 0u) ? 1u : 0u; mine = (j == x) ? c : mine; }
        if (sum == G) break;
        __builtin_amdgcn_s_sleep(1);
        if ((++sp & 255u) == 0u) { if (xb_ld(&bar[XB_TMO])) break; if (sp > XB_SPIN_CAP) { atomicAdd(&bar[XB_TMO], 1u); break; } }
    }
    nloc = mine > 0u ? mine : 1u; nx = cnt > 0u ? cnt : 1u;
}

__device__ __forceinline__ void xcd_barrier(const XcdBarrier& b) {
    asm volatile("s_waitcnt vmcnt(0)" ::: "memory");
    __syncthreads();
    if (threadIdx.x == 0) {
        unsigned* bar = b.bar;
        __builtin_amdgcn_s_waitcnt(0);
        unsigned nloc = b.st[0], nx = b.st[1];
        if (nloc == 0u) { xcd_barrier_complete(bar, b.x, nloc, nx); b.st[0] = nloc; b.st[1] = nx; }
        const unsigned old = xb_add(&bar[XB_XSUB(b.x)], 1u);
        const unsigned gen = old / nloc;
        if (old + 1u == (gen + 1u) * nloc) {
            __builtin_amdgcn_fence(__ATOMIC_RELEASE, "agent");
            asm volatile("s_waitcnt vmcnt(0)" ::: "memory");
            const unsigned og = xb_add(&bar[XB_TOP], 1u);
            const unsigned tg = og / nx;
            if (og + 1u == (tg + 1u) * nx) xb_add(&bar[XB_TOPGEN], 1u);
            else XB_SPIN(xb_ld(&bar[XB_TOPGEN]) == tg, bar);
            __builtin_amdgcn_fence(__ATOMIC_ACQUIRE, "agent");
            xb_add(&bar[XB_XGEN(b.x)], 1u);
            asm volatile("s_waitcnt vmcnt(0)" ::: "memory");
        } else {
            XB_SPIN(xb_ld(&bar[XB_XGEN(b.x)]) == gen, bar);
            __builtin_amdgcn_fence(__ATOMIC_ACQUIRE, "agent");
            asm volatile("s_waitcnt vmcnt(0)" ::: "memory");
        }
    }
    __syncthreads();
}

struct Frame {
    LAS unsigned char* lds; unsigned char* ldsg;
    int tid, lane, wave, G, bid, gw, NGW;
    float* out; unsigned char* ws;
};

__device__ __forceinline__ void ph_mod(Frame& F, const Params& P) {
    const float* c = P.in[1]; const float* cctx = P.in[3]; const float* w_ada = P.in[4]; const float* b_ada = P.in[5]; float* MOD = (float*)(F.ws + WS_MOD);
    float* s = (float*)F.ldsg; float* red = s + NR * D;
    constexpr int NMODIT = DEPTH * (MODW / 128); const int mb = F.bid - (F.G - NMODIT);
    if (mb >= 0) { for (int i = F.tid; i < NR * D; i += NTHREADS) { const int r = i / D, k = i % D; const float v = r < NB ? c[r * D + k] : cctx[k]; s[i] = silu_f(v); } }
    for (int it = mb; it >= 0 && it < NMODIT; it += F.G) {
        const int l = it / (MODW / 128), j = (it % (MODW / 128)) * 128 + 2 * F.lane;
        __syncthreads();
        float a0[NR], a1[NR];
#pragma unroll
        for (int r = 0; r < NR; ++r) { a0[r] = 0.f; a1[r] = 0.f; }
        const float* w = w_ada + ((size_t)l * D + 128 * F.wave) * MODW + j;
#pragma unroll 16
        for (int k = 0; k < 128; ++k) { const float2 wv = *(const float2*)(w + (size_t)k * MODW);
#pragma unroll
            for (int r = 0; r < NR; ++r) { const float sv = s[r * D + 128 * F.wave + k]; a0[r] += sv * wv.x; a1[r] += sv * wv.y; } }
#pragma unroll
        for (int r = 0; r < NR; ++r) { red[(F.wave * NR + r) * 128 + 2 * F.lane] = a0[r]; red[(F.wave * NR + r) * 128 + 2 * F.lane + 1] = a1[r]; }
        __syncthreads();
        for (int idx = F.tid; idx < NR * 128; idx += NTHREADS) { const int r = idx >> 7, cc = idx & 127; float a = 0.f;
#pragma unroll
            for (int w8 = 0; w8 < 8; ++w8) a += red[(w8 * NR + r) * 128 + cc];
            const int jj = (it % (MODW / 128)) * 128 + cc; MOD[((size_t)l * NR + r) * MODW + jj] = a + b_ada[l * MODW + jj]; }
    }
    __syncthreads();
}
__device__ __forceinline__ void transpose_item(const float* W, int ldw, int K, bf16* WT, int dst_row0, int k0, int n0, LAS float* scr, int lane) {
#pragma unroll
    for (int i = 0; i < 8; ++i) { const int kk = 8 * i + (lane >> 3), nq = (lane & 7) * 4; const float4 v = *(const float4*)(W + (size_t)(k0 + kk) * ldw + n0 + nq);
        scr[kk * 33 + nq] = v.x; scr[kk * 33 + nq + 1] = v.y; scr[kk * 33 + nq + 2] = v.z; scr[kk * 33 + nq + 3] = v.w; }
    asm volatile("s_waitcnt lgkmcnt(0)" ::: "memory");
    const int c = lane & 7;
#pragma unroll
    for (int j = 0; j < 4; ++j) { const int n = (lane >> 3) + 8 * j; const LAS float* s = scr + (8 * c) * 33 + n;
        v4u o; o.x = pk2(s[0 * 33], s[1 * 33]); o.y = pk2(s[2 * 33], s[3 * 33]); o.z = pk2(s[4 * 33], s[5 * 33]); o.w = pk2(s[6 * 33], s[7 * 33]);
        *(v4u*)(WT + (size_t)(dst_row0 + n) * K + k0 + 8 * c) = o; }
    asm volatile("s_waitcnt lgkmcnt(0)" ::: "memory");
}
__device__ __forceinline__ void ph_convert(Frame& F, const Params& P, int l, int it0, int it1, int rank, int nw) {
    const float* w_ffn_in = P.in[7]; const float* w_ffn_out = P.in[8]; const float* w_in = P.in[9]; const float* w_out = P.in[10];
    bf16* Wi_t = (bf16*)(F.ws + WS_WI); bf16* Wo_t = (bf16*)(F.ws + WS_WO); bf16* Win_t = (bf16*)(F.ws + WS_WIN); bf16* Wout_t = (bf16*)(F.ws + WS_WOUT);
    LAS float* scr = (LAS float*)(F.lds + F.wave * 16384);
    constexpr int NSRC = SRC_GATE - SRC_COL0; constexpr int I_FI = (D / 64) * (2 * DFF / 32), I_FO = (DFF / 64) * (D / 32), I_IN = (D / 64) * (NSRC / 32), I_OUT = (D / 64) * (D / 32);
    constexpr int NITEMS = 2 * I_FI + 2 * I_FO + I_IN + I_OUT;
    if (it1 > NITEMS) it1 = NITEMS;
    for (int it = it0 + rank; it < it1; it += nw) {
        int r = it;
        if (r < 2 * I_FI) { const int mat = 2 * l + r / I_FI; r %= I_FI; const int nblk = 2 * DFF / 32, kb = r / nblk, nb = r % nblk, n0 = 32 * nb;
            const int nn = n0 < DFF ? n0 : n0 - DFF; const int drow = 256 * (nn / 128) + (n0 < DFF ? 0 : 128) + (nn % 128);
            transpose_item(w_ffn_in + (size_t)mat * D * 2 * DFF, 2 * DFF, D, Wi_t + (size_t)mat * 2 * DFF * D, drow, 64 * kb, n0, scr, F.lane); continue; }
        r -= 2 * I_FI;
        if (r < 2 * I_FO) { const int mat = 2 * l + r / I_FO; r %= I_FO; const int nblk = D / 32, kb = r / nblk, nb = r % nblk;
            transpose_item(w_ffn_out + (size_t)mat * DFF * D, D, DFF, Wo_t + (size_t)mat * D * DFF, 32 * nb, 64 * kb, 32 * nb, scr, F.lane); continue; }
        r -= 2 * I_FO;
        if (r < I_IN) { const int nblk = NSRC / 32, kb = r / nblk, nb = r % nblk;
            transpose_item(w_in + (size_t)l * D * DIN, DIN, D, Win_t + (size_t)l * DU * D, 512 + 32 * nb, 64 * kb, SRC_COL0 + 32 * nb, scr, F.lane); continue; }
        r -= I_IN;
        { const int nblk = D / 32, kb = r / nblk, nb = r % nblk;
            transpose_item(w_out + (size_t)l * D * D, D, D, Wout_t + (size_t)l * D * D, 32 * nb, 64 * kb, 32 * nb, scr, F.lane); }
    }
}
__device__ __forceinline__ void ph_first(Frame& F, const Params& P) {
    const float* xin = P.in[0]; const float* cin = P.in[2]; const float* g = P.in[6]; const float* MOD = (const float*)(F.ws + WS_MOD);
    bf16* H = (bf16*)(F.ws + WS_HB); float* RS = (float*)(F.ws + WS_RS);
    constexpr int RB = 4;
    for (int r0 = F.gw * RB; r0 < T; r0 += F.NGW * RB) {
        float4 v[RB][4];
#pragma unroll
        for (int i = 0; i < RB; ++i) { const int r = r0 + i; const float* src = r < TL ? xin + (size_t)r * D : cin + (size_t)(r - TL) * D;
#pragma unroll
            for (int j = 0; j < 4; ++j) v[i][j] = ((const float4*)src)[F.lane + 64 * j]; }
        const int mr = mod_row(r0);
        float4 gs[4];
#pragma unroll
        for (int j = 0; j < 4; ++j) { const int q = F.lane + 64 * j; const float4 gv = ((const float4*)g)[q], sc = ((const float4*)(MOD + (size_t)mr * MODW + 1 * D))[q]; gs[j] = make_float4(gv.x * (1.f + sc.x), gv.y * (1.f + sc.y), gv.z * (1.f + sc.z), gv.w * (1.f + sc.w)); }
        float ss[RB];
#pragma unroll
        for (int i = 0; i < RB; ++i) { const int r = r0 + i; ss[i] = 0.f;
#pragma unroll
            for (int j = 0; j < 4; ++j) { const float4 x = v[i][j]; ss[i] += x.x * x.x + x.y * x.y + x.z * x.z + x.w * x.w;
                uint2 o; o.x = pk2(x.x * gs[j].x, x.y * gs[j].y); o.y = pk2(x.z * gs[j].z, x.w * gs[j].w); ((uint2*)(H + (size_t)r * D))[F.lane + 64 * j] = o; } }
#pragma unroll
        for (int i = 0; i < RB; ++i) ss[i] = wave_sum(ss[i], F.lane);
#pragma unroll
        for (int i = 0; i < RB; ++i) if (F.lane < 16) RS[(size_t)(r0 + i) * 16 + F.lane] = F.lane == 0 ? ss[i] : 0.f;
    }
}
__device__ __forceinline__ void ph_bias(Frame& F, const Params& P, int l) {
    const float* MOD = (const float*)(F.ws + WS_MOD); const bf16* Wi_t = (const bf16*)(F.ws + WS_WI); const bf16* Win_t = (const bf16*)(F.ws + WS_WIN);
    float* SWFI = (float*)(F.ws + WS_SWFI); float* SWIN = (float*)(F.ws + WS_SWIN); float* SWG = (float*)(F.ws + WS_SWG);
#pragma unroll 1
    for (int mg = 0; mg < 4; ++mg) {
        const bool fi = mg < 2; const int mat = fi ? 2 * l + mg : l, sidx = fi ? (mg ? 6 : 0) : 3, nrows = fi ? 2 * DFF : (mg == 2 ? DU : 16);
        float sh[NR][16];
#pragma unroll
        for (int r = 0; r < NR; ++r) { const float4* sp = (const float4*)(MOD + ((size_t)l * NR + r) * MODW + sidx * D + F.lane * 16);
#pragma unroll
            for (int q4 = 0; q4 < 4; ++q4) { const float4 s4 = sp[q4]; sh[r][4 * q4] = s4.x; sh[r][4 * q4 + 1] = s4.y; sh[r][4 * q4 + 2] = s4.z; sh[r][4 * q4 + 3] = s4.w; } }
        const bf16* wbase = fi ? Wi_t + (size_t)mat * 2 * DFF * D : (mg == 2 ? Win_t + (size_t)mat * DU * D : (const bf16*)(F.ws + WS_WGT) + (size_t)l * 32 * D);
        float* obase = fi ? SWFI + (size_t)mat * NR * 2 * DFF : (mg == 2 ? SWIN + (size_t)mat * NR * DU : SWG + (size_t)l * NR * 16);
        for (int row = F.gw; row < nrows; row += F.NGW) {
            const bf16* wr = wbase + (size_t)row * D + F.lane * 16;
            const half8 w0 = __builtin_bit_cast(half8, *(const v4u*)wr), w1 = __builtin_bit_cast(half8, *(const v4u*)(wr + 8));
            float x[16];
#pragma unroll
            for (int i = 0; i < 16; ++i) x[i] = i < 8 ? (float)w0[i] : (float)w1[i - 8];
#pragma unroll
            for (int r = 0; r < NR; ++r) { float a = 0.f;
#pragma unroll
                for (int i = 0; i < 16; ++i) a += sh[r][i] * x[i];
                a = wave_sum(a, F.lane); if (F.lane == 0) obase[(size_t)r * nrows + row] = a; }
        }
    }
}
__device__ __forceinline__ void ph_rope_table(Frame& F, const Params& P) {
    float2* RT = (float2*)(F.ws + WS_ROPE); bf16* WgT = (bf16*)(F.ws + WS_WGT);
    for (int i = F.bid * NTHREADS + F.tid; i < DEPTH * 32 * D; i += F.G * NTHREADS) { const int l = i / (32 * D), j = (i / D) & 31, k = i % D; WgT[i] = (bf16)(j < 16 ? f2bf(P.in[9][((size_t)l * D + k) * DIN + SRC_GATE + j]) : 0u); }
    for (int i = F.bid + F.G * F.tid; i < 64 * 16 && F.tid < 8; i += F.G * 8) { const int p = i >> 4, f = i & 15;     const float ang = (float)p * powf(10000.f, -(float)f / 16.f); RT[i] = make_float2(cosf(ang), sinf(ang)); }
}
__device__ __forceinline__ void ph_final(Frame& F, const Params& P) {
    const float* g = P.in[16]; const float* RS = (const float*)(F.ws + WS_RS); const bf16* X16 = (const bf16*)(F.ws + WS_X16);
    constexpr int RB = 4;
    float4 gv[4];
#pragma unroll
    for (int j = 0; j < 4; ++j) gv[j] = ((const float4*)g)[F.lane + 64 * j];
    for (int r0 = F.gw * RB; r0 < TL; r0 += F.NGW * RB) {
        half4 hx[RB][4]; float rstd[RB];
#pragma unroll
        for (int i = 0; i < RB; ++i) { rstd[i] = rstd_row(RS, r0 + i);
#pragma unroll
            for (int j = 0; j < 4; ++j) hx[i][j] = *(const half4*)(X16 + (size_t)(r0 + i) * D + 4 * (F.lane + 64 * j)); }
#pragma unroll
        for (int i = 0; i < RB; ++i) { float* o = F.out + (size_t)(r0 + i) * D;
#pragma unroll
            for (int j = 0; j < 4; ++j) ((float4*)o)[F.lane + 64 * j] = make_float4((float)hx[i][j][0] * rstd[i] * gv[j].x, (float)hx[i][j][1] * rstd[i] * gv[j].y, (float)hx[i][j][2] * rstd[i] * gv[j].z, (float)hx[i][j][3] * rstd[i] * gv[j].w); }
    }
}
__device__ __forceinline__ void ph_gates(Frame& F, int l) {
    const bf16* H = (const bf16*)(F.ws + WS_HB); float* G = (float*)(F.ws + WS_G); const float* RS = (const float*)(F.ws + WS_RS); const float* SWG = (const float*)(F.ws + WS_SWG) + l * NR * 16;
    const bf16* WgT = (const bf16*)(F.ws + WS_WGT) + (size_t)l * 32 * D;
    const int r32 = F.lane & 31, hh = F.lane >> 5;
    for (int rb = (F.gw + F.NGW - 100 * NWAVES) % F.NGW; rb < T / 32; rb += F.NGW) {
        const bf16* hp = H + (size_t)(rb * 32 + r32) * D + 8 * hh; const bf16* wp = WgT + (size_t)r32 * D + 8 * hh;
        f32x16 acc = {};
#pragma unroll 8
        for (int s = 0; s < 64; ++s) acc = __builtin_amdgcn_mfma_f32_32x32x16_f16(__builtin_bit_cast(half8, *(const v4u*)(wp + 16 * s)), __builtin_bit_cast(half8, *(const v4u*)(hp + 16 * s)), acc, 0, 0, 0);
        const int row = rb * 32 + r32; const float rstd = rstd_row(RS, row); const float* sb = SWG + mod_row(row) * 16;
#pragma unroll
        for (int q4 = 0; q4 < 2; ++q4) { const int j0 = 8 * q4 + 4 * hh; f32x4v o;
#pragma unroll
            for (int i = 0; i < 4; ++i) o[i] = acc[4 * q4 + i] * rstd + sb[j0 + i];
            *(f32x4v*)(G + (size_t)row * 16 + j0) = o; }
    }
}
constexpr int TP = 144;
constexpr int NCH = 68, NCHAIN = 32, NITEM = NCHAIN * NCH;
__device__ __forceinline__ f32x16 mfma32(half8 a, half8 b, f32x16 c) { return __builtin_amdgcn_mfma_f32_32x32x16_f16(a, b, c, 0, 0, 0); }
__device__ __forceinline__ float wave_max(float v, int lane) {
#pragma unroll
    for (int o = 1; o < 64; o <<= 1) v = fmaxf(v, lane_xor(v, lane, o));
    return v; }
struct ChunkGeo { int N, rb, p0, dp; };
__device__ __forceinline__ ChunkGeo chunk_geo(int b, int dir, int c  ) {
    ChunkGeo g; const bool isctx = c < 4; const int cc = isctx ? c : c - 4; g.N = isctx ? CTX : SEQ; g.rb = isctx ? TL + b * CTX : b * SEQ;
    if (dir == 0) { g.p0 = cc * 64; g.dp = 1; } else { g.p0 = g.N - 1 - cc * 64; g.dp = -1; }
    return g; }
struct Conv16Raw { v4u c0, c1, m0, m1, n0, n1; };
__device__ __forceinline__ void conv16_load(const bf16* urow  , int p, int N, int colbase, Conv16Raw& r) {
    r.c0 = *(const v4u*)(urow + colbase); r.c1 = *(const v4u*)(urow + colbase + 8);
    const v4u z = {0u, 0u, 0u, 0u}; r.m0 = z; r.m1 = z; r.n0 = z; r.n1 = z;
    if (p > 0) { r.m0 = *(const v4u*)(urow - DU + colbase); r.m1 = *(const v4u*)(urow - DU + colbase + 8); }
    if (p < N - 1) { r.n0 = *(const v4u*)(urow + DU + colbase); r.n1 = *(const v4u*)(urow + DU + colbase + 8); }
}
template <int TS, class CP> __device__ __forceinline__ void conv16_math(const Conv16Raw& r, CP cw, float scale, float (&out)[16]) {
    const half8 hc0 = __builtin_bit_cast(half8, r.c0), hc1 = __builtin_bit_cast(half8, r.c1), hm0 = __builtin_bit_cast(half8, r.m0), hm1 = __builtin_bit_cast(half8, r.m1), hn0 = __builtin_bit_cast(half8, r.n0), hn1 = __builtin_bit_cast(half8, r.n1);
#pragma unroll
    for (int i = 0; i < 16; ++i) { const float xm = i < 8 ? (float)hm0[i] : (float)hm1[i - 8], xc = i < 8 ? (float)hc0[i] : (float)hc1[i - 8], xn = i < 8 ? (float)hn0[i] : (float)hn1[i - 8];
        const float a = xm * cw[i] + xc * cw[TS + i] + xn * cw[2 * TS + i]; out[i] = a * __builtin_amdgcn_rcpf(1.f + __expf(-a)) * scale; }
}
__device__ __forceinline__ void conv16(const bf16* urow  , int p, int N, int colbase, const float* cw, float scale, float (&out)[16]) {
    Conv16Raw r; conv16_load(urow, p, N, colbase, r); conv16_math<512>(r, cw, scale, out);
}
__device__ __forceinline__ void st_row16(LAS unsigned char* tile, int row, int c0, const float (&v)[16]) {
    v4u a, b; a.x = pk2(v[0], v[1]); a.y = pk2(v[2], v[3]); a.z = pk2(v[4], v[5]); a.w = pk2(v[6], v[7]); b.x = pk2(v[8], v[9]); b.y = pk2(v[10], v[11]); b.z = pk2(v[12], v[13]); b.w = pk2(v[14], v[15]);
    *(LAS v4u*)(tile + row * TP + c0 * 2) = a; *(LAS v4u*)(tile + row * TP + c0 * 2 + 16) = b; }
__device__ __forceinline__ void st_col16(LAS unsigned char* tile, int col, int r0, const float (&v)[16]) {
#pragma unroll
    for (int i = 0; i < 16; ++i) *(LAS unsigned short*)(tile + (r0 + i) * TP + col * 2) = (unsigned short)f2bf(v[i]); }
__device__ __forceinline__ half8 ld_row8(const LAS unsigned char* tile, int row, int c0) { return __builtin_bit_cast(half8, *(const LAS v4u*)(tile + row * TP + c0 * 2)); }

#define TP_DECL unsigned long long tp0 = 0; (void)tp0
#define TP_ON(id) do { if (PROBE_ID == (id)) { __syncthreads(); tp0 = __builtin_amdgcn_s_memrealtime(); } } while (0)
#define TP_OFF(id) do { if (PROBE_ID == (id)) { asm volatile("s_waitcnt vmcnt(0)" ::: "memory"); __syncthreads(); const unsigned long long tp1 = __builtin_amdgcn_s_memrealtime(); \
        if (blockIdx.x == PROBE_WG) { const unsigned long long tgt = tp1 + 4ull * (tp1 - tp0); while (__builtin_amdgcn_s_memrealtime() < tgt) __builtin_amdgcn_s_sleep(8); } } } while (0)
__device__ __forceinline__ void ph_mlstm_m1(Frame& F, const float* conv, const float* b_i, const float* b_f) {
    const bf16* U = (const bf16*)(F.ws + WS_R); const float* G = (const float*)(F.ws + WS_G);
    bf16* CL = (bf16*)(F.ws + WS_HS); float* NL = (float*)(F.ws + WS_NL); float* AM = (float*)(F.ws + WS_AM);
    const int dir = F.wave >> 2, wg = F.wave & 3, tg = F.tid & 255, r32 = F.lane & 31, hh = F.lane >> 5;
    LAS unsigned char* base = F.lds + dir * 24576; LAS unsigned char* KT = base; LAS unsigned char* VT = base + 9216; LAS float* wS = (LAS float*)(base + 18432);
    for (int idx = F.bid >> 3; idx < 2 * NCH; idx += 32) {
        const int bh = (F.bid & 7) * 2 + idx / NCH, c = idx % NCH, b = bh >> 2, h = bh & 3; const ChunkGeo g = chunk_geo(b, dir, c); const int item = (bh * 2 + dir) * NCH + c;
        if (wg == 0) { const int p = g.p0 + g.dp * F.lane; const float* g0 = G + (size_t)(g.rb + p) * 16;
            const float liv = g0[dir * 4 + h] + b_i[dir * 4 + h], lfv = logsigmoid_f(g0[8 + dir * 4 + h] + b_f[dir * 4 + h]);
            float bc = lfv;
#pragma unroll
            for (int o = 1; o < 64; o <<= 1) { const float t = lane_get(bc, F.lane - o); if (F.lane >= o) bc += t; }
            const float a = lane_get(bc, 63); const float dl = a - bc + liv; const float ml = wave_max(dl, F.lane);
            wS[F.lane] = __expf(dl - ml);
            if (F.lane == 0) { AM[item * 2] = a; AM[item * 2 + 1] = ml; } }
        __syncthreads();
        { const int tau = tg >> 2, d0 = (tg & 3) * 16; const int p = g.p0 + g.dp * tau; const bf16* urow = U + (size_t)(g.rb + p) * DU;
          float kv[16], vv[16]; conv16(urow, p, g.N, C_MK + h * 64 + d0, conv + 256 + h * 64 + d0, 0.125f, kv);
          const float w = wS[tau]; const half8 v0 = __builtin_bit_cast(half8, *(const v4u*)(urow + C_MV + h * 64 + d0)), v1 = __builtin_bit_cast(half8, *(const v4u*)(urow + C_MV + h * 64 + d0 + 8));
#pragma unroll
          for (int i = 0; i < 16; ++i) vv[i] = (i < 8 ? (float)v0[i] : (float)v1[i - 8]) * w;
          st_col16(KT, tau, d0, kv); st_col16(VT, tau, d0, vv); }
        __syncthreads();
        { const int tm = wg >> 1, tn = wg & 1; f32x16 acc = {};
#pragma unroll
          for (int s = 0; s < 4; ++s) acc = mfma32(ld_row8(VT, 32 * tm + r32, 16 * s + 8 * hh), ld_row8(KT, 32 * tn + r32, 16 * s + 8 * hh), acc);
          bf16* cl = CL + (size_t)item * 4096 + 32 * tn + r32;
#pragma unroll
          for (int r = 0; r < 16; ++r) cl[(size_t)(32 * tm + (r & 3) + 8 * (r >> 2) + 4 * hh) * 64] = (bf16)f2bf(acc[r]);
          if (tg < 64) { float a = 0.f; const LAS unsigned char* kr = KT + tg * TP;
#pragma unroll 8
              for (int s = 0; s < 64; ++s) a += wS[s] * bf2f(*(const LAS unsigned short*)(kr + s * 2));
              NL[(size_t)item * 64 + tg] = a; } }
        __syncthreads();
    }
}
__device__ __forceinline__ void ph_mlstm_m2(Frame& F) {
    bf16* CL = (bf16*)(F.ws + WS_HS); float* NL = (float*)(F.ws + WS_NL); const float* AM = (const float*)(F.ws + WS_AM); float* MS = (float*)(F.ws + WS_MS);
    for (int vb = F.bid; vb < NCHAIN * 8; vb += F.G) {
        const int chain = vb >> 3, sl = vb & 7, e = sl * NTHREADS + F.tid; const bool don = (sl == 0 && F.tid < 64);
        bf16* cp = CL + (size_t)chain * NCH * 4096 + e; float* np = NL + (size_t)chain * NCH * 64 + (F.tid & 63); const float* am = AM + (size_t)chain * NCH * 2;
        float cl[NCH];
#pragma unroll
        for (int c = 0; c < NCH; ++c) cl[c] = bf2f(cp[(size_t)c * 4096]);
        { float C = 0.f, m = 0.f;
#pragma unroll
          for (int c = 0; c < NCH; ++c) { const float a = am[c * 2], ml = am[c * 2 + 1]; const float mn = fmaxf(a + m, ml), al = __expf(a + m - mn), be = __expf(ml - mn);
              cp[(size_t)c * 4096] = (bf16)f2bf(fminf(fmaxf(C, -60000.f), 60000.f)); C = al * C + be * cl[c];
              if (sl == 0 && F.tid == 0) MS[chain * NCH + c] = m;
              m = mn; } }
        if (don) {
#pragma unroll
            for (int c = 0; c < NCH; ++c) cl[c] = np[c * 64];
            float nvv = 0.f, m = 0.f;
#pragma unroll
            for (int c = 0; c < NCH; ++c) { const float a = am[c * 2], ml = am[c * 2 + 1]; const float mn = fmaxf(a + m, ml), al = __expf(a + m - mn), be = __expf(ml - mn);
                np[c * 64] = nvv; nvv = al * nvv + be * cl[c]; m = mn; } }
    }
}
__device__ __forceinline__ void ph_mlstm_m3(Frame& F, const float* conv, const float* b_i, const float* b_f, bool do_ctx) {
    const bf16* U = (const bf16*)(F.ws + WS_R); const float* G = (const float*)(F.ws + WS_G); bf16* Y = (bf16*)F.out;
    const bf16* CL = (const bf16*)(F.ws + WS_HS); const float* NL = (const float*)(F.ws + WS_NL); const float* AM = (const float*)(F.ws + WS_AM);
    bf16* CS = (bf16*)(F.ws + WS_HS) + (size_t)NITEM * 4096; float* NS = (float*)(F.ws + WS_NS2); float* MS = (float*)(F.ws + WS_MS2);
    const int dir = F.wave >> 2, wg = F.wave & 3, tg = F.tid & 255, r32 = F.lane & 31, hh = F.lane >> 5;
    LAS unsigned char* base = F.lds + dir * 40960; LAS unsigned char* Qs = base; LAS unsigned char* Ks = base + 9216; LAS unsigned char* VT = base + 18432; LAS unsigned char* Cs = base + 27648;
    LAS float* HO = (LAS float*)(F.lds + 81920);
    LAS float* cwS = (LAS float*)(F.lds + 100352);
    LAS float* GS = (LAS float*)(F.lds + 102400);
    if (F.bid >= 256) return;
    TP_DECL; TP_ON(331);
    const int bh = (F.bid & 7) * 2 + ((F.bid >> 3) & 1), sg = F.bid >> 4, b = bh >> 2, h = bh & 3;
    if (F.tid < 384) { const int qk = F.tid / 192, r = F.tid % 192; cwS[F.tid] = conv[qk * 256 + (r >> 6) * 512 + h * 64 + (r & 63)]; }     const bool has_ctx = do_ctx && sg < 4;
    {
      const int chain = bh * 2 + dir; const int lo = 4 + (dir ? 60 - 4 * sg : 4 * sg), last = lo + 3;
      const int cown = has_ctx ? (dir ? 3 - sg : sg) : -1;
      const bf16* cp = CL + (size_t)chain * NCH * 4096 + tg * 16; const float* np = NL + (size_t)chain * NCH * 64 + (tg & 63); const float* am = AM + (size_t)chain * NCH * 2;
      float C[16]; float nvv = 0.f, m = 0.f;
#pragma unroll
      for (int i = 0; i < 16; ++i) C[i] = 0.f;
      constexpr int PF = 8; v4u pl0[PF], pl1[PF]; float pnl[PF]; v2f pam[PF];
#pragma unroll
      for (int i = 0; i < PF; ++i) { pl0[i] = *(const v4u*)(cp + (size_t)i * 4096); pl1[i] = *(const v4u*)(cp + (size_t)i * 4096 + 8); pnl[i] = np[i * 64]; pam[i] = *(const v2f*)(am + i * 2); }
      for (int c0 = 0; c0 <= last; c0 += PF) {
#pragma unroll
          for (int i = 0; i < PF; ++i) { const int cs = c0 + i;
              const half8 x0 = __builtin_bit_cast(half8, pl0[i]), x1 = __builtin_bit_cast(half8, pl1[i]); const float xn = pnl[i]; const v2f xa = pam[i];
              { const int cn = cs + PF < NCH ? cs + PF : NCH - 1; pl0[i] = *(const v4u*)(cp + (size_t)cn * 4096); pl1[i] = *(const v4u*)(cp + (size_t)cn * 4096 + 8); pnl[i] = np[cn * 64]; pam[i] = *(const v2f*)(am + cn * 2); }
              if (cs <= last) {
                  if (cs >= lo || cs == cown) {
                      #define CK(i) fminf(fmaxf(C[i], -60000.f), 60000.f)
                      v4u w0, w1; w0.x = pk2(CK(0), CK(1)); w0.y = pk2(CK(2), CK(3)); w0.z = pk2(CK(4), CK(5)); w0.w = pk2(CK(6), CK(7)); w1.x = pk2(CK(8), CK(9)); w1.y = pk2(CK(10), CK(11)); w1.z = pk2(CK(12), CK(13)); w1.w = pk2(CK(14), CK(15));
#undef CK
                      bf16* cq = CS + ((size_t)chain * NCH + cs) * 4096 + tg * 16; *(v4u*)cq = w0; *(v4u*)(cq + 8) = w1;
                      if (tg < 64) NS[((size_t)chain * NCH + cs) * 64 + tg] = nvv;
                      if (tg == 0) MS[chain * NCH + cs] = m; }
                  if (cs < last) { const float a = xa.x, ml = xa.y; const float mn = fmaxf(a + m, ml), al = __expf(a + m - mn), be = __expf(ml - mn);
#pragma unroll
                      for (int e = 0; e < 16; ++e) C[e] = al * C[e] + be * (e < 8 ? (float)x0[e] : (float)x1[e - 8]);
                      nvv = al * nvv + be * xn; m = mn; } } } }
      asm volatile("s_waitcnt vmcnt(0)" ::: "memory"); }
    __syncthreads();
    TP_OFF(331);
    for (int k = F.wave; k < (has_ctx ? 10 : 8); k += NWAVES) { const int ii = (k >> 1) - (has_ctx ? 1 : 0), d = k & 1;
        const bool isctx = ii < 0; const int pb = isctx ? sg : 4 * sg + ii, N = isctx ? CTX : SEQ, rb = isctx ? TL + b * CTX : b * SEQ;
        const int cs = d == 0 ? pb : N / 64 - 1 - pb; const int item = (bh * 2 + d) * NCH + (isctx ? cs : 4 + cs);
        const int p = (d == 0 ? pb * 64 : pb * 64 + 63) + (d == 0 ? 1 : -1) * F.lane; const float* g0 = G + (size_t)(rb + p) * 16;
        const float liv = g0[d * 4 + h] + b_i[d * 4 + h], lfv = logsigmoid_f(g0[8 + d * 4 + h] + b_f[d * 4 + h]);
        float bc = lfv;
#pragma unroll
        for (int o = 1; o < 64; o <<= 1) { const float t = lane_get(bc, F.lane - o); if (F.lane >= o) bc += t; }
        const float lmb = liv - bc; float pm = lmb;
#pragma unroll
        for (int o = 1; o < 64; o <<= 1) { const float t = lane_get(pm, F.lane - o); if (F.lane >= o) pm = fmaxf(pm, t); }
        const float m0 = MS[item]; const float mt = bc + fmaxf(m0, pm);
        LAS float* gs = GS + k * 320;
        gs[F.lane] = bc; gs[64 + F.lane] = lmb; gs[128 + F.lane] = mt; gs[192 + F.lane] = __expf(bc + m0 - mt); gs[256 + F.lane] = NS[(size_t)item * 64 + F.lane]; }
    struct Raw { Conv16Raw q, k; v4u v0, v1, c0, c1; half4 mo[4]; };
    auto load_raw = [&](int ii, Raw& R) {
        const bool isctx = ii < 0; const int pb = isctx ? sg : 4 * sg + ii, N = isctx ? CTX : SEQ, rb = isctx ? TL + b * CTX : b * SEQ;
        const int cs = dir == 0 ? pb : N / 64 - 1 - pb; const int item = (bh * 2 + dir) * NCH + (isctx ? cs : 4 + cs);
        const int p0 = dir == 0 ? pb * 64 : pb * 64 + 63, dp = dir == 0 ? 1 : -1;
        { const int tau = tg >> 2, d0 = (tg & 3) * 16; const int p = p0 + dp * tau; const bf16* urow = U + (size_t)(rb + p) * DU;
          conv16_load(urow, p, N, C_MQ + h * 64 + d0, R.q); conv16_load(urow, p, N, C_MK + h * 64 + d0, R.k);
          R.v0 = *(const v4u*)(urow + C_MV + h * 64 + d0); R.v1 = *(const v4u*)(urow + C_MV + h * 64 + d0 + 8);
          const bf16* cg = CS + (size_t)item * 4096 + tau * 64 + d0; R.c0 = *(const v4u*)cg; R.c1 = *(const v4u*)(cg + 8); }
        if (dir == 1) { const int tt = wg & 1, tv = wg >> 1; const int tau = 32 * tt + r32, pos = 63 - tau; const size_t row = (size_t)(rb + pb * 64 + pos);
#pragma unroll
            for (int q4 = 0; q4 < 4; ++q4) R.mo[q4] = *(const half4*)(U + row * DU + C_MO + h * 64 + 32 * tv + 8 * q4 + 4 * hh); }
    };
    Raw R; load_raw(has_ctx ? -1 : 0, R);
    for (int ii = has_ctx ? -1 : 0; ii < 4; ++ii) {
        const bool isctx = ii < 0; const int pb = isctx ? sg : 4 * sg + ii, rb = isctx ? TL + b * CTX : b * SEQ;
        TP_ON(332);
        LAS float* gs = GS + ((ii + (has_ctx ? 1 : 0)) * 2 + dir) * 320; LAS float* bcS = gs; LAS float* lmbS = gs + 64; LAS float* mtS = gs + 128; LAS float* wpS = gs + 192; LAS float* n0S = gs + 256;
        { const int tau = tg >> 2, d0 = (tg & 3) * 16;
          float qv[16], kv[16], vv[16]; conv16_math<64>(R.q, cwS + d0, 1.0f, qv); conv16_math<64>(R.k, cwS + 192 + d0, 0.125f, kv);
          const half8 v0 = __builtin_bit_cast(half8, R.v0), v1 = __builtin_bit_cast(half8, R.v1);
#pragma unroll
          for (int i = 0; i < 16; ++i) vv[i] = i < 8 ? (float)v0[i] : (float)v1[i - 8];
          st_row16(Qs, tau, d0, qv); st_row16(Ks, tau, d0, kv); st_col16(VT, tau, d0, vv);
          *(LAS v4u*)(Cs + tau * TP + d0 * 2) = R.c0; *(LAS v4u*)(Cs + tau * TP + d0 * 2 + 16) = R.c1; }
        half4 mo_cur[4];
#pragma unroll
        for (int q4 = 0; q4 < 4; ++q4) mo_cur[q4] = R.mo[q4];
        if (PROBE_ID != 332 && PROBE_ID != 333 && PROBE_ID != 334) { if (ii + 1 < 4) load_raw(ii + 1, R); }
        __syncthreads();
        TP_OFF(332); if (PROBE_ID == 332 || PROBE_ID == 333 || PROBE_ID == 334) { if (ii + 1 < 4) load_raw(ii + 1, R); }
        TP_ON(333);
        f32x16 ho;
        { const int tt = wg & 1, tv = wg >> 1; const int tau = 32 * tt + r32;
          half8 qf[4];
#pragma unroll
          for (int s = 0; s < 4; ++s) qf[s] = ld_row8(Qs, tau, 16 * s + 8 * hh);
          f32x16 st0 = {}, st1 = {};
#pragma unroll
          for (int s = 0; s < 4; ++s) { st0 = mfma32(ld_row8(Ks, r32, 16 * s + 8 * hh), qf[s], st0); st1 = mfma32(ld_row8(Ks, 32 + r32, 16 * s + 8 * hh), qf[s], st1); }
          const float ct = bcS[tau] - mtS[tau]; float dpart = 0.f;
#pragma unroll
          for (int r = 0; r < 16; ++r) { const int sg = (r & 3) + 8 * (r >> 2) + 4 * hh;
              const float w0 = sg <= tau ? __expf(ct + lmbS[sg]) : 0.f, w1 = sg + 32 <= tau ? __expf(ct + lmbS[sg + 32]) : 0.f;
              st0[r] *= w0; st1[r] *= w1; dpart += st0[r] + st1[r]; }
          float qn = 0.f;
#pragma unroll
          for (int s = 0; s < 4; ++s)
#pragma unroll
              for (int j = 0; j < 8; ++j) qn += (float)qf[s][j] * n0S[16 * s + 8 * hh + j];
          dpart += lane_xor(dpart, F.lane, 32); qn += lane_xor(qn, F.lane, 32);
          const float wp = wpS[tau], mt = mtS[tau]; const float den = dpart + wp * qn; const float inv = 1.f / fmaxf(fabsf(den), __expf(-mt));
          f32x16 an = {}, ac = {};
#pragma unroll
          for (int ks = 0; ks < 4; ++ks) { const f32x16& sx = (ks >> 1) ? st1 : st0; const int rbs = 8 * (ks & 1);
              half8 bf;
#pragma unroll
              for (int j = 0; j < 8; ++j) bf[j] = (_Float16)sx[rbs + j];
              const LAS unsigned char* vr = VT + (32 * tv + r32) * TP + (16 * ks + 4 * hh) * 2;
              const half4 a0 = *(const LAS half4*)vr, a1 = *(const LAS half4*)(vr + 16);
              const half8 af = {a0[0], a0[1], a0[2], a0[3], a1[0], a1[1], a1[2], a1[3]};
              an = mfma32(af, bf, an); }
#pragma unroll
          for (int s = 0; s < 4; ++s) ac = mfma32(ld_row8(Cs, 32 * tv + r32, 16 * s + 8 * hh), qf[s], ac);
#pragma unroll
          for (int r = 0; r < 16; ++r) ho[r] = (an[r] + wp * ac[r]) * inv;
          if (dir == 0) {
#pragma unroll
              for (int q4 = 0; q4 < 4; ++q4) { f32x4v x = {ho[4 * q4], ho[4 * q4 + 1], ho[4 * q4 + 2], ho[4 * q4 + 3]}; *(LAS f32x4v*)(HO + tau * 68 + 32 * tv + 8 * q4 + 4 * hh) = x; } } }
        __syncthreads();
        TP_OFF(333); TP_ON(334);
        if (dir == 1) { const int tt = wg & 1, tv = wg >> 1; const int tau = 32 * tt + r32, pos = 63 - tau; const size_t row = (size_t)(rb + pb * 64 + pos);
#pragma unroll
            for (int q4 = 0; q4 < 4; ++q4) { const int v0 = 32 * tv + 8 * q4 + 4 * hh; const f32x4v x = *(const LAS f32x4v*)(HO + pos * 68 + v0);
                const half4 mo = mo_cur[q4]; float o[4];
#pragma unroll
                for (int i = 0; i < 4; ++i) { const float g = 1.f / (1.f + __expf(-(float)mo[i])); o[i] = fminf(fmaxf(g * (x[i] + ho[4 * q4 + i]), -60000.f), 60000.f); }
                uint2 w; w.x = pk2(o[0], o[1]); w.y = pk2(o[2], o[3]); *(uint2*)(Y + row * D + 768 + h * 64 + v0) = w; } }
        __syncthreads();
        TP_OFF(334);
    }
}


__device__ __forceinline__ void ph_attn(Frame& F, const float* sink, bool do_ctx) {
    const bf16* U = (const bf16*)(F.ws + WS_R); bf16* Y = (bf16*)F.out;
    const int g = F.wave >> 1, qh = F.wave & 1, r32 = F.lane & 31, hh = F.lane >> 5;
    const int lrow = F.tid >> 3, lch = F.tid & 7;
    constexpr float LOG2E = 1.4426950408889634f;
    const int nunits = 512 + (do_ctx ? 32 : 0);
    for (int uk = 0; uk < 3; ++uk) {
        int u; if (uk < 2) u = (F.bid & 7) * 64 + (F.bid >> 3) * 2 + uk; else { if (F.bid < 64 || F.bid >= 96) break; u = 512 + (F.bid - 64); }
        if (u >= nunits) break;
        const bool lat = u < 512; int b, kvh, qb;
        if (lat) { b = u >> 7; kvh = (u >> 6) & 1; qb = u & 63; } else { const int v = u - 512; b = v >> 3; kvh = (v >> 2) & 1; qb = v & 3; }
        const int head = kvh * 4 + g;
        const size_t qrow = (size_t)(lat ? b * SEQ : TL + b * CTX) + qb * 64 + qh * 32 + r32;
        half8 qf[4];
#pragma unroll
        for (int s = 0; s < 4; ++s) qf[s] = __builtin_bit_cast(half8, *(const v4u*)(U + qrow * DU + C_Q + head * 64 + 16 * s + 8 * hh));
        const int kt_lo = lat ? (qb - 2 < 0 ? 0 : qb - 2) : 0, kt_hi = lat ? (qb + 2 > 63 ? 63 : qb + 2) : -1; const int nloc = kt_hi - kt_lo + 1, nt = nloc + 4;
        float m = sink[head] * LOG2E, l = 1.f; f32x16 o0 = {}, o1 = {};
        v4u kreg, vreg;
#define ATT_TILE_ROW0(t) ((t) < nloc ? (size_t)b * SEQ + (size_t)(kt_lo + (t)) * 64 : (size_t)TL + (size_t)b * CTX + (size_t)((t) - nloc) * 64)
#define ATT_LOAD(t) do { const bf16* rp = U + (ATT_TILE_ROW0(t) + lrow) * DU + kvh * 64 + 8 * lch; kreg = *(const v4u*)(rp + C_K); vreg = *(const v4u*)(rp + C_V); } while (0)
#define ATT_STORE(buf) do { LAS unsigned char* kb = F.lds + (buf) * 9216; LAS unsigned char* vb = F.lds + 18432 + (buf) * 9216; *(LAS v4u*)(kb + lrow * TP + lch * 16) = kreg; \
        const half8 vh = __builtin_bit_cast(half8, vreg); _Pragma("unroll") for (int i = 0; i < 8; ++i) *(LAS _Float16*)(vb + (8 * lch + i) * TP + lrow * 2) = vh[i]; } while (0)
        ATT_LOAD(0); ATT_STORE(0);
        __syncthreads();
        for (int t = 0; t < nt; ++t) {
            if (t + 1 < nt) ATT_LOAD(t + 1);
            const LAS unsigned char* Kb = F.lds + (t & 1) * 9216; const LAS unsigned char* Vb = F.lds + 18432 + (t & 1) * 9216;
            f32x16 s0, s1;
#pragma unroll
            for (int r = 0; r < 16; ++r) { s0[r] = -m; s1[r] = -m; }
#pragma unroll
            for (int s = 0; s < 4; ++s) { s0 = mfma32(ld_row8(Kb, r32, 16 * s + 8 * hh), qf[s], s0); s1 = mfma32(ld_row8(Kb, 32 + r32, 16 * s + 8 * hh), qf[s], s1); }
            int ttype = 0; if (t < nloc) { const int kt = kt_lo + t; ttype = (kt == qb - 2) ? 1 : (kt == qb + 2) ? 2 : 0; }
            const int qi = qh * 32 + r32;
            if (ttype != 0) {
#pragma unroll
                for (int r = 0; r < 16; ++r) { const int jk = (r & 3) + 8 * (r >> 2) + 4 * hh;
                    const bool v0 = ttype == 1 ? (jk >= qi) : (jk <= qi), v1 = ttype == 1 ? (jk + 32 >= qi) : (jk + 32 <= qi);
                    s0[r] = v0 ? s0[r] : -INFINITY; s1[r] = v1 ? s1[r] : -INFINITY; } }
            float mx = fmaxf(s0[0], s1[0]);
#pragma unroll
            for (int r = 1; r < 16; ++r) mx = fmaxf(mx, fmaxf(s0[r], s1[r]));
            mx = fmaxf(mx, lane_xor(mx, F.lane, 32));
            if (__builtin_amdgcn_ballot_w64(mx > 0.f) != 0ull) {
                const float dl = fmaxf(mx, 0.f), alpha = __builtin_amdgcn_exp2f(-dl); m += dl; l *= alpha;
#pragma unroll
                for (int r = 0; r < 16; ++r) { s0[r] -= dl; s1[r] -= dl; o0[r] *= alpha; o1[r] *= alpha; } }
            float ls = 0.f;
#pragma unroll
            for (int r = 0; r < 16; ++r) { s0[r] = __builtin_amdgcn_exp2f(s0[r]); s1[r] = __builtin_amdgcn_exp2f(s1[r]); ls += s0[r] + s1[r]; }
            ls += lane_xor(ls, F.lane, 32); l += ls;
#pragma unroll
            for (int ks = 0; ks < 4; ++ks) { const f32x16& sx = (ks >> 1) ? s1 : s0; const int rbs = 8 * (ks & 1);
                half8 pf;
#pragma unroll
                for (int j = 0; j < 8; ++j) pf[j] = (_Float16)sx[rbs + j];
                const LAS unsigned char* v0p = Vb + r32 * TP + (16 * ks + 4 * hh) * 2; const LAS unsigned char* v1p = v0p + 32 * TP;
                const half4 a0 = *(const LAS half4*)v0p, a1 = *(const LAS half4*)(v0p + 16), c0 = *(const LAS half4*)v1p, c1 = *(const LAS half4*)(v1p + 16);
                const half8 af0 = {a0[0], a0[1], a0[2], a0[3], a1[0], a1[1], a1[2], a1[3]}, af1 = {c0[0], c0[1], c0[2], c0[3], c1[0], c1[1], c1[2], c1[3]};
                o0 = mfma32(af0, pf, o0); o1 = mfma32(af1, pf, o1); }
            if (t + 1 < nt) ATT_STORE((t + 1) & 1);
            __syncthreads();
        }
#undef ATT_TILE_ROW0
#undef ATT_LOAD
#undef ATT_STORE
        const float il = 1.f / l; LAS unsigned char* stg = F.lds + 40960 + F.wave * 4608;
#pragma unroll
        for (int q4 = 0; q4 < 4; ++q4) { typedef unsigned v2u __attribute__((ext_vector_type(2))); v2u w0, w1;
            w0.x = pk2(o0[4 * q4] * il, o0[4 * q4 + 1] * il); w0.y = pk2(o0[4 * q4 + 2] * il, o0[4 * q4 + 3] * il);
            w1.x = pk2(o1[4 * q4] * il, o1[4 * q4 + 1] * il); w1.y = pk2(o1[4 * q4 + 2] * il, o1[4 * q4 + 3] * il);
            *(LAS v2u*)(stg + r32 * TP + (8 * q4 + 4 * hh) * 2) = w0; *(LAS v2u*)(stg + r32 * TP + (32 + 8 * q4 + 4 * hh) * 2) = w1; }
        asm volatile("s_waitcnt lgkmcnt(0)" ::: "memory");
        { bf16* yb = Y + (qrow - r32) * D + 256 + head * 64;
#pragma unroll
          for (int i = 0; i < 4; ++i) { const int row = i * 8 + (F.lane >> 3), ch = F.lane & 7; *(v4u*)(yb + (size_t)row * D + ch * 8) = *(const LAS v4u*)(stg + row * TP + ch * 16); } }
    }
}


constexpr int FP = 272;
__device__ __forceinline__ void ph_fft_consts(Frame& F) {
    bf16* M1 = (bf16*)(F.ws + WS_FM1); bf16* M3 = (bf16*)(F.ws + WS_FM3); float2* TW = (float2*)(F.ws + WS_TW); float2* CT = (float2*)(F.ws + WS_CT);
    for (int i = F.bid * NTHREADS + F.tid; i < 16384 + 8192 + 4096 + 256; i += F.G * NTHREADS) {
        float s, c;
        if (i < 16384) { const int row = i >> 7, col = i & 127, pr = row >> 6, k1 = row & 63, pc = col >> 6, n1 = col & 63; sincospif((float)((k1 * n1) & 63) * (1.f / 32.f), &s, &c);
            M1[i] = (bf16)f2bf(pr == pc ? c : (pr == 0 ? s : -s)); }
        else if (i < 16384 + 8192) { const int j = i - 16384, k2 = j >> 7, col = j & 127, pc = col >> 6, n2 = col & 63; sincospif((float)((k2 * n2) & 63) * (1.f / 32.f), &s, &c); M3[j] = (bf16)f2bf(pc == 0 ? c : s); }
        else if (i < 16384 + 8192 + 4096) { const int j = i - 16384 - 8192; sincospif((float)j * (1.f / 2048.f), &s, &c); TW[j] = make_float2(c, s); }
        else { const int j = i - 16384 - 8192 - 4096; sincospif((float)j * (1.f / 128.f), &s, &c); CT[j] = make_float2(c, s); }
    }
    bf16* DMC = (bf16*)(F.ws + WS_DMC);
    for (int i = F.bid * NTHREADS + F.tid; i < 256 * 512; i += F.G * NTHREADS) { const int k = i >> 9, pn = i & 511, n = pn & 255; float s, c; sincospif((float)((k * n) & 255) * (1.f / 128.f), &s, &c); DMC[i] = (bf16)f2bf(4.f * (pn < 256 ? c : s)); }
}
__device__ __forceinline__ void ph_fold(Frame& F, const Params& P, int l, int bid0, int nb) {
    const float* w_in = P.in[9]; const float* wfo = P.in[11]; bf16* Win_t = (bf16*)(F.ws + WS_WIN);
    float* Wx = (float*)F.ldsg; float* ct = Wx + 4096; float* st = ct + 64;
    if (F.bid < bid0 || F.bid >= bid0 + nb) return;
    for (int it = F.bid - bid0; it < 128; it += nb) {
        const int g = (it >> 5) & 3, part = (it >> 4) & 1, kb = it & 15;
        __syncthreads();
        if (F.tid < 64) { float s, c; sincospif((float)F.tid * (1.f / 32.f), &s, &c); ct[F.tid] = c; st[F.tid] = s; }
        __syncthreads();
        const float* wf = wfo + ((size_t)l * 4 + g) * 4096;
        { const int e = F.tid & 63, c0 = F.tid >> 6; float wfc[64];
#pragma unroll
          for (int m = 0; m < 64; ++m) wfc[m] = wf[m * 64 + e];
          const float* tb = part == 0 ? ct : st; const float sg = part == 0 ? (1.f / 512.f) : (-1.f / 512.f);
#pragma unroll 1
          for (int i = 0; i < 8; ++i) { const int c = c0 + 8 * i; float a = 0.f;
#pragma unroll
              for (int m = 0; m < 64; ++m) a += tb[(m * c) & 63] * wfc[m];
              Wx[c * 64 + e] = a * sg; } }
        __syncthreads();
        const int k = kb * 64 + (F.tid >> 3), e0 = (F.tid & 7) * 8; const float* wr = w_in + ((size_t)l * D + k) * DIN + g * 64;
        float acc[8];
#pragma unroll
        for (int j = 0; j < 8; ++j) acc[j] = 0.f;
        float4 av[16];
#pragma unroll
        for (int c4 = 0; c4 < 16; ++c4) av[c4] = ((const float4*)wr)[c4];
#pragma unroll
        for (int c4 = 0; c4 < 16; ++c4) { const float aa[4] = {av[c4].x, av[c4].y, av[c4].z, av[c4].w};
#pragma unroll
            for (int ci = 0; ci < 4; ++ci) { const float* wx = Wx + (4 * c4 + ci) * 64 + e0; const float4 w0 = *(const float4*)wx, w1 = *(const float4*)(wx + 4);
                acc[0] += aa[ci] * w0.x; acc[1] += aa[ci] * w0.y; acc[2] += aa[ci] * w0.z; acc[3] += aa[ci] * w0.w; acc[4] += aa[ci] * w1.x; acc[5] += aa[ci] * w1.y; acc[6] += aa[ci] * w1.z; acc[7] += aa[ci] * w1.w; } }
#pragma unroll
        for (int j = 0; j < 8; ++j) Win_t[((size_t)l * DU + part * 256 + g * 64 + e0 + j) * D + k] = (bf16)f2bf(acc[j]);
    }
    __syncthreads();
}
__device__ __forceinline__ void ph_fft(Frame& F) {
    TP_DECL;
    const bf16* U = (const bf16*)(F.ws + WS_R); bf16* Y = (bf16*)F.out; const float2* TW = (const float2*)(F.ws + WS_TW);
    LAS unsigned char* BUF = F.lds; LAS unsigned char* M1s = F.lds + 69632; LAS unsigned char* M3s = F.lds + 69632 + 34816;
    const int r32 = F.lane & 31, hh = F.lane >> 5, w = F.wave;
    __syncthreads();
    TP_ON(3131);
    if (F.bid < 256) {
        const v4u* m1 = (const v4u*)(F.ws + WS_FM1); const v4u* m3 = (const v4u*)(F.ws + WS_FM3);
        for (int i = F.tid; i < 128 * 16; i += NTHREADS) *(LAS v4u*)(M1s + (i >> 4) * FP + (i & 15) * 16) = m1[i];
        for (int i = F.tid; i < 64 * 16; i += NTHREADS) *(LAS v4u*)(M3s + (i >> 4) * FP + (i & 15) * 16) = m3[i];
    }
    for (int itb = F.bid; itb < 256; itb += F.G) {
        const int it = (((itb & 7) * 4 + (itb >> 6)) << 3) | ((itb >> 3) & 7);
        const int b = it >> 6, cg = it & 63;
        __syncthreads();
        for (int q = w; q < 128; q += NWAVES) { const int n2 = q >> 1, part = q & 1, n1 = F.lane;
            const half4 x = *(const half4*)(U + (size_t)(b * SEQ + 64 * n1 + n2) * DU + part * 256 + cg * 4);
#pragma unroll
            for (int i = 0; i < 4; ++i) *(LAS _Float16*)(BUF + (n2 * 4 + i) * FP + (part * 64 + n1) * 2) = x[i]; }
        __syncthreads();
        TP_OFF(3131); TP_ON(3132);
        f32x16 acc[4] = {};
#pragma unroll
        for (int s = 0; s < 8; ++s) { const half8 bf = __builtin_bit_cast(half8, *(const LAS v4u*)(BUF + (32 * w + r32) * FP + (16 * s + 8 * hh) * 2));
#pragma unroll
            for (int tm = 0; tm < 4; ++tm) acc[tm] = mfma32(__builtin_bit_cast(half8, *(const LAS v4u*)(M1s + (32 * tm + r32) * FP + (16 * s + 8 * hh) * 2)), bf, acc[tm]); }
        int nidx = 32 * w + r32; asm volatile("" : "+v"(nidx));
        const int n2 = nidx >> 2, col = nidx & 3;
        __syncthreads();
#pragma unroll
        for (int tm = 0; tm < 2; ++tm)
#pragma unroll
            for (int r = 0; r < 16; ++r) { const int k1 = 32 * tm + (r & 3) + 8 * (r >> 2) + 4 * hh; const float ang = (float)((k1 * n2) & 4095) * (1.f / 4096.f); float2 t; t.x = __builtin_amdgcn_cosf(ang); t.y = __builtin_amdgcn_sinf(ang);
                const float re = acc[tm][r], im = acc[tm + 2][r];
                *(LAS _Float16*)(BUF + (k1 * 4 + col) * FP + n2 * 2) = (_Float16)(re * t.x + im * t.y);
                *(LAS _Float16*)(BUF + (k1 * 4 + col) * FP + (64 + n2) * 2) = (_Float16)(im * t.x - re * t.y); }
        __syncthreads();
        TP_OFF(3132); TP_ON(3133);
        f32x16 y0 = {}, y1 = {};
#pragma unroll
        for (int s = 0; s < 8; ++s) { const half8 bf = __builtin_bit_cast(half8, *(const LAS v4u*)(BUF + (32 * w + r32) * FP + (16 * s + 8 * hh) * 2));
            y0 = mfma32(__builtin_bit_cast(half8, *(const LAS v4u*)(M3s + r32 * FP + (16 * s + 8 * hh) * 2)), bf, y0);
            y1 = mfma32(__builtin_bit_cast(half8, *(const LAS v4u*)(M3s + (32 + r32) * FP + (16 * s + 8 * hh) * 2)), bf, y1); }
        const int k1o = nidx >> 2; bf16* yb = Y + (size_t)(b * SEQ) * D + cg * 4 + col;
#pragma unroll
        for (int rep = 0; rep < (PROBE_ID == 316 ? 3 : 1); ++rep) {
#pragma unroll
        for (int r = 0; r < 16; ++r) { const int k2 = (r & 3) + 8 * (r >> 2) + 4 * hh;
            yb[(size_t)(k1o + 64 * k2) * D] = (bf16)f2bf(y0[r]); yb[(size_t)(k1o + 64 * (k2 + 32)) * D] = (bf16)f2bf(y1[r]); }
        asm volatile("s_waitcnt vmcnt(0)" ::: "memory"); }
        TP_OFF(3133);
    }
    __syncthreads();
}
__device__ __forceinline__ void ph_ctx_dft(Frame& F) {
    const bf16* U = (const bf16*)(F.ws + WS_R); bf16* Y = (bf16*)F.out; const bf16* Dm = (const bf16*)(F.ws + WS_DMC);
    constexpr int GP = 1040;
    LAS unsigned char* Gt = F.lds; const int r32 = F.lane & 31, hh = F.lane >> 5;
    for (int it = (F.bid + 160) & 255; it < NB * 8; it += 256) {
        const int b = it >> 3, cg = it & 7;
        __syncthreads();
        for (int q = F.tid; q < 2 * CTX * 4; q += NTHREADS) { const int part = q >> 10, n = (q >> 2) & 255, c8 = q & 3;
            const half8 x = __builtin_bit_cast(half8, *(const v4u*)(U + (size_t)(TL + b * CTX + n) * DU + part * 256 + cg * 32 + c8 * 8));
#pragma unroll
            for (int i = 0; i < 8; ++i) *(LAS _Float16*)(Gt + (c8 * 8 + i) * GP + (part * 256 + n) * 2) = x[i]; }
        __syncthreads();
        f32x16 acc = {}; const bf16* dr = Dm + (size_t)(32 * F.wave + r32) * 512 + 8 * hh; const LAS unsigned char* gr = Gt + r32 * GP + 16 * hh;
#pragma unroll 8
        for (int s = 0; s < 32; ++s) acc = mfma32(__builtin_bit_cast(half8, *(const v4u*)(dr + 16 * s)), __builtin_bit_cast(half8, *(const LAS v4u*)(gr + 32 * s)), acc);
        bf16* yb = Y + (size_t)(TL + b * CTX) * D + cg * 32 + r32;
#pragma unroll
        for (int r = 0; r < 16; ++r) yb[(size_t)(32 * F.wave + (r & 3) + 8 * (r >> 2) + 4 * hh) * D] = (bf16)f2bf(acc[r]);
    }
    __syncthreads();
}

__device__ __forceinline__ void ph_ctx_resid_gemm(Frame& F, const bf16* A  , const bf16* Bt  , int K, const float* xsrc, const float* ng, int gate_off, int nscale_off, float coef) {
    bf16* x16 = (bf16*)(F.ws + WS_X16) + (size_t)TL * D; const float* gate = (const float*)(F.ws + WS_MOD) + gate_off + (size_t)NB * MODW; const float* nscale = (const float*)(F.ws + WS_MOD) + nscale_off + (size_t)NB * MODW;
    bf16* hraw = (bf16*)(F.ws + WS_HB) + (size_t)TL * D; float* rowss = (float*)(F.ws + WS_RS) + (size_t)TL * 16;
    const int r16 = F.lane & 15, fq = F.lane >> 4; const int kc = K >> 3;
    LAS float* red = (LAS float*)F.lds;
    for (int pc = F.bid; pc < 256; pc += F.G) {
        const int xq = pc & 7, jq = pc >> 3; const int rt = (xq >> 1) * 4 + (jq >> 3), ct = (xq & 1) * 8 + (jq & 7);
        const bf16* ap = A + (size_t)(TL + rt * 64 + r16) * K + F.wave * kc + 8 * fq;
        const bf16* bp = Bt + (size_t)(ct * 64 + r16) * K + F.wave * kc + 8 * fq;
        pg8::f32x4 acc[4][4];
#pragma unroll
        for (int ci = 0; ci < 4; ++ci)
#pragma unroll
            for (int tj = 0; tj < 4; ++tj) acc[ci][tj] = (pg8::f32x4){0.f, 0.f, 0.f, 0.f};
        constexpr int PB = 4; const int nst = kc / 32;
        v4u lb[PB][4], la[PB][4];
#pragma unroll
        for (int i = 0; i < PB; ++i) { const int s = i < nst ? i : 0;
#pragma unroll
            for (int q = 0; q < 4; ++q) { lb[i][q] = *(const v4u*)(bp + (size_t)(16 * q) * K + 32 * s); la[i][q] = *(const v4u*)(ap + (size_t)(16 * q) * K + 32 * s); } }
        for (int s0 = 0; s0 < nst; s0 += PB) {
#pragma unroll
            for (int i = 0; i < PB; ++i) {
                half8 bfr[4], afr[4];
#pragma unroll
                for (int q = 0; q < 4; ++q) { bfr[q] = __builtin_bit_cast(half8, lb[i][q]); afr[q] = __builtin_bit_cast(half8, la[i][q]); }
                const int sn = s0 + PB + i; const int sl = sn < nst ? sn : nst - 1;
#pragma unroll
                for (int q = 0; q < 4; ++q) { lb[i][q] = *(const v4u*)(bp + (size_t)(16 * q) * K + 32 * sl); la[i][q] = *(const v4u*)(ap + (size_t)(16 * q) * K + 32 * sl); }
                if (s0 + i < nst) {
#pragma unroll
                    for (int ci = 0; ci < 4; ++ci)
#pragma unroll
                        for (int tj = 0; tj < 4; ++tj) acc[ci][tj] = __builtin_amdgcn_mfma_f32_16x16x32_f16(bfr[ci], afr[tj], acc[ci][tj], 0, 0, 0); } } }
        __syncthreads();
#pragma unroll
        for (int ci = 0; ci < 4; ++ci)
#pragma unroll
            for (int tj = 0; tj < 4; ++tj) { const int row = 16 * tj + r16, chunk = 4 * ci + fq; f32x4v v = {acc[ci][tj][0], acc[ci][tj][1], acc[ci][tj][2], acc[ci][tj][3]};
                *(LAS f32x4v*)(red + ((F.wave * 64 + row) * 16 + (chunk ^ (row & 15))) * 4) = v; }
        __syncthreads();
        { const int row = F.tid >> 3, cg8 = F.tid & 7; f32x4v s0 = {0.f, 0.f, 0.f, 0.f}, s1 = s0;
#pragma unroll
          for (int w8 = 0; w8 < 8; ++w8) { s0 += *(const LAS f32x4v*)(red + ((w8 * 64 + row) * 16 + ((2 * cg8) ^ (row & 15))) * 4); s1 += *(const LAS f32x4v*)(red + ((w8 * 64 + row) * 16 + ((2 * cg8 + 1) ^ (row & 15))) * 4); }
          const int grow = rt * 64 + row, c = ct * 64 + cg8 * 8; float ssq = 0.f;
          { const size_t off = (size_t)grow * D + c; f32x4v xo0, xo1;
            if (xsrc) { xo0 = *(const f32x4v*)(xsrc + off); xo1 = *(const f32x4v*)(xsrc + off + 4); }
            else { const half8 hx = __builtin_bit_cast(half8, *(const v4u*)(x16 + off)); xo0 = (f32x4v){(float)hx[0], (float)hx[1], (float)hx[2], (float)hx[3]}; xo1 = (f32x4v){(float)hx[4], (float)hx[5], (float)hx[6], (float)hx[7]}; }
            const f32x4v x0 = xo0 + *(const f32x4v*)(gate + c) * coef * s0, x1 = xo1 + *(const f32x4v*)(gate + c + 4) * coef * s1;
            { v4u w; w.x = pk2(x0[0], x0[1]); w.y = pk2(x0[2], x0[3]); w.z = pk2(x1[0], x1[1]); w.w = pk2(x1[2], x1[3]); *(v4u*)(x16 + off) = w; }
            ssq += ((x0[0] * x0[0] + x0[1] * x0[1]) + (x0[2] * x0[2] + x0[3] * x0[3])) + ((x1[0] * x1[0] + x1[1] * x1[1]) + (x1[2] * x1[2] + x1[3] * x1[3]));
            if (ng) { const f32x4v h0 = x0 * (*(const f32x4v*)(ng + c) * (*(const f32x4v*)(nscale + c) + 1.f)), h1 = x1 * (*(const f32x4v*)(ng + c + 4) * (*(const f32x4v*)(nscale + c + 4) + 1.f));
                v4u w; w.x = pk2(h0[0], h0[1]); w.y = pk2(h0[2], h0[3]); w.z = pk2(h1[0], h1[1]); w.w = pk2(h1[2], h1[3]); *(v4u*)(hraw + off) = w; } }
          ssq += lane_xor(ssq, F.lane, 1); ssq += lane_xor(ssq, F.lane, 2); ssq += lane_xor(ssq, F.lane, 4);
          if (cg8 == 0) rowss[(size_t)grow * 16 + ct] = ssq; }
    }
    __syncthreads();
}

template <class Epi> __device__ __forceinline__ void run_gemm(Frame& F, const bf16* A, const bf16* Bt, int M, int N, int K, const Epi& E) {
    pg8::Gemm g{A, Bt, M, N, K}; pg8::StaticOrder S; S.init(M, N, F.G, F.bid);
    pg8::gemm_phase<Epi, pg8::StaticOrder, true, true>(F.lds, g, S, E, F.tid);
}
template <class Epi> __device__ __forceinline__ void run_gemm_normed(Frame& F, const bf16* A, const bf16* Bt, int M, int N, int K, const Epi& E, const float* sw) {
    pg8::Gemm g{A, Bt, M, N, K}; RstdOrder S; S.init(M, N, F.G, F.bid); S.rowss = (const float*)(F.ws + WS_RS); S.tab = (LAS float*)(F.lds + RSTD_TAB_OFF); S.tid = F.tid; S.cnt = 0; S.sw = sw; S.ncols = N;
    pg8::gemm_phase<Epi, RstdOrder, true, true>(F.lds, g, S, E, F.tid);
}
__device__ __forceinline__ Frame make_frame(const Params& P, unsigned char* lds_raw) {
    Frame F; int t = threadIdx.x; asm volatile("" : "+v"(t));
    F.lds = (LAS unsigned char*)lds_raw; F.ldsg = lds_raw;
    F.tid = t; F.lane = t & 63; F.wave = __builtin_amdgcn_readfirstlane(t >> 6);
    int g = gridDim.x, b = blockIdx.x; asm volatile("" : "+s"(g), "+s"(b));
    F.G = g; F.bid = b; F.gw = b * NWAVES + F.wave; F.NGW = g * NWAVES;
    GAS unsigned char* ws = (GAS unsigned char*)P.ws; GAS float* out = (GAS float*)P.out; asm volatile("" : "+s"(ws), "+s"(out));
    F.out = (float*)out; F.ws = (unsigned char*)ws;
    return F;
}
__device__ __forceinline__ void grid_bar(const Params& P, unsigned char* lds_raw) {
    GAS unsigned char* wsg = (GAS unsigned char*)P.ws; asm volatile("" : "+s"(wsg)); unsigned char* ws = (unsigned char*)wsg;
    XcdBarrier b; b.bar = (unsigned*)(ws + WS_CTL) + CW_BAR; b.x = xb_xcc_id(); b.st = (volatile LAS unsigned*)((LAS unsigned char*)lds_raw + MISC_OFF) + 8;
    xcd_barrier(b);
}
__global__ void __launch_bounds__(NTHREADS, 2) mega_fwd(Params P) {
    extern __shared__ __attribute__((aligned(16))) unsigned char lds_raw[];
    { const int tid = threadIdx.x;
      for (int u = tid; u < (LDS_BYTES - MISC_OFF) / 4; u += NTHREADS) ((LAS unsigned*)((LAS unsigned char*)lds_raw + MISC_OFF))[u] = 0u;
      __syncthreads();
      (void)xcd_barrier_post((unsigned*)(P.ws + WS_CTL) + CW_BAR, (volatile LAS unsigned*)((LAS unsigned char*)lds_raw + MISC_OFF) + 8); }
#define GRID_BAR() grid_bar(P, lds_raw)
    unsigned long long tacc = 0, t0 = 0; (void)tacc; (void)t0;
#define T_ON(id) do { if (PROBE_ID == (id)) t0 = __builtin_amdgcn_s_memrealtime(); } while (0)
#define T_OFF(id) do { if (PROBE_ID == (id)) { const unsigned long long t1 = __builtin_amdgcn_s_memrealtime(); tacc += t1 - t0; \
        if (blockIdx.x == PROBE_WG) { const unsigned long long tgt = t1 + 4ull * (t1 - t0); while (__builtin_amdgcn_s_memrealtime() < tgt) __builtin_amdgcn_s_sleep(8); } } } while (0)
#define FRAME() Frame F = make_frame(P, lds_raw); Ptrs p{F.out, (float*)(F.ws + WS_XC)}; (void)p

    T_ON(1); T_ON(11); T_ON(9);
    T_ON(111);
    { FRAME(); ph_mod(F, P); }
    T_OFF(111); T_ON(112);
    { FRAME(); constexpr int NCV = 9856, NMODWG = DEPTH * (MODW / 128);
      constexpr int NA1 = 1792;
      if (F.G == 256) { if (F.bid < 256 - NMODWG) { const int rk = F.bid * NWAVES + F.wave, nw = (256 - NMODWG) * NWAVES; ph_convert(F, P, 0, 0, NCV, rk, nw); ph_convert(F, P, 1, 0, NA1, rk, nw); }
                        else { const int rk = (F.bid - (256 - NMODWG)) * NWAVES + F.wave, nw = NMODWG * NWAVES; ph_convert(F, P, 1, NA1, NCV, rk, nw); } }
      else { ph_convert(F, P, 0, 0, NCV, F.gw, F.NGW); ph_convert(F, P, 1, 0, NCV, F.gw, F.NGW); } }
    T_OFF(112); T_ON(113);
    { FRAME(); ph_fold(F, P, 0, 0, 128); ph_fold(F, P, 1, 128, 128); }
    T_OFF(113); T_ON(114);
    { FRAME(); ph_fft_consts(F); ph_rope_table(F, P); }
    T_OFF(114);
    GRID_BAR(); T_OFF(11); T_ON(12);
    T_ON(121);
    { FRAME(); ph_first(F, P); }
    T_OFF(121); T_ON(122);
    { FRAME(); ph_bias(F, P, 0); ph_bias(F, P, 1); }
    T_OFF(122);
    GRID_BAR(); T_OFF(1); T_OFF(12);
#pragma unroll 1
    for (int l = 0; l < DEPTH; ++l) {
#pragma unroll 1
        for (int half = 0; half < 2; ++half) {
            const int sub = half * 2, f = half;
            if (half == 1) {
                T_ON(2); T_ON(23);
                { FRAME(); EpiUProj E{F.ws, l, (LAS float*)(F.lds + RSTD_TAB_OFF), 0};
                  run_gemm_normed(F, (const bf16*)(F.ws + WS_HB), (const bf16*)(F.ws + WS_WIN) + (size_t)l * DU * D, T, DU, D, E, (const float*)(F.ws + WS_SWIN) + (size_t)l * NR * DU); }
                { FRAME(); ph_gates(F, l); }
                GRID_BAR(); T_OFF(2); T_OFF(23); T_ON(3); T_ON(31);
                T_ON(311);
                { FRAME(); ph_mlstm_m1(F, P.in[13] + (size_t)l * 3 * 512, P.in[14] + l * 8, P.in[15] + l * 8); }
                T_OFF(311); T_ON(312);
                { FRAME(); ph_attn(F, P.in[12] + l * 8, l + 1 < DEPTH); }
                T_OFF(312); T_ON(313); T_ON(316);
                { FRAME(); ph_fft(F); }
                T_OFF(313); T_OFF(316);
                if (PROBE_ID == 315) { T_ON(315); { FRAME(); ph_fft(F); } T_OFF(315); }
                T_ON(314);
                { FRAME(); if (l + 1 < DEPTH) ph_ctx_dft(F); }
                T_OFF(314);
                GRID_BAR(); T_OFF(31); T_ON(33);
                { FRAME(); ph_mlstm_m3(F, P.in[13] + (size_t)l * 3 * 512, P.in[14] + l * 8, P.in[15] + l * 8, l + 1 < DEPTH); }
                GRID_BAR(); T_OFF(3); T_OFF(33); T_ON(2); T_ON(24);
                { FRAME(); const bool ctx_piece = l + 1 < DEPTH, piece_first = (F.bid & 1) == 0;
                  if (ctx_piece && piece_first) ph_ctx_resid_gemm(F, (const bf16*)F.out, (const bf16*)(F.ws + WS_WOUT) + (size_t)l * D * D, D, nullptr, P.in[6] + ((size_t)l * 3 + 2) * D, l * NR * MODW + 5 * D, l * NR * MODW + 7 * D, 1.0f);
                  { EpiResid E{F.ws, nullptr, P.in[6] + ((size_t)l * 3 + 2) * D, l * NR * MODW + 5 * D, l * NR * MODW + 7 * D, 1.0f};
                    run_gemm(F, (const bf16*)F.out, (const bf16*)(F.ws + WS_WOUT) + (size_t)l * D * D, TL, D, D, E); }
                  if (ctx_piece && !piece_first) ph_ctx_resid_gemm(F, (const bf16*)F.out, (const bf16*)(F.ws + WS_WOUT) + (size_t)l * D * D, D, nullptr, P.in[6] + ((size_t)l * 3 + 2) * D, l * NR * MODW + 5 * D, l * NR * MODW + 7 * D, 1.0f); }
                GRID_BAR(); T_OFF(2); T_OFF(24);
            }
            T_ON(2); T_ON(21);
            { FRAME(); EpiSwiglu E{F.ws, l * 2 + f, (LAS float*)(F.lds + RSTD_TAB_OFF), 0};
              run_gemm_normed(F, (const bf16*)(F.ws + WS_HB), (const bf16*)(F.ws + WS_WI) + (size_t)(l * 2 + f) * 2 * DFF * D, T, 2 * DFF, D, E, (const float*)(F.ws + WS_SWFI) + (size_t)(l * 2 + f) * NR * 2 * DFF); }
            GRID_BAR(); T_OFF(21); T_ON(22);
            { FRAME();
              const bool has_next = (half == 0) || (l + 1 < DEPTH);
              const float* ngp = half == 0 ? P.in[6] + ((size_t)l * 3 + 1) * D : P.in[6] + ((size_t)(l + 1) * 3 + 0) * D;
              const int nsc = half == 0 ? l * NR * MODW + 4 * D : (l + 1) * NR * MODW + 1 * D;
              const bool first = (l == 0 && half == 0);
              const bool ctx_piece = (half == 0 || l + 1 < DEPTH); const bool piece_first = (F.bid & 1) == 0;
              if (ctx_piece && piece_first) ph_ctx_resid_gemm(F, (const bf16*)(F.ws + WS_R), (const bf16*)(F.ws + WS_WO) + (size_t)(l * 2 + f) * D * DFF, DFF, first ? P.in[2] : nullptr, has_next ? ngp : nullptr, l * NR * MODW + (3 * sub + 2) * D, nsc, 0.5f);
              { EpiResid E{F.ws, first ? P.in[0] : nullptr, has_next ? ngp : nullptr, l * NR * MODW + (3 * sub + 2) * D, nsc, 0.5f};
                run_gemm(F, (const bf16*)(F.ws + WS_R), (const bf16*)(F.ws + WS_WO) + (size_t)(l * 2 + f) * D * DFF, TL, D, DFF, E); }
              if (ctx_piece && !piece_first) ph_ctx_resid_gemm(F, (const bf16*)(F.ws + WS_R), (const bf16*)(F.ws + WS_WO) + (size_t)(l * 2 + f) * D * DFF, DFF, first ? P.in[2] : nullptr, has_next ? ngp : nullptr, l * NR * MODW + (3 * sub + 2) * D, nsc, 0.5f); }
            GRID_BAR(); T_OFF(2); T_OFF(22);
        }
    }
    if (PROBE_ID == 77) { GRID_BAR(); GRID_BAR(); GRID_BAR(); GRID_BAR(); GRID_BAR(); GRID_BAR(); GRID_BAR(); GRID_BAR(); }
    T_ON(4);
    { FRAME(); ph_final(F, P); }
    if (PROBE_ID == 4 || PROBE_ID == 9) { GRID_BAR(); T_OFF(4); T_OFF(9); GRID_BAR(); }
}
}

extern "C" void kernel_launch(void* const* d_in, const int* in_sizes, int n_in, void* d_out, int out_size, void* d_ws, size_t ws_size, hipStream_t stream) {
    static int grid = 0;
    if (grid == 0) {
        if (n_in != 17 || ws_size < WS_END) { fprintf(stderr, "kernel_launch: need 17 inputs and %zu bytes of workspace; got %d inputs, %zu bytes\n", (size_t)WS_END, n_in, ws_size); grid = -1; return; }
        int dev = 0, cus = 0, per_cu = 0;
        if (hipGetDevice(&dev) != hipSuccess || hipDeviceGetAttribute(&cus, hipDeviceAttributeMultiprocessorCount, dev) != hipSuccess) { grid = -1; return; }
        if (hipFuncSetAttribute((const void*)mega_fwd, hipFuncAttributeMaxDynamicSharedMemorySize, LDS_BYTES) != hipSuccess) { fprintf(stderr, "kernel_launch: hipFuncSetAttribute failed\n"); grid = -1; return; }
        if (hipOccupancyMaxActiveBlocksPerMultiprocessor(&per_cu, (const void*)mega_fwd, NTHREADS, LDS_BYTES) != hipSuccess || per_cu < 1) { fprintf(stderr, "kernel_launch: occupancy query says %d workgroups per CU\n", per_cu); (void)hipGetLastError(); grid = -1; return; }
        if (cus != 256) { fprintf(stderr, "kernel_launch: this kernel is laid out for a 256-CU device (got %d); nothing launched\n", cus); grid = -1; return; }
        grid = cus;
    }
    if (grid < 0) return;
    (void)hipMemsetAsync((char*)d_ws + WS_CTL, 0, CTL_ZERO_BYTES, stream);
    Params P{};
    for (int i = 0; i < 17; ++i) P.in[i] = (const float*)d_in[i];
    P.out = (float*)d_out; P.ws = (unsigned char*)d_ws;
    hipLaunchKernelGGL(mega_fwd, dim3(grid), dim3(NTHREADS), LDS_BYTES, stream, P);
}
```
